# Optimizing an MI355X kernel written in HIP

```python
import jax, jax.numpy as jnp
from jax import lax
import numpy as np

D_MODEL = 1024
BATCH = 1
SEQ = 16384
DEPTH = 2

GRID_W = 64
HEAD_DIM = 64
A_Q_HEADS = 8
A_KV_HEADS = 2
A_GROUP = A_Q_HEADS // A_KV_HEADS
B_HEADS = 4
B_V_DIM = 2 * HEAD_DIM
A_WIDTH = A_Q_HEADS * HEAD_DIM
B_WIDTH = B_HEADS * B_V_DIM
A_Q_COLS = A_Q_HEADS * HEAD_DIM
A_KV_COLS = A_KV_HEADS * HEAD_DIM
B_QK_COLS = 2 * B_HEADS * HEAD_DIM
B_V_COLS = B_HEADS * B_V_DIM
IN_COLS = A_Q_COLS + 2 * A_KV_COLS + 2 * B_QK_COLS + B_V_COLS
N_BRANCH = 2
D_FF = 2816
Q_BLOCK = 128
ROPE_THETA = 10000.0
ROPE_AXIS_DIM = HEAD_DIM // 2
N_ADA = 9
EPS = 1e-6

kernel_name = 'hybrid_gqa_axialrope_diffattn_macaron_adaln'


def rms_norm(x, g):
    xf = x.astype(jnp.float32)
    y = xf * lax.rsqrt(jnp.mean(xf * xf, axis=-1, keepdims=True) + EPS)
    return (y * g.astype(jnp.float32)).astype(x.dtype)


def modulate(x, shift, scale):
    return x * (1 + scale[:, None, :]) + shift[:, None, :]


def swiglu(x, w_gate, w_up, w_down):
    return (jax.nn.silu(x @ w_gate) * (x @ w_up)) @ w_down


def axial_angles(seq):
    rows = seq // GRID_W
    row = jnp.broadcast_to(jnp.arange(rows)[:, None], (rows, GRID_W)).reshape(seq) - rows // 2
    col = jnp.broadcast_to(jnp.arange(GRID_W)[None, :], (rows, GRID_W)).reshape(seq) - GRID_W // 2
    inv = 1.0 / (ROPE_THETA ** (jnp.arange(0, ROPE_AXIS_DIM, 2, dtype=jnp.float32) / ROPE_AXIS_DIM))
    ang_r = row.astype(jnp.float32)[:, None] * inv
    ang_c = col.astype(jnp.float32)[:, None] * inv
    return ang_r, ang_c


def rotate_section(x, ang):
    cos = jnp.cos(ang)[:, None, :]
    sin = jnp.sin(ang)[:, None, :]
    x1, x2 = jnp.split(x, 2, axis=-1)
    return jnp.concatenate([x1 * cos - x2 * sin, x2 * cos + x1 * sin], axis=-1)


def axial_rope(x, ang_r, ang_c):
    xf = x.astype(jnp.float32)
    xr, xc = jnp.split(xf, 2, axis=-1)
    return jnp.concatenate([rotate_section(xr, ang_r), rotate_section(xc, ang_c)], axis=-1).astype(x.dtype)


def gqa_attention(q, k, v):
    b, s = q.shape[0], q.shape[1]
    nblk = s // Q_BLOCK
    qb = q.reshape(b, nblk, Q_BLOCK, A_KV_HEADS, A_GROUP, HEAD_DIM).transpose(1, 0, 2, 3, 4, 5)
    scale = HEAD_DIM ** -0.5

    def block(qi):
        sc = jnp.einsum('bqkgd,bskd->bkgqs', qi, k, preferred_element_type=jnp.float32) * scale
        p = jax.nn.softmax(sc, axis=-1).astype(v.dtype)
        return jnp.einsum('bkgqs,bskd->bqkgd', p, v)

    o = lax.map(block, qb)
    return o.transpose(1, 0, 2, 3, 4, 5).reshape(b, s, A_WIDTH)


def diff_attention(q, k, v, lam, slopes):
    b, s = q.shape[0], q.shape[1]
    nblk = s // Q_BLOCK
    qb = q.reshape(b, nblk, Q_BLOCK, 2, B_HEADS, HEAD_DIM).transpose(1, 0, 2, 3, 4, 5)
    scale = HEAD_DIM ** -0.5
    kpos = jnp.arange(s, dtype=jnp.float32)

    def block(args):
        qi, bi = args
        qpos = (bi * Q_BLOCK + jnp.arange(Q_BLOCK)).astype(jnp.float32)
        dist = jnp.abs(qpos[:, None] - kpos[None, :])
        bias = -slopes[:, None, None] * dist[None]
        sc = jnp.einsum('bqmhd,bsmhd->bmhqs', qi, k, preferred_element_type=jnp.float32) * scale
        p = jax.nn.softmax(sc + bias[None, None], axis=-1)
        w = (p[:, 0] - lam * p[:, 1]).astype(v.dtype)
        return jnp.einsum('bhqs,bshe->bqhe', w, v)

    o = lax.map(block, (qb, jnp.arange(nblk)))
    return o.transpose(1, 0, 2, 3, 4).reshape(b, s, B_HEADS, B_V_DIM)


def token_mixing(n, ang_r, ang_c, lam_init, w_in, qk_g, lam_p, subln_g, w_ba, w_bb, w_gate, b_gate, w_o):
    b, s, _ = n.shape
    proj = n @ w_in
    c1 = A_Q_COLS
    c2 = c1 + A_KV_COLS
    c3 = c2 + A_KV_COLS
    c4 = c3 + B_QK_COLS
    c5 = c4 + B_QK_COLS
    qa, ka, va, qd, kd, vd = jnp.split(proj, [c1, c2, c3, c4, c5], axis=-1)

    qa = axial_rope(rms_norm(qa.reshape(b, s, A_Q_HEADS, HEAD_DIM), qk_g[0]), ang_r, ang_c)
    ka = axial_rope(rms_norm(ka.reshape(b, s, A_KV_HEADS, HEAD_DIM), qk_g[1]), ang_r, ang_c)
    va = va.reshape(b, s, A_KV_HEADS, HEAD_DIM)
    qa = qa.reshape(b, s, A_KV_HEADS, A_GROUP, HEAD_DIM)
    ya = gqa_attention(qa, ka, va) @ w_ba

    lp = lam_p.astype(jnp.float32)
    lam = jnp.exp(jnp.sum(lp[0] * lp[1])) - jnp.exp(jnp.sum(lp[2] * lp[3])) + lam_init
    slopes = 2.0 ** (-8.0 * jnp.arange(1, B_HEADS + 1, dtype=jnp.float32) / B_HEADS)
    qd = qd.reshape(b, s, 2, B_HEADS, HEAD_DIM)
    kd = kd.reshape(b, s, 2, B_HEADS, HEAD_DIM)
    vd = vd.reshape(b, s, B_HEADS, B_V_DIM)
    od = diff_attention(qd, kd, vd, lam, slopes)
    od = rms_norm(od, subln_g) * (1.0 - lam_init)
    yb = od.reshape(b, s, B_WIDTH) @ w_bb

    g = jax.nn.sigmoid(n @ w_gate + b_gate)
    ga, gb = jnp.split(g, N_BRANCH, axis=-1)
    return (ga * ya + gb * yb) @ w_o


def setup_inputs(seed: int = 0) -> dict:
    key = jax.random.key(seed)
    ks = jax.random.split(key, 24)
    D, L, F = D_MODEL, DEPTH, D_FF

    def nrm(k, shape, scale):
        return jax.random.normal(k, shape, jnp.float32) * scale

    return {
        'x': nrm(ks[0], (BATCH, SEQ, D), 1.0),
        'c': nrm(ks[1], (BATCH, D), 1.0),
        'ada_w': nrm(ks[2], (L, D, N_ADA * D), 0.5 * D ** -0.5),
        'ada_b': nrm(ks[3], (L, N_ADA * D), 0.01),
        'norm_g': 1.0 + nrm(ks[4], (L, 3, D), 0.02),
        'ffn_wg': nrm(ks[5], (L, 2, D, F), D ** -0.5),
        'ffn_wu': nrm(ks[6], (L, 2, D, F), D ** -0.5),
        'ffn_wd': nrm(ks[7], (L, 2, F, D), F ** -0.5),
        'w_in': nrm(ks[8], (L, D, IN_COLS), D ** -0.5),
        'qk_g': 1.0 + nrm(ks[9], (L, 2, HEAD_DIM), 0.02),
        'lam_p': nrm(ks[10], (L, 4, HEAD_DIM), 0.1),
        'subln_g': 1.0 + nrm(ks[11], (L, B_V_DIM), 0.02),
        'w_ba': nrm(ks[12], (L, A_WIDTH, D), A_WIDTH ** -0.5),
        'w_bb': nrm(ks[13], (L, B_WIDTH, D), B_WIDTH ** -0.5),
        'w_gate': nrm(ks[14], (L, D, N_BRANCH * D), D ** -0.5),
        'b_gate': nrm(ks[15], (L, N_BRANCH * D), 0.01),
        'w_o': nrm(ks[16], (L, D, D), D ** -0.5),
        'final_g': 1.0 + nrm(ks[17], (D,), 0.02),
    }


def reference(x, c, ada_w, ada_b, norm_g, ffn_wg, ffn_wu, ffn_wd, w_in, qk_g, lam_p, subln_g, w_ba, w_bb, w_gate, b_gate, w_o, final_g):
    s = x.shape[1]
    ang_r, ang_c = axial_angles(s)
    c_act = jax.nn.silu(c)
    h = x
    for l in range(DEPTH):
        mod = c_act @ ada_w[l] + ada_b[l]
        sh1, sc1, g1, sh2, sc2, g2, sh3, sc3, g3 = jnp.split(mod, N_ADA, axis=-1)
        lam_init = 0.8 - 0.6 * float(np.exp(-0.3 * l))

        n1 = modulate(rms_norm(h, norm_g[l, 0]), sh1, sc1)
        h = h + 0.5 * g1[:, None, :] * swiglu(n1, ffn_wg[l, 0], ffn_wu[l, 0], ffn_wd[l, 0])

        n2 = modulate(rms_norm(h, norm_g[l, 1]), sh2, sc2)
        y = token_mixing(n2, ang_r, ang_c, lam_init, w_in[l], qk_g[l], lam_p[l], subln_g[l],
                         w_ba[l], w_bb[l], w_gate[l], b_gate[l], w_o[l])
        h = h + g2[:, None, :] * y

        n3 = modulate(rms_norm(h, norm_g[l, 2]), sh3, sc3)
        h = h + 0.5 * g3[:, None, :] * swiglu(n3, ffn_wg[l, 1], ffn_wu[l, 1], ffn_wd[l, 1])
    return rms_norm(h, final_g)
```

```cpp
#include <hip/hip_runtime.h>
#include <hip/hip_cooperative_groups.h>
#include <cstdio>
#include <cstdint>
namespace cg = cooperative_groups;

#ifndef MK_MULTI
#define MK_MULTI 0
#endif

#define DI __device__ __forceinline__
typedef unsigned short bf16_t;
typedef short bf16x8 __attribute__((ext_vector_type(8)));
typedef float f32x4 __attribute__((ext_vector_type(4)));
typedef float f32x16 __attribute__((ext_vector_type(16)));
typedef unsigned u32x4 __attribute__((ext_vector_type(4)));
typedef unsigned u32x2 __attribute__((ext_vector_type(2)));

constexpr int S = 16384, D = 1024, F = 2816, NGU = 5632, NIN = 4352;
constexpr int NPH = 24;
constexpr float QSCALE = 0.125f * 1.4426950408889634f;
constexpr float LOG2E = 1.4426950408889634f;

constexpr size_t OFF_MOD = 0;
constexpr size_t OFF_LAM = 80000;
constexpr size_t OFF_ROPE = 81920;
constexpr size_t OFF_WGU = 1u << 20;
constexpr size_t SZ_WGU = (size_t)NGU * D * 2;
constexpr size_t OFF_WD = OFF_WGU + 4 * SZ_WGU;
constexpr size_t SZ_WD = (size_t)D * F * 2;
constexpr size_t OFF_WIN = OFF_WD + 4 * SZ_WD;
constexpr size_t SZ_WIN = (size_t)NIN * D * 2;
constexpr size_t OFF_WBA = OFF_WIN + 2 * SZ_WIN;
constexpr size_t SZ_WB = (size_t)D * 512 * 2;
constexpr size_t OFF_WBB = OFF_WBA + 2 * SZ_WB;
constexpr size_t OFF_WO = OFF_WBB + 2 * SZ_WB;
constexpr size_t SZ_WO = (size_t)D * D * 2;
constexpr size_t OFF_N = OFF_WO + 2 * SZ_WO;
constexpr size_t OFF_MIX = OFF_N + (size_t)S * D * 2;
constexpr size_t OFF_Q = OFF_MIX;
constexpr size_t OFF_QD = OFF_Q + (size_t)S * 512 * 2;
constexpr size_t OFF_KA = OFF_QD + (size_t)S * 512 * 2;
constexpr size_t OFF_VTA = OFF_KA + (size_t)S * 128 * 2;
constexpr size_t OFF_KD = OFF_VTA + (size_t)S * 128 * 2;
constexpr size_t OFF_VTD = OFF_KD + (size_t)S * 512 * 2;
constexpr size_t OFF_G = OFF_VTD + (size_t)S * 512 * 2;
constexpr size_t OFF_ATTA = OFF_G + (size_t)S * 2048 * 2;
constexpr size_t OFF_OD = OFF_ATTA + (size_t)S * 512 * 2;
constexpr size_t OFF_ACT = OFF_MIX;
constexpr size_t WS_END = OFF_OD + (size_t)S * 512 * 2;
static_assert((size_t)S * F * 2 <= WS_END - OFF_MIX, "act overlay");

struct Params {
    const float *x, *c, *ada_w, *ada_b, *norm_g, *ffn_wg, *ffn_wu, *ffn_wd, *w_in, *qk_g, *lam_p, *subln_g, *w_ba, *w_bb, *w_gate, *b_gate, *w_o, *final_g;
    float* out; unsigned char* ws; int ph_lo, ph_hi;
};

typedef __bf16 bf16v2 __attribute__((ext_vector_type(2)));
typedef float f32x2 __attribute__((ext_vector_type(2)));
DI unsigned pk2(float lo, float hi) { f32x2 v = {lo, hi}; bf16v2 b = __builtin_convertvector(v, bf16v2); return __builtin_bit_cast(unsigned, b); }
DI float bf_lo(unsigned u) { return __uint_as_float(u << 16); }
DI float bf_hi(unsigned u) { return __uint_as_float(u & 0xffff0000u); }
DI int lds_off(int row, int chunk) { return row * 128 + ((chunk ^ ((row >> 1) & 7)) << 4); }
DI float fast_exp2(float x) { return __builtin_amdgcn_exp2f(x); }
DI float fast_rcp(float x) { return __builtin_amdgcn_rcpf(x); }
DI int otid() { int t = threadIdx.x; asm volatile("" : "+v"(t)); return t; }
#define SB() __builtin_amdgcn_sched_barrier(0)

DI int perm64(int n) { return (n & ~63) | (((n >> 2) & 3) << 4) | (((n >> 4) & 3) << 2) | (n & 3); }
DI int gumap(int j) { return 128 * (j >> 6) + 64 * ((j >> 5) & 1) + 16 * ((j >> 2) & 1) + 4 * ((j >> 3) & 3) + (j & 3); }

DI void transpose_tile(const float* __restrict__ src, int N, int k0, int n0, bf16_t* __restrict__ dst, int ldd, int mode, int roff, float* ldsf) {
    const int tid = otid();
    {
        const int kk = tid >> 4, nn4 = (tid & 15) * 4;
#pragma unroll
        for (int ps = 0; ps < 2; ++ps) {
            const int k = kk + 32 * ps;
            const f32x4 v = *(const f32x4*)(src + (size_t)(k0 + k) * N + n0 + nn4);
            ldsf[k * 65 + nn4 + 0] = v[0]; ldsf[k * 65 + nn4 + 1] = v[1]; ldsf[k * 65 + nn4 + 2] = v[2]; ldsf[k * 65 + nn4 + 3] = v[3];
        }
    }
    __syncthreads();
    {
        const int n = tid >> 3, ch = tid & 7, gn = n0 + n;
        int drow;
        if (mode == 0) drow = gn + roff; else if (mode == 1) drow = perm64(gn); else drow = gumap(gn) + roff;
        float v[8];
#pragma unroll
        for (int i = 0; i < 8; ++i) v[i] = ldsf[(ch * 8 + i) * 65 + n];
        u32x4 pk = {pk2(v[0], v[1]), pk2(v[2], v[3]), pk2(v[4], v[5]), pk2(v[6], v[7])};
        *(u32x4*)(dst + (size_t)drow * ldd + k0 + ch * 8) = pk;
    }
    __syncthreads();
}

DI void phase_prologue(const Params& p, char* lds) {
    const int tid = otid();
    float* ldsf = (float*)lds;
    constexpr int N_MOD = 144, N_TR_L = 5824, N_ITEMS = N_MOD + 1 + 2 * N_TR_L;
    for (int it = blockIdx.x; it < N_ITEMS; it += gridDim.x) {
        if (it < N_MOD) {
            const int l = it / 72, j0 = (it % 72) * 128, jj = tid & 31, ii = tid >> 5;
            f32x4 a = {0.f, 0.f, 0.f, 0.f};
            const float* wb = p.ada_w + (size_t)l * 1024 * 9216 + j0 + 4 * jj;
            for (int i = ii; i < 1024; i += 16) {
                const float cv = p.c[i]; const float ca = cv / (1.f + expf(-cv));
                const f32x4 w = *(const f32x4*)(wb + (size_t)i * 9216);
                a += ca * w;
            }
            *(f32x4*)(ldsf + ii * 128 + 4 * jj) = a;
            __syncthreads();
            if (tid < 128) {
                float s = 0.f;
#pragma unroll
                for (int r = 0; r < 16; ++r) s += ldsf[r * 128 + tid];
                ((float*)(p.ws + OFF_MOD))[l * 9216 + j0 + tid] = s + p.ada_b[l * 9216 + j0 + tid];
            }
            __syncthreads();
        } else if (it == N_MOD) {
            if (tid < 64) {
#pragma unroll
                for (int l = 0; l < 2; ++l) {
                    const float* lp = p.lam_p + l * 256;
                    float a = lp[tid] * lp[64 + tid], b = lp[128 + tid] * lp[192 + tid];
#pragma unroll
                    for (int o = 32; o > 0; o >>= 1) { a += __shfl_xor(a, o); b += __shfl_xor(b, o); }
                    const float li = l == 0 ? 0.2f : 0.35550906759096926f;
                    if (tid == 0) ((float*)(p.ws + OFF_LAM))[l] = expf(a) - expf(b) + li;
                }
            }
            float* rope = (float*)(p.ws + OFF_ROPE);
            for (int e = tid; e < 320 * 16; e += 512) {
                const int pi = e >> 4, i = e & 15;
                const int pos = pi < 256 ? pi - 128 : (pi - 256) - 32;
                const float inv = (float)exp(-(double)i * (1.0 / 16.0) * 9.210340371976184);
                const float angf = (float)pos * inv;
                double r = (double)angf; r -= rint(r * 0.15915494309189535) * 6.283185307179586;
                const double r2 = r * r;
                double sn = 0.0, cs = 0.0;
#pragma unroll
                for (int n = 14; n >= 1; --n) { sn = (sn + 1.0) * (-r2 / (double)((2 * n) * (2 * n + 1))); cs = (cs + 1.0) * (-r2 / (double)((2 * n - 1) * (2 * n))); }
                sn = (sn + 1.0) * r; cs = cs + 1.0;
                if (pi < 256) { rope[pi * 16 + i] = (float)cs; rope[4096 + pi * 16 + i] = (float)sn; }
                else { rope[8192 + (pi - 256) * 16 + i] = (float)cs; rope[9216 + (pi - 256) * 16 + i] = (float)sn; }
            }
        } else {
            const int tt = it - N_MOD - 1, l = tt / N_TR_L, r = tt % N_TR_L;
            if (r < 4224) {
                const int f = r / 2112, r2 = r % 2112, which = r2 / 704, r3 = r2 % 704;
                const size_t lf = (size_t)(l * 2 + f);
                if (which < 2) {
                    const float* src = (which == 0 ? p.ffn_wg : p.ffn_wu) + lf * D * F;
                    transpose_tile(src, F, (r3 / 44) * 64, (r3 % 44) * 64, (bf16_t*)(p.ws + OFF_WGU + lf * SZ_WGU), D, 2, which * 32, ldsf);
                } else {
                    transpose_tile(p.ffn_wd + lf * F * D, D, (r3 / 16) * 64, (r3 % 16) * 64, (bf16_t*)(p.ws + OFF_WD + lf * SZ_WD), F, 1, 0, ldsf);
                }
            } else if (r < 4800) {
                const int r3 = r - 4224;
                transpose_tile(p.w_in + (size_t)l * D * 2304, 2304, (r3 / 36) * 64, (r3 % 36) * 64, (bf16_t*)(p.ws + OFF_WIN + l * SZ_WIN), D, 0, 0, ldsf);
            } else if (r < 5312) {
                const int r3 = r - 4800;
                transpose_tile(p.w_gate + (size_t)l * D * 2048, 2048, (r3 / 32) * 64, (r3 % 32) * 64, (bf16_t*)(p.ws + OFF_WIN + l * SZ_WIN), D, 0, 2304, ldsf);
            } else if (r < 5440) {
                const int r3 = r - 5312;
                transpose_tile(p.w_ba + (size_t)l * 512 * D, D, (r3 / 16) * 64, (r3 % 16) * 64, (bf16_t*)(p.ws + OFF_WBA + l * SZ_WB), 512, 1, 0, ldsf);
            } else if (r < 5568) {
                const int r3 = r - 5440;
                transpose_tile(p.w_bb + (size_t)l * 512 * D, D, (r3 / 16) * 64, (r3 % 16) * 64, (bf16_t*)(p.ws + OFF_WBB + l * SZ_WB), 512, 1, 0, ldsf);
            } else {
                const int r3 = r - 5568;
                transpose_tile(p.w_o + (size_t)l * D * D, D, (r3 / 16) * 64, (r3 % 16) * 64, (bf16_t*)(p.ws + OFF_WO + l * SZ_WO), D, 1, 0, ldsf);
            }
        }
    }
}

DI void phase_norm(const float* hin, const float* __restrict__ g, const float* __restrict__ sh, const float* __restrict__ sc, bf16_t* nout, float* fout) {
    const int lane = threadIdx.x & 63, wid = threadIdx.x >> 6;
    const int nw = gridDim.x * 8;
    for (int row = blockIdx.x * 8 + wid; row < S; row += nw) {
        const float* hp = hin + (size_t)row * D;
        f32x4 v[4]; float ss = 0.f;
#pragma unroll
        for (int i = 0; i < 4; ++i) { v[i] = *(const f32x4*)(hp + (i * 64 + lane) * 4); ss += v[i][0] * v[i][0] + v[i][1] * v[i][1] + v[i][2] * v[i][2] + v[i][3] * v[i][3]; }
#pragma unroll
        for (int o = 32; o > 0; o >>= 1) ss += __shfl_xor(ss, o);
        const float rstd = rsqrtf(ss * (1.0f / 1024.0f) + 1e-6f);
#pragma unroll
        for (int i = 0; i < 4; ++i) {
            const int col = (i * 64 + lane) * 4;
            const f32x4 gv = *(const f32x4*)(g + col);
            f32x4 y = v[i] * rstd * gv;
            if (sc) { const f32x4 s1 = *(const f32x4*)(sc + col), s0 = *(const f32x4*)(sh + col); y = y * (1.0f + s1) + s0; }
            if (fout) *(f32x4*)(fout + (size_t)row * D + col) = y;
            else { u32x2 pk = {pk2(y[0], y[1]), pk2(y[2], y[3])}; *(u32x2*)(nout + (size_t)row * D + col) = pk; }
        }
    }
}

DI void gemm_mainloop(const bf16_t* __restrict__ A, int lda, const bf16_t* __restrict__ W, int ldw, int K, f32x4 (&acc)[4][4], char* lds) {
    const int tid = otid(), lane = tid & 63, wid = tid >> 6, wt = wid >> 1, wc = wid & 1;
    const int srow = tid >> 3, sch = tid & 7;
    const bf16_t* ag = A + (size_t)srow * lda + sch * 8;
    const bf16_t* wg = W + (size_t)srow * ldw + sch * 8;
    const int so = lds_off(srow, sch);
    u32x4 ra[4], rw[2];
#pragma unroll
    for (int i = 0; i < 4; ++i) ra[i] = *(const u32x4*)(ag + (size_t)(64 * i) * lda);
#pragma unroll
    for (int i = 0; i < 2; ++i) rw[i] = *(const u32x4*)(wg + (size_t)(64 * i) * ldw);
#pragma unroll
    for (int i = 0; i < 4; ++i) *(u32x4*)(lds + so + i * 8192) = ra[i];
#pragma unroll
    for (int i = 0; i < 2; ++i) *(u32x4*)(lds + 32768 + so + i * 8192) = rw[i];
    __syncthreads();
    const int fr = lane & 15, fq = lane >> 4, sw = (fr >> 1) & 7;
    const int a_base = (64 * wt + fr) * 128, w_base = 32768 + (64 * wc + fr) * 128;
    const int nk = K >> 6;
    for (int kt = 0; kt < nk; ++kt) {
        const char* st = lds + (kt & 1) * 49152;
        const bool more = kt + 1 < nk;
        if (more) {
            const int ko = (kt + 1) * 64;
#pragma unroll
            for (int i = 0; i < 4; ++i) ra[i] = *(const u32x4*)(ag + (size_t)(64 * i) * lda + ko);
#pragma unroll
            for (int i = 0; i < 2; ++i) rw[i] = *(const u32x4*)(wg + (size_t)(64 * i) * ldw + ko);
        }
#pragma unroll
        for (int kk = 0; kk < 2; ++kk) {
            const int co = ((kk * 4 + fq) ^ sw) << 4;
            bf16x8 af[4], wf[4];
#pragma unroll
            for (int i = 0; i < 4; ++i) af[i] = *(const bf16x8*)(st + a_base + i * 2048 + co);
#pragma unroll
            for (int i = 0; i < 4; ++i) wf[i] = *(const bf16x8*)(st + w_base + i * 2048 + co);
#pragma unroll
            for (int mw = 0; mw < 4; ++mw)
#pragma unroll
                for (int nt = 0; nt < 4; ++nt) acc[mw][nt] = __builtin_amdgcn_mfma_f32_16x16x32_bf16(wf[mw], af[nt], acc[mw][nt], 0, 0, 0);
        }
        if (more) {
            char* sn = lds + ((kt + 1) & 1) * 49152;
#pragma unroll
            for (int i = 0; i < 4; ++i) *(u32x4*)(sn + so + i * 8192) = ra[i];
#pragma unroll
            for (int i = 0; i < 2; ++i) *(u32x4*)(sn + 32768 + so + i * 8192) = rw[i];
        }
        __syncthreads();
    }
}
DI void zero_acc(f32x4 (&acc)[4][4]) {
#pragma unroll
    for (int a = 0; a < 4; ++a)
#pragma unroll
        for (int b = 0; b < 4; ++b) acc[a][b] = (f32x4){0.f, 0.f, 0.f, 0.f};
}

DI void phase_gateup(const bf16_t* n, const bf16_t* wgu, bf16_t* act, char* lds) {
    const int tid_ = otid(), lane = tid_ & 63, wid = tid_ >> 6, wt = wid >> 1, wc = wid & 1, fr = lane & 15, fq = lane >> 4;
    constexpr int NTILES = 64 * (NGU / 128);
    for (int t = blockIdx.x; t < NTILES; t += gridDim.x) {
        const int bm = t & 63, bn = t >> 6, row0 = bm * 256;
        f32x4 acc[4][4]; zero_acc(acc);
        gemm_mainloop(n + (size_t)row0 * D, D, wgu + (size_t)bn * 128 * D, D, D, acc, lds);
#pragma unroll
        for (int nt = 0; nt < 4; ++nt) {
            const int token = row0 + 64 * wt + 16 * nt + fr;
            float v[8];
#pragma unroll
            for (int m = 0; m < 2; ++m)
#pragma unroll
                for (int r = 0; r < 4; ++r) { const float gg = acc[m][nt][r], uu = acc[m + 2][nt][r]; v[4 * m + r] = gg * fast_rcp(1.0f + __expf(-gg)) * uu; }
            u32x4 pk = {pk2(v[0], v[1]), pk2(v[2], v[3]), pk2(v[4], v[5]), pk2(v[6], v[7])};
            *(u32x4*)(act + (size_t)token * F + 64 * bn + 32 * wc + 8 * fq) = pk;
        }
    }
}

DI void phase_resid(const bf16_t* A, int K, const bf16_t* W, const float* hin, float* hout, const float* __restrict__ gvec, float gs, char* lds) {
    const int tid_ = otid(), lane = tid_ & 63, wid = tid_ >> 6, wt = wid >> 1, wc = wid & 1, fr = lane & 15, fq = lane >> 4;
    constexpr int NTILES = 64 * 8;
    for (int t = blockIdx.x; t < NTILES; t += gridDim.x) {
        const int bm = t & 63, bn = t >> 6, row0 = bm * 256, ch0 = bn * 128 + 64 * wc + 16 * fq;
        f32x4 acc[4][4]; zero_acc(acc);
        gemm_mainloop(A + (size_t)row0 * K, K, W + (size_t)bn * 128 * K, K, K, acc, lds);
        f32x4 gv[4];
#pragma unroll
        for (int mw = 0; mw < 4; ++mw) gv[mw] = *(const f32x4*)(gvec + ch0 + 4 * mw) * gs;
#pragma unroll
        for (int nt = 0; nt < 4; ++nt) {
            const size_t off = (size_t)(row0 + 64 * wt + 16 * nt + fr) * D + ch0;
#pragma unroll
            for (int mw = 0; mw < 4; ++mw) { const f32x4 hv = *(const f32x4*)(hin + off + 4 * mw); *(f32x4*)(hout + off + 4 * mw) = hv + gv[mw] * acc[mw][nt]; }
        }
    }
}

DI void phase_merge(const bf16_t* atta, const bf16_t* od, const bf16_t* wba, const bf16_t* wbb, const bf16_t* G, bf16_t* merged, float* spill, char* lds) {
    const int tid_ = otid(), lane = tid_ & 63, wid = tid_ >> 6, wt = wid >> 1, wc = wid & 1, fr = lane & 15, fq = lane >> 4;
    constexpr int NTILES = 64 * 8;
    for (int t = blockIdx.x; t < NTILES; t += gridDim.x) {
        const int bm = t & 63, bn = t >> 6, row0 = bm * 256, ch0 = bn * 128 + 64 * wc + 16 * fq;
        f32x4 acc[4][4]; zero_acc(acc);
        gemm_mainloop(atta + (size_t)row0 * 512, 512, wba + (size_t)bn * 128 * 512, 512, 512, acc, lds);
        float* sp = spill + ((size_t)blockIdx.x * 16 * 512 + tid_) * 4;
#pragma unroll
        for (int nt = 0; nt < 4; ++nt) {
            const bf16_t* gp = G + (size_t)(row0 + 64 * wt + 16 * nt + fr) * 2048 + ch0;
#pragma unroll
            for (int mw = 0; mw < 4; ++mw) { const u32x2 gu = *(const u32x2*)(gp + 4 * mw); const f32x4 ga = {bf_lo(gu[0]), bf_hi(gu[0]), bf_lo(gu[1]), bf_hi(gu[1])};
                *(f32x4*)(sp + (size_t)(nt * 4 + mw) * 2048) = ga * acc[mw][nt]; }
        }
        zero_acc(acc);
        gemm_mainloop(od + (size_t)row0 * 512, 512, wbb + (size_t)bn * 128 * 512, 512, 512, acc, lds);
#pragma unroll
        for (int nt = 0; nt < 4; ++nt) {
            const size_t tok = (size_t)(row0 + 64 * wt + 16 * nt + fr);
            const bf16_t* gp = G + tok * 2048 + 1024 + ch0;
            unsigned w[8];
#pragma unroll
            for (int mw = 0; mw < 4; ++mw) { const u32x2 gu = *(const u32x2*)(gp + 4 * mw); const f32x4 gb = {bf_lo(gu[0]), bf_hi(gu[0]), bf_lo(gu[1]), bf_hi(gu[1])};
                const f32x4 o = *(const f32x4*)(sp + (size_t)(nt * 4 + mw) * 2048) + gb * acc[mw][nt]; w[2 * mw] = pk2(o[0], o[1]); w[2 * mw + 1] = pk2(o[2], o[3]); }
            bf16_t* mp = merged + tok * D + ch0;
            *(u32x4*)(mp) = (u32x4){w[0], w[1], w[2], w[3]};
            *(u32x4*)(mp + 8) = (u32x4){w[4], w[5], w[6], w[7]};
        }
    }
}

DI void phase_win(const Params& p, int l, char* lds) {
    const int tid_ = otid(), lane = tid_ & 63, wid = tid_ >> 6, wt = wid >> 1, wc = wid & 1, fr = lane & 15, fq = lane >> 4;
    const bf16_t* n = (const bf16_t*)(p.ws + OFF_N);
    const bf16_t* W = (const bf16_t*)(p.ws + OFF_WIN + l * SZ_WIN);
    bf16_t* Q = (bf16_t*)(p.ws + OFF_Q); bf16_t* QD = (bf16_t*)(p.ws + OFF_QD); bf16_t* KA = (bf16_t*)(p.ws + OFF_KA); bf16_t* VTA = (bf16_t*)(p.ws + OFF_VTA);
    bf16_t* KD = (bf16_t*)(p.ws + OFF_KD); bf16_t* VTD = (bf16_t*)(p.ws + OFF_VTD); bf16_t* G = (bf16_t*)(p.ws + OFF_G);
    const float* rope = (const float*)(p.ws + OFF_ROPE);
    constexpr int NTILES = 64 * (NIN / 128);
    for (int t = blockIdx.x; t < NTILES; t += gridDim.x) {
        const int bm = t & 63, bn = t >> 6, row0 = bm * 256;
        f32x4 acc[4][4]; zero_acc(acc);
        gemm_mainloop(n + (size_t)row0 * D, D, W + (size_t)bn * 128 * D, D, D, acc, lds);
        const int cw = bn * 128 + 64 * wc;
        if (cw < 640) {
            const bool isq = cw < 512;
            const float* gq = p.qk_g + l * 128 + (isq ? 0 : 64);
            f32x4 gv[4];
#pragma unroll
            for (int mw = 0; mw < 4; ++mw) gv[mw] = *(const f32x4*)(gq + 16 * mw + 4 * fq);
#pragma unroll
            for (int nt = 0; nt < 4; ++nt) {
                const int token = row0 + 64 * wt + 16 * nt + fr;
                float ss = 0.f;
#pragma unroll
                for (int mw = 0; mw < 4; ++mw) ss += acc[mw][nt][0] * acc[mw][nt][0] + acc[mw][nt][1] * acc[mw][nt][1] + acc[mw][nt][2] * acc[mw][nt][2] + acc[mw][nt][3] * acc[mw][nt][3];
                ss += __shfl_xor(ss, 16); ss += __shfl_xor(ss, 32);
                const float rstd = rsqrtf(ss * (1.0f / 64.0f) + 1e-6f);
                f32x4 y[4];
#pragma unroll
                for (int mw = 0; mw < 4; ++mw) y[mw] = acc[mw][nt] * rstd * gv[mw];
                const int prow = token >> 6, pcol = token & 63;
                const f32x4 cr = *(const f32x4*)(rope + prow * 16 + 4 * fq), sr = *(const f32x4*)(rope + 4096 + prow * 16 + 4 * fq);
                const f32x4 cc = *(const f32x4*)(rope + 8192 + pcol * 16 + 4 * fq), sc = *(const f32x4*)(rope + 9216 + pcol * 16 + 4 * fq);
                f32x4 o[4];
                o[0] = y[0] * cr - y[1] * sr; o[1] = y[1] * cr + y[0] * sr; o[2] = y[2] * cc - y[3] * sc; o[3] = y[3] * cc + y[2] * sc;
                const float qs = isq ? QSCALE : 1.0f;
                bf16_t* dst = isq ? (Q + (size_t)token * 512 + cw) : (KA + (size_t)token * 128 + (cw - 512));
#pragma unroll
                for (int mw = 0; mw < 4; ++mw) { const f32x4 z = o[mw] * qs; *(u32x2*)(dst + 16 * mw + 4 * fq) = (u32x2){pk2(z[0], z[1]), pk2(z[2], z[3])}; }
            }
        } else if (cw < 768 || (cw >= 1792 && cw < 2304)) {
            bf16_t* vt = cw < 768 ? (VTA + (size_t)(cw - 640) * S) : (VTD + (size_t)(cw - 1792) * S);
#pragma unroll
            for (int nt = 0; nt < 4; ++nt) {
                const int token = row0 + 64 * wt + 16 * nt + fr;
#pragma unroll
                for (int mw = 0; mw < 4; ++mw)
#pragma unroll
                    for (int r = 0; r < 4; ++r) vt[(size_t)(16 * mw + 4 * fq + r) * S + token] = (bf16_t)(pk2(acc[mw][nt][r], 0.f) & 0xffffu);
            }
        } else if (cw < 1792) {
            const bool isq = cw < 1280; const float qs = isq ? QSCALE : 1.0f;
            bf16_t* base = isq ? (QD + (cw - 768)) : (KD + (cw - 1280));
#pragma unroll
            for (int nt = 0; nt < 4; ++nt) {
                bf16_t* dst = base + (size_t)(row0 + 64 * wt + 16 * nt + fr) * 512;
#pragma unroll
                for (int mw = 0; mw < 4; ++mw) { const f32x4 z = acc[mw][nt] * qs; *(u32x2*)(dst + 16 * mw + 4 * fq) = (u32x2){pk2(z[0], z[1]), pk2(z[2], z[3])}; }
            }
        } else {
            const int gc = cw - 2304;
            const float* bg = p.b_gate + l * 2048 + gc;
            f32x4 bv[4];
#pragma unroll
            for (int mw = 0; mw < 4; ++mw) bv[mw] = *(const f32x4*)(bg + 16 * mw + 4 * fq);
#pragma unroll
            for (int nt = 0; nt < 4; ++nt) {
                bf16_t* dst = G + (size_t)(row0 + 64 * wt + 16 * nt + fr) * 2048 + gc;
#pragma unroll
                for (int mw = 0; mw < 4; ++mw) {
                    const f32x4 xx = acc[mw][nt] + bv[mw]; f32x4 z;
#pragma unroll
                    for (int r = 0; r < 4; ++r) z[r] = fast_rcp(1.0f + __expf(-xx[r]));
                    *(u32x2*)(dst + 16 * mw + 4 * fq) = (u32x2){pk2(z[0], z[1]), pk2(z[2], z[3])};
                }
            }
        }
    }
}

#define MFMA32(a, b, c) __builtin_amdgcn_mfma_f32_32x32x16_bf16((a), (b), (c), 0, 0, 0)
template <int DV, bool ALIBI>
DI void attn_pass(const bf16_t* __restrict__ Qp, const bf16_t* __restrict__ Kb, int kpitch, const bf16_t* __restrict__ Vtb, float slope2, int qpos, f32x16 (&o)[DV / 32], float& l_out, char* lds) {
    constexpr int NV = DV / 64, NDT = DV / 32, STAGE = 8192 + DV * 128;
    const int tid = otid(), lane = tid & 63, r32 = lane & 31, h = lane >> 5;
    bf16x8 qf[4];
#pragma unroll
    for (int d0 = 0; d0 < 4; ++d0) qf[d0] = *(const bf16x8*)(Qp + 16 * d0 + 8 * h);
    const int srow = tid >> 3, sch = tid & 7, so = lds_off(srow, sch);
    const bf16_t* kg = Kb + (size_t)srow * kpitch + sch * 8;
    const bf16_t* vg = Vtb + (size_t)srow * S + sch * 8;
    u32x4 rk, rv[NV];
    rk = *(const u32x4*)kg;
#pragma unroll
    for (int i = 0; i < NV; ++i) rv[i] = *(const u32x4*)(vg + (size_t)(64 * i) * S);
    *(u32x4*)(lds + so) = rk;
#pragma unroll
    for (int i = 0; i < NV; ++i) *(u32x4*)(lds + 8192 + so + i * 8192) = rv[i];
    __syncthreads();
    const int pi = (r32 & 0x13) | ((r32 & 4) << 1) | ((r32 & 8) >> 1);
    const int k_base = pi * 128, k_sw = (pi >> 1) & 7, v_base = 8192 + r32 * 128, v_sw = (r32 >> 1) & 7;
    float m = -1e30f, l = 0.f;
#pragma unroll
    for (int dt = 0; dt < NDT; ++dt)
#pragma unroll
        for (int r = 0; r < 16; ++r) o[dt][r] = 0.f;
    constexpr int NTL = S / 64;
    for (int t = 0; t < NTL; ++t) {
        const char* st = lds + (t & 1) * STAGE;
        const bool more = t + 1 < NTL;
        if (more) {
            rk = *(const u32x4*)(kg + (size_t)(t + 1) * 64 * kpitch);
#pragma unroll
            for (int i = 0; i < NV; ++i) rv[i] = *(const u32x4*)(vg + (size_t)(64 * i) * S + (t + 1) * 64);
        }
        f32x16 sc[2];
#pragma unroll
        for (int kt = 0; kt < 2; ++kt) {
#pragma unroll
            for (int r = 0; r < 16; ++r) sc[kt][r] = 0.f;
#pragma unroll
            for (int d0 = 0; d0 < 4; ++d0) {
                const bf16x8 kf = *(const bf16x8*)(st + kt * 4096 + k_base + (((2 * d0 + h) ^ k_sw) << 4));
                sc[kt] = MFMA32(kf, qf[d0], sc[kt]);
            }
        }
        SB();
        if (ALIBI) {
#pragma unroll
            for (int kt = 0; kt < 2; ++kt) {
                const float dq = (float)(qpos - (64 * t + 32 * kt + 8 * h));
#pragma unroll
                for (int r = 0; r < 16; ++r) sc[kt][r] = __builtin_fmaf(-slope2, __builtin_fabsf(dq - (float)(16 * (r >> 3) + (r & 7))), sc[kt][r]);
            }
        }
        float mt = sc[0][0];
#pragma unroll
        for (int r = 1; r < 16; ++r) mt = __builtin_fmaxf(mt, sc[0][r]);
#pragma unroll
        for (int r = 0; r < 16; ++r) mt = __builtin_fmaxf(mt, sc[1][r]);
        mt = __builtin_fmaxf(mt, __shfl_xor(mt, 32));
        if (__any(mt > m + 8.0f)) {
            const float mn = __builtin_fmaxf(m, mt), al = fast_exp2(m - mn);
            l *= al; m = mn;
#pragma unroll
            for (int dt = 0; dt < NDT; ++dt)
#pragma unroll
                for (int r = 0; r < 16; ++r) o[dt][r] *= al;
        }
        float ps = 0.f;
#pragma unroll
        for (int kt = 0; kt < 2; ++kt)
#pragma unroll
            for (int r = 0; r < 16; ++r) { const float e = fast_exp2(sc[kt][r] - m); sc[kt][r] = e; ps += e; }
        l += ps;
        bf16x8 pf[4];
#pragma unroll
        for (int ks = 0; ks < 4; ++ks) {
            const int kt = ks >> 1, b = (ks & 1) * 8;
            u32x4 w = {pk2(sc[kt][b], sc[kt][b + 1]), pk2(sc[kt][b + 2], sc[kt][b + 3]), pk2(sc[kt][b + 4], sc[kt][b + 5]), pk2(sc[kt][b + 6], sc[kt][b + 7])};
            pf[ks] = __builtin_bit_cast(bf16x8, w);
        }
        SB();
#pragma unroll
        for (int dt = 0; dt < NDT; ++dt) {
#pragma unroll
            for (int ks = 0; ks < 4; ++ks) {
                const bf16x8 vf = *(const bf16x8*)(st + v_base + dt * 4096 + (((2 * ks + h) ^ v_sw) << 4));
                o[dt] = MFMA32(vf, pf[ks], o[dt]);
            }
            if (dt & 1) SB();
        }
        if (more) {
            char* sn = lds + ((t + 1) & 1) * STAGE;
            *(u32x4*)(sn + so) = rk;
#pragma unroll
            for (int i = 0; i < NV; ++i) *(u32x4*)(sn + 8192 + so + i * 8192) = rv[i];
        }
        __syncthreads();
    }
    l += __shfl_xor(l, 32);
    l_out = l;
}

DI void phase_attn(const Params& p, int l, char* lds) {
    const int tid = otid(), lane = tid & 63, wid = tid >> 6, r32 = lane & 31, h = lane >> 5;
    const bf16_t* Q = (const bf16_t*)(p.ws + OFF_Q); const bf16_t* QD = (const bf16_t*)(p.ws + OFF_QD); const bf16_t* KA = (const bf16_t*)(p.ws + OFF_KA);
    const bf16_t* VTA = (const bf16_t*)(p.ws + OFF_VTA); const bf16_t* KD = (const bf16_t*)(p.ws + OFF_KD); const bf16_t* VTD = (const bf16_t*)(p.ws + OFF_VTD);
    bf16_t* ATTA = (bf16_t*)(p.ws + OFF_ATTA); bf16_t* OD = (bf16_t*)(p.ws + OFF_OD); float* BO0 = (float*)(p.ws + OFF_N);
    const float lam = ((const float*)(p.ws + OFF_LAM))[l];
    const float oml = 1.0f - (l == 0 ? 0.2f : 0.35550906759096926f);
    for (int u = blockIdx.x; u < 256; u += gridDim.x) {
        const int hb = (u & 7) >> 1, qb = ((u & 1) << 5) + (u >> 3);
        const int token = 256 * qb + 32 * wid + r32;
        const float slope2 = exp2f(-2.0f * (float)(hb + 1)) * LOG2E;
        float* bo = BO0 + (size_t)token * 512 + hb * 128;
        f32x16 o[4]; float ls;
        attn_pass<128, true>(QD + (size_t)token * 512 + hb * 64, KD + hb * 64, 512, VTD + (size_t)(hb * 128) * S, slope2, token, o, ls, lds);
        {
            const float inv = 1.0f / ls;
#pragma unroll
            for (int dt = 0; dt < 4; ++dt)
#pragma unroll
                for (int g = 0; g < 4; ++g) *(f32x4*)(bo + 32 * dt + 8 * g + 4 * h) = (f32x4){o[dt][4 * g] * inv, o[dt][4 * g + 1] * inv, o[dt][4 * g + 2] * inv, o[dt][4 * g + 3] * inv};
        }
        attn_pass<128, true>(QD + (size_t)token * 512 + 256 + hb * 64, KD + 256 + hb * 64, 512, VTD + (size_t)(hb * 128) * S, slope2, token, o, ls, lds);
        {
            const float inv = lam / ls; float ss = 0.f;
#pragma unroll
            for (int dt = 0; dt < 4; ++dt)
#pragma unroll
                for (int g = 0; g < 4; ++g) {
                    const f32x4 a = *(const f32x4*)(bo + 32 * dt + 8 * g + 4 * h);
#pragma unroll
                    for (int j = 0; j < 4; ++j) { const float v = a[j] - o[dt][4 * g + j] * inv; o[dt][4 * g + j] = v; ss += v * v; }
                }
            ss += __shfl_xor(ss, 32);
            const float rstd = rsqrtf(ss * (1.0f / 128.0f) + 1e-6f) * oml;
            const float* sg = p.subln_g + l * 128;
            bf16_t* dst = OD + (size_t)token * 512 + hb * 128;
#pragma unroll
            for (int dt = 0; dt < 4; ++dt)
#pragma unroll
                for (int g = 0; g < 4; ++g) {
                    const int d = 32 * dt + 8 * g + 4 * h;
                    const f32x4 gg = *(const f32x4*)(sg + d);
                    *(u32x2*)(dst + d) = (u32x2){pk2(o[dt][4 * g] * rstd * gg[0], o[dt][4 * g + 1] * rstd * gg[1]), pk2(o[dt][4 * g + 2] * rstd * gg[2], o[dt][4 * g + 3] * rstd * gg[3])};
                }
        }
    }
    for (int u = blockIdx.x; u < 512; u += gridDim.x) {
        const int hq = u & 7, qb = u >> 3, kv = hq >> 2;
        const int token = 256 * qb + 32 * wid + r32;
        f32x16 o[2]; float ls;
        attn_pass<64, false>(Q + (size_t)token * 512 + hq * 64, KA + kv * 64, 128, VTA + (size_t)(kv * 64) * S, 0.f, token, o, ls, lds);
        const float inv = 1.0f / ls;
        bf16_t* dst = ATTA + (size_t)token * 512 + hq * 64;
#pragma unroll
        for (int dt = 0; dt < 2; ++dt)
#pragma unroll
            for (int g = 0; g < 4; ++g)
                *(u32x2*)(dst + 32 * dt + 8 * g + 4 * h) = (u32x2){pk2(o[dt][4 * g] * inv, o[dt][4 * g + 1] * inv), pk2(o[dt][4 * g + 2] * inv, o[dt][4 * g + 3] * inv)};
    }
}

__global__ void __launch_bounds__(512) mega(Params p) {
    __shared__ __attribute__((aligned(16))) char lds[98304];
    cg::grid_group grid = cg::this_grid();
    bf16_t* nbuf = (bf16_t*)(p.ws + OFF_N);
    bf16_t* act = (bf16_t*)(p.ws + OFF_ACT);
    for (int ph = p.ph_lo; ph < p.ph_hi; ++ph) {
        if (ph == 0) phase_prologue(p, lds);
        else {
            const int l = ph == 23 ? 1 : (ph - 1) / 11, k = ph == 23 ? 11 : (ph - 1) % 11;
            const float* mod = (const float*)(p.ws + OFF_MOD) + l * 9216;
            switch (k) {
            case 0: case 3: case 8: case 11: {
                const int i = k == 0 ? 0 : (k == 3 ? 1 : 2);
                const float* hin = (ph == 1) ? p.x : p.out;
                if (k == 11) phase_norm(hin, p.final_g, nullptr, nullptr, nullptr, p.out);
                else phase_norm(hin, p.norm_g + (l * 3 + i) * D, mod + (3 * i) * D, mod + (3 * i + 1) * D, nbuf, nullptr);
            } break;
            case 1: case 9: {
                const int f = k == 1 ? 0 : 1;
                phase_gateup(nbuf, (const bf16_t*)(p.ws + OFF_WGU + (size_t)(l * 2 + f) * SZ_WGU), act, lds);
            } break;
            case 2: case 10: case 7: {
                if (k == 7) phase_resid((const bf16_t*)(p.ws + OFF_Q), D, (const bf16_t*)(p.ws + OFF_WO + l * SZ_WO), p.out, p.out, mod + 5 * D, 1.0f, lds);
                else {
                    const int f = k == 2 ? 0 : 1;
                    phase_resid(act, F, (const bf16_t*)(p.ws + OFF_WD + (size_t)(l * 2 + f) * SZ_WD), (ph == 3) ? p.x : p.out, p.out, mod + (f == 0 ? 2 : 8) * D, 0.5f, lds);
                }
            } break;
            case 4: phase_win(p, l, lds); break;
            case 5: phase_attn(p, l, lds); break;
            case 6: phase_merge((const bf16_t*)(p.ws + OFF_ATTA), (const bf16_t*)(p.ws + OFF_OD), (const bf16_t*)(p.ws + OFF_WBA + l * SZ_WB), (const bf16_t*)(p.ws + OFF_WBB + l * SZ_WB),
                                (const bf16_t*)(p.ws + OFF_G), (bf16_t*)(p.ws + OFF_Q), (float*)(p.ws + OFF_N), lds); break;
            default: break;
            }
        }
        if (ph + 1 < p.ph_hi) grid.sync();
    }
}

extern "C" void kernel_launch(void* const* d_in, const int* in_sizes, int n_in, void* d_out, int out_size, void* d_ws, size_t ws_size, hipStream_t stream) {
    if (n_in != 18 || out_size != S * D || ws_size < WS_END) { fprintf(stderr, "kernel_launch: unexpected shapes / workspace (n_in %d out %d ws %zu need %zu)\n", n_in, out_size, ws_size, (size_t)WS_END); return; }
    Params p{};
    const float** pp = (const float**)&p;
    for (int i = 0; i < 18; ++i) pp[i] = (const float*)d_in[i];
    p.out = (float*)d_out; p.ws = (unsigned char*)d_ws;
#if MK_MULTI
    for (int ph = 0; ph < NPH; ++ph) { p.ph_lo = ph; p.ph_hi = ph + 1; hipLaunchKernelGGL(mega, dim3(256), dim3(512), 0, stream, p); }
#else
    static int grid = 0;
    if (!grid) {
        int dev = 0, cus = 0, per_cu = 0;
        hipGetDevice(&dev); hipDeviceGetAttribute(&cus, hipDeviceAttributeMultiprocessorCount, dev);
        hipOccupancyMaxActiveBlocksPerMultiprocessor(&per_cu, (const void*)mega, 512, 0);
        if (per_cu < 1) { fprintf(stderr, "kernel_launch: occupancy query says %d blocks per CU\n", per_cu); per_cu = 1; }
        grid = cus;
    }
    p.ph_lo = 0; p.ph_hi = NPH;
    void* args[] = {&p};
    hipError_t e = hipLaunchCooperativeKernel((const void*)mega, dim3(grid), dim3(512), args, 0, stream);
    if (e != hipSuccess) fprintf(stderr, "cooperative launch failed: %s (grid %d)\n", hipGetErrorString(e), grid);
#endif
}
```

```cpp
#include <hip/hip_runtime.h>
#include <hip/hip_cooperative_groups.h>
#include <cstdio>
#include <cstdint>
namespace cg = cooperative_groups;

#ifndef MK_MULTI
#define MK_MULTI 0
#endif

#ifndef PROBE_DUP
#define PROBE_DUP -1
#endif
#define DI __device__ __forceinline__
typedef unsigned short bf16_t;
typedef short bf16x8 __attribute__((ext_vector_type(8)));
typedef float f32x4 __attribute__((ext_vector_type(4)));
typedef float f32x16 __attribute__((ext_vector_type(16)));
typedef unsigned u32x4 __attribute__((ext_vector_type(4)));
typedef unsigned u32x2 __attribute__((ext_vector_type(2)));

constexpr int S = 16384, D = 1024, F = 2816, NGU = 5632, NIN = 4352;
constexpr int NPH = 24;
constexpr float QSCALE = 0.125f * 1.4426950408889634f;
constexpr float LOG2E = 1.4426950408889634f;

constexpr size_t OFF_MOD = 0;
constexpr size_t OFF_LAM = 80000;
constexpr size_t OFF_STAT = 80128;
constexpr size_t OFF_ROPE = 81920;
constexpr size_t OFF_WGU = 1u << 20;
constexpr size_t SZ_WGU = (size_t)NGU * D * 2;
constexpr size_t OFF_WD = OFF_WGU + 4 * SZ_WGU;
constexpr size_t SZ_WD = (size_t)D * F * 2;
constexpr size_t OFF_WIN = OFF_WD + 4 * SZ_WD;
constexpr size_t SZ_WIN = (size_t)NIN * D * 2;
constexpr size_t OFF_WBA = OFF_WIN + 2 * SZ_WIN;
constexpr size_t SZ_WB = (size_t)D * 512 * 2;
constexpr size_t OFF_WBB = OFF_WBA + 2 * SZ_WB;
constexpr size_t OFF_WO = OFF_WBB + 2 * SZ_WB;
constexpr size_t SZ_WO = (size_t)D * D * 2;
constexpr size_t OFF_N = OFF_WO + 2 * SZ_WO;
constexpr size_t OFF_MIX = OFF_N + (size_t)S * D * 2;
constexpr size_t OFF_Q = OFF_MIX;
constexpr size_t OFF_QD = OFF_Q + (size_t)S * 512 * 2;
constexpr size_t OFF_KA = OFF_QD + (size_t)S * 512 * 2;
constexpr size_t OFF_VTA = OFF_KA + (size_t)S * 128 * 2;
constexpr size_t OFF_KD = OFF_VTA + (size_t)S * 128 * 2;
constexpr size_t OFF_VTD = OFF_KD + (size_t)S * 512 * 2;
constexpr size_t OFF_G = OFF_VTD + (size_t)S * 512 * 2;
constexpr size_t OFF_ATTA = OFF_G + (size_t)S * 2048 * 2;
constexpr size_t OFF_OD = OFF_ATTA + (size_t)S * 512 * 2;
constexpr size_t OFF_ACT = OFF_MIX;
constexpr size_t WS_END = OFF_OD + (size_t)S * 512 * 2;
static_assert((size_t)S * F * 2 <= WS_END - OFF_MIX, "act overlay");

struct Params {
    const float *x, *c, *ada_w, *ada_b, *norm_g, *ffn_wg, *ffn_wu, *ffn_wd, *w_in, *qk_g, *lam_p, *subln_g, *w_ba, *w_bb, *w_gate, *b_gate, *w_o, *final_g;
    float* out; unsigned char* ws; int ph_lo, ph_hi;
};

typedef __bf16 bf16v2 __attribute__((ext_vector_type(2)));
typedef float f32x2 __attribute__((ext_vector_type(2)));
DI unsigned pk2(float lo, float hi) { f32x2 v = {lo, hi}; bf16v2 b = __builtin_convertvector(v, bf16v2); return __builtin_bit_cast(unsigned, b); }
DI float bf_lo(unsigned u) { return __uint_as_float(u << 16); }
DI float bf_hi(unsigned u) { return __uint_as_float(u & 0xffff0000u); }
DI int lds_off(int row, int chunk) { return row * 128 + ((chunk ^ ((row >> 1) & 7)) << 4); }
DI float fast_exp2(float x) { return __builtin_amdgcn_exp2f(x); }
DI float fast_rcp(float x) { return __builtin_amdgcn_rcpf(x); }
DI int otid() { int t = threadIdx.x; asm volatile("" : "+v"(t)); return t; }
#define SB() __builtin_amdgcn_sched_barrier(0)

DI int perm64(int n) { return (n & ~63) | (((n >> 2) & 3) << 4) | (((n >> 4) & 3) << 2) | (n & 3); }
DI int gumap(int j) { return 128 * (j >> 6) + 64 * ((j >> 5) & 1) + 16 * ((j >> 2) & 1) + 4 * ((j >> 3) & 3) + (j & 3); }

DI void transpose_tile(const float* __restrict__ src, int N, int k0, int n0, bf16_t* __restrict__ dst, int ldd, int mode, int roff, float* ldsf) {
    const int tid = otid();
    {
        const int kk = tid >> 4, nn4 = (tid & 15) * 4;
#pragma unroll
        for (int ps = 0; ps < 2; ++ps) {
            const int k = kk + 32 * ps;
            const f32x4 v = *(const f32x4*)(src + (size_t)(k0 + k) * N + n0 + nn4);
            ldsf[k * 65 + nn4 + 0] = v[0]; ldsf[k * 65 + nn4 + 1] = v[1]; ldsf[k * 65 + nn4 + 2] = v[2]; ldsf[k * 65 + nn4 + 3] = v[3];
        }
    }
    __syncthreads();
    {
        const int n = tid >> 3, ch = tid & 7, gn = n0 + n;
        int drow;
        if (mode == 0) drow = gn + roff; else if (mode == 1) drow = perm64(gn); else drow = gumap(gn) + roff;
        float v[8];
#pragma unroll
        for (int i = 0; i < 8; ++i) v[i] = ldsf[(ch * 8 + i) * 65 + n];
        u32x4 pk = {pk2(v[0], v[1]), pk2(v[2], v[3]), pk2(v[4], v[5]), pk2(v[6], v[7])};
        *(u32x4*)(dst + (size_t)drow * ldd + k0 + ch * 8) = pk;
    }
    __syncthreads();
}

DI void phase_prologue(const Params& p, char* lds) {
    const int tid = otid();
    float* ldsf = (float*)lds;
    constexpr int N_MOD = 144, N_TR_L = 5824, N_ITEMS = N_MOD + 1 + 2 * N_TR_L;
    for (int it = blockIdx.x; it < N_ITEMS; it += gridDim.x) {
        if (it < N_MOD) {
            const int l = it / 72, j0 = (it % 72) * 128, jj = tid & 31, ii = tid >> 5;
            f32x4 a = {0.f, 0.f, 0.f, 0.f};
            const float* wb = p.ada_w + (size_t)l * 1024 * 9216 + j0 + 4 * jj;
            for (int i = ii; i < 1024; i += 16) {
                const float cv = p.c[i]; const float ca = cv / (1.f + expf(-cv));
                const f32x4 w = *(const f32x4*)(wb + (size_t)i * 9216);
                a += ca * w;
            }
            *(f32x4*)(ldsf + ii * 128 + 4 * jj) = a;
            __syncthreads();
            if (tid < 128) {
                float s = 0.f;
#pragma unroll
                for (int r = 0; r < 16; ++r) s += ldsf[r * 128 + tid];
                ((float*)(p.ws + OFF_MOD))[l * 9216 + j0 + tid] = s + p.ada_b[l * 9216 + j0 + tid];
            }
            __syncthreads();
        } else if (it == N_MOD) {
            if (tid < 64) {
#pragma unroll
                for (int l = 0; l < 2; ++l) {
                    const float* lp = p.lam_p + l * 256;
                    float a = lp[tid] * lp[64 + tid], b = lp[128 + tid] * lp[192 + tid];
#pragma unroll
                    for (int o = 32; o > 0; o >>= 1) { a += __shfl_xor(a, o); b += __shfl_xor(b, o); }
                    const float li = l == 0 ? 0.2f : 0.35550906759096926f;
                    if (tid == 0) ((float*)(p.ws + OFF_LAM))[l] = expf(a) - expf(b) + li;
                }
            }
            if (tid < 64) ((unsigned*)(p.ws + OFF_STAT))[tid] = 0u;
            float* rope = (float*)(p.ws + OFF_ROPE);
            for (int e = tid; e < 320 * 16; e += 512) {
                const int pi = e >> 4, i = e & 15;
                const int pos = pi < 256 ? pi - 128 : (pi - 256) - 32;
                const float inv = (float)exp(-(double)i * (1.0 / 16.0) * 9.210340371976184);
                const float angf = (float)pos * inv;
                double r = (double)angf; r -= rint(r * 0.15915494309189535) * 6.283185307179586;
                const double r2 = r * r;
                double sn = 0.0, cs = 0.0;
#pragma unroll
                for (int n = 14; n >= 1; --n) { sn = (sn + 1.0) * (-r2 / (double)((2 * n) * (2 * n + 1))); cs = (cs + 1.0) * (-r2 / (double)((2 * n - 1) * (2 * n))); }
                sn = (sn + 1.0) * r; cs = cs + 1.0;
                if (pi < 256) { rope[pi * 16 + i] = (float)cs; rope[4096 + pi * 16 + i] = (float)sn; }
                else { rope[8192 + (pi - 256) * 16 + i] = (float)cs; rope[9216 + (pi - 256) * 16 + i] = (float)sn; }
            }
        } else {
            const int tt = it - N_MOD - 1, l = tt / N_TR_L, r = tt % N_TR_L;
            if (r < 4224) {
                const int f = r / 2112, r2 = r % 2112, which = r2 / 704, r3 = r2 % 704;
                const size_t lf = (size_t)(l * 2 + f);
                if (which < 2) {
                    const float* src = (which == 0 ? p.ffn_wg : p.ffn_wu) + lf * D * F;
                    transpose_tile(src, F, (r3 / 44) * 64, (r3 % 44) * 64, (bf16_t*)(p.ws + OFF_WGU + lf * SZ_WGU), D, 2, which * 32, ldsf);
                } else {
                    transpose_tile(p.ffn_wd + lf * F * D, D, (r3 / 16) * 64, (r3 % 16) * 64, (bf16_t*)(p.ws + OFF_WD + lf * SZ_WD), F, 1, 0, ldsf);
                }
            } else if (r < 4800) {
                const int r3 = r - 4224;
                transpose_tile(p.w_in + (size_t)l * D * 2304, 2304, (r3 / 36) * 64, (r3 % 36) * 64, (bf16_t*)(p.ws + OFF_WIN + l * SZ_WIN), D, 0, 0, ldsf);
            } else if (r < 5312) {
                const int r3 = r - 4800;
                transpose_tile(p.w_gate + (size_t)l * D * 2048, 2048, (r3 / 32) * 64, (r3 % 32) * 64, (bf16_t*)(p.ws + OFF_WIN + l * SZ_WIN), D, 0, 2304, ldsf);
            } else if (r < 5440) {
                const int r3 = r - 5312;
                transpose_tile(p.w_ba + (size_t)l * 512 * D, D, (r3 / 16) * 64, (r3 % 16) * 64, (bf16_t*)(p.ws + OFF_WBA + l * SZ_WB), 512, 1, 0, ldsf);
            } else if (r < 5568) {
                const int r3 = r - 5440;
                transpose_tile(p.w_bb + (size_t)l * 512 * D, D, (r3 / 16) * 64, (r3 % 16) * 64, (bf16_t*)(p.ws + OFF_WBB + l * SZ_WB), 512, 1, 0, ldsf);
            } else {
                const int r3 = r - 5568;
                transpose_tile(p.w_o + (size_t)l * D * D, D, (r3 / 16) * 64, (r3 % 16) * 64, (bf16_t*)(p.ws + OFF_WO + l * SZ_WO), D, 1, 0, ldsf);
            }
        }
    }
}

DI void phase_norm(const float* hin, const float* __restrict__ g, const float* __restrict__ sh, const float* __restrict__ sc, bf16_t* nout, float* fout) {
    const int lane = threadIdx.x & 63, wid = threadIdx.x >> 6;
    const int nw = gridDim.x * 8;
    for (int row = blockIdx.x * 8 + wid; row < S; row += nw) {
        const float* hp = hin + (size_t)row * D;
        f32x4 v[4]; float ss = 0.f;
#pragma unroll
        for (int i = 0; i < 4; ++i) { v[i] = *(const f32x4*)(hp + (i * 64 + lane) * 4); ss += v[i][0] * v[i][0] + v[i][1] * v[i][1] + v[i][2] * v[i][2] + v[i][3] * v[i][3]; }
#pragma unroll
        for (int o = 32; o > 0; o >>= 1) ss += __shfl_xor(ss, o);
        const float rstd = rsqrtf(ss * (1.0f / 1024.0f) + 1e-6f);
#pragma unroll
        for (int i = 0; i < 4; ++i) {
            const int col = (i * 64 + lane) * 4;
            const f32x4 gv = *(const f32x4*)(g + col);
            f32x4 y = v[i] * rstd * gv;
            if (sc) { const f32x4 s1 = *(const f32x4*)(sc + col), s0 = *(const f32x4*)(sh + col); y = y * (1.0f + s1) + s0; }
            if (fout) *(f32x4*)(fout + (size_t)row * D + col) = y;
            else { u32x2 pk = {pk2(y[0], y[1]), pk2(y[2], y[3])}; *(u32x2*)(nout + (size_t)row * D + col) = pk; }
        }
    }
}

DI void glds16(const void* g, char* l) { __builtin_amdgcn_global_load_lds((const unsigned*)g, (unsigned*)l, 16, 0, 0); }
template <int N> DI void waitv() { asm volatile("s_waitcnt vmcnt(%0)" ::"n"(N) : "memory"); }
DI void rawbar() { __builtin_amdgcn_s_barrier(); }
constexpr int GST = 49152;
DI void gemm_mainloop(const bf16_t* __restrict__ A, int lda, const bf16_t* __restrict__ W, int ldw, int K, f32x4 (&acc)[4][4], char* lds) {
    const int tid = otid(), lane = tid & 63, wid = tid >> 6, wt = wid >> 1, wc = wid & 1;
    const int srow = tid >> 3, sch = (tid & 7) ^ ((srow >> 1) & 7);
    const bf16_t* ag = A + (size_t)srow * lda + sch * 8;
    const bf16_t* wg = W + (size_t)srow * ldw + sch * 8;
    char* const ld = lds + tid * 16;
    const int nk = K >> 6;
#define G_ISSUE(kt_, st_) do { const int ko_ = (kt_) * 64; char* sn_ = ld + (st_) * GST; \
        _Pragma("unroll") for (int i = 0; i < 4; ++i) glds16(ag + (size_t)(64 * i) * lda + ko_, sn_ + i * 8192); \
        _Pragma("unroll") for (int i = 0; i < 2; ++i) glds16(wg + (size_t)(64 * i) * ldw + ko_, sn_ + 32768 + i * 8192); } while (0)
    waitv<0>();
    G_ISSUE(0, 0); G_ISSUE(1, 1);
    const int fr = lane & 15, fq = lane >> 4, sw = (fr >> 1) & 7;
    const int a_base = (64 * wt + fr) * 128, w_base = 32768 + (64 * wc + fr) * 128;
    int cur = 0, nxt = 2;
    for (int kt = 0; kt < nk; ++kt) {
        if (kt + 1 < nk) waitv<6>(); else waitv<0>();
        rawbar();
        if (kt + 2 < nk) G_ISSUE(kt + 2, nxt);
        const char* st = lds + cur * GST;
#pragma unroll
        for (int kk = 0; kk < 2; ++kk) {
            const int co = ((kk * 4 + fq) ^ sw) << 4;
            bf16x8 af[4], wf[4];
#pragma unroll
            for (int i = 0; i < 4; ++i) af[i] = *(const bf16x8*)(st + a_base + i * 2048 + co);
#pragma unroll
            for (int i = 0; i < 4; ++i) wf[i] = *(const bf16x8*)(st + w_base + i * 2048 + co);
#pragma unroll
            for (int mw = 0; mw < 4; ++mw)
#pragma unroll
                for (int nt = 0; nt < 4; ++nt) acc[mw][nt] = __builtin_amdgcn_mfma_f32_16x16x32_bf16(wf[mw], af[nt], acc[mw][nt], 0, 0, 0);
        }
        cur = cur == 2 ? 0 : cur + 1; nxt = nxt == 2 ? 0 : nxt + 1;
    }
#undef G_ISSUE
    __syncthreads();
}
DI void zero_acc(f32x4 (&acc)[4][4]) {
#pragma unroll
    for (int a = 0; a < 4; ++a)
#pragma unroll
        for (int b = 0; b < 4; ++b) acc[a][b] = (f32x4){0.f, 0.f, 0.f, 0.f};
}

DI void phase_gateup(const bf16_t* n, const bf16_t* wgu, bf16_t* act, char* lds) {
    const int tid_ = otid(), lane = tid_ & 63, wid = tid_ >> 6, wt = wid >> 1, wc = wid & 1, fr = lane & 15, fq = lane >> 4;
    constexpr int NTILES = 64 * (NGU / 128);
    for (int t = blockIdx.x; t < NTILES; t += gridDim.x) {
        const int bm = t & 63, bn = t >> 6, row0 = bm * 256;
        f32x4 acc[4][4]; zero_acc(acc);
        gemm_mainloop(n + (size_t)row0 * D, D, wgu + (size_t)bn * 128 * D, D, D, acc, lds);
#pragma unroll
        for (int nt = 0; nt < 4; ++nt) {
            const int token = row0 + 64 * wt + 16 * nt + fr;
            float v[8];
#pragma unroll
            for (int m = 0; m < 2; ++m)
#pragma unroll
                for (int r = 0; r < 4; ++r) { const float gg = acc[m][nt][r], uu = acc[m + 2][nt][r]; v[4 * m + r] = gg * fast_rcp(1.0f + __expf(-gg)) * uu; }
            u32x4 pk = {pk2(v[0], v[1]), pk2(v[2], v[3]), pk2(v[4], v[5]), pk2(v[6], v[7])};
            *(u32x4*)(act + (size_t)token * F + 64 * bn + 32 * wc + 8 * fq) = pk;
        }
    }
}

DI void phase_resid(const bf16_t* A, int K, const bf16_t* W, const float* hin, float* hout, const float* __restrict__ gvec, float gs, char* lds) {
    const int tid_ = otid(), lane = tid_ & 63, wid = tid_ >> 6, wt = wid >> 1, wc = wid & 1, fr = lane & 15, fq = lane >> 4;
    constexpr int NTILES = 64 * 8;
    for (int t = blockIdx.x; t < NTILES; t += gridDim.x) {
        const int bm = t & 63, bn = t >> 6, row0 = bm * 256, ch0 = bn * 128 + 64 * wc + 16 * fq;
        f32x4 acc[4][4]; zero_acc(acc);
        gemm_mainloop(A + (size_t)row0 * K, K, W + (size_t)bn * 128 * K, K, K, acc, lds);
        f32x4 gv[4];
#pragma unroll
        for (int mw = 0; mw < 4; ++mw) gv[mw] = *(const f32x4*)(gvec + ch0 + 4 * mw) * gs;
#pragma unroll
        for (int nt = 0; nt < 4; ++nt) {
            const size_t off = (size_t)(row0 + 64 * wt + 16 * nt + fr) * D + ch0;
#pragma unroll
            for (int mw = 0; mw < 4; ++mw) { const f32x4 hv = *(const f32x4*)(hin + off + 4 * mw); *(f32x4*)(hout + off + 4 * mw) = hv + gv[mw] * acc[mw][nt]; }
        }
    }
}

DI void phase_merge(const bf16_t* atta, const bf16_t* od, const bf16_t* wba, const bf16_t* wbb, const bf16_t* G, bf16_t* merged, float* spill, char* lds) {
    const int tid_ = otid(), lane = tid_ & 63, wid = tid_ >> 6, wt = wid >> 1, wc = wid & 1, fr = lane & 15, fq = lane >> 4;
    constexpr int NTILES = 64 * 8;
    for (int t = blockIdx.x; t < NTILES; t += gridDim.x) {
        const int bm = t & 63, bn = t >> 6, row0 = bm * 256, ch0 = bn * 128 + 64 * wc + 16 * fq;
        f32x4 acc[4][4]; zero_acc(acc);
        gemm_mainloop(atta + (size_t)row0 * 512, 512, wba + (size_t)bn * 128 * 512, 512, 512, acc, lds);
        float* sp = spill + ((size_t)blockIdx.x * 16 * 512 + tid_) * 4;
#pragma unroll
        for (int nt = 0; nt < 4; ++nt) {
            const bf16_t* gp = G + (size_t)(row0 + 64 * wt + 16 * nt + fr) * 2048 + ch0;
#pragma unroll
            for (int mw = 0; mw < 4; ++mw) { const u32x2 gu = *(const u32x2*)(gp + 4 * mw); const f32x4 ga = {bf_lo(gu[0]), bf_hi(gu[0]), bf_lo(gu[1]), bf_hi(gu[1])};
                *(f32x4*)(sp + (size_t)(nt * 4 + mw) * 2048) = ga * acc[mw][nt]; }
        }
        zero_acc(acc);
        gemm_mainloop(od + (size_t)row0 * 512, 512, wbb + (size_t)bn * 128 * 512, 512, 512, acc, lds);
#pragma unroll
        for (int nt = 0; nt < 4; ++nt) {
            const size_t tok = (size_t)(row0 + 64 * wt + 16 * nt + fr);
            const bf16_t* gp = G + tok * 2048 + 1024 + ch0;
            unsigned w[8];
#pragma unroll
            for (int mw = 0; mw < 4; ++mw) { const u32x2 gu = *(const u32x2*)(gp + 4 * mw); const f32x4 gb = {bf_lo(gu[0]), bf_hi(gu[0]), bf_lo(gu[1]), bf_hi(gu[1])};
                const f32x4 o = *(const f32x4*)(sp + (size_t)(nt * 4 + mw) * 2048) + gb * acc[mw][nt]; w[2 * mw] = pk2(o[0], o[1]); w[2 * mw + 1] = pk2(o[2], o[3]); }
            bf16_t* mp = merged + tok * D + ch0;
            *(u32x4*)(mp) = (u32x4){w[0], w[1], w[2], w[3]};
            *(u32x4*)(mp + 8) = (u32x4){w[4], w[5], w[6], w[7]};
        }
    }
}

DI void phase_win(const Params& p, int l, char* lds) {
    const int tid_ = otid(), lane = tid_ & 63, wid = tid_ >> 6, wt = wid >> 1, wc = wid & 1, fr = lane & 15, fq = lane >> 4;
    const bf16_t* n = (const bf16_t*)(p.ws + OFF_N);
    const bf16_t* W = (const bf16_t*)(p.ws + OFF_WIN + l * SZ_WIN);
    bf16_t* Q = (bf16_t*)(p.ws + OFF_Q); bf16_t* QD = (bf16_t*)(p.ws + OFF_QD); bf16_t* KA = (bf16_t*)(p.ws + OFF_KA); bf16_t* VTA = (bf16_t*)(p.ws + OFF_VTA);
    bf16_t* KD = (bf16_t*)(p.ws + OFF_KD); bf16_t* VTD = (bf16_t*)(p.ws + OFF_VTD); bf16_t* G = (bf16_t*)(p.ws + OFF_G);
    const float* rope = (const float*)(p.ws + OFF_ROPE);
    constexpr int NTILES = 64 * (NIN / 128);
    for (int t = blockIdx.x; t < NTILES; t += gridDim.x) {
        const int bm = t & 63, bn = t >> 6, row0 = bm * 256;
        f32x4 acc[4][4]; zero_acc(acc);
        gemm_mainloop(n + (size_t)row0 * D, D, W + (size_t)bn * 128 * D, D, D, acc, lds);
        const int cw = bn * 128 + 64 * wc;
        if (cw < 640) {
            const bool isq = cw < 512;
            const float* gq = p.qk_g + l * 128 + (isq ? 0 : 64);
            f32x4 gv[4];
#pragma unroll
            for (int mw = 0; mw < 4; ++mw) gv[mw] = *(const f32x4*)(gq + 16 * mw + 4 * fq);
#pragma unroll
            for (int nt = 0; nt < 4; ++nt) {
                const int token = row0 + 64 * wt + 16 * nt + fr;
                float ss = 0.f;
#pragma unroll
                for (int mw = 0; mw < 4; ++mw) ss += acc[mw][nt][0] * acc[mw][nt][0] + acc[mw][nt][1] * acc[mw][nt][1] + acc[mw][nt][2] * acc[mw][nt][2] + acc[mw][nt][3] * acc[mw][nt][3];
                ss += __shfl_xor(ss, 16); ss += __shfl_xor(ss, 32);
                const float rstd = rsqrtf(ss * (1.0f / 64.0f) + 1e-6f);
                f32x4 y[4];
#pragma unroll
                for (int mw = 0; mw < 4; ++mw) y[mw] = acc[mw][nt] * rstd * gv[mw];
                const int prow = token >> 6, pcol = token & 63;
                const f32x4 cr = *(const f32x4*)(rope + prow * 16 + 4 * fq), sr = *(const f32x4*)(rope + 4096 + prow * 16 + 4 * fq);
                const f32x4 cc = *(const f32x4*)(rope + 8192 + pcol * 16 + 4 * fq), sc = *(const f32x4*)(rope + 9216 + pcol * 16 + 4 * fq);
                f32x4 o[4];
                o[0] = y[0] * cr - y[1] * sr; o[1] = y[1] * cr + y[0] * sr; o[2] = y[2] * cc - y[3] * sc; o[3] = y[3] * cc + y[2] * sc;
                const float qs = isq ? QSCALE : 1.0f;
                bf16_t* dst = isq ? (Q + (size_t)token * 512 + cw) : (KA + (size_t)token * 128 + (cw - 512));
#pragma unroll
                for (int mw = 0; mw < 4; ++mw) { const f32x4 z = o[mw] * qs; *(u32x2*)(dst + 16 * mw + 4 * fq) = (u32x2){pk2(z[0], z[1]), pk2(z[2], z[3])}; }
            }
        } else if (cw < 768 || (cw >= 1792 && cw < 2304)) {
            bf16_t* vt = cw < 768 ? (VTA + (size_t)(cw - 640) * S) : (VTD + (size_t)(cw - 1792) * S);
#pragma unroll
            for (int nt = 0; nt < 4; ++nt) {
                const int token = row0 + 64 * wt + 16 * nt + fr;
#pragma unroll
                for (int mw = 0; mw < 4; ++mw)
#pragma unroll
                    for (int r = 0; r < 4; ++r) vt[(size_t)(16 * mw + 4 * fq + r) * S + token] = (bf16_t)(pk2(acc[mw][nt][r], 0.f) & 0xffffu);
            }
        } else if (cw < 1792) {
            const bool isq = cw < 1280; const float qs = isq ? QSCALE : 1.0f;
            bf16_t* base = isq ? (QD + (cw - 768)) : (KD + (cw - 1280));
            float nmax = 0.f;
#pragma unroll
            for (int nt = 0; nt < 4; ++nt) {
                bf16_t* dst = base + (size_t)(row0 + 64 * wt + 16 * nt + fr) * 512;
                float ss = 0.f;
#pragma unroll
                for (int mw = 0; mw < 4; ++mw) { const f32x4 z = acc[mw][nt] * qs; ss += z[0] * z[0] + z[1] * z[1] + z[2] * z[2] + z[3] * z[3];
                    *(u32x2*)(dst + 16 * mw + 4 * fq) = (u32x2){pk2(z[0], z[1]), pk2(z[2], z[3])}; }
                nmax = __builtin_fmaxf(nmax, ss);
                if (nt == 3) { }
            }
            {
                float best = 0.f;
#pragma unroll
                for (int nt = 0; nt < 4; ++nt) {
                    float ss = 0.f;
#pragma unroll
                    for (int mw = 0; mw < 4; ++mw) { const f32x4 z = acc[mw][nt] * qs; ss += z[0] * z[0] + z[1] * z[1] + z[2] * z[2] + z[3] * z[3]; }
                    ss += __shfl_xor(ss, 16); ss += __shfl_xor(ss, 32);
                    best = __builtin_fmaxf(best, ss);
                }
#pragma unroll
                for (int o = 8; o > 0; o >>= 1) best = __builtin_fmaxf(best, __shfl_xor(best, o));
                (void)nmax;
                if (lane == 0) atomicMax((unsigned*)(p.ws + OFF_STAT) + l * 16 + (isq ? 0 : 8) + ((cw - (isq ? 768 : 1280)) >> 6), __float_as_uint(best));
            }
        } else {
            const int gc = cw - 2304;
            const float* bg = p.b_gate + l * 2048 + gc;
            f32x4 bv[4];
#pragma unroll
            for (int mw = 0; mw < 4; ++mw) bv[mw] = *(const f32x4*)(bg + 16 * mw + 4 * fq);
#pragma unroll
            for (int nt = 0; nt < 4; ++nt) {
                bf16_t* dst = G + (size_t)(row0 + 64 * wt + 16 * nt + fr) * 2048 + gc;
#pragma unroll
                for (int mw = 0; mw < 4; ++mw) {
                    const f32x4 xx = acc[mw][nt] + bv[mw]; f32x4 z;
#pragma unroll
                    for (int r = 0; r < 4; ++r) z[r] = fast_rcp(1.0f + __expf(-xx[r]));
                    *(u32x2*)(dst + 16 * mw + 4 * fq) = (u32x2){pk2(z[0], z[1]), pk2(z[2], z[3])};
                }
            }
        }
    }
}

#define MFMA32(a, b, c) __builtin_amdgcn_mfma_f32_32x32x16_bf16((a), (b), (c), 0, 0, 0)
template <int DV, bool ALIBI>
DI void attn_pass(const bf16_t* __restrict__ Qp, const bf16_t* __restrict__ Kb, int kpitch, const bf16_t* __restrict__ Vtb, float slope2, int qpos, int t_lo, int t_hi,
                  f32x16 (&o)[DV / 32], float& l_out, char* lds) {
    constexpr int NV = DV / 64, NDT = DV / 32, STAGE = 8192 + DV * 128, G = 1 + NV;
    const int tid = otid(), lane = tid & 63, r32 = lane & 31, h = lane >> 5;
    bf16x8 qf[4];
#pragma unroll
    for (int d0 = 0; d0 < 4; ++d0) qf[d0] = *(const bf16x8*)(Qp + 16 * d0 + 8 * h);
    const int srow = tid >> 3, sch = (tid & 7) ^ ((srow >> 1) & 7);
    const bf16_t* kg = Kb + (size_t)srow * kpitch + sch * 8;
    const bf16_t* vg = Vtb + (size_t)srow * S + sch * 8;
    char* const ld = lds + tid * 16;
#define A_ISSUE(t_, st_) do { char* sn_ = ld + (st_) * STAGE; glds16(kg + (size_t)(t_) * 64 * kpitch, sn_); \
        _Pragma("unroll") for (int i = 0; i < NV; ++i) glds16(vg + (size_t)(64 * i) * S + (t_) * 64, sn_ + 8192 + i * 8192); } while (0)
    waitv<0>();
    A_ISSUE(t_lo, 0);
    if (t_lo + 1 <= t_hi) A_ISSUE(t_lo + 1, 1);
    if (t_lo + 2 <= t_hi) A_ISSUE(t_lo + 2, 2);
    const int pi = (r32 & 0x13) | ((r32 & 4) << 1) | ((r32 & 8) >> 1);
    const int k_base = pi * 128, k_sw = (pi >> 1) & 7, v_base = 8192 + r32 * 128, v_sw = (r32 >> 1) & 7;
    float m = -1e30f, l = 0.f;
#pragma unroll
    for (int dt = 0; dt < NDT; ++dt)
#pragma unroll
        for (int r = 0; r < 16; ++r) o[dt][r] = 0.f;
    int cur = 0;
    for (int t = t_lo; t <= t_hi; ++t) {
        const int rem = t_hi - t;
        if (rem >= 2) waitv<2 * G>(); else if (rem == 1) waitv<G>(); else waitv<0>();
        rawbar();
        if (rem >= 3) A_ISSUE(t + 3, (cur + 3) & 3);
        const char* st = lds + cur * STAGE;
        cur = (cur + 1) & 3;
        f32x16 sc[2];
#pragma unroll
        for (int kt = 0; kt < 2; ++kt) {
#pragma unroll
            for (int r = 0; r < 16; ++r) sc[kt][r] = 0.f;
#pragma unroll
            for (int d0 = 0; d0 < 4; ++d0) {
                const bf16x8 kf = *(const bf16x8*)(st + kt * 4096 + k_base + (((2 * d0 + h) ^ k_sw) << 4));
                sc[kt] = MFMA32(kf, qf[d0], sc[kt]);
            }
        }
        SB();
        if (ALIBI) {
#pragma unroll
            for (int kt = 0; kt < 2; ++kt) {
                const float dq = (float)(qpos - (64 * t + 32 * kt + 8 * h));
#pragma unroll
                for (int r = 0; r < 16; ++r) sc[kt][r] = __builtin_fmaf(-slope2, __builtin_fabsf(dq - (float)(16 * (r >> 3) + (r & 7))), sc[kt][r]);
            }
        }
        float mt = sc[0][0];
#pragma unroll
        for (int r = 1; r < 16; ++r) mt = __builtin_fmaxf(mt, sc[0][r]);
#pragma unroll
        for (int r = 0; r < 16; ++r) mt = __builtin_fmaxf(mt, sc[1][r]);
        mt = __builtin_fmaxf(mt, __shfl_xor(mt, 32));
        if (__any(mt > m + 8.0f)) {
            const float mn = __builtin_fmaxf(m, mt), al = fast_exp2(m - mn);
            l *= al; m = mn;
#pragma unroll
            for (int dt = 0; dt < NDT; ++dt)
#pragma unroll
                for (int r = 0; r < 16; ++r) o[dt][r] *= al;
        }
        float ps = 0.f;
#pragma unroll
        for (int kt = 0; kt < 2; ++kt)
#pragma unroll
            for (int r = 0; r < 16; ++r) { const float e = fast_exp2(sc[kt][r] - m); sc[kt][r] = e; ps += e; }
        l += ps;
        bf16x8 pf[4];
#pragma unroll
        for (int ks = 0; ks < 4; ++ks) {
            const int kt = ks >> 1, b = (ks & 1) * 8;
            u32x4 w = {pk2(sc[kt][b], sc[kt][b + 1]), pk2(sc[kt][b + 2], sc[kt][b + 3]), pk2(sc[kt][b + 4], sc[kt][b + 5]), pk2(sc[kt][b + 6], sc[kt][b + 7])};
            pf[ks] = __builtin_bit_cast(bf16x8, w);
        }
        SB();
#pragma unroll
        for (int dt = 0; dt < NDT; ++dt) {
#pragma unroll
            for (int ks = 0; ks < 4; ++ks) {
                const bf16x8 vf = *(const bf16x8*)(st + v_base + dt * 4096 + (((2 * ks + h) ^ v_sw) << 4));
                o[dt] = MFMA32(vf, pf[ks], o[dt]);
            }
            if (dt & 1) SB();
        }
    }
#undef A_ISSUE
    __syncthreads();
    l += __shfl_xor(l, 32);
    l_out = l;
}

DI void phase_attn(const Params& p, int l, char* lds) {
    const int tid = otid(), lane = tid & 63, wid = tid >> 6, r32 = lane & 31, h = lane >> 5;
    const bf16_t* Q = (const bf16_t*)(p.ws + OFF_Q); const bf16_t* QD = (const bf16_t*)(p.ws + OFF_QD); const bf16_t* KA = (const bf16_t*)(p.ws + OFF_KA);
    const bf16_t* VTA = (const bf16_t*)(p.ws + OFF_VTA); const bf16_t* KD = (const bf16_t*)(p.ws + OFF_KD); const bf16_t* VTD = (const bf16_t*)(p.ws + OFF_VTD);
    bf16_t* ATTA = (bf16_t*)(p.ws + OFF_ATTA); bf16_t* OD = (bf16_t*)(p.ws + OFF_OD); float* BO0 = (float*)(p.ws + OFF_N);
    const float lam = ((const float*)(p.ws + OFF_LAM))[l];
    const float oml = 1.0f - (l == 0 ? 0.2f : 0.35550906759096926f);
    unsigned* qcnt = (unsigned*)(p.ws + OFF_STAT) + 32 + l;
    const unsigned* stat = (const unsigned*)(p.ws + OFF_STAT) + l * 16;
    volatile unsigned* lword = (volatile unsigned*)(lds + 147456 - 16);
    for (;;) {
        if (tid == 0) *lword = atomicAdd(qcnt, 1u);
        __syncthreads();
        const int u = (int)*lword;
        __syncthreads();
        if (u >= 768) break;
        if (u < 128 || u >= 640) {
            const int hb = u < 64 ? 3 : (u < 128 ? 2 : (u < 704 ? 1 : 0)), qb = u & 63;
            const int token = 256 * qb + 32 * wid + r32;
            const float slope2 = exp2f(-2.0f * (float)(hb + 1)) * LOG2E;
            float* bo = BO0 + (size_t)token * 512 + hb * 128;
            f32x16 o[4]; float ls;
            int tl[2], th[2];
#pragma unroll
            for (int mp = 0; mp < 2; ++mp) {
                const float qk = sqrtf(__uint_as_float(stat[mp * 4 + hb]) * __uint_as_float(stat[8 + mp * 4 + hb])) * 1.02f;
                const float R = __builtin_fminf((2.0f * qk + 150.0f) / slope2, 40000.0f);
                const int klo = 256 * qb - (int)R - 1, khi = 256 * qb + 255 + (int)R + 1;
                tl[mp] = klo < 0 ? 0 : (klo >> 6); th[mp] = khi >= S ? (S / 64 - 1) : (khi >> 6);
            }
            attn_pass<128, true>(QD + (size_t)token * 512 + hb * 64, KD + hb * 64, 512, VTD + (size_t)(hb * 128) * S, slope2, token, tl[0], th[0], o, ls, lds);
            {
                const float inv = 1.0f / ls;
#pragma unroll
                for (int dt = 0; dt < 4; ++dt)
#pragma unroll
                    for (int g = 0; g < 4; ++g) *(f32x4*)(bo + 32 * dt + 8 * g + 4 * h) = (f32x4){o[dt][4 * g] * inv, o[dt][4 * g + 1] * inv, o[dt][4 * g + 2] * inv, o[dt][4 * g + 3] * inv};
            }
            attn_pass<128, true>(QD + (size_t)token * 512 + 256 + hb * 64, KD + 256 + hb * 64, 512, VTD + (size_t)(hb * 128) * S, slope2, token, tl[1], th[1], o, ls, lds);
            {
                const float inv = lam / ls; float ss = 0.f;
#pragma unroll
                for (int dt = 0; dt < 4; ++dt)
#pragma unroll
                    for (int g = 0; g < 4; ++g) {
                        const f32x4 a = *(const f32x4*)(bo + 32 * dt + 8 * g + 4 * h);
#pragma unroll
                        for (int j = 0; j < 4; ++j) { const float v = a[j] - o[dt][4 * g + j] * inv; o[dt][4 * g + j] = v; ss += v * v; }
                    }
                ss += __shfl_xor(ss, 32);
                const float rstd = rsqrtf(ss * (1.0f / 128.0f) + 1e-6f) * oml;
                const float* sg = p.subln_g + l * 128;
                bf16_t* dst = OD + (size_t)token * 512 + hb * 128;
#pragma unroll
                for (int dt = 0; dt < 4; ++dt)
#pragma unroll
                    for (int g = 0; g < 4; ++g) {
                        const int d = 32 * dt + 8 * g + 4 * h;
                        const f32x4 gg = *(const f32x4*)(sg + d);
                        *(u32x2*)(dst + d) = (u32x2){pk2(o[dt][4 * g] * rstd * gg[0], o[dt][4 * g + 1] * rstd * gg[1]), pk2(o[dt][4 * g + 2] * rstd * gg[2], o[dt][4 * g + 3] * rstd * gg[3])};
                    }
            }
        } else {
            const int v = u - 128, kv = v >> 8, hq = kv * 4 + (v & 3), qb = (v >> 2) & 63;
            const int token = 256 * qb + 32 * wid + r32;
            f32x16 o[2]; float ls;
            attn_pass<64, false>(Q + (size_t)token * 512 + hq * 64, KA + kv * 64, 128, VTA + (size_t)(kv * 64) * S, 0.f, token, 0, S / 64 - 1, o, ls, lds);
            const float inv = 1.0f / ls;
            bf16_t* dst = ATTA + (size_t)token * 512 + hq * 64;
#pragma unroll
            for (int dt = 0; dt < 2; ++dt)
#pragma unroll
                for (int g = 0; g < 4; ++g)
                    *(u32x2*)(dst + 32 * dt + 8 * g + 4 * h) = (u32x2){pk2(o[dt][4 * g] * inv, o[dt][4 * g + 1] * inv), pk2(o[dt][4 * g + 2] * inv, o[dt][4 * g + 3] * inv)};
        }
    }
}

__global__ void __launch_bounds__(512) mega(Params p) {
    __shared__ __attribute__((aligned(16))) char lds[147456];
    cg::grid_group grid = cg::this_grid();
    bf16_t* nbuf = (bf16_t*)(p.ws + OFF_N);
    bf16_t* act = (bf16_t*)(p.ws + OFF_ACT);
    int rep = 0;
    for (int ph = p.ph_lo; ph < p.ph_hi; ++ph) {
        if (ph == 0) phase_prologue(p, lds);
        else {
            const int l = ph == 23 ? 1 : (ph - 1) / 11, k = ph == 23 ? 11 : (ph - 1) % 11;
            const float* mod = (const float*)(p.ws + OFF_MOD) + l * 9216;
            switch (k) {
            case 0: case 3: case 8: case 11: {
                const int i = k == 0 ? 0 : (k == 3 ? 1 : 2);
                const float* hin = (ph == 1) ? p.x : p.out;
                if (k == 11) phase_norm(hin, p.final_g, nullptr, nullptr, nullptr, p.out);
                else phase_norm(hin, p.norm_g + (l * 3 + i) * D, mod + (3 * i) * D, mod + (3 * i + 1) * D, nbuf, nullptr);
            } break;
            case 1: case 9: {
                const int f = k == 1 ? 0 : 1;
                phase_gateup(nbuf, (const bf16_t*)(p.ws + OFF_WGU + (size_t)(l * 2 + f) * SZ_WGU), act, lds);
            } break;
            case 2: case 10: case 7: {
                if (k == 7) phase_resid((const bf16_t*)(p.ws + OFF_Q), D, (const bf16_t*)(p.ws + OFF_WO + l * SZ_WO), p.out, p.out, mod + 5 * D, 1.0f, lds);
                else {
                    const int f = k == 2 ? 0 : 1;
                    phase_resid(act, F, (const bf16_t*)(p.ws + OFF_WD + (size_t)(l * 2 + f) * SZ_WD), (ph == 3) ? p.x : p.out, p.out, mod + (f == 0 ? 2 : 8) * D, 0.5f, lds);
                }
            } break;
            case 4: phase_win(p, l, lds); break;
            case 5: phase_attn(p, l, lds); break;
            case 6: phase_merge((const bf16_t*)(p.ws + OFF_ATTA), (const bf16_t*)(p.ws + OFF_OD), (const bf16_t*)(p.ws + OFF_WBA + l * SZ_WB), (const bf16_t*)(p.ws + OFF_WBB + l * SZ_WB),
                                (const bf16_t*)(p.ws + OFF_G), (bf16_t*)(p.ws + OFF_Q), (float*)(p.ws + OFF_N), lds); break;
            default: break;
            }
        }
        if (ph + 1 < p.ph_hi) grid.sync();
        if (PROBE_DUP >= 0 && rep == 0 && (ph == 0 ? PROBE_DUP == 100 : ((ph - 1) % 11 == PROBE_DUP && ph != 23))) { rep = 1; --ph; } else rep = 0;
    }
}

extern "C" void kernel_launch(void* const* d_in, const int* in_sizes, int n_in, void* d_out, int out_size, void* d_ws, size_t ws_size, hipStream_t stream) {
    if (n_in != 18 || out_size != S * D || ws_size < WS_END) { fprintf(stderr, "kernel_launch: unexpected shapes / workspace (n_in %d out %d ws %zu need %zu)\n", n_in, out_size, ws_size, (size_t)WS_END); return; }
    Params p{};
    const float** pp = (const float**)&p;
    for (int i = 0; i < 18; ++i) pp[i] = (const float*)d_in[i];
    p.out = (float*)d_out; p.ws = (unsigned char*)d_ws;
#if MK_MULTI
    for (int ph = 0; ph < NPH; ++ph) { p.ph_lo = ph; p.ph_hi = ph + 1; hipLaunchKernelGGL(mega, dim3(256), dim3(512), 0, stream, p); }
#else
    static int grid = 0;
    if (!grid) {
        int dev = 0, cus = 0, per_cu = 0;
        hipGetDevice(&dev); hipDeviceGetAttribute(&cus, hipDeviceAttributeMultiprocessorCount, dev);
        hipOccupancyMaxActiveBlocksPerMultiprocessor(&per_cu, (const void*)mega, 512, 0);
        if (per_cu < 1) { fprintf(stderr, "kernel_launch: occupancy query says %d blocks per CU\n", per_cu); per_cu = 1; }
        grid = cus;
    }
    p.ph_lo = 0; p.ph_hi = NPH;
    void* args[] = {&p};
    hipError_t e = hipLaunchCooperativeKernel((const void*)mega, dim3(grid), dim3(512), args, 0, stream);
    if (e != hipSuccess) fprintf(stderr, "cooperative launch failed: %s (grid %d)\n", hipGetErrorString(e), grid);
#endif
}
```

```cpp
#include <hip/hip_runtime.h>
#include <hip/hip_cooperative_groups.h>
#include <cstdio>
#include <cstdint>
namespace cg = cooperative_groups;

#ifndef MK_MULTI
#define MK_MULTI 0
#endif

#ifndef PROBE_DUP
#define PROBE_DUP -1
#endif
#define DI __device__ __forceinline__
typedef unsigned short bf16_t;
typedef short bf16x8 __attribute__((ext_vector_type(8)));
typedef float f32x4 __attribute__((ext_vector_type(4)));
typedef float f32x16 __attribute__((ext_vector_type(16)));
typedef unsigned u32x4 __attribute__((ext_vector_type(4)));
typedef unsigned u32x2 __attribute__((ext_vector_type(2)));

constexpr int S = 16384, D = 1024, F = 2816, NGU = 5632, NIN = 4352;
constexpr int NPH = 24;
constexpr float QSCALE = 0.125f * 1.4426950408889634f;
constexpr float LOG2E = 1.4426950408889634f;

constexpr size_t OFF_MOD = 0;
constexpr size_t OFF_LAM = 80000;
constexpr size_t OFF_STAT = 80128;
constexpr size_t OFF_ROPE = 81920;
constexpr size_t OFF_WGU = 1u << 20;
constexpr size_t SZ_WGU = (size_t)NGU * D * 2;
constexpr size_t OFF_WD = OFF_WGU + 4 * SZ_WGU;
constexpr size_t SZ_WD = (size_t)D * F * 2;
constexpr size_t OFF_WIN = OFF_WD + 4 * SZ_WD;
constexpr size_t SZ_WIN = (size_t)NIN * D * 2;
constexpr size_t OFF_WBA = OFF_WIN + 2 * SZ_WIN;
constexpr size_t SZ_WB = (size_t)D * 512 * 2;
constexpr size_t OFF_WBB = OFF_WBA + 2 * SZ_WB;
constexpr size_t OFF_WO = OFF_WBB + 2 * SZ_WB;
constexpr size_t SZ_WO = (size_t)D * D * 2;
constexpr size_t OFF_N = OFF_WO + 2 * SZ_WO;
constexpr size_t OFF_MIX = OFF_N + (size_t)S * D * 2;
constexpr size_t OFF_Q = OFF_MIX;
constexpr size_t OFF_QD = OFF_Q + (size_t)S * 512 * 2;
constexpr size_t OFF_KA = OFF_QD + (size_t)S * 512 * 2;
constexpr size_t OFF_VTA = OFF_KA + (size_t)S * 128 * 2;
constexpr size_t OFF_KD = OFF_VTA + (size_t)S * 128 * 2;
constexpr size_t OFF_VTD = OFF_KD + (size_t)S * 512 * 2;
constexpr size_t OFF_G = OFF_VTD + (size_t)S * 512 * 2;
constexpr size_t OFF_ATTA = OFF_G + (size_t)S * 2048 * 2;
constexpr size_t OFF_OD = OFF_ATTA + (size_t)S * 512 * 2;
constexpr size_t OFF_ACT = OFF_MIX;
constexpr size_t WS_END = OFF_OD + (size_t)S * 512 * 2;
static_assert((size_t)S * F * 2 <= WS_END - OFF_MIX, "act overlay");

struct Params {
    const float *x, *c, *ada_w, *ada_b, *norm_g, *ffn_wg, *ffn_wu, *ffn_wd, *w_in, *qk_g, *lam_p, *subln_g, *w_ba, *w_bb, *w_gate, *b_gate, *w_o, *final_g;
    float* out; unsigned char* ws; int ph_lo, ph_hi;
};

typedef __bf16 bf16v2 __attribute__((ext_vector_type(2)));
typedef float f32x2 __attribute__((ext_vector_type(2)));
DI unsigned pk2(float lo, float hi) { f32x2 v = {lo, hi}; bf16v2 b = __builtin_convertvector(v, bf16v2); return __builtin_bit_cast(unsigned, b); }
DI float bf_lo(unsigned u) { return __uint_as_float(u << 16); }
DI float bf_hi(unsigned u) { return __uint_as_float(u & 0xffff0000u); }
DI int lds_off(int row, int chunk) { return row * 128 + ((chunk ^ ((row >> 1) & 7)) << 4); }
DI float fast_exp2(float x) { return __builtin_amdgcn_exp2f(x); }
DI float fast_rcp(float x) { return __builtin_amdgcn_rcpf(x); }
DI int otid() { int t = threadIdx.x; asm volatile("" : "+v"(t)); return t; }
#define SB() __builtin_amdgcn_sched_barrier(0)

DI int perm64(int n) { return (n & ~63) | (((n >> 2) & 3) << 4) | (((n >> 4) & 3) << 2) | (n & 3); }
DI int gumap(int j) { return 128 * (j >> 6) + 64 * ((j >> 5) & 1) + 16 * ((j >> 2) & 1) + 4 * ((j >> 3) & 3) + (j & 3); }

struct TrDesc { const float* src; bf16_t* dst; int N, k0, n0, ldd, mode, roff; };
DI void tr_decode(const Params& p, int tt, TrDesc& d) {
    constexpr int N_TR_L = 5824;
    const int l = tt / N_TR_L, r = tt % N_TR_L;
    if (r < 4224) {
        const int f = r / 2112, r2 = r % 2112, which = r2 / 704, r3 = r2 % 704;
        const size_t lf = (size_t)(l * 2 + f);
        if (which < 2) { d.src = (which == 0 ? p.ffn_wg : p.ffn_wu) + lf * D * F; d.N = F; d.k0 = (r3 / 44) * 64; d.n0 = (r3 % 44) * 64; d.dst = (bf16_t*)(p.ws + OFF_WGU + lf * SZ_WGU); d.ldd = D; d.mode = 2; d.roff = which * 32; }
        else { d.src = p.ffn_wd + lf * F * D; d.N = D; d.k0 = (r3 / 16) * 64; d.n0 = (r3 % 16) * 64; d.dst = (bf16_t*)(p.ws + OFF_WD + lf * SZ_WD); d.ldd = F; d.mode = 1; d.roff = 0; }
    } else if (r < 4800) { const int r3 = r - 4224; d.src = p.w_in + (size_t)l * D * 2304; d.N = 2304; d.k0 = (r3 / 36) * 64; d.n0 = (r3 % 36) * 64; d.dst = (bf16_t*)(p.ws + OFF_WIN + l * SZ_WIN); d.ldd = D; d.mode = 0; d.roff = 0; }
    else if (r < 5312) { const int r3 = r - 4800; d.src = p.w_gate + (size_t)l * D * 2048; d.N = 2048; d.k0 = (r3 / 32) * 64; d.n0 = (r3 % 32) * 64; d.dst = (bf16_t*)(p.ws + OFF_WIN + l * SZ_WIN); d.ldd = D; d.mode = 0; d.roff = 2304; }
    else if (r < 5440) { const int r3 = r - 5312; d.src = p.w_ba + (size_t)l * 512 * D; d.N = D; d.k0 = (r3 / 16) * 64; d.n0 = (r3 % 16) * 64; d.dst = (bf16_t*)(p.ws + OFF_WBA + l * SZ_WB); d.ldd = 512; d.mode = 1; d.roff = 0; }
    else if (r < 5568) { const int r3 = r - 5440; d.src = p.w_bb + (size_t)l * 512 * D; d.N = D; d.k0 = (r3 / 16) * 64; d.n0 = (r3 % 16) * 64; d.dst = (bf16_t*)(p.ws + OFF_WBB + l * SZ_WB); d.ldd = 512; d.mode = 1; d.roff = 0; }
    else { const int r3 = r - 5568; d.src = p.w_o + (size_t)l * D * D; d.N = D; d.k0 = (r3 / 16) * 64; d.n0 = (r3 % 16) * 64; d.dst = (bf16_t*)(p.ws + OFF_WO + l * SZ_WO); d.ldd = D; d.mode = 1; d.roff = 0; }
}
DI void tr_load(const TrDesc& d, int tid, f32x4 (&v)[2]) {
    const int kk = tid >> 4, nn4 = (tid & 15) * 4;
#pragma unroll
    for (int ps = 0; ps < 2; ++ps) v[ps] = *(const f32x4*)(d.src + (size_t)(d.k0 + kk + 32 * ps) * d.N + d.n0 + nn4);
}
DI void tr_store(const TrDesc& d, int tid, const f32x4 (&v)[2], float* ldsf) {
    {
        const int kk = tid >> 4, nn4 = (tid & 15) * 4;
#pragma unroll
        for (int ps = 0; ps < 2; ++ps) { const int k = kk + 32 * ps; ldsf[k * 65 + nn4 + 0] = v[ps][0]; ldsf[k * 65 + nn4 + 1] = v[ps][1]; ldsf[k * 65 + nn4 + 2] = v[ps][2]; ldsf[k * 65 + nn4 + 3] = v[ps][3]; }
    }
    __syncthreads();
    {
        const int n = tid >> 3, ch = tid & 7, gn = d.n0 + n;
        int drow;
        if (d.mode == 0) drow = gn + d.roff; else if (d.mode == 1) drow = perm64(gn); else drow = gumap(gn) + d.roff;
        float w[8];
#pragma unroll
        for (int i = 0; i < 8; ++i) w[i] = ldsf[(ch * 8 + i) * 65 + n];
        u32x4 pk = {pk2(w[0], w[1]), pk2(w[2], w[3]), pk2(w[4], w[5]), pk2(w[6], w[7])};
        *(u32x4*)(d.dst + (size_t)drow * d.ldd + d.k0 + ch * 8) = pk;
    }
    __syncthreads();
}

DI void phase_prologue(const Params& p, char* lds) {
    const int tid = otid();
    float* ldsf = (float*)lds;
    constexpr int N_MOD = 288, N_TR = 2 * 5824;
    for (int it = blockIdx.x; it < N_MOD; it += gridDim.x) {
        const int l = it / 144, j0 = (it % 144) * 64, jj = tid & 15, ii = tid >> 4;
        float* cact = ldsf + 2048;
        for (int i = tid; i < 1024; i += 512) { const float cv = p.c[i]; cact[i] = cv / (1.f + expf(-cv)); }
        __syncthreads();
        f32x4 a = {0.f, 0.f, 0.f, 0.f};
        const float* wb = p.ada_w + (size_t)l * 1024 * 9216 + j0 + 4 * jj;
#pragma unroll 8
        for (int r = 0; r < 32; ++r) { const int i = ii + 32 * r; a += cact[i] * *(const f32x4*)(wb + (size_t)i * 9216); }
        *(f32x4*)(ldsf + ii * 64 + 4 * jj) = a;
        __syncthreads();
        if (tid < 64) {
            float sm = 0.f;
#pragma unroll
            for (int r = 0; r < 32; ++r) sm += ldsf[r * 64 + tid];
            ((float*)(p.ws + OFF_MOD))[l * 9216 + j0 + tid] = sm + p.ada_b[l * 9216 + j0 + tid];
        }
        __syncthreads();
    }
    if (blockIdx.x == gridDim.x - 1) {
        if (tid < 64) {
#pragma unroll
            for (int l = 0; l < 2; ++l) {
                const float* lp = p.lam_p + l * 256;
                float a = lp[tid] * lp[64 + tid], b = lp[128 + tid] * lp[192 + tid];
#pragma unroll
                for (int o = 32; o > 0; o >>= 1) { a += __shfl_xor(a, o); b += __shfl_xor(b, o); }
                const float li = l == 0 ? 0.2f : 0.35550906759096926f;
                if (tid == 0) ((float*)(p.ws + OFF_LAM))[l] = expf(a) - expf(b) + li;
            }
        }
        if (tid < 64) ((unsigned*)(p.ws + OFF_STAT))[tid] = 0u;
        float* rope = (float*)(p.ws + OFF_ROPE);
        for (int e = tid; e < 320 * 16; e += 512) {
            const int pi = e >> 4, i = e & 15;
            const int pos = pi < 256 ? pi - 128 : (pi - 256) - 32;
            const float inv = exp2f(-(float)i * (13.287712379549449f / 16.0f));
            const float angf = (float)pos * inv;
            double r = (double)angf; r -= rint(r * 0.15915494309189535) * 6.283185307179586;
            const double r2 = r * r;
            double sn = 0.0, cs = 0.0;
#pragma unroll 1
            for (int n = 14; n >= 1; --n) { sn = (sn + 1.0) * (-r2 / (double)((2 * n) * (2 * n + 1))); cs = (cs + 1.0) * (-r2 / (double)((2 * n - 1) * (2 * n))); }
            sn = (sn + 1.0) * r; cs = cs + 1.0;
            if (pi < 256) { rope[pi * 16 + i] = (float)cs; rope[4096 + pi * 16 + i] = (float)sn; }
            else { rope[8192 + (pi - 256) * 16 + i] = (float)cs; rope[9216 + (pi - 256) * 16 + i] = (float)sn; }
        }
    }
    {
        int tt = blockIdx.x;
        TrDesc d; f32x4 v[2];
        if (tt < N_TR) { tr_decode(p, tt, d); tr_load(d, tid, v); }
        while (tt < N_TR) {
            const int tn = tt + gridDim.x;
            TrDesc dn; f32x4 vn[2];
            if (tn < N_TR) { tr_decode(p, tn, dn); tr_load(dn, tid, vn); }
            tr_store(d, tid, v, ldsf);
            if (tn < N_TR) { d = dn; v[0] = vn[0]; v[1] = vn[1]; }
            tt = tn;
        }
    }
}

DI void phase_norm(const float* hin, const float* __restrict__ g, const float* __restrict__ sh, const float* __restrict__ sc, bf16_t* nout, float* fout) {
    const int tid_ = otid(), lane = tid_ & 63, wid = tid_ >> 6;
    const int nw = gridDim.x * 8;
    for (int row = blockIdx.x * 8 + wid; row < S; row += nw) {
        const float* hp = hin + (size_t)row * D;
        f32x4 v[4]; float ss = 0.f;
#pragma unroll
        for (int i = 0; i < 4; ++i) { v[i] = *(const f32x4*)(hp + (i * 64 + lane) * 4); ss += v[i][0] * v[i][0] + v[i][1] * v[i][1] + v[i][2] * v[i][2] + v[i][3] * v[i][3]; }
#pragma unroll
        for (int o = 32; o > 0; o >>= 1) ss += __shfl_xor(ss, o);
        const float rstd = rsqrtf(ss * (1.0f / 1024.0f) + 1e-6f);
#pragma unroll
        for (int i = 0; i < 4; ++i) {
            const int col = (i * 64 + lane) * 4;
            const f32x4 gv = *(const f32x4*)(g + col);
            f32x4 y = v[i] * rstd * gv;
            if (sc) { const f32x4 s1 = *(const f32x4*)(sc + col), s0 = *(const f32x4*)(sh + col); y = y * (1.0f + s1) + s0; }
            if (fout) *(f32x4*)(fout + (size_t)row * D + col) = y;
            else { u32x2 pk = {pk2(y[0], y[1]), pk2(y[2], y[3])}; *(u32x2*)(nout + (size_t)row * D + col) = pk; }
        }
    }
}

DI void glds16(const void* g, char* l) { __builtin_amdgcn_global_load_lds((const unsigned*)g, (unsigned*)l, 16, 0, 0); }
template <int N> DI void waitv() { asm volatile("s_waitcnt vmcnt(%0)" ::"n"(N) : "memory"); }
DI void rawbar() { __builtin_amdgcn_s_barrier(); }
constexpr int GST = 49152;
DI void gemm_mainloop(const bf16_t* __restrict__ A, int lda, const bf16_t* __restrict__ W, int ldw, int K, f32x4 (&acc)[4][4], char* lds) {
    const int tid = otid(), lane = tid & 63, wid = tid >> 6, wt = wid >> 1, wc = wid & 1;
    const int srow = tid >> 3, sch = (tid & 7) ^ ((srow >> 1) & 7);
    const bf16_t* ag = A + (size_t)srow * lda + sch * 8;
    const bf16_t* wg = W + (size_t)srow * ldw + sch * 8;
    char* const ld = lds + tid * 16;
    const int nk = K >> 6;
#define G_ISSUE(kt_, st_) do { const int ko_ = (kt_) * 64; char* sn_ = ld + (st_) * GST; \
        _Pragma("unroll") for (int i = 0; i < 4; ++i) glds16(ag + (size_t)(64 * i) * lda + ko_, sn_ + i * 8192); \
        _Pragma("unroll") for (int i = 0; i < 2; ++i) glds16(wg + (size_t)(64 * i) * ldw + ko_, sn_ + 32768 + i * 8192); } while (0)
    waitv<0>();
    G_ISSUE(0, 0); G_ISSUE(1, 1);
    const int fr = lane & 15, fq = lane >> 4, sw = (fr >> 1) & 7;
    const int a_base = (64 * wt + fr) * 128, w_base = 32768 + (64 * wc + fr) * 128;
    int cur = 0, nxt = 2;
    for (int kt = 0; kt < nk; ++kt) {
        if (kt + 1 < nk) waitv<6>(); else waitv<0>();
        rawbar();
        if (kt + 2 < nk) G_ISSUE(kt + 2, nxt);
        const char* st = lds + cur * GST;
#pragma unroll
        for (int kk = 0; kk < 2; ++kk) {
            const int co = ((kk * 4 + fq) ^ sw) << 4;
            bf16x8 af[4], wf[4];
#pragma unroll
            for (int i = 0; i < 4; ++i) af[i] = *(const bf16x8*)(st + a_base + i * 2048 + co);
#pragma unroll
            for (int i = 0; i < 4; ++i) wf[i] = *(const bf16x8*)(st + w_base + i * 2048 + co);
#pragma unroll
            for (int mw = 0; mw < 4; ++mw)
#pragma unroll
                for (int nt = 0; nt < 4; ++nt) acc[mw][nt] = __builtin_amdgcn_mfma_f32_16x16x32_bf16(wf[mw], af[nt], acc[mw][nt], 0, 0, 0);
        }
        cur = cur == 2 ? 0 : cur + 1; nxt = nxt == 2 ? 0 : nxt + 1;
    }
#undef G_ISSUE
    __syncthreads();
}
constexpr int GST2 = 65536;
DI void gemm_mainloop2(const bf16_t* __restrict__ A, int lda, const bf16_t* __restrict__ W, int ldw, int K, f32x4 (&acc)[4][8], char* lds) {
    const int tid = otid(), lane = tid & 63, wid = tid >> 6, wt = wid >> 2, wc = wid & 3;
    const int srow = tid >> 3, sch = (tid & 7) ^ ((srow >> 1) & 7);
    const bf16_t* ag = A + (size_t)srow * lda + sch * 8;
    const bf16_t* wg = W + (size_t)srow * ldw + sch * 8;
    char* const ld = lds + tid * 16;
    const int nk = K >> 6;
#define G2_ISSUE(kt_, st_) do { const int ko_ = (kt_) * 64; char* sn_ = ld + (st_) * GST2; \
        _Pragma("unroll") for (int i = 0; i < 4; ++i) glds16(ag + (size_t)(64 * i) * lda + ko_, sn_ + i * 8192); \
        _Pragma("unroll") for (int i = 0; i < 4; ++i) glds16(wg + (size_t)(64 * i) * ldw + ko_, sn_ + 32768 + i * 8192); } while (0)
    waitv<0>();
    G2_ISSUE(0, 0);
    const int fr = lane & 15, fq = lane >> 4, sw = (fr >> 1) & 7;
    const int a_base = (128 * wt + fr) * 128, w_base = 32768 + (64 * wc + fr) * 128;
    for (int kt = 0; kt < nk; ++kt) {
        waitv<0>();
        rawbar();
        if (kt + 1 < nk) G2_ISSUE(kt + 1, (kt + 1) & 1);
        const char* st = lds + (kt & 1) * GST2;
#pragma unroll
        for (int kk = 0; kk < 2; ++kk) {
            const int co = ((kk * 4 + fq) ^ sw) << 4;
            bf16x8 af[8], wf[4];
#pragma unroll
            for (int i = 0; i < 4; ++i) wf[i] = *(const bf16x8*)(st + w_base + i * 2048 + co);
#pragma unroll
            for (int i = 0; i < 8; ++i) af[i] = *(const bf16x8*)(st + a_base + i * 2048 + co);
            __builtin_amdgcn_s_setprio(1);
#pragma unroll
            for (int nt = 0; nt < 8; ++nt)
#pragma unroll
                for (int mw = 0; mw < 4; ++mw) acc[mw][nt] = __builtin_amdgcn_mfma_f32_16x16x32_bf16(wf[mw], af[nt], acc[mw][nt], 0, 0, 0);
            __builtin_amdgcn_s_setprio(0);
            SB();
        }
    }
#undef G2_ISSUE
    __syncthreads();
}
DI void zero_acc2(f32x4 (&acc)[4][8]) {
#pragma unroll
    for (int a = 0; a < 4; ++a)
#pragma unroll
        for (int b = 0; b < 8; ++b) acc[a][b] = (f32x4){0.f, 0.f, 0.f, 0.f};
}
DI void zero_acc(f32x4 (&acc)[4][4]) {
#pragma unroll
    for (int a = 0; a < 4; ++a)
#pragma unroll
        for (int b = 0; b < 4; ++b) acc[a][b] = (f32x4){0.f, 0.f, 0.f, 0.f};
}

DI void phase_gateup(const bf16_t* n, const bf16_t* wgu, bf16_t* act, char* lds) {
    const int tid_ = otid(), lane = tid_ & 63, wid = tid_ >> 6, wt = wid >> 2, wc = wid & 3, fr = lane & 15, fq = lane >> 4;
    constexpr int NTILES = 64 * (NGU / 256);
    for (int t = blockIdx.x; t < NTILES; t += gridDim.x) {
        const int bm = t & 63, bn = t >> 6, row0 = bm * 256;
        f32x4 acc[4][8]; zero_acc2(acc);
        gemm_mainloop2(n + (size_t)row0 * D, D, wgu + (size_t)bn * 256 * D, D, D, acc, lds);
#pragma unroll
        for (int nt = 0; nt < 8; ++nt) {
            const int token = row0 + 128 * wt + 16 * nt + fr;
            float v[8];
#pragma unroll
            for (int m = 0; m < 2; ++m)
#pragma unroll
                for (int r = 0; r < 4; ++r) { const float gg = acc[m][nt][r], uu = acc[m + 2][nt][r]; v[4 * m + r] = gg * fast_rcp(1.0f + __expf(-gg)) * uu; }
            u32x4 pk = {pk2(v[0], v[1]), pk2(v[2], v[3]), pk2(v[4], v[5]), pk2(v[6], v[7])};
            *(u32x4*)(act + (size_t)token * F + 32 * (4 * bn + wc) + 8 * fq) = pk;
        }
    }
}

DI void phase_resid(const bf16_t* A, int K, const bf16_t* W, const float* hin, float* hout, const float* __restrict__ gvec, float gs, char* lds) {
    const int tid_ = otid(), lane = tid_ & 63, wid = tid_ >> 6, wt = wid >> 2, wc = wid & 3, fr = lane & 15, fq = lane >> 4;
    constexpr int NTILES = 64 * 4;
    for (int t = blockIdx.x; t < NTILES; t += gridDim.x) {
        const int bm = t & 63, bn = t >> 6, row0 = bm * 256, ch0 = bn * 256 + 64 * wc + 16 * fq;
        f32x4 acc[4][8]; zero_acc2(acc);
        gemm_mainloop2(A + (size_t)row0 * K, K, W + (size_t)bn * 256 * K, K, K, acc, lds);
        f32x4 gv[4];
#pragma unroll
        for (int mw = 0; mw < 4; ++mw) gv[mw] = *(const f32x4*)(gvec + ch0 + 4 * mw) * gs;
#pragma unroll
        for (int nt = 0; nt < 8; ++nt) {
            const size_t off = (size_t)(row0 + 128 * wt + 16 * nt + fr) * D + ch0;
#pragma unroll
            for (int mw = 0; mw < 4; ++mw) { const f32x4 hv = *(const f32x4*)(hin + off + 4 * mw); *(f32x4*)(hout + off + 4 * mw) = hv + gv[mw] * acc[mw][nt]; }
            SB();
        }
    }
}

DI void phase_merge(const bf16_t* atta, const bf16_t* od, const bf16_t* wba, const bf16_t* wbb, const bf16_t* G, bf16_t* merged, float* spill, char* lds) {
    const int tid_ = otid(), lane = tid_ & 63, wid = tid_ >> 6, wt = wid >> 1, wc = wid & 1, fr = lane & 15, fq = lane >> 4;
    constexpr int NTILES = 64 * 8;
    for (int t = blockIdx.x; t < NTILES; t += gridDim.x) {
        const int bm = t & 63, bn = t >> 6, row0 = bm * 256, ch0 = bn * 128 + 64 * wc + 16 * fq;
        f32x4 acc[4][4]; zero_acc(acc);
        gemm_mainloop(atta + (size_t)row0 * 512, 512, wba + (size_t)bn * 128 * 512, 512, 512, acc, lds);
        float* sp = spill + ((size_t)blockIdx.x * 16 * 512 + tid_) * 4;
#pragma unroll
        for (int nt = 0; nt < 4; ++nt) {
            const bf16_t* gp = G + (size_t)(row0 + 64 * wt + 16 * nt + fr) * 2048 + ch0;
#pragma unroll
            for (int mw = 0; mw < 4; ++mw) { const u32x2 gu = *(const u32x2*)(gp + 4 * mw); const f32x4 ga = {bf_lo(gu[0]), bf_hi(gu[0]), bf_lo(gu[1]), bf_hi(gu[1])};
                *(f32x4*)(sp + (size_t)(nt * 4 + mw) * 2048) = ga * acc[mw][nt]; }
        }
        zero_acc(acc);
        gemm_mainloop(od + (size_t)row0 * 512, 512, wbb + (size_t)bn * 128 * 512, 512, 512, acc, lds);
#pragma unroll
        for (int nt = 0; nt < 4; ++nt) {
            const size_t tok = (size_t)(row0 + 64 * wt + 16 * nt + fr);
            const bf16_t* gp = G + tok * 2048 + 1024 + ch0;
            unsigned w[8];
#pragma unroll
            for (int mw = 0; mw < 4; ++mw) { const u32x2 gu = *(const u32x2*)(gp + 4 * mw); const f32x4 gb = {bf_lo(gu[0]), bf_hi(gu[0]), bf_lo(gu[1]), bf_hi(gu[1])};
                const f32x4 o = *(const f32x4*)(sp + (size_t)(nt * 4 + mw) * 2048) + gb * acc[mw][nt]; w[2 * mw] = pk2(o[0], o[1]); w[2 * mw + 1] = pk2(o[2], o[3]); }
            bf16_t* mp = merged + tok * D + ch0;
            *(u32x4*)(mp) = (u32x4){w[0], w[1], w[2], w[3]};
            *(u32x4*)(mp + 8) = (u32x4){w[4], w[5], w[6], w[7]};
        }
    }
}

DI void phase_win(const Params& p, int l, char* lds) {
    const int tid_ = otid(), lane = tid_ & 63, wid = tid_ >> 6, wt = wid >> 1, wc = wid & 1, fr = lane & 15, fq = lane >> 4;
    const bf16_t* n = (const bf16_t*)(p.ws + OFF_N);
    const bf16_t* W = (const bf16_t*)(p.ws + OFF_WIN + l * SZ_WIN);
    bf16_t* Q = (bf16_t*)(p.ws + OFF_Q); bf16_t* QD = (bf16_t*)(p.ws + OFF_QD); bf16_t* KA = (bf16_t*)(p.ws + OFF_KA); bf16_t* VTA = (bf16_t*)(p.ws + OFF_VTA);
    bf16_t* KD = (bf16_t*)(p.ws + OFF_KD); bf16_t* VTD = (bf16_t*)(p.ws + OFF_VTD); bf16_t* G = (bf16_t*)(p.ws + OFF_G);
    const float* rope = (const float*)(p.ws + OFF_ROPE);
    constexpr int NTILES = 64 * (NIN / 128);
    for (int t = blockIdx.x; t < NTILES; t += gridDim.x) {
        const int bm = t & 63, bn = t >> 6, row0 = bm * 256;
        f32x4 acc[4][4]; zero_acc(acc);
        gemm_mainloop(n + (size_t)row0 * D, D, W + (size_t)bn * 128 * D, D, D, acc, lds);
        const int cw = bn * 128 + 64 * wc;
        if (cw < 640) {
            const bool isq = cw < 512;
            const float* gq = p.qk_g + l * 128 + (isq ? 0 : 64);
            f32x4 gv[4];
#pragma unroll
            for (int mw = 0; mw < 4; ++mw) gv[mw] = *(const f32x4*)(gq + 16 * mw + 4 * fq);
#pragma unroll
            for (int nt = 0; nt < 4; ++nt) {
                const int token = row0 + 64 * wt + 16 * nt + fr;
                float ss = 0.f;
#pragma unroll
                for (int mw = 0; mw < 4; ++mw) ss += acc[mw][nt][0] * acc[mw][nt][0] + acc[mw][nt][1] * acc[mw][nt][1] + acc[mw][nt][2] * acc[mw][nt][2] + acc[mw][nt][3] * acc[mw][nt][3];
                ss += __shfl_xor(ss, 16); ss += __shfl_xor(ss, 32);
                const float rstd = rsqrtf(ss * (1.0f / 64.0f) + 1e-6f);
                f32x4 y[4];
#pragma unroll
                for (int mw = 0; mw < 4; ++mw) y[mw] = acc[mw][nt] * rstd * gv[mw];
                const int prow = token >> 6, pcol = token & 63;
                const f32x4 cr = *(const f32x4*)(rope + prow * 16 + 4 * fq), sr = *(const f32x4*)(rope + 4096 + prow * 16 + 4 * fq);
                const f32x4 cc = *(const f32x4*)(rope + 8192 + pcol * 16 + 4 * fq), sc = *(const f32x4*)(rope + 9216 + pcol * 16 + 4 * fq);
                f32x4 o[4];
                o[0] = y[0] * cr - y[1] * sr; o[1] = y[1] * cr + y[0] * sr; o[2] = y[2] * cc - y[3] * sc; o[3] = y[3] * cc + y[2] * sc;
                const float qs = isq ? QSCALE : 1.0f;
                bf16_t* dst = isq ? (Q + (size_t)token * 512 + cw) : (KA + (size_t)token * 128 + (cw - 512));
#pragma unroll
                for (int mw = 0; mw < 4; ++mw) { const f32x4 z = o[mw] * qs; *(u32x2*)(dst + 16 * mw + 4 * fq) = (u32x2){pk2(z[0], z[1]), pk2(z[2], z[3])}; }
            }
        } else if (cw < 768 || (cw >= 1792 && cw < 2304)) {
            bf16_t* vt = cw < 768 ? (VTA + (size_t)(cw - 640) * S) : (VTD + (size_t)(cw - 1792) * S);
#pragma unroll
            for (int nt = 0; nt < 4; ++nt) {
                const int token = row0 + 64 * wt + 16 * nt + fr;
#pragma unroll
                for (int mw = 0; mw < 4; ++mw)
#pragma unroll
                    for (int r = 0; r < 4; ++r) vt[(size_t)(16 * mw + 4 * fq + r) * S + token] = (bf16_t)(pk2(acc[mw][nt][r], 0.f) & 0xffffu);
            }
        } else if (cw < 1792) {
            const bool isq = cw < 1280; const float qs = isq ? QSCALE : 1.0f;
            bf16_t* base = isq ? (QD + (cw - 768)) : (KD + (cw - 1280));
#pragma unroll
            for (int nt = 0; nt < 4; ++nt) {
                bf16_t* dst = base + (size_t)(row0 + 64 * wt + 16 * nt + fr) * 512;
#pragma unroll
                for (int mw = 0; mw < 4; ++mw) { const f32x4 z = acc[mw][nt] * qs; *(u32x2*)(dst + 16 * mw + 4 * fq) = (u32x2){pk2(z[0], z[1]), pk2(z[2], z[3])}; }
            }
            {
                float best = 0.f;
#pragma unroll
                for (int nt = 0; nt < 4; ++nt) {
                    float ss = 0.f;
#pragma unroll
                    for (int mw = 0; mw < 4; ++mw) { const f32x4 z = acc[mw][nt] * qs; ss += z[0] * z[0] + z[1] * z[1] + z[2] * z[2] + z[3] * z[3]; }
                    ss += __shfl_xor(ss, 16); ss += __shfl_xor(ss, 32);
                    best = __builtin_fmaxf(best, ss);
                }
#pragma unroll
                for (int o = 8; o > 0; o >>= 1) best = __builtin_fmaxf(best, __shfl_xor(best, o));
                if (lane == 0) atomicMax((unsigned*)(p.ws + OFF_STAT) + l * 16 + (isq ? 0 : 8) + ((cw - (isq ? 768 : 1280)) >> 6), __float_as_uint(best));
            }
        } else {
            const int gc = cw - 2304;
            const float* bg = p.b_gate + l * 2048 + gc;
            f32x4 bv[4];
#pragma unroll
            for (int mw = 0; mw < 4; ++mw) bv[mw] = *(const f32x4*)(bg + 16 * mw + 4 * fq);
#pragma unroll
            for (int nt = 0; nt < 4; ++nt) {
                bf16_t* dst = G + (size_t)(row0 + 64 * wt + 16 * nt + fr) * 2048 + gc;
#pragma unroll
                for (int mw = 0; mw < 4; ++mw) {
                    const f32x4 xx = acc[mw][nt] + bv[mw]; f32x4 z;
#pragma unroll
                    for (int r = 0; r < 4; ++r) z[r] = fast_rcp(1.0f + __expf(-xx[r]));
                    *(u32x2*)(dst + 16 * mw + 4 * fq) = (u32x2){pk2(z[0], z[1]), pk2(z[2], z[3])};
                }
            }
        }
    }
}

#define MFMA32(a, b, c) __builtin_amdgcn_mfma_f32_32x32x16_bf16((a), (b), (c), 0, 0, 0)
template <int DV, bool ALIBI>
DI void attn_pass(const bf16_t* __restrict__ Qp, const bf16_t* __restrict__ Kb, int kpitch, const bf16_t* __restrict__ Vtb, float slope2, int qpos, int t_lo, int t_hi, float m_init,
                  f32x16 (&o)[DV / 32], float& l_out, char* lds) {
    constexpr int NV = DV / 64, NDT = DV / 32, STAGE = 8192 + DV * 128, G = 1 + NV;
    const int tid = otid(), lane = tid & 63, r32 = lane & 31, h = lane >> 5;
    bf16x8 qf[4];
#pragma unroll
    for (int d0 = 0; d0 < 4; ++d0) qf[d0] = *(const bf16x8*)(Qp + 16 * d0 + 8 * h);
    const int srow = tid >> 3, sch = (tid & 7) ^ ((srow >> 1) & 7);
    const bf16_t* kg = Kb + (size_t)srow * kpitch + sch * 8;
    const bf16_t* vg = Vtb + (size_t)srow * S + sch * 8;
    char* const ld = lds + tid * 16;
#define A_ISSUE(t_, st_) do { char* sn_ = ld + (st_) * STAGE; glds16(kg + (size_t)(t_) * 64 * kpitch, sn_); \
        _Pragma("unroll") for (int i = 0; i < NV; ++i) glds16(vg + (size_t)(64 * i) * S + (t_) * 64, sn_ + 8192 + i * 8192); } while (0)
    waitv<0>();
    A_ISSUE(t_lo, 0);
    if (t_lo + 1 <= t_hi) A_ISSUE(t_lo + 1, 1);
    if (t_lo + 2 <= t_hi) A_ISSUE(t_lo + 2, 2);
    const int pi = (r32 & 0x13) | ((r32 & 4) << 1) | ((r32 & 8) >> 1);
    const int k_base = pi * 128, k_sw = (pi >> 1) & 7, v_base = 8192 + r32 * 128, v_sw = (r32 >> 1) & 7;
    float m = m_init, l = 0.f;
#pragma unroll
    for (int dt = 0; dt < NDT; ++dt)
#pragma unroll
        for (int r = 0; r < 16; ++r) o[dt][r] = 0.f;
    int cur = 0;
    for (int t = t_lo; t <= t_hi; ++t) {
        const int rem = t_hi - t;
        if (rem >= 2) waitv<2 * G>(); else if (rem == 1) waitv<G>(); else waitv<0>();
        rawbar();
        if (rem >= 3) A_ISSUE(t + 3, (cur + 3) & 3);
        const char* st = lds + cur * STAGE;
        cur = (cur + 1) & 3;
        bf16x8 kf[2][4];
#pragma unroll
        for (int kt = 0; kt < 2; ++kt)
#pragma unroll
            for (int d0 = 0; d0 < 4; ++d0) kf[kt][d0] = *(const bf16x8*)(st + kt * 4096 + k_base + (((2 * d0 + h) ^ k_sw) << 4));
        f32x16 sc[2];
        const float nm = -m;
#pragma unroll
        for (int kt = 0; kt < 2; ++kt)
#pragma unroll
            for (int r = 0; r < 16; ++r) sc[kt][r] = nm;
        SB();
        __builtin_amdgcn_s_setprio(1);
#pragma unroll
        for (int d0 = 0; d0 < 4; ++d0)
#pragma unroll
            for (int kt = 0; kt < 2; ++kt) sc[kt] = MFMA32(kf[kt][d0], qf[d0], sc[kt]);
        __builtin_amdgcn_s_setprio(0);
        bf16x8 vf[2][4];
        if (NDT == 2) {
#pragma unroll
            for (int dt = 0; dt < 2; ++dt)
#pragma unroll
                for (int ks = 0; ks < 4; ++ks) vf[dt][ks] = *(const bf16x8*)(st + v_base + dt * 4096 + (((2 * ks + h) ^ v_sw) << 4));
        }
        SB();
        if (ALIBI) {
#pragma unroll
            for (int kt = 0; kt < 2; ++kt) {
                const float dq = (float)(qpos - (64 * t + 32 * kt + 8 * h));
#pragma unroll
                for (int r = 0; r < 16; ++r) sc[kt][r] = __builtin_fmaf(-slope2, __builtin_fabsf(dq - (float)(16 * (r >> 3) + (r & 7))), sc[kt][r]);
            }
        }
        float mt = sc[0][0];
#pragma unroll
        for (int r = 1; r < 16; ++r) mt = __builtin_fmaxf(mt, sc[0][r]);
#pragma unroll
        for (int r = 0; r < 16; ++r) mt = __builtin_fmaxf(mt, sc[1][r]);
        mt = __builtin_fmaxf(mt, __shfl_xor(mt, 32));
        if (__any(mt > 8.0f)) {
            const float dl = __builtin_fmaxf(mt, 0.f), al = fast_exp2(-dl);
            l *= al; m += dl;
#pragma unroll
            for (int kt = 0; kt < 2; ++kt)
#pragma unroll
                for (int r = 0; r < 16; ++r) sc[kt][r] -= dl;
#pragma unroll
            for (int dt = 0; dt < NDT; ++dt)
#pragma unroll
                for (int r = 0; r < 16; ++r) o[dt][r] *= al;
        }
        float ps = 0.f;
#pragma unroll
        for (int kt = 0; kt < 2; ++kt)
#pragma unroll
            for (int r = 0; r < 16; ++r) { const float e = fast_exp2(sc[kt][r]); sc[kt][r] = e; ps += e; }
        l += ps;
        bf16x8 pf[4];
#pragma unroll
        for (int ks = 0; ks < 4; ++ks) {
            const int kt = ks >> 1, b = (ks & 1) * 8;
            u32x4 w = {pk2(sc[kt][b], sc[kt][b + 1]), pk2(sc[kt][b + 2], sc[kt][b + 3]), pk2(sc[kt][b + 4], sc[kt][b + 5]), pk2(sc[kt][b + 6], sc[kt][b + 7])};
            pf[ks] = __builtin_bit_cast(bf16x8, w);
        }
        SB();
        if (NDT == 4) {
#pragma unroll
            for (int gp = 0; gp < 2; ++gp) {
#pragma unroll
                for (int dt = 0; dt < 2; ++dt)
#pragma unroll
                    for (int ks = 0; ks < 4; ++ks) vf[dt][ks] = *(const bf16x8*)(st + v_base + (dt + 2 * gp) * 4096 + (((2 * ks + h) ^ v_sw) << 4));
                __builtin_amdgcn_s_setprio(1);
#pragma unroll
                for (int ks = 0; ks < 4; ++ks)
#pragma unroll
                    for (int dt = 0; dt < 2; ++dt) o[(dt + 2 * gp) % NDT] = MFMA32(vf[dt][ks], pf[ks], o[(dt + 2 * gp) % NDT]);
                __builtin_amdgcn_s_setprio(0);
                SB();
            }
        } else {
            __builtin_amdgcn_s_setprio(1);
#pragma unroll
            for (int ks = 0; ks < 4; ++ks)
#pragma unroll
                for (int dt = 0; dt < 2; ++dt) o[dt] = MFMA32(vf[dt][ks], pf[ks], o[dt]);
            __builtin_amdgcn_s_setprio(0);
        }
        SB();
    }
#undef A_ISSUE
    __syncthreads();
    l += __shfl_xor(l, 32);
    l_out = l;
}

DI void phase_attn(const Params& p, int l, char* lds) {
    const int tid = otid(), lane = tid & 63, wid = tid >> 6, r32 = lane & 31, h = lane >> 5;
    const bf16_t* Q = (const bf16_t*)(p.ws + OFF_Q); const bf16_t* QD = (const bf16_t*)(p.ws + OFF_QD); const bf16_t* KA = (const bf16_t*)(p.ws + OFF_KA);
    const bf16_t* VTA = (const bf16_t*)(p.ws + OFF_VTA); const bf16_t* KD = (const bf16_t*)(p.ws + OFF_KD); const bf16_t* VTD = (const bf16_t*)(p.ws + OFF_VTD);
    bf16_t* ATTA = (bf16_t*)(p.ws + OFF_ATTA); bf16_t* OD = (bf16_t*)(p.ws + OFF_OD); float* BO0 = (float*)(p.ws + OFF_N);
    const float lam = ((const float*)(p.ws + OFF_LAM))[l];
    const float oml = 1.0f - (l == 0 ? 0.2f : 0.35550906759096926f);
    unsigned* qcnt = (unsigned*)(p.ws + OFF_STAT) + 32 + l;
    const unsigned* stat = (const unsigned*)(p.ws + OFF_STAT) + l * 16;
    volatile unsigned* lword = (volatile unsigned*)(lds + 147456 - 16);
    for (;;) {
        if (tid == 0) *lword = atomicAdd(qcnt, 1u);
        __syncthreads();
        const int u = (int)*lword;
        __syncthreads();
        if (u >= 768) break;
        if (u < 128 || u >= 640) {
            const int hb = u < 64 ? 3 : (u < 128 ? 2 : (u < 704 ? 1 : 0)), qb = u & 63;
            const int token = 256 * qb + 32 * wid + r32;
            const float slope2 = exp2f(-2.0f * (float)(hb + 1)) * LOG2E;
            float* bo = BO0 + (size_t)token * 512 + hb * 128;
            f32x16 o[4]; float ls;
            int tl[2], th[2]; float mi[2];
#pragma unroll
            for (int mp = 0; mp < 2; ++mp) {
                const float qk = sqrtf(__uint_as_float(stat[mp * 4 + hb]) * __uint_as_float(stat[8 + mp * 4 + hb])) * 1.02f;
                const float R = __builtin_fminf((2.0f * qk + 150.0f) / slope2, 40000.0f);
                const int klo = 256 * qb - (int)R - 1, khi = 256 * qb + 255 + (int)R + 1;
                mi[mp] = -qk;
                tl[mp] = klo < 0 ? 0 : (klo >> 6); th[mp] = khi >= S ? (S / 64 - 1) : (khi >> 6);
            }
            attn_pass<128, true>(QD + (size_t)token * 512 + hb * 64, KD + hb * 64, 512, VTD + (size_t)(hb * 128) * S, slope2, token, tl[0], th[0], mi[0], o, ls, lds);
            {
                const float inv = 1.0f / ls;
#pragma unroll
                for (int dt = 0; dt < 4; ++dt)
#pragma unroll
                    for (int g = 0; g < 4; ++g) *(f32x4*)(bo + 32 * dt + 8 * g + 4 * h) = (f32x4){o[dt][4 * g] * inv, o[dt][4 * g + 1] * inv, o[dt][4 * g + 2] * inv, o[dt][4 * g + 3] * inv};
            }
            attn_pass<128, true>(QD + (size_t)token * 512 + 256 + hb * 64, KD + 256 + hb * 64, 512, VTD + (size_t)(hb * 128) * S, slope2, token, tl[1], th[1], mi[1], o, ls, lds);
            {
                const float inv = lam / ls; float ss = 0.f;
#pragma unroll
                for (int dt = 0; dt < 4; ++dt)
#pragma unroll
                    for (int g = 0; g < 4; ++g) {
                        const f32x4 a = *(const f32x4*)(bo + 32 * dt + 8 * g + 4 * h);
#pragma unroll
                        for (int j = 0; j < 4; ++j) { const float v = a[j] - o[dt][4 * g + j] * inv; o[dt][4 * g + j] = v; ss += v * v; }
                    }
                ss += __shfl_xor(ss, 32);
                const float rstd = rsqrtf(ss * (1.0f / 128.0f) + 1e-6f) * oml;
                const float* sg = p.subln_g + l * 128;
                bf16_t* dst = OD + (size_t)token * 512 + hb * 128;
#pragma unroll
                for (int dt = 0; dt < 4; ++dt)
#pragma unroll
                    for (int g = 0; g < 4; ++g) {
                        const int d = 32 * dt + 8 * g + 4 * h;
                        const f32x4 gg = *(const f32x4*)(sg + d);
                        *(u32x2*)(dst + d) = (u32x2){pk2(o[dt][4 * g] * rstd * gg[0], o[dt][4 * g + 1] * rstd * gg[1]), pk2(o[dt][4 * g + 2] * rstd * gg[2], o[dt][4 * g + 3] * rstd * gg[3])};
                    }
            }
        } else {
            const int v = u - 128, kv = v >> 8, hq = kv * 4 + (v & 3), qb = (v >> 2) & 63;
            const int token = 256 * qb + 32 * wid + r32;
            f32x16 o[2]; float ls;
            attn_pass<64, false>(Q + (size_t)token * 512 + hq * 64, KA + kv * 64, 128, VTA + (size_t)(kv * 64) * S, 0.f, token, 0, S / 64 - 1, 0.f, o, ls, lds);
            const float inv = 1.0f / ls;
            bf16_t* dst = ATTA + (size_t)token * 512 + hq * 64;
#pragma unroll
            for (int dt = 0; dt < 2; ++dt)
#pragma unroll
                for (int g = 0; g < 4; ++g)
                    *(u32x2*)(dst + 32 * dt + 8 * g + 4 * h) = (u32x2){pk2(o[dt][4 * g] * inv, o[dt][4 * g + 1] * inv), pk2(o[dt][4 * g + 2] * inv, o[dt][4 * g + 3] * inv)};
        }
    }
}

__global__ void __launch_bounds__(512) mega(Params pin) {
    __shared__ __attribute__((aligned(16))) char lds[147456];
    cg::grid_group grid = cg::this_grid();
    int rep = 0;
    for (int ph = pin.ph_lo; ph < pin.ph_hi; ++ph) {
        Params p = pin;
        asm volatile("" : "+s"(p.ws), "+s"(p.out), "+s"(p.x));
        bf16_t* nbuf = (bf16_t*)(p.ws + OFF_N);
        bf16_t* act = (bf16_t*)(p.ws + OFF_ACT);
        if (ph == 0) phase_prologue(p, lds);
        else {
            const int l = ph == 23 ? 1 : (ph - 1) / 11, k = ph == 23 ? 11 : (ph - 1) % 11;
            const float* mod = (const float*)(p.ws + OFF_MOD) + l * 9216;
            switch (k) {
            case 0: case 3: case 8: case 11: {
                const int i = k == 0 ? 0 : (k == 3 ? 1 : 2);
                const float* hin = (ph == 1) ? p.x : p.out;
                if (k == 11) phase_norm(hin, p.final_g, nullptr, nullptr, nullptr, p.out);
                else phase_norm(hin, p.norm_g + (l * 3 + i) * D, mod + (3 * i) * D, mod + (3 * i + 1) * D, nbuf, nullptr);
            } break;
            case 1: case 9: {
                const int f = k == 1 ? 0 : 1;
                phase_gateup(nbuf, (const bf16_t*)(p.ws + OFF_WGU + (size_t)(l * 2 + f) * SZ_WGU), act, lds);
            } break;
            case 2: case 10: case 7: {
                if (k == 7) phase_resid((const bf16_t*)(p.ws + OFF_Q), D, (const bf16_t*)(p.ws + OFF_WO + l * SZ_WO), p.out, p.out, mod + 5 * D, 1.0f, lds);
                else {
                    const int f = k == 2 ? 0 : 1;
                    phase_resid(act, F, (const bf16_t*)(p.ws + OFF_WD + (size_t)(l * 2 + f) * SZ_WD), (ph == 3) ? p.x : p.out, p.out, mod + (f == 0 ? 2 : 8) * D, 0.5f, lds);
                }
            } break;
            case 4: phase_win(p, l, lds); break;
            case 5: phase_attn(p, l, lds); break;
            case 6: phase_merge((const bf16_t*)(p.ws + OFF_ATTA), (const bf16_t*)(p.ws + OFF_OD), (const bf16_t*)(p.ws + OFF_WBA + l * SZ_WB), (const bf16_t*)(p.ws + OFF_WBB + l * SZ_WB),
                                (const bf16_t*)(p.ws + OFF_G), (bf16_t*)(p.ws + OFF_Q), (float*)(p.ws + OFF_N), lds); break;
            default: break;
            }
        }
        if (ph + 1 < pin.ph_hi) grid.sync();
        if (PROBE_DUP >= 0 && rep == 0 && (ph == 0 ? PROBE_DUP == 100 : ((ph - 1) % 11 == PROBE_DUP && ph != 23))) { rep = 1; --ph; } else rep = 0;
    }
}

extern "C" void kernel_launch(void* const* d_in, const int* in_sizes, int n_in, void* d_out, int out_size, void* d_ws, size_t ws_size, hipStream_t stream) {
    if (n_in != 18 || out_size != S * D || ws_size < WS_END) { fprintf(stderr, "kernel_launch: unexpected shapes / workspace (n_in %d out %d ws %zu need %zu)\n", n_in, out_size, ws_size, (size_t)WS_END); return; }
    Params p{};
    const float** pp = (const float**)&p;
    for (int i = 0; i < 18; ++i) pp[i] = (const float*)d_in[i];
    p.out = (float*)d_out; p.ws = (unsigned char*)d_ws;
#if MK_MULTI
    for (int ph = 0; ph < NPH; ++ph) { p.ph_lo = ph; p.ph_hi = ph + 1; hipLaunchKernelGGL(mega, dim3(256), dim3(512), 0, stream, p); }
#else
    static int grid = 0;
    if (!grid) {
        int dev = 0, cus = 0, per_cu = 0;
        hipGetDevice(&dev); hipDeviceGetAttribute(&cus, hipDeviceAttributeMultiprocessorCount, dev);
        hipOccupancyMaxActiveBlocksPerMultiprocessor(&per_cu, (const void*)mega, 512, 0);
        if (per_cu < 1) { fprintf(stderr, "kernel_launch: occupancy query says %d blocks per CU\n", per_cu); per_cu = 1; }
        grid = cus;
    }
    p.ph_lo = 0; p.ph_hi = NPH;
    void* args[] = {&p};
    hipError_t e = hipLaunchCooperativeKernel((const void*)mega, dim3(grid), dim3(512), args, 0, stream);
    if (e != hipSuccess) fprintf(stderr, "cooperative launch failed: %s (grid %d)\n", hipGetErrorString(e), grid);
#endif
}
```

```cpp
#include <hip/hip_runtime.h>
#include <hip/hip_cooperative_groups.h>
#include <cstdio>
#include <cstdint>
namespace cg = cooperative_groups;

#ifndef MK_MULTI
#define MK_MULTI 0
#endif

#ifndef PROBE_DUP
#define PROBE_DUP -1
#endif
#define DI __device__ __forceinline__
typedef unsigned short bf16_t;
typedef short bf16x8 __attribute__((ext_vector_type(8)));
typedef float f32x4 __attribute__((ext_vector_type(4)));
typedef float f32x16 __attribute__((ext_vector_type(16)));
typedef unsigned u32x4 __attribute__((ext_vector_type(4)));
typedef unsigned u32x2 __attribute__((ext_vector_type(2)));

constexpr int S = 16384, D = 1024, F = 2816, NGU = 5632, NIN = 4352;
constexpr int NPH = 24;
constexpr float QSCALE = 0.125f * 1.4426950408889634f;
constexpr float LOG2E = 1.4426950408889634f;

constexpr size_t OFF_MOD = 0;
constexpr size_t OFF_LAM = 80000;
constexpr size_t OFF_STAT = 80128;
constexpr size_t OFF_ROPE = 81920;
constexpr size_t OFF_WGU = 1u << 20;
constexpr size_t SZ_WGU = (size_t)NGU * D * 2;
constexpr size_t OFF_WD = OFF_WGU + 4 * SZ_WGU;
constexpr size_t SZ_WD = (size_t)D * F * 2;
constexpr size_t OFF_WIN = OFF_WD + 4 * SZ_WD;
constexpr size_t SZ_WIN = (size_t)NIN * D * 2;
constexpr size_t OFF_WBA = OFF_WIN + 2 * SZ_WIN;
constexpr size_t SZ_WB = (size_t)D * 512 * 2;
constexpr size_t OFF_WBB = OFF_WBA + 2 * SZ_WB;
constexpr size_t OFF_WO = OFF_WBB + 2 * SZ_WB;
constexpr size_t SZ_WO = (size_t)D * D * 2;
constexpr size_t OFF_N = OFF_WO + 2 * SZ_WO;
constexpr size_t OFF_MIX = OFF_N + (size_t)S * D * 2;
constexpr size_t OFF_Q = OFF_MIX;
constexpr size_t OFF_QD = OFF_Q + (size_t)S * 512 * 2;
constexpr size_t OFF_KA = OFF_QD + (size_t)S * 512 * 2;
constexpr size_t OFF_VTA = OFF_KA + (size_t)S * 128 * 2;
constexpr size_t OFF_KD = OFF_VTA + (size_t)S * 128 * 2;
constexpr size_t OFF_VTD = OFF_KD + (size_t)S * 512 * 2;
constexpr size_t OFF_G = OFF_VTD + (size_t)S * 512 * 2;
constexpr size_t OFF_ATTA = OFF_G + (size_t)S * 2048 * 2;
constexpr size_t OFF_OD = OFF_ATTA + (size_t)S * 512 * 2;
constexpr size_t OFF_ACT = OFF_MIX;
constexpr size_t WS_END = OFF_OD + (size_t)S * 512 * 2;
static_assert((size_t)S * F * 2 <= WS_END - OFF_MIX, "act overlay");

struct Params {
    const float *x, *c, *ada_w, *ada_b, *norm_g, *ffn_wg, *ffn_wu, *ffn_wd, *w_in, *qk_g, *lam_p, *subln_g, *w_ba, *w_bb, *w_gate, *b_gate, *w_o, *final_g;
    float* out; unsigned char* ws; int ph_lo, ph_hi;
};

typedef __bf16 bf16v2 __attribute__((ext_vector_type(2)));
typedef float f32x2 __attribute__((ext_vector_type(2)));
DI unsigned pk2(float lo, float hi) { f32x2 v = {lo, hi}; bf16v2 b = __builtin_convertvector(v, bf16v2); return __builtin_bit_cast(unsigned, b); }
DI float bf_lo(unsigned u) { return __uint_as_float(u << 16); }
DI float bf_hi(unsigned u) { return __uint_as_float(u & 0xffff0000u); }
DI int lds_off(int row, int chunk) { return row * 128 + ((chunk ^ ((row >> 1) & 7)) << 4); }
DI float fast_exp2(float x) { return __builtin_amdgcn_exp2f(x); }
DI float fast_rcp(float x) { return __builtin_amdgcn_rcpf(x); }
DI int otid() { int t = threadIdx.x; asm volatile("" : "+v"(t)); return t; }
#define SB() __builtin_amdgcn_sched_barrier(0)

DI int perm64(int n) { return (n & ~63) | (((n >> 2) & 3) << 4) | (((n >> 4) & 3) << 2) | (n & 3); }
DI int gumap(int j) { return 128 * (j >> 6) + 64 * ((j >> 5) & 1) + 16 * ((j >> 2) & 1) + 4 * ((j >> 3) & 3) + (j & 3); }

struct TrDesc { const float* src; bf16_t* dst; int N, k0, n0, ldd, mode, roff; };
DI void tr_decode(const Params& p, int tt, TrDesc& d) {
    constexpr int N_TR_L = 5824;
    const int l = tt / N_TR_L, r = tt % N_TR_L;
    if (r < 4224) {
        const int f = r / 2112, r2 = r % 2112, which = r2 / 704, r3 = r2 % 704;
        const size_t lf = (size_t)(l * 2 + f);
        if (which < 2) { d.src = (which == 0 ? p.ffn_wg : p.ffn_wu) + lf * D * F; d.N = F; d.k0 = (r3 / 44) * 64; d.n0 = (r3 % 44) * 64; d.dst = (bf16_t*)(p.ws + OFF_WGU + lf * SZ_WGU); d.ldd = D; d.mode = 2; d.roff = which * 32; }
        else { d.src = p.ffn_wd + lf * F * D; d.N = D; d.k0 = (r3 / 16) * 64; d.n0 = (r3 % 16) * 64; d.dst = (bf16_t*)(p.ws + OFF_WD + lf * SZ_WD); d.ldd = F; d.mode = 1; d.roff = 0; }
    } else if (r < 4800) { const int r3 = r - 4224; d.src = p.w_in + (size_t)l * D * 2304; d.N = 2304; d.k0 = (r3 / 36) * 64; d.n0 = (r3 % 36) * 64; d.dst = (bf16_t*)(p.ws + OFF_WIN + l * SZ_WIN); d.ldd = D; d.mode = 0; d.roff = 0; }
    else if (r < 5312) { const int r3 = r - 4800; d.src = p.w_gate + (size_t)l * D * 2048; d.N = 2048; d.k0 = (r3 / 32) * 64; d.n0 = (r3 % 32) * 64; d.dst = (bf16_t*)(p.ws + OFF_WIN + l * SZ_WIN); d.ldd = D; d.mode = 0; d.roff = 2304; }
    else if (r < 5440) { const int r3 = r - 5312; d.src = p.w_ba + (size_t)l * 512 * D; d.N = D; d.k0 = (r3 / 16) * 64; d.n0 = (r3 % 16) * 64; d.dst = (bf16_t*)(p.ws + OFF_WBA + l * SZ_WB); d.ldd = 512; d.mode = 1; d.roff = 0; }
    else if (r < 5568) { const int r3 = r - 5440; d.src = p.w_bb + (size_t)l * 512 * D; d.N = D; d.k0 = (r3 / 16) * 64; d.n0 = (r3 % 16) * 64; d.dst = (bf16_t*)(p.ws + OFF_WBB + l * SZ_WB); d.ldd = 512; d.mode = 1; d.roff = 0; }
    else { const int r3 = r - 5568; d.src = p.w_o + (size_t)l * D * D; d.N = D; d.k0 = (r3 / 16) * 64; d.n0 = (r3 % 16) * 64; d.dst = (bf16_t*)(p.ws + OFF_WO + l * SZ_WO); d.ldd = D; d.mode = 1; d.roff = 0; }
}
DI void tr_load(const TrDesc& d, int tid, f32x4 (&v)[2]) {
    const int kk = tid >> 4, nn4 = (tid & 15) * 4;
#pragma unroll
    for (int ps = 0; ps < 2; ++ps) v[ps] = *(const f32x4*)(d.src + (size_t)(d.k0 + kk + 32 * ps) * d.N + d.n0 + nn4);
}
DI void tr_store(const TrDesc& d, int tid, const f32x4 (&v)[2], float* ldsf) {
    {
        const int kk = tid >> 4, nn4 = (tid & 15) * 4;
#pragma unroll
        for (int ps = 0; ps < 2; ++ps) { const int k = kk + 32 * ps; ldsf[k * 65 + nn4 + 0] = v[ps][0]; ldsf[k * 65 + nn4 + 1] = v[ps][1]; ldsf[k * 65 + nn4 + 2] = v[ps][2]; ldsf[k * 65 + nn4 + 3] = v[ps][3]; }
    }
    __syncthreads();
    {
        const int n = tid >> 3, ch = tid & 7, gn = d.n0 + n;
        int drow;
        if (d.mode == 0) drow = gn + d.roff; else if (d.mode == 1) drow = perm64(gn); else drow = gumap(gn) + d.roff;
        float w[8];
#pragma unroll
        for (int i = 0; i < 8; ++i) w[i] = ldsf[(ch * 8 + i) * 65 + n];
        u32x4 pk = {pk2(w[0], w[1]), pk2(w[2], w[3]), pk2(w[4], w[5]), pk2(w[6], w[7])};
        *(u32x4*)(d.dst + (size_t)drow * d.ldd + d.k0 + ch * 8) = pk;
    }
    __syncthreads();
}

DI void phase_prologue(const Params& p, char* lds) {
    const int tid = otid();
    float* ldsf = (float*)lds;
    constexpr int N_MOD = 288, N_TR = 2 * 5824;
    for (int it = blockIdx.x; it < N_MOD; it += gridDim.x) {
        const int l = it / 144, j0 = (it % 144) * 64, jj = tid & 15, ii = tid >> 4;
        float* cact = ldsf + 2048;
        for (int i = tid; i < 1024; i += 512) { const float cv = p.c[i]; cact[i] = cv / (1.f + expf(-cv)); }
        __syncthreads();
        f32x4 a = {0.f, 0.f, 0.f, 0.f};
        const float* wb = p.ada_w + (size_t)l * 1024 * 9216 + j0 + 4 * jj;
#pragma unroll 8
        for (int r = 0; r < 32; ++r) { const int i = ii + 32 * r; a += cact[i] * *(const f32x4*)(wb + (size_t)i * 9216); }
        *(f32x4*)(ldsf + ii * 64 + 4 * jj) = a;
        __syncthreads();
        if (tid < 64) {
            float sm = 0.f;
#pragma unroll
            for (int r = 0; r < 32; ++r) sm += ldsf[r * 64 + tid];
            ((float*)(p.ws + OFF_MOD))[l * 9216 + j0 + tid] = sm + p.ada_b[l * 9216 + j0 + tid];
        }
        __syncthreads();
    }
    if (blockIdx.x == gridDim.x - 1) {
        if (tid < 64) {
#pragma unroll
            for (int l = 0; l < 2; ++l) {
                const float* lp = p.lam_p + l * 256;
                float a = lp[tid] * lp[64 + tid], b = lp[128 + tid] * lp[192 + tid];
#pragma unroll
                for (int o = 32; o > 0; o >>= 1) { a += __shfl_xor(a, o); b += __shfl_xor(b, o); }
                const float li = l == 0 ? 0.2f : 0.35550906759096926f;
                if (tid == 0) ((float*)(p.ws + OFF_LAM))[l] = expf(a) - expf(b) + li;
            }
        }
        if (tid < 64) ((unsigned*)(p.ws + OFF_STAT))[tid] = 0u;
        float* rope = (float*)(p.ws + OFF_ROPE);
        for (int e = tid; e < 320 * 16; e += 512) {
            const int pi = e >> 4, i = e & 15;
            const int pos = pi < 256 ? pi - 128 : (pi - 256) - 32;
            const float inv = exp2f(-(float)i * (13.287712379549449f / 16.0f));
            const float angf = (float)pos * inv;
            double r = (double)angf; r -= rint(r * 0.15915494309189535) * 6.283185307179586;
            const double r2 = r * r;
            double sn = 0.0, cs = 0.0;
#pragma unroll 1
            for (int n = 14; n >= 1; --n) { sn = (sn + 1.0) * (-r2 / (double)((2 * n) * (2 * n + 1))); cs = (cs + 1.0) * (-r2 / (double)((2 * n - 1) * (2 * n))); }
            sn = (sn + 1.0) * r; cs = cs + 1.0;
            if (pi < 256) { rope[pi * 16 + i] = (float)cs; rope[4096 + pi * 16 + i] = (float)sn; }
            else { rope[8192 + (pi - 256) * 16 + i] = (float)cs; rope[9216 + (pi - 256) * 16 + i] = (float)sn; }
        }
    }
    {
        int tt = blockIdx.x;
        TrDesc d; f32x4 v[2];
        if (tt < N_TR) { tr_decode(p, tt, d); tr_load(d, tid, v); }
        while (tt < N_TR) {
            const int tn = tt + gridDim.x;
            TrDesc dn; f32x4 vn[2];
            if (tn < N_TR) { tr_decode(p, tn, dn); tr_load(dn, tid, vn); }
            tr_store(d, tid, v, ldsf);
            if (tn < N_TR) { d = dn; v[0] = vn[0]; v[1] = vn[1]; }
            tt = tn;
        }
    }
}

DI void phase_norm(const float* hin, const float* __restrict__ g, const float* __restrict__ sh, const float* __restrict__ sc, bf16_t* nout, float* fout) {
    const int tid_ = otid(), lane = tid_ & 63, wid = tid_ >> 6;
    const int nw = gridDim.x * 8;
    for (int row = blockIdx.x * 8 + wid; row < S; row += nw) {
        const float* hp = hin + (size_t)row * D;
        f32x4 v[4]; float ss = 0.f;
#pragma unroll
        for (int i = 0; i < 4; ++i) { v[i] = *(const f32x4*)(hp + (i * 64 + lane) * 4); ss += v[i][0] * v[i][0] + v[i][1] * v[i][1] + v[i][2] * v[i][2] + v[i][3] * v[i][3]; }
#pragma unroll
        for (int o = 32; o > 0; o >>= 1) ss += __shfl_xor(ss, o);
        const float rstd = rsqrtf(ss * (1.0f / 1024.0f) + 1e-6f);
#pragma unroll
        for (int i = 0; i < 4; ++i) {
            const int col = (i * 64 + lane) * 4;
            const f32x4 gv = *(const f32x4*)(g + col);
            f32x4 y = v[i] * rstd * gv;
            if (sc) { const f32x4 s1 = *(const f32x4*)(sc + col), s0 = *(const f32x4*)(sh + col); y = y * (1.0f + s1) + s0; }
            if (fout) *(f32x4*)(fout + (size_t)row * D + col) = y;
            else { u32x2 pk = {pk2(y[0], y[1]), pk2(y[2], y[3])}; *(u32x2*)(nout + (size_t)row * D + col) = pk; }
        }
    }
}

DI void glds16(const void* g, char* l) { __builtin_amdgcn_global_load_lds((const unsigned*)g, (unsigned*)l, 16, 0, 0); }
template <int N> DI void waitv() { asm volatile("s_waitcnt vmcnt(%0)" ::"n"(N) : "memory"); }
DI void rawbar() { __builtin_amdgcn_s_barrier(); }
constexpr int GST = 49152;
DI void gemm_mainloop(const bf16_t* __restrict__ A, int lda, const bf16_t* __restrict__ W, int ldw, int K, f32x4 (&acc)[4][4], char* lds) {
    const int tid = otid(), lane = tid & 63, wid = tid >> 6, wt = wid >> 1, wc = wid & 1;
    const int srow = tid >> 3, sch = (tid & 7) ^ ((srow >> 1) & 7);
    const bf16_t* ag = A + (size_t)srow * lda + sch * 8;
    const bf16_t* wg = W + (size_t)srow * ldw + sch * 8;
    char* const ld = lds + tid * 16;
    const int nk = K >> 6;
#define G_ISSUE(kt_, st_) do { const int ko_ = (kt_) * 64; char* sn_ = ld + (st_) * GST; \
        _Pragma("unroll") for (int i = 0; i < 4; ++i) glds16(ag + (size_t)(64 * i) * lda + ko_, sn_ + i * 8192); \
        _Pragma("unroll") for (int i = 0; i < 2; ++i) glds16(wg + (size_t)(64 * i) * ldw + ko_, sn_ + 32768 + i * 8192); } while (0)
    waitv<0>();
    G_ISSUE(0, 0); G_ISSUE(1, 1);
    const int fr = lane & 15, fq = lane >> 4, sw = (fr >> 1) & 7;
    const int a_base = (64 * wt + fr) * 128, w_base = 32768 + (64 * wc + fr) * 128;
    int cur = 0, nxt = 2;
    for (int kt = 0; kt < nk; ++kt) {
        if (kt + 1 < nk) waitv<6>(); else waitv<0>();
        rawbar();
        if (kt + 2 < nk) G_ISSUE(kt + 2, nxt);
        const char* st = lds + cur * GST;
#pragma unroll
        for (int kk = 0; kk < 2; ++kk) {
            const int co = ((kk * 4 + fq) ^ sw) << 4;
            bf16x8 af[4], wf[4];
#pragma unroll
            for (int i = 0; i < 4; ++i) af[i] = *(const bf16x8*)(st + a_base + i * 2048 + co);
#pragma unroll
            for (int i = 0; i < 4; ++i) wf[i] = *(const bf16x8*)(st + w_base + i * 2048 + co);
#pragma unroll
            for (int mw = 0; mw < 4; ++mw)
#pragma unroll
                for (int nt = 0; nt < 4; ++nt) acc[mw][nt] = __builtin_amdgcn_mfma_f32_16x16x32_bf16(wf[mw], af[nt], acc[mw][nt], 0, 0, 0);
        }
        cur = cur == 2 ? 0 : cur + 1; nxt = nxt == 2 ? 0 : nxt + 1;
    }
#undef G_ISSUE
    __syncthreads();
}
constexpr int GST2 = 65536;
DI void gemm_mainloop2(const bf16_t* __restrict__ A, int lda, const bf16_t* __restrict__ W, int ldw, int K, f32x4 (&acc)[4][8], char* lds) {
    const int tid = otid(), lane = tid & 63, wid = tid >> 6, wt = wid >> 2, wc = wid & 3;
    const int srow = tid >> 3, sch = (tid & 7) ^ ((srow >> 1) & 7);
    const bf16_t* ag = A + (size_t)srow * lda + sch * 8;
    const bf16_t* wg = W + (size_t)srow * ldw + sch * 8;
    char* const ld = lds + tid * 16;
    const int nk = K >> 6;
#define G2_ISSUE(kt_, st_) do { const int ko_ = (kt_) * 64; char* sn_ = ld + (st_) * GST2; \
        _Pragma("unroll") for (int i = 0; i < 4; ++i) glds16(ag + (size_t)(64 * i) * lda + ko_, sn_ + i * 8192); \
        _Pragma("unroll") for (int i = 0; i < 4; ++i) glds16(wg + (size_t)(64 * i) * ldw + ko_, sn_ + 32768 + i * 8192); } while (0)
    waitv<0>();
    G2_ISSUE(0, 0);
    const int fr = lane & 15, fq = lane >> 4, sw = (fr >> 1) & 7;
    const int a_base = (128 * wt + fr) * 128, w_base = 32768 + (64 * wc + fr) * 128;
    for (int kt = 0; kt < nk; ++kt) {
        waitv<0>();
        rawbar();
        if (kt + 1 < nk) G2_ISSUE(kt + 1, (kt + 1) & 1);
        const char* st = lds + (kt & 1) * GST2;
#pragma unroll
        for (int kk = 0; kk < 2; ++kk) {
            const int co = ((kk * 4 + fq) ^ sw) << 4;
            bf16x8 af[8], wf[4];
#pragma unroll
            for (int i = 0; i < 4; ++i) wf[i] = *(const bf16x8*)(st + w_base + i * 2048 + co);
#pragma unroll
            for (int i = 0; i < 8; ++i) af[i] = *(const bf16x8*)(st + a_base + i * 2048 + co);
            __builtin_amdgcn_s_setprio(1);
#pragma unroll
            for (int nt = 0; nt < 8; ++nt)
#pragma unroll
                for (int mw = 0; mw < 4; ++mw) acc[mw][nt] = __builtin_amdgcn_mfma_f32_16x16x32_bf16(wf[mw], af[nt], acc[mw][nt], 0, 0, 0);
            __builtin_amdgcn_s_setprio(0);
            SB();
        }
    }
#undef G2_ISSUE
    __syncthreads();
}
DI void zero_acc2(f32x4 (&acc)[4][8]) {
#pragma unroll
    for (int a = 0; a < 4; ++a)
#pragma unroll
        for (int b = 0; b < 8; ++b) acc[a][b] = (f32x4){0.f, 0.f, 0.f, 0.f};
}
DI void zero_acc(f32x4 (&acc)[4][4]) {
#pragma unroll
    for (int a = 0; a < 4; ++a)
#pragma unroll
        for (int b = 0; b < 4; ++b) acc[a][b] = (f32x4){0.f, 0.f, 0.f, 0.f};
}

DI void phase_gateup(const bf16_t* n, const bf16_t* wgu, bf16_t* act, char* lds) {
    const int tid_ = otid(), lane = tid_ & 63, wid = tid_ >> 6, wt = wid >> 2, wc = wid & 3, fr = lane & 15, fq = lane >> 4;
    constexpr int NTILES = 64 * (NGU / 256);
    for (int t = blockIdx.x; t < NTILES; t += gridDim.x) {
        const int bm = t & 63, bn = t >> 6, row0 = bm * 256;
        f32x4 acc[4][8]; zero_acc2(acc);
        gemm_mainloop2(n + (size_t)row0 * D, D, wgu + (size_t)bn * 256 * D, D, D, acc, lds);
#pragma unroll
        for (int nt = 0; nt < 8; ++nt) {
            const int token = row0 + 128 * wt + 16 * nt + fr;
            float v[8];
#pragma unroll
            for (int m = 0; m < 2; ++m)
#pragma unroll
                for (int r = 0; r < 4; ++r) { const float gg = acc[m][nt][r], uu = acc[m + 2][nt][r]; v[4 * m + r] = gg * fast_rcp(1.0f + __expf(-gg)) * uu; }
            u32x4 pk = {pk2(v[0], v[1]), pk2(v[2], v[3]), pk2(v[4], v[5]), pk2(v[6], v[7])};
            *(u32x4*)(act + (size_t)token * F + 32 * (4 * bn + wc) + 8 * fq) = pk;
        }
    }
}

DI void phase_resid(const bf16_t* A, int K, const bf16_t* W, const float* hin, float* hout, const float* __restrict__ gvec, float gs, char* lds) {
    const int tid_ = otid(), lane = tid_ & 63, wid = tid_ >> 6, wt = wid >> 2, wc = wid & 3, fr = lane & 15, fq = lane >> 4;
    constexpr int NTILES = 64 * 4;
    for (int t = blockIdx.x; t < NTILES; t += gridDim.x) {
        const int bm = t & 63, bn = t >> 6, row0 = bm * 256, ch0 = bn * 256 + 64 * wc + 16 * fq;
        f32x4 acc[4][8]; zero_acc2(acc);
        gemm_mainloop2(A + (size_t)row0 * K, K, W + (size_t)bn * 256 * K, K, K, acc, lds);
        f32x4 gv[4];
#pragma unroll
        for (int mw = 0; mw < 4; ++mw) gv[mw] = *(const f32x4*)(gvec + ch0 + 4 * mw) * gs;
#pragma unroll
        for (int nt = 0; nt < 8; ++nt) {
            const size_t off = (size_t)(row0 + 128 * wt + 16 * nt + fr) * D + ch0;
#pragma unroll
            for (int mw = 0; mw < 4; ++mw) { const f32x4 hv = *(const f32x4*)(hin + off + 4 * mw); *(f32x4*)(hout + off + 4 * mw) = hv + gv[mw] * acc[mw][nt]; }
            SB();
        }
    }
}

DI void phase_merge(const bf16_t* atta, const bf16_t* od, const bf16_t* wba, const bf16_t* wbb, const bf16_t* G, bf16_t* merged, float* spill, char* lds) {
    const int tid_ = otid(), lane = tid_ & 63, wid = tid_ >> 6, wt = wid >> 1, wc = wid & 1, fr = lane & 15, fq = lane >> 4;
    constexpr int NTILES = 64 * 8;
    for (int t = blockIdx.x; t < NTILES; t += gridDim.x) {
        const int bm = t & 63, bn = t >> 6, row0 = bm * 256, ch0 = bn * 128 + 64 * wc + 16 * fq;
        f32x4 acc[4][4]; zero_acc(acc);
        gemm_mainloop(atta + (size_t)row0 * 512, 512, wba + (size_t)bn * 128 * 512, 512, 512, acc, lds);
        float* sp = spill + ((size_t)blockIdx.x * 16 * 512 + tid_) * 4;
#pragma unroll
        for (int nt = 0; nt < 4; ++nt) {
            const bf16_t* gp = G + (size_t)(row0 + 64 * wt + 16 * nt + fr) * 2048 + ch0;
#pragma unroll
            for (int mw = 0; mw < 4; ++mw) { const u32x2 gu = *(const u32x2*)(gp + 4 * mw); const f32x4 ga = {bf_lo(gu[0]), bf_hi(gu[0]), bf_lo(gu[1]), bf_hi(gu[1])};
                *(f32x4*)(sp + (size_t)(nt * 4 + mw) * 2048) = ga * acc[mw][nt]; }
        }
        zero_acc(acc);
        gemm_mainloop(od + (size_t)row0 * 512, 512, wbb + (size_t)bn * 128 * 512, 512, 512, acc, lds);
#pragma unroll
        for (int nt = 0; nt < 4; ++nt) {
            const size_t tok = (size_t)(row0 + 64 * wt + 16 * nt + fr);
            const bf16_t* gp = G + tok * 2048 + 1024 + ch0;
            unsigned w[8];
#pragma unroll
            for (int mw = 0; mw < 4; ++mw) { const u32x2 gu = *(const u32x2*)(gp + 4 * mw); const f32x4 gb = {bf_lo(gu[0]), bf_hi(gu[0]), bf_lo(gu[1]), bf_hi(gu[1])};
                const f32x4 o = *(const f32x4*)(sp + (size_t)(nt * 4 + mw) * 2048) + gb * acc[mw][nt]; w[2 * mw] = pk2(o[0], o[1]); w[2 * mw + 1] = pk2(o[2], o[3]); }
            bf16_t* mp = merged + tok * D + ch0;
            *(u32x4*)(mp) = (u32x4){w[0], w[1], w[2], w[3]};
            *(u32x4*)(mp + 8) = (u32x4){w[4], w[5], w[6], w[7]};
        }
    }
}

DI void phase_win(const Params& p, int l, char* lds) {
    const int tid_ = otid(), lane = tid_ & 63, wid = tid_ >> 6, wt = wid >> 1, wc = wid & 1, fr = lane & 15, fq = lane >> 4;
    const bf16_t* n = (const bf16_t*)(p.ws + OFF_N);
    const bf16_t* W = (const bf16_t*)(p.ws + OFF_WIN + l * SZ_WIN);
    bf16_t* Q = (bf16_t*)(p.ws + OFF_Q); bf16_t* QD = (bf16_t*)(p.ws + OFF_QD); bf16_t* KA = (bf16_t*)(p.ws + OFF_KA); bf16_t* VTA = (bf16_t*)(p.ws + OFF_VTA);
    bf16_t* KD = (bf16_t*)(p.ws + OFF_KD); bf16_t* VTD = (bf16_t*)(p.ws + OFF_VTD); bf16_t* G = (bf16_t*)(p.ws + OFF_G);
    const float* rope = (const float*)(p.ws + OFF_ROPE);
    constexpr int NTILES = 64 * (NIN / 128);
    for (int t = blockIdx.x; t < NTILES; t += gridDim.x) {
        const int bm = t & 63, bn = t >> 6, row0 = bm * 256;
        f32x4 acc[4][4]; zero_acc(acc);
        gemm_mainloop(n + (size_t)row0 * D, D, W + (size_t)bn * 128 * D, D, D, acc, lds);
        const int cw = bn * 128 + 64 * wc;
        if (cw < 640) {
            const bool isq = cw < 512;
            const float* gq = p.qk_g + l * 128 + (isq ? 0 : 64);
            f32x4 gv[4];
#pragma unroll
            for (int mw = 0; mw < 4; ++mw) gv[mw] = *(const f32x4*)(gq + 16 * mw + 4 * fq);
#pragma unroll
            for (int nt = 0; nt < 4; ++nt) {
                const int token = row0 + 64 * wt + 16 * nt + fr;
                float ss = 0.f;
#pragma unroll
                for (int mw = 0; mw < 4; ++mw) ss += acc[mw][nt][0] * acc[mw][nt][0] + acc[mw][nt][1] * acc[mw][nt][1] + acc[mw][nt][2] * acc[mw][nt][2] + acc[mw][nt][3] * acc[mw][nt][3];
                ss += __shfl_xor(ss, 16); ss += __shfl_xor(ss, 32);
                const float rstd = rsqrtf(ss * (1.0f / 64.0f) + 1e-6f);
                f32x4 y[4];
#pragma unroll
                for (int mw = 0; mw < 4; ++mw) y[mw] = acc[mw][nt] * rstd * gv[mw];
                const int prow = token >> 6, pcol = token & 63;
                const f32x4 cr = *(const f32x4*)(rope + prow * 16 + 4 * fq), sr = *(const f32x4*)(rope + 4096 + prow * 16 + 4 * fq);
                const f32x4 cc = *(const f32x4*)(rope + 8192 + pcol * 16 + 4 * fq), sc = *(const f32x4*)(rope + 9216 + pcol * 16 + 4 * fq);
                f32x4 o[4];
                o[0] = y[0] * cr - y[1] * sr; o[1] = y[1] * cr + y[0] * sr; o[2] = y[2] * cc - y[3] * sc; o[3] = y[3] * cc + y[2] * sc;
                const float qs = isq ? QSCALE : 1.0f;
                bf16_t* dst = isq ? (Q + (size_t)token * 512 + cw) : (KA + (size_t)token * 128 + (cw - 512));
#pragma unroll
                for (int mw = 0; mw < 4; ++mw) { const f32x4 z = o[mw] * qs; *(u32x2*)(dst + 16 * mw + 4 * fq) = (u32x2){pk2(z[0], z[1]), pk2(z[2], z[3])}; }
            }
        } else if (cw < 768 || (cw >= 1792 && cw < 2304)) {
            bf16_t* vt = cw < 768 ? (VTA + (size_t)(cw - 640) * S) : (VTD + (size_t)(cw - 1792) * S);
#pragma unroll
            for (int nt = 0; nt < 4; ++nt) {
                const int token = row0 + 64 * wt + 16 * nt + fr;
#pragma unroll
                for (int mw = 0; mw < 4; ++mw)
#pragma unroll
                    for (int r = 0; r < 4; ++r) vt[(size_t)(16 * mw + 4 * fq + r) * S + token] = (bf16_t)(pk2(acc[mw][nt][r], 0.f) & 0xffffu);
            }
        } else if (cw < 1792) {
            const bool isq = cw < 1280; const float qs = isq ? QSCALE : 1.0f;
            bf16_t* base = isq ? (QD + (cw - 768)) : (KD + (cw - 1280));
#pragma unroll
            for (int nt = 0; nt < 4; ++nt) {
                bf16_t* dst = base + (size_t)(row0 + 64 * wt + 16 * nt + fr) * 512;
#pragma unroll
                for (int mw = 0; mw < 4; ++mw) { const f32x4 z = acc[mw][nt] * qs; *(u32x2*)(dst + 16 * mw + 4 * fq) = (u32x2){pk2(z[0], z[1]), pk2(z[2], z[3])}; }
            }
            {
                float best = 0.f;
#pragma unroll
                for (int nt = 0; nt < 4; ++nt) {
                    float ss = 0.f;
#pragma unroll
                    for (int mw = 0; mw < 4; ++mw) { const f32x4 z = acc[mw][nt] * qs; ss += z[0] * z[0] + z[1] * z[1] + z[2] * z[2] + z[3] * z[3]; }
                    ss += __shfl_xor(ss, 16); ss += __shfl_xor(ss, 32);
                    best = __builtin_fmaxf(best, ss);
                }
#pragma unroll
                for (int o = 8; o > 0; o >>= 1) best = __builtin_fmaxf(best, __shfl_xor(best, o));
                if (lane == 0) atomicMax((unsigned*)(p.ws + OFF_STAT) + l * 16 + (isq ? 0 : 8) + ((cw - (isq ? 768 : 1280)) >> 6), __float_as_uint(best));
            }
        } else {
            const int gc = cw - 2304;
            const float* bg = p.b_gate + l * 2048 + gc;
            f32x4 bv[4];
#pragma unroll
            for (int mw = 0; mw < 4; ++mw) bv[mw] = *(const f32x4*)(bg + 16 * mw + 4 * fq);
#pragma unroll
            for (int nt = 0; nt < 4; ++nt) {
                bf16_t* dst = G + (size_t)(row0 + 64 * wt + 16 * nt + fr) * 2048 + gc;
#pragma unroll
                for (int mw = 0; mw < 4; ++mw) {
                    const f32x4 xx = acc[mw][nt] + bv[mw]; f32x4 z;
#pragma unroll
                    for (int r = 0; r < 4; ++r) z[r] = fast_rcp(1.0f + __expf(-xx[r]));
                    *(u32x2*)(dst + 16 * mw + 4 * fq) = (u32x2){pk2(z[0], z[1]), pk2(z[2], z[3])};
                }
            }
        }
    }
}

#define MFMA32(a, b, c) __builtin_amdgcn_mfma_f32_32x32x16_bf16((a), (b), (c), 0, 0, 0)
template <int DV, bool ALIBI>
DI void attn_pass(const bf16_t* __restrict__ Qp, const bf16_t* __restrict__ Kb, int kpitch, const bf16_t* __restrict__ Vtb, float slope2, int qpos, int t_lo, int t_hi, float m_init,
                  f32x16 (&o)[DV / 32], float& l_out, char* lds) {
    constexpr int NV = DV / 64, NDT = DV / 32, STAGE = 8192 + DV * 128, G = 1 + NV;
    const int tid = otid(), lane = tid & 63, r32 = lane & 31, h = lane >> 5;
    bf16x8 qf[4];
#pragma unroll
    for (int d0 = 0; d0 < 4; ++d0) qf[d0] = *(const bf16x8*)(Qp + 16 * d0 + 8 * h);
    const int srow = tid >> 3, sch = (tid & 7) ^ ((srow >> 1) & 7);
    const bf16_t* kg = Kb + (size_t)srow * kpitch + sch * 8;
    const bf16_t* vg = Vtb + (size_t)srow * S + sch * 8;
    char* const ld = lds + tid * 16;
#define A_ISSUE(t_, st_) do { char* sn_ = ld + (st_) * STAGE; glds16(kg + (size_t)(t_) * 64 * kpitch, sn_); \
        _Pragma("unroll") for (int i = 0; i < NV; ++i) glds16(vg + (size_t)(64 * i) * S + (t_) * 64, sn_ + 8192 + i * 8192); } while (0)
    waitv<0>();
    A_ISSUE(t_lo, 0);
    if (t_lo + 1 <= t_hi) A_ISSUE(t_lo + 1, 1);
    if (t_lo + 2 <= t_hi) A_ISSUE(t_lo + 2, 2);
    const int pi = (r32 & 0x13) | ((r32 & 4) << 1) | ((r32 & 8) >> 1);
    const int k_base = pi * 128, k_sw = (pi >> 1) & 7, v_base = 8192 + r32 * 128, v_sw = (r32 >> 1) & 7;
    float m = m_init, l = 0.f;
#pragma unroll
    for (int dt = 0; dt < NDT; ++dt)
#pragma unroll
        for (int r = 0; r < 16; ++r) o[dt][r] = 0.f;
    int cur = 0;
    for (int t = t_lo; t <= t_hi; ++t) {
        const int rem = t_hi - t;
        if (rem >= 2) waitv<2 * G>(); else if (rem == 1) waitv<G>(); else waitv<0>();
        rawbar();
        if (rem >= 3) A_ISSUE(t + 3, (cur + 3) & 3);
        const char* st = lds + cur * STAGE;
        cur = (cur + 1) & 3;
        bf16x8 kf[2][4];
#pragma unroll
        for (int kt = 0; kt < 2; ++kt)
#pragma unroll
            for (int d0 = 0; d0 < 4; ++d0) kf[kt][d0] = *(const bf16x8*)(st + kt * 4096 + k_base + (((2 * d0 + h) ^ k_sw) << 4));
        f32x16 sc[2];
        const float nm = -m;
#pragma unroll
        for (int kt = 0; kt < 2; ++kt)
#pragma unroll
            for (int r = 0; r < 16; ++r) sc[kt][r] = nm;
        SB();
        __builtin_amdgcn_s_setprio(1);
#pragma unroll
        for (int d0 = 0; d0 < 4; ++d0)
#pragma unroll
            for (int kt = 0; kt < 2; ++kt) sc[kt] = MFMA32(kf[kt][d0], qf[d0], sc[kt]);
        __builtin_amdgcn_s_setprio(0);
        bf16x8 vf[2][4];
        if (NDT == 2) {
#pragma unroll
            for (int dt = 0; dt < 2; ++dt)
#pragma unroll
                for (int ks = 0; ks < 4; ++ks) vf[dt][ks] = *(const bf16x8*)(st + v_base + dt * 4096 + (((2 * ks + h) ^ v_sw) << 4));
        }
        SB();
        if (ALIBI) {
#pragma unroll
            for (int kt = 0; kt < 2; ++kt) {
                const float dq = (float)(qpos - (64 * t + 32 * kt + 8 * h));
#pragma unroll
                for (int r = 0; r < 16; ++r) sc[kt][r] = __builtin_fmaf(-slope2, __builtin_fabsf(dq - (float)(16 * (r >> 3) + (r & 7))), sc[kt][r]);
            }
        }
        float mt = sc[0][0];
#pragma unroll
        for (int r = 1; r < 16; ++r) mt = __builtin_fmaxf(mt, sc[0][r]);
#pragma unroll
        for (int r = 0; r < 16; ++r) mt = __builtin_fmaxf(mt, sc[1][r]);
        mt = __builtin_fmaxf(mt, __shfl_xor(mt, 32));
        if (__any(mt > 8.0f)) {
            const float dl = __builtin_fmaxf(mt, 0.f), al = fast_exp2(-dl);
            l *= al; m += dl;
#pragma unroll
            for (int kt = 0; kt < 2; ++kt)
#pragma unroll
                for (int r = 0; r < 16; ++r) sc[kt][r] -= dl;
#pragma unroll
            for (int dt = 0; dt < NDT; ++dt)
#pragma unroll
                for (int r = 0; r < 16; ++r) o[dt][r] *= al;
        }
        float ps = 0.f;
#pragma unroll
        for (int kt = 0; kt < 2; ++kt)
#pragma unroll
            for (int r = 0; r < 16; ++r) { const float e = fast_exp2(sc[kt][r]); sc[kt][r] = e; ps += e; }
        l += ps;
        bf16x8 pf[4];
#pragma unroll
        for (int ks = 0; ks < 4; ++ks) {
            const int kt = ks >> 1, b = (ks & 1) * 8;
            u32x4 w = {pk2(sc[kt][b], sc[kt][b + 1]), pk2(sc[kt][b + 2], sc[kt][b + 3]), pk2(sc[kt][b + 4], sc[kt][b + 5]), pk2(sc[kt][b + 6], sc[kt][b + 7])};
            pf[ks] = __builtin_bit_cast(bf16x8, w);
        }
        SB();
        if (NDT == 4) {
#pragma unroll
            for (int gp = 0; gp < 2; ++gp) {
#pragma unroll
                for (int dt = 0; dt < 2; ++dt)
#pragma unroll
                    for (int ks = 0; ks < 4; ++ks) vf[dt][ks] = *(const bf16x8*)(st + v_base + (dt + 2 * gp) * 4096 + (((2 * ks + h) ^ v_sw) << 4));
                __builtin_amdgcn_s_setprio(1);
#pragma unroll
                for (int ks = 0; ks < 4; ++ks)
#pragma unroll
                    for (int dt = 0; dt < 2; ++dt) o[(dt + 2 * gp) % NDT] = MFMA32(vf[dt][ks], pf[ks], o[(dt + 2 * gp) % NDT]);
                __builtin_amdgcn_s_setprio(0);
                SB();
            }
        } else {
            __builtin_amdgcn_s_setprio(1);
#pragma unroll
            for (int ks = 0; ks < 4; ++ks)
#pragma unroll
                for (int dt = 0; dt < 2; ++dt) o[dt] = MFMA32(vf[dt][ks], pf[ks], o[dt]);
            __builtin_amdgcn_s_setprio(0);
        }
        SB();
    }
#undef A_ISSUE
    __syncthreads();
    l += __shfl_xor(l, 32);
    l_out = l;
}

DI void attn_pass_a(const bf16_t* __restrict__ Qp, const bf16_t* __restrict__ Kb, int kpitch, const bf16_t* __restrict__ Vtb, float mref, f32x16 (&o)[2], float& l_out, char* lds) {
    constexpr int STAGE = 16384, NTL = S / 64;
    const int tid = otid(), lane = tid & 63, r32 = lane & 31, h = lane >> 5;
    bf16x8 qf[4];
#pragma unroll
    for (int d0 = 0; d0 < 4; ++d0) qf[d0] = *(const bf16x8*)(Qp + 16 * d0 + 8 * h);
    const int srow = tid >> 3, sch = (tid & 7) ^ ((srow >> 1) & 7);
    const bf16_t* kg = Kb + (size_t)srow * kpitch + sch * 8;
    const bf16_t* vg = Vtb + (size_t)srow * S + sch * 8;
    char* const ld = lds + tid * 16;
#define AA_ISSUE(t_, st_) do { char* sn_ = ld + (st_) * STAGE; glds16(kg + (size_t)(t_) * 64 * kpitch, sn_); glds16(vg + (t_) * 64, sn_ + 8192); } while (0)
    waitv<0>();
    AA_ISSUE(0, 0); AA_ISSUE(1, 1); AA_ISSUE(2, 2);
    const int pi = (r32 & 0x13) | ((r32 & 4) << 1) | ((r32 & 8) >> 1);
    const int k_base = pi * 128, k_sw = (pi >> 1) & 7, v_base = 8192 + r32 * 128, v_sw = (r32 >> 1) & 7;
    f32x16 negm, lacc;
#pragma unroll
    for (int r = 0; r < 16; ++r) { negm[r] = -mref; lacc[r] = 0.f; o[0][r] = 0.f; o[1][r] = 0.f; }
    const bf16x8 ones = {(short)0x3F80, (short)0x3F80, (short)0x3F80, (short)0x3F80, (short)0x3F80, (short)0x3F80, (short)0x3F80, (short)0x3F80};
    f32x16 sA[2], sB[2];
#define AA_QK(DST, stp_) do { bf16x8 kf_[2][4]; \
        _Pragma("unroll") for (int kt = 0; kt < 2; ++kt) _Pragma("unroll") for (int d0 = 0; d0 < 4; ++d0) kf_[kt][d0] = *(const bf16x8*)((stp_) + kt * 4096 + k_base + (((2 * d0 + h) ^ k_sw) << 4)); \
        SB(); __builtin_amdgcn_s_setprio(1); \
        DST[0] = MFMA32(kf_[0][0], qf[0], negm); DST[1] = MFMA32(kf_[1][0], qf[0], negm); \
        _Pragma("unroll") for (int d0 = 1; d0 < 4; ++d0) { DST[0] = MFMA32(kf_[0][d0], qf[d0], DST[0]); DST[1] = MFMA32(kf_[1][d0], qf[d0], DST[1]); } \
        __builtin_amdgcn_s_setprio(0); } while (0)
    waitv<4>();
    rawbar();
    AA_QK(sA, lds);
#define AA_STEP(CUR, NXT, t_) do { const int t = (t_); \
        if (t + 2 < NTL) waitv<2>(); else waitv<0>();              \
        rawbar();                                                  \
        if (t + 3 < NTL) AA_ISSUE(t + 3, (t + 3) & 3); \
        const char* st = lds + (t & 3) * STAGE; \
        if (t + 1 < NTL) AA_QK(NXT, lds + ((t + 1) & 3) * STAGE); \
        bf16x8 vf[2][4]; \
        _Pragma("unroll") for (int dt = 0; dt < 2; ++dt) _Pragma("unroll") for (int ks = 0; ks < 4; ++ks) vf[dt][ks] = *(const bf16x8*)(st + v_base + dt * 4096 + (((2 * ks + h) ^ v_sw) << 4)); \
        SB(); \
        _Pragma("unroll") for (int kt = 0; kt < 2; ++kt) _Pragma("unroll") for (int r = 0; r < 16; ++r) CUR[kt][r] = fast_exp2(CUR[kt][r]); \
        bf16x8 pf[4]; \
        _Pragma("unroll") for (int ks = 0; ks < 4; ++ks) { const int kt = ks >> 1, b = (ks & 1) * 8; \
            u32x4 w = {pk2(CUR[kt][b], CUR[kt][b + 1]), pk2(CUR[kt][b + 2], CUR[kt][b + 3]), pk2(CUR[kt][b + 4], CUR[kt][b + 5]), pk2(CUR[kt][b + 6], CUR[kt][b + 7])}; \
            pf[ks] = __builtin_bit_cast(bf16x8, w); } \
        SB(); __builtin_amdgcn_s_setprio(1); \
        _Pragma("unroll") for (int ks = 0; ks < 4; ++ks) { _Pragma("unroll") for (int dt = 0; dt < 2; ++dt) o[dt] = MFMA32(vf[dt][ks], pf[ks], o[dt]); lacc = MFMA32(ones, pf[ks], lacc); } \
        __builtin_amdgcn_s_setprio(0); SB(); } while (0)
    for (int t2 = 0; t2 < NTL; t2 += 2) { AA_STEP(sA, sB, t2); AA_STEP(sB, sA, t2 + 1); }
#undef AA_STEP
#undef AA_QK
#undef AA_ISSUE
    __syncthreads();
    l_out = lacc[0];
}

DI void phase_attn(const Params& p, int l, int rep, char* lds) {
    const int tid = otid(), lane = tid & 63, wid = tid >> 6, r32 = lane & 31, h = lane >> 5;
    const bf16_t* Q = (const bf16_t*)(p.ws + OFF_Q); const bf16_t* QD = (const bf16_t*)(p.ws + OFF_QD); const bf16_t* KA = (const bf16_t*)(p.ws + OFF_KA);
    const bf16_t* VTA = (const bf16_t*)(p.ws + OFF_VTA); const bf16_t* KD = (const bf16_t*)(p.ws + OFF_KD); const bf16_t* VTD = (const bf16_t*)(p.ws + OFF_VTD);
    bf16_t* ATTA = (bf16_t*)(p.ws + OFF_ATTA); bf16_t* OD = (bf16_t*)(p.ws + OFF_OD); float* BO0 = (float*)(p.ws + OFF_N);
    const float lam = ((const float*)(p.ws + OFF_LAM))[l];
    const float oml = 1.0f - (l == 0 ? 0.2f : 0.35550906759096926f);
    float bA;
    { float gq = __builtin_fabsf(p.qk_g[l * 128 + lane]), gk = __builtin_fabsf(p.qk_g[l * 128 + 64 + lane]);
#pragma unroll
      for (int o_ = 32; o_ > 0; o_ >>= 1) { gq = __builtin_fmaxf(gq, __shfl_xor(gq, o_)); gk = __builtin_fmaxf(gk, __shfl_xor(gk, o_)); }
      bA = 64.0f * gq * gk * QSCALE * 1.01f; }
    unsigned* qcnt = (unsigned*)(p.ws + OFF_STAT) + 32 + l + 2 * rep;
    const unsigned* stat = (const unsigned*)(p.ws + OFF_STAT) + l * 16;
    volatile unsigned* lword = (volatile unsigned*)(lds + 147456 - 16);
    for (;;) {
        if (tid == 0) *lword = atomicAdd(qcnt, 1u);
        __syncthreads();
        const int u = (int)*lword;
        __syncthreads();
        if (u >= 768) break;
        if (PROBE_DUP == 5 && rep && (u < 128 || u >= 640)) continue;
        if (u < 128 || u >= 640) {
            const int hb = u < 64 ? 3 : (u < 128 ? 2 : (u < 704 ? 1 : 0)), qb = u & 63;
            const int token = 256 * qb + 32 * wid + r32;
            const float slope2 = exp2f(-2.0f * (float)(hb + 1)) * LOG2E;
            float* bo = BO0 + (size_t)token * 512 + hb * 128;
            f32x16 o[4]; float ls;
            int tl[2], th[2]; float mi[2];
#pragma unroll
            for (int mp = 0; mp < 2; ++mp) {
                const float qk = sqrtf(__uint_as_float(stat[mp * 4 + hb]) * __uint_as_float(stat[8 + mp * 4 + hb])) * 1.02f;
                const float R = __builtin_fminf((2.0f * qk + 150.0f) / slope2, 40000.0f);
                const int klo = 256 * qb - (int)R - 1, khi = 256 * qb + 255 + (int)R + 1;
                mi[mp] = -qk;
                tl[mp] = klo < 0 ? 0 : (klo >> 6); th[mp] = khi >= S ? (S / 64 - 1) : (khi >> 6);
            }
            attn_pass<128, true>(QD + (size_t)token * 512 + hb * 64, KD + hb * 64, 512, VTD + (size_t)(hb * 128) * S, slope2, token, tl[0], th[0], mi[0], o, ls, lds);
            {
                const float inv = 1.0f / ls;
#pragma unroll
                for (int dt = 0; dt < 4; ++dt)
#pragma unroll
                    for (int g = 0; g < 4; ++g) *(f32x4*)(bo + 32 * dt + 8 * g + 4 * h) = (f32x4){o[dt][4 * g] * inv, o[dt][4 * g + 1] * inv, o[dt][4 * g + 2] * inv, o[dt][4 * g + 3] * inv};
            }
            attn_pass<128, true>(QD + (size_t)token * 512 + 256 + hb * 64, KD + 256 + hb * 64, 512, VTD + (size_t)(hb * 128) * S, slope2, token, tl[1], th[1], mi[1], o, ls, lds);
            {
                const float inv = lam / ls; float ss = 0.f;
#pragma unroll
                for (int dt = 0; dt < 4; ++dt)
#pragma unroll
                    for (int g = 0; g < 4; ++g) {
                        const f32x4 a = *(const f32x4*)(bo + 32 * dt + 8 * g + 4 * h);
#pragma unroll
                        for (int j = 0; j < 4; ++j) { const float v = a[j] - o[dt][4 * g + j] * inv; o[dt][4 * g + j] = v; ss += v * v; }
                    }
                ss += __shfl_xor(ss, 32);
                const float rstd = rsqrtf(ss * (1.0f / 128.0f) + 1e-6f) * oml;
                const float* sg = p.subln_g + l * 128;
                bf16_t* dst = OD + (size_t)token * 512 + hb * 128;
#pragma unroll
                for (int dt = 0; dt < 4; ++dt)
#pragma unroll
                    for (int g = 0; g < 4; ++g) {
                        const int d = 32 * dt + 8 * g + 4 * h;
                        const f32x4 gg = *(const f32x4*)(sg + d);
                        *(u32x2*)(dst + d) = (u32x2){pk2(o[dt][4 * g] * rstd * gg[0], o[dt][4 * g + 1] * rstd * gg[1]), pk2(o[dt][4 * g + 2] * rstd * gg[2], o[dt][4 * g + 3] * rstd * gg[3])};
                    }
            }
        } else {
            const int v = u - 128, kv = v >> 8, hq = kv * 4 + (v & 3), qb = (v >> 2) & 63;
            const int token = 256 * qb + 32 * wid + r32;
            f32x16 o[2]; float ls;
            if (bA <= 40.0f) attn_pass_a(Q + (size_t)token * 512 + hq * 64, KA + kv * 64, 128, VTA + (size_t)(kv * 64) * S, bA, o, ls, lds);
            else attn_pass<64, false>(Q + (size_t)token * 512 + hq * 64, KA + kv * 64, 128, VTA + (size_t)(kv * 64) * S, 0.f, token, 0, S / 64 - 1, 0.f, o, ls, lds);
            const float inv = 1.0f / ls;
            bf16_t* dst = ATTA + (size_t)token * 512 + hq * 64;
#pragma unroll
            for (int dt = 0; dt < 2; ++dt)
#pragma unroll
                for (int g = 0; g < 4; ++g)
                    *(u32x2*)(dst + 32 * dt + 8 * g + 4 * h) = (u32x2){pk2(o[dt][4 * g] * inv, o[dt][4 * g + 1] * inv), pk2(o[dt][4 * g + 2] * inv, o[dt][4 * g + 3] * inv)};
        }
    }
}

__global__ void __launch_bounds__(512) mega(Params pin) {
    __shared__ __attribute__((aligned(16))) char lds[147456];
    cg::grid_group grid = cg::this_grid();
    int rep = 0;
    for (int ph = pin.ph_lo; ph < pin.ph_hi; ++ph) {
        Params p = pin;
        asm volatile("" : "+s"(p.ws), "+s"(p.out), "+s"(p.x));
        bf16_t* nbuf = (bf16_t*)(p.ws + OFF_N);
        bf16_t* act = (bf16_t*)(p.ws + OFF_ACT);
        if (ph == 0) phase_prologue(p, lds);
        else {
            const int l = ph == 23 ? 1 : (ph - 1) / 11, k = ph == 23 ? 11 : (ph - 1) % 11;
            const float* mod = (const float*)(p.ws + OFF_MOD) + l * 9216;
            switch (k) {
            case 0: case 3: case 8: case 11: {
                const int i = k == 0 ? 0 : (k == 3 ? 1 : 2);
                const float* hin = (ph == 1) ? p.x : p.out;
                if (k == 11) phase_norm(hin, p.final_g, nullptr, nullptr, nullptr, p.out);
                else phase_norm(hin, p.norm_g + (l * 3 + i) * D, mod + (3 * i) * D, mod + (3 * i + 1) * D, nbuf, nullptr);
            } break;
            case 1: case 9: {
                const int f = k == 1 ? 0 : 1;
                phase_gateup(nbuf, (const bf16_t*)(p.ws + OFF_WGU + (size_t)(l * 2 + f) * SZ_WGU), act, lds);
            } break;
            case 2: case 10: case 7: {
                if (k == 7) phase_resid((const bf16_t*)(p.ws + OFF_Q), D, (const bf16_t*)(p.ws + OFF_WO + l * SZ_WO), p.out, p.out, mod + 5 * D, rep ? 0.0f : 1.0f, lds);
                else {
                    const int f = k == 2 ? 0 : 1;
                    phase_resid(act, F, (const bf16_t*)(p.ws + OFF_WD + (size_t)(l * 2 + f) * SZ_WD), (ph == 3 && !rep) ? p.x : p.out, p.out, mod + (f == 0 ? 2 : 8) * D, rep ? 0.0f : 0.5f, lds);
                }
            } break;
            case 4: phase_win(p, l, lds); break;
            case 5: phase_attn(p, l, rep, lds); break;
            case 6: phase_merge((const bf16_t*)(p.ws + OFF_ATTA), (const bf16_t*)(p.ws + OFF_OD), (const bf16_t*)(p.ws + OFF_WBA + l * SZ_WB), (const bf16_t*)(p.ws + OFF_WBB + l * SZ_WB),
                                (const bf16_t*)(p.ws + OFF_G), (bf16_t*)(p.ws + OFF_Q), (float*)(p.ws + OFF_N), lds); break;
            default: break;
            }
        }
        if (ph + 1 < pin.ph_hi) grid.sync();
        if (PROBE_DUP >= 0 && rep == 0 && (ph == 0 ? PROBE_DUP == 100 : ((ph - 1) % 11 == PROBE_DUP && ph != 23))) { rep = 1; --ph; } else rep = 0;
    }
}

extern "C" void kernel_launch(void* const* d_in, const int* in_sizes, int n_in, void* d_out, int out_size, void* d_ws, size_t ws_size, hipStream_t stream) {
    if (n_in != 18 || out_size != S * D || ws_size < WS_END) { fprintf(stderr, "kernel_launch: unexpected shapes / workspace (n_in %d out %d ws %zu need %zu)\n", n_in, out_size, ws_size, (size_t)WS_END); return; }
    Params p{};
    const float** pp = (const float**)&p;
    for (int i = 0; i < 18; ++i) pp[i] = (const float*)d_in[i];
    p.out = (float*)d_out; p.ws = (unsigned char*)d_ws;
#if MK_MULTI
    for (int ph = 0; ph < NPH; ++ph) { p.ph_lo = ph; p.ph_hi = ph + 1; hipLaunchKernelGGL(mega, dim3(256), dim3(512), 0, stream, p); }
#else
    static int grid = 0;
    if (!grid) {
        int dev = 0, cus = 0, per_cu = 0;
        hipGetDevice(&dev); hipDeviceGetAttribute(&cus, hipDeviceAttributeMultiprocessorCount, dev);
        hipOccupancyMaxActiveBlocksPerMultiprocessor(&per_cu, (const void*)mega, 512, 0);
        if (per_cu < 1) { fprintf(stderr, "kernel_launch: occupancy query says %d blocks per CU\n", per_cu); per_cu = 1; }
        grid = cus;
    }
    p.ph_lo = 0; p.ph_hi = NPH;
    void* args[] = {&p};
    hipError_t e = hipLaunchCooperativeKernel((const void*)mega, dim3(grid), dim3(512), args, 0, stream);
    if (e != hipSuccess) fprintf(stderr, "cooperative launch failed: %s (grid %d)\n", hipGetErrorString(e), grid);
#endif
}
```

```cpp
#include <hip/hip_runtime.h>
#include <hip/hip_cooperative_groups.h>
#include <cstdio>
#include <cstdint>
namespace cg = cooperative_groups;

#ifndef MK_MULTI
#define MK_MULTI 0
#endif

#ifndef PROBE_DUP
#define PROBE_DUP -1
#endif
#define DI __device__ __forceinline__
typedef unsigned short bf16_t;
typedef short bf16x8 __attribute__((ext_vector_type(8)));
typedef float f32x4 __attribute__((ext_vector_type(4)));
typedef float f32x16 __attribute__((ext_vector_type(16)));
typedef unsigned u32x4 __attribute__((ext_vector_type(4)));
typedef unsigned u32x2 __attribute__((ext_vector_type(2)));

constexpr int S = 16384, D = 1024, F = 2816, NGU = 5632, NIN = 4352;
constexpr int NPH = 24;
constexpr float QSCALE = 0.125f * 1.4426950408889634f;
constexpr float LOG2E = 1.4426950408889634f;

constexpr size_t OFF_MOD = 0;
constexpr size_t OFF_LAM = 80000;
constexpr size_t OFF_STAT = 80128;
constexpr size_t OFF_ROPE = 81920;
constexpr size_t OFF_WGU = 1u << 20;
constexpr size_t SZ_WGU = (size_t)NGU * D * 2;
constexpr size_t OFF_WD = OFF_WGU + 4 * SZ_WGU;
constexpr size_t SZ_WD = (size_t)D * F * 2;
constexpr size_t OFF_WIN = OFF_WD + 4 * SZ_WD;
constexpr size_t SZ_WIN = (size_t)NIN * D * 2;
constexpr size_t OFF_WBA = OFF_WIN + 2 * SZ_WIN;
constexpr size_t SZ_WB = (size_t)D * 512 * 2;
constexpr size_t OFF_WBB = OFF_WBA + 2 * SZ_WB;
constexpr size_t OFF_WO = OFF_WBB + 2 * SZ_WB;
constexpr size_t SZ_WO = (size_t)D * D * 2;
constexpr size_t OFF_N = OFF_WO + 2 * SZ_WO;
constexpr size_t OFF_MIX = OFF_N + (size_t)S * D * 2;
constexpr size_t OFF_Q = OFF_MIX;
constexpr size_t OFF_QD = OFF_Q + (size_t)S * 512 * 2;
constexpr size_t OFF_KA = OFF_QD + (size_t)S * 512 * 2;
constexpr size_t OFF_VTA = OFF_KA + (size_t)S * 128 * 2;
constexpr size_t OFF_KD = OFF_VTA + (size_t)S * 128 * 2;
constexpr size_t OFF_VTD = OFF_KD + (size_t)S * 512 * 2;
constexpr size_t OFF_G = OFF_VTD + (size_t)S * 512 * 2;
constexpr size_t OFF_ATTA = OFF_G + (size_t)S * 2048 * 2;
constexpr size_t OFF_OD = OFF_ATTA + (size_t)S * 512 * 2;
constexpr size_t OFF_ACT = OFF_MIX;
constexpr size_t WS_END = OFF_OD + (size_t)S * 512 * 2;
static_assert((size_t)S * F * 2 <= WS_END - OFF_MIX, "act overlay");

struct Params {
    const float *x, *c, *ada_w, *ada_b, *norm_g, *ffn_wg, *ffn_wu, *ffn_wd, *w_in, *qk_g, *lam_p, *subln_g, *w_ba, *w_bb, *w_gate, *b_gate, *w_o, *final_g;
    float* out; unsigned char* ws; int ph_lo, ph_hi;
};

typedef __bf16 bf16v2 __attribute__((ext_vector_type(2)));
typedef float f32x2 __attribute__((ext_vector_type(2)));
DI unsigned pk2(float lo, float hi) { f32x2 v = {lo, hi}; bf16v2 b = __builtin_convertvector(v, bf16v2); return __builtin_bit_cast(unsigned, b); }
DI float bf_lo(unsigned u) { return __uint_as_float(u << 16); }
DI float bf_hi(unsigned u) { return __uint_as_float(u & 0xffff0000u); }
DI int lds_off(int row, int chunk) { return row * 128 + ((chunk ^ ((row >> 1) & 7)) << 4); }
DI float fast_exp2(float x) { return __builtin_amdgcn_exp2f(x); }
DI float fast_rcp(float x) { return __builtin_amdgcn_rcpf(x); }
DI int otid() { int t = threadIdx.x; asm volatile("" : "+v"(t)); return t; }
#define SB() __builtin_amdgcn_sched_barrier(0)

DI int perm64(int n) { return (n & ~63) | (((n >> 2) & 3) << 4) | (((n >> 4) & 3) << 2) | (n & 3); }
DI int gumap(int j) { return 128 * (j >> 6) + 64 * ((j >> 5) & 1) + 16 * ((j >> 2) & 1) + 4 * ((j >> 3) & 3) + (j & 3); }

struct TrDesc { const float* src; bf16_t* dst; int N, k0, n0, ldd, mode, roff; };
DI void tr_decode(const Params& p, int tt, TrDesc& d) {
    constexpr int N_TR_L = 5824;
    const int l = tt / N_TR_L, r = tt % N_TR_L;
    if (r < 4224) {
        const int f = r / 2112, r2 = r % 2112, which = r2 / 704, r3 = r2 % 704;
        const size_t lf = (size_t)(l * 2 + f);
        if (which < 2) { d.src = (which == 0 ? p.ffn_wg : p.ffn_wu) + lf * D * F; d.N = F; d.k0 = (r3 / 44) * 64; d.n0 = (r3 % 44) * 64; d.dst = (bf16_t*)(p.ws + OFF_WGU + lf * SZ_WGU); d.ldd = D; d.mode = 2; d.roff = which * 32; }
        else { d.src = p.ffn_wd + lf * F * D; d.N = D; d.k0 = (r3 / 16) * 64; d.n0 = (r3 % 16) * 64; d.dst = (bf16_t*)(p.ws + OFF_WD + lf * SZ_WD); d.ldd = F; d.mode = 1; d.roff = 0; }
    } else if (r < 4800) { const int r3 = r - 4224; d.src = p.w_in + (size_t)l * D * 2304; d.N = 2304; d.k0 = (r3 / 36) * 64; d.n0 = (r3 % 36) * 64; d.dst = (bf16_t*)(p.ws + OFF_WIN + l * SZ_WIN); d.ldd = D; d.mode = 0; d.roff = 0; }
    else if (r < 5312) { const int r3 = r - 4800; d.src = p.w_gate + (size_t)l * D * 2048; d.N = 2048; d.k0 = (r3 / 32) * 64; d.n0 = (r3 % 32) * 64; d.dst = (bf16_t*)(p.ws + OFF_WIN + l * SZ_WIN); d.ldd = D; d.mode = 0; d.roff = 2304; }
    else if (r < 5440) { const int r3 = r - 5312; d.src = p.w_ba + (size_t)l * 512 * D; d.N = D; d.k0 = (r3 / 16) * 64; d.n0 = (r3 % 16) * 64; d.dst = (bf16_t*)(p.ws + OFF_WBA + l * SZ_WB); d.ldd = 512; d.mode = 1; d.roff = 0; }
    else if (r < 5568) { const int r3 = r - 5440; d.src = p.w_bb + (size_t)l * 512 * D; d.N = D; d.k0 = (r3 / 16) * 64; d.n0 = (r3 % 16) * 64; d.dst = (bf16_t*)(p.ws + OFF_WBB + l * SZ_WB); d.ldd = 512; d.mode = 1; d.roff = 0; }
    else { const int r3 = r - 5568; d.src = p.w_o + (size_t)l * D * D; d.N = D; d.k0 = (r3 / 16) * 64; d.n0 = (r3 % 16) * 64; d.dst = (bf16_t*)(p.ws + OFF_WO + l * SZ_WO); d.ldd = D; d.mode = 1; d.roff = 0; }
}
DI void tr_load(const TrDesc& d, int tid, f32x4 (&v)[2]) {
    const int kk = tid >> 4, nn4 = (tid & 15) * 4;
#pragma unroll
    for (int ps = 0; ps < 2; ++ps) v[ps] = *(const f32x4*)(d.src + (size_t)(d.k0 + kk + 32 * ps) * d.N + d.n0 + nn4);
}
DI void tr_store(const TrDesc& d, int tid, const f32x4 (&v)[2], float* ldsf) {
    {
        const int kk = tid >> 4, nn4 = (tid & 15) * 4;
#pragma unroll
        for (int ps = 0; ps < 2; ++ps) { const int k = kk + 32 * ps; ldsf[k * 65 + nn4 + 0] = v[ps][0]; ldsf[k * 65 + nn4 + 1] = v[ps][1]; ldsf[k * 65 + nn4 + 2] = v[ps][2]; ldsf[k * 65 + nn4 + 3] = v[ps][3]; }
    }
    __syncthreads();
    {
        const int n = tid >> 3, ch = tid & 7, gn = d.n0 + n;
        int drow;
        if (d.mode == 0) drow = gn + d.roff; else if (d.mode == 1) drow = perm64(gn); else drow = gumap(gn) + d.roff;
        float w[8];
#pragma unroll
        for (int i = 0; i < 8; ++i) w[i] = ldsf[(ch * 8 + i) * 65 + n];
        u32x4 pk = {pk2(w[0], w[1]), pk2(w[2], w[3]), pk2(w[4], w[5]), pk2(w[6], w[7])};
        *(u32x4*)(d.dst + (size_t)drow * d.ldd + d.k0 + ch * 8) = pk;
    }
    __syncthreads();
}

DI void phase_prologue(const Params& p, char* lds) {
    const int tid = otid();
    float* ldsf = (float*)lds;
    constexpr int N_MOD = 288, N_TR = 2 * 5824;
    for (int it = blockIdx.x; it < N_MOD; it += gridDim.x) {
        const int l = it / 144, j0 = (it % 144) * 64, jj = tid & 15, ii = tid >> 4;
        float* cact = ldsf + 2048;
        for (int i = tid; i < 1024; i += 512) { const float cv = p.c[i]; cact[i] = cv / (1.f + expf(-cv)); }
        __syncthreads();
        f32x4 a = {0.f, 0.f, 0.f, 0.f};
        const float* wb = p.ada_w + (size_t)l * 1024 * 9216 + j0 + 4 * jj;
#pragma unroll 8
        for (int r = 0; r < 32; ++r) { const int i = ii + 32 * r; a += cact[i] * *(const f32x4*)(wb + (size_t)i * 9216); }
        *(f32x4*)(ldsf + ii * 64 + 4 * jj) = a;
        __syncthreads();
        if (tid < 64) {
            float sm = 0.f;
#pragma unroll
            for (int r = 0; r < 32; ++r) sm += ldsf[r * 64 + tid];
            ((float*)(p.ws + OFF_MOD))[l * 9216 + j0 + tid] = sm + p.ada_b[l * 9216 + j0 + tid];
        }
        __syncthreads();
    }
    if (blockIdx.x == gridDim.x - 1) {
        if (tid < 64) {
#pragma unroll
            for (int l = 0; l < 2; ++l) {
                const float* lp = p.lam_p + l * 256;
                float a = lp[tid] * lp[64 + tid], b = lp[128 + tid] * lp[192 + tid];
#pragma unroll
                for (int o = 32; o > 0; o >>= 1) { a += __shfl_xor(a, o); b += __shfl_xor(b, o); }
                const float li = l == 0 ? 0.2f : 0.35550906759096926f;
                if (tid == 0) ((float*)(p.ws + OFF_LAM))[l] = expf(a) - expf(b) + li;
            }
        }
        if (tid < 64) ((unsigned*)(p.ws + OFF_STAT))[tid] = 0u;
        float* rope = (float*)(p.ws + OFF_ROPE);
        for (int e = tid; e < 320 * 16; e += 512) {
            const int pi = e >> 4, i = e & 15;
            const int pos = pi < 256 ? pi - 128 : (pi - 256) - 32;
            const float inv = exp2f(-(float)i * (13.287712379549449f / 16.0f));
            const float angf = (float)pos * inv;
            double r = (double)angf; r -= rint(r * 0.15915494309189535) * 6.283185307179586;
            const double r2 = r * r;
            double sn = 0.0, cs = 0.0;
#pragma unroll 1
            for (int n = 14; n >= 1; --n) { sn = (sn + 1.0) * (-r2 / (double)((2 * n) * (2 * n + 1))); cs = (cs + 1.0) * (-r2 / (double)((2 * n - 1) * (2 * n))); }
            sn = (sn + 1.0) * r; cs = cs + 1.0;
            if (pi < 256) { rope[pi * 16 + i] = (float)cs; rope[4096 + pi * 16 + i] = (float)sn; }
            else { rope[8192 + (pi - 256) * 16 + i] = (float)cs; rope[9216 + (pi - 256) * 16 + i] = (float)sn; }
        }
    }
    {
        int tt = blockIdx.x;
        TrDesc d; f32x4 v[2];
        if (tt < N_TR) { tr_decode(p, tt, d); tr_load(d, tid, v); }
        while (tt < N_TR) {
            const int tn = tt + gridDim.x;
            TrDesc dn; f32x4 vn[2];
            if (tn < N_TR) { tr_decode(p, tn, dn); tr_load(dn, tid, vn); }
            tr_store(d, tid, v, ldsf);
            if (tn < N_TR) { d = dn; v[0] = vn[0]; v[1] = vn[1]; }
            tt = tn;
        }
    }
}

DI void phase_norm(const float* hin, const float* __restrict__ g, const float* __restrict__ sh, const float* __restrict__ sc, bf16_t* nout, float* fout) {
    const int tid_ = otid(), lane = tid_ & 63, wid = tid_ >> 6;
    const int nw = gridDim.x * 8;
    for (int row = blockIdx.x * 8 + wid; row < S; row += nw) {
        const float* hp = hin + (size_t)row * D;
        f32x4 v[4]; float ss = 0.f;
#pragma unroll
        for (int i = 0; i < 4; ++i) { v[i] = *(const f32x4*)(hp + (i * 64 + lane) * 4); ss += v[i][0] * v[i][0] + v[i][1] * v[i][1] + v[i][2] * v[i][2] + v[i][3] * v[i][3]; }
#pragma unroll
        for (int o = 32; o > 0; o >>= 1) ss += __shfl_xor(ss, o);
        const float rstd = rsqrtf(ss * (1.0f / 1024.0f) + 1e-6f);
#pragma unroll
        for (int i = 0; i < 4; ++i) {
            const int col = (i * 64 + lane) * 4;
            const f32x4 gv = *(const f32x4*)(g + col);
            f32x4 y = v[i] * rstd * gv;
            if (sc) { const f32x4 s1 = *(const f32x4*)(sc + col), s0 = *(const f32x4*)(sh + col); y = y * (1.0f + s1) + s0; }
            if (fout) *(f32x4*)(fout + (size_t)row * D + col) = y;
            else { u32x2 pk = {pk2(y[0], y[1]), pk2(y[2], y[3])}; *(u32x2*)(nout + (size_t)row * D + col) = pk; }
        }
    }
}

DI void glds16(const void* g, char* l) { __builtin_amdgcn_global_load_lds((const unsigned*)g, (unsigned*)l, 16, 0, 0); }
template <int N> DI void waitv() { asm volatile("s_waitcnt vmcnt(%0)" ::"n"(N) : "memory"); }
DI void rawbar() { __builtin_amdgcn_s_barrier(); }
constexpr int GST = 49152;
DI void gemm_mainloop(const bf16_t* __restrict__ A, int lda, const bf16_t* __restrict__ W, int ldw, int K, f32x4 (&acc)[4][4], char* lds) {
    const int tid = otid(), lane = tid & 63, wid = tid >> 6, wt = wid >> 1, wc = wid & 1;
    const int srow = tid >> 3, sch = (tid & 7) ^ ((srow >> 1) & 7);
    const bf16_t* ag = A + (size_t)srow * lda + sch * 8;
    const bf16_t* wg = W + (size_t)srow * ldw + sch * 8;
    char* const ld = lds + tid * 16;
    const int nk = K >> 6;
#define G_ISSUE(kt_, st_) do { const int ko_ = (kt_) * 64; char* sn_ = ld + (st_) * GST; \
        _Pragma("unroll") for (int i = 0; i < 4; ++i) glds16(ag + (size_t)(64 * i) * lda + ko_, sn_ + i * 8192); \
        _Pragma("unroll") for (int i = 0; i < 2; ++i) glds16(wg + (size_t)(64 * i) * ldw + ko_, sn_ + 32768 + i * 8192); } while (0)
    waitv<0>();
    G_ISSUE(0, 0); G_ISSUE(1, 1);
    const int fr = lane & 15, fq = lane >> 4, sw = (fr >> 1) & 7;
    const int a_base = (64 * wt + fr) * 128, w_base = 32768 + (64 * wc + fr) * 128;
    int cur = 0, nxt = 2;
    for (int kt = 0; kt < nk; ++kt) {
        if (kt + 1 < nk) waitv<6>(); else waitv<0>();
        rawbar();
        if (kt + 2 < nk) G_ISSUE(kt + 2, nxt);
        const char* st = lds + cur * GST;
#pragma unroll
        for (int kk = 0; kk < 2; ++kk) {
            const int co = ((kk * 4 + fq) ^ sw) << 4;
            bf16x8 af[4], wf[4];
#pragma unroll
            for (int i = 0; i < 4; ++i) af[i] = *(const bf16x8*)(st + a_base + i * 2048 + co);
#pragma unroll
            for (int i = 0; i < 4; ++i) wf[i] = *(const bf16x8*)(st + w_base + i * 2048 + co);
#pragma unroll
            for (int mw = 0; mw < 4; ++mw)
#pragma unroll
                for (int nt = 0; nt < 4; ++nt) acc[mw][nt] = __builtin_amdgcn_mfma_f32_16x16x32_bf16(wf[mw], af[nt], acc[mw][nt], 0, 0, 0);
        }
        cur = cur == 2 ? 0 : cur + 1; nxt = nxt == 2 ? 0 : nxt + 1;
    }
#undef G_ISSUE
    __syncthreads();
}
constexpr int GST2 = 65536;
DI void gemm_mainloop2(const bf16_t* __restrict__ A, int lda, const bf16_t* __restrict__ W, int ldw, int K, f32x4 (&acc)[4][8], char* lds) {
    const int tid = otid(), lane = tid & 63, wid = tid >> 6, wt = wid >> 2, wc = wid & 3;
    const int srow = tid >> 3, sch = (tid & 7) ^ ((srow >> 1) & 7);
    const bf16_t* ag = A + (size_t)srow * lda + sch * 8;
    const bf16_t* wg = W + (size_t)srow * ldw + sch * 8;
    char* const ld = lds + tid * 16;
    const int nk = K >> 6;
#define G2_ISSUE(kt_, st_) do { const int ko_ = (kt_) * 64; char* sn_ = ld + (st_) * GST2; \
        _Pragma("unroll") for (int i = 0; i < 4; ++i) glds16(ag + (size_t)(64 * i) * lda + ko_, sn_ + i * 8192); \
        _Pragma("unroll") for (int i = 0; i < 4; ++i) glds16(wg + (size_t)(64 * i) * ldw + ko_, sn_ + 32768 + i * 8192); } while (0)
    waitv<0>();
    G2_ISSUE(0, 0);
    const int fr = lane & 15, fq = lane >> 4, sw = (fr >> 1) & 7;
    const int a_base = (128 * wt + fr) * 128, w_base = 32768 + (64 * wc + fr) * 128;
    for (int kt = 0; kt < nk; ++kt) {
        waitv<0>();
        rawbar();
        if (kt + 1 < nk) G2_ISSUE(kt + 1, (kt + 1) & 1);
        const char* st = lds + (kt & 1) * GST2;
#pragma unroll
        for (int kk = 0; kk < 2; ++kk) {
            const int co = ((kk * 4 + fq) ^ sw) << 4;
            bf16x8 af[8], wf[4];
#pragma unroll
            for (int i = 0; i < 4; ++i) wf[i] = *(const bf16x8*)(st + w_base + i * 2048 + co);
#pragma unroll
            for (int i = 0; i < 8; ++i) af[i] = *(const bf16x8*)(st + a_base + i * 2048 + co);
            __builtin_amdgcn_s_setprio(1);
#pragma unroll
            for (int nt = 0; nt < 8; ++nt)
#pragma unroll
                for (int mw = 0; mw < 4; ++mw) acc[mw][nt] = __builtin_amdgcn_mfma_f32_16x16x32_bf16(wf[mw], af[nt], acc[mw][nt], 0, 0, 0);
            __builtin_amdgcn_s_setprio(0);
            SB();
        }
    }
#undef G2_ISSUE
    __syncthreads();
}
DI void zero_acc2(f32x4 (&acc)[4][8]) {
#pragma unroll
    for (int a = 0; a < 4; ++a)
#pragma unroll
        for (int b = 0; b < 8; ++b) acc[a][b] = (f32x4){0.f, 0.f, 0.f, 0.f};
}
DI void zero_acc(f32x4 (&acc)[4][4]) {
#pragma unroll
    for (int a = 0; a < 4; ++a)
#pragma unroll
        for (int b = 0; b < 4; ++b) acc[a][b] = (f32x4){0.f, 0.f, 0.f, 0.f};
}

DI void phase_gateup(const bf16_t* n, const bf16_t* wgu, bf16_t* act, char* lds) {
    const int tid_ = otid(), lane = tid_ & 63, wid = tid_ >> 6, wt = wid >> 2, wc = wid & 3, fr = lane & 15, fq = lane >> 4;
    constexpr int NTILES = 64 * (NGU / 256);
    for (int t = blockIdx.x; t < NTILES; t += gridDim.x) {
        const int bm = t & 63, bn = t >> 6, row0 = bm * 256;
        f32x4 acc[4][8]; zero_acc2(acc);
        gemm_mainloop2(n + (size_t)row0 * D, D, wgu + (size_t)bn * 256 * D, D, D, acc, lds);
#pragma unroll
        for (int nt = 0; nt < 8; ++nt) {
            const int token = row0 + 128 * wt + 16 * nt + fr;
            float v[8];
#pragma unroll
            for (int m = 0; m < 2; ++m)
#pragma unroll
                for (int r = 0; r < 4; ++r) { const float gg = acc[m][nt][r], uu = acc[m + 2][nt][r]; v[4 * m + r] = gg * fast_rcp(1.0f + __expf(-gg)) * uu; }
            u32x4 pk = {pk2(v[0], v[1]), pk2(v[2], v[3]), pk2(v[4], v[5]), pk2(v[6], v[7])};
            *(u32x4*)(act + (size_t)token * F + 32 * (4 * bn + wc) + 8 * fq) = pk;
        }
    }
}

DI void phase_resid(const bf16_t* A, int K, const bf16_t* W, const float* hin, float* hout, const float* __restrict__ gvec, float gs, char* lds) {
    const int tid_ = otid(), lane = tid_ & 63, wid = tid_ >> 6, wt = wid >> 2, wc = wid & 3, fr = lane & 15, fq = lane >> 4;
    constexpr int NTILES = 64 * 4;
    for (int t = blockIdx.x; t < NTILES; t += gridDim.x) {
        const int bm = t & 63, bn = t >> 6, row0 = bm * 256, ch0 = bn * 256 + 64 * wc + 16 * fq;
        f32x4 acc[4][8]; zero_acc2(acc);
        gemm_mainloop2(A + (size_t)row0 * K, K, W + (size_t)bn * 256 * K, K, K, acc, lds);
        f32x4 gv[4];
#pragma unroll
        for (int mw = 0; mw < 4; ++mw) gv[mw] = *(const f32x4*)(gvec + ch0 + 4 * mw) * gs;
#pragma unroll
        for (int nt = 0; nt < 8; ++nt) {
            const size_t off = (size_t)(row0 + 128 * wt + 16 * nt + fr) * D + ch0;
#pragma unroll
            for (int mw = 0; mw < 4; ++mw) { const f32x4 hv = *(const f32x4*)(hin + off + 4 * mw); *(f32x4*)(hout + off + 4 * mw) = hv + gv[mw] * acc[mw][nt]; }
            SB();
        }
    }
}

DI void phase_merge(const bf16_t* atta, const bf16_t* od, const bf16_t* wba, const bf16_t* wbb, const bf16_t* G, bf16_t* merged, float* spill, char* lds) {
    const int tid_ = otid(), lane = tid_ & 63, wid = tid_ >> 6, wt = wid >> 1, wc = wid & 1, fr = lane & 15, fq = lane >> 4;
    constexpr int NTILES = 64 * 8;
    for (int t = blockIdx.x; t < NTILES; t += gridDim.x) {
        const int bm = t & 63, bn = t >> 6, row0 = bm * 256, ch0 = bn * 128 + 64 * wc + 16 * fq;
        f32x4 acc[4][4]; zero_acc(acc);
        gemm_mainloop(atta + (size_t)row0 * 512, 512, wba + (size_t)bn * 128 * 512, 512, 512, acc, lds);
        float* sp = spill + ((size_t)blockIdx.x * 16 * 512 + tid_) * 4;
#pragma unroll
        for (int nt = 0; nt < 4; ++nt) {
            const bf16_t* gp = G + (size_t)(row0 + 64 * wt + 16 * nt + fr) * 2048 + ch0;
#pragma unroll
            for (int mw = 0; mw < 4; ++mw) { const u32x2 gu = *(const u32x2*)(gp + 4 * mw); const f32x4 ga = {bf_lo(gu[0]), bf_hi(gu[0]), bf_lo(gu[1]), bf_hi(gu[1])};
                *(f32x4*)(sp + (size_t)(nt * 4 + mw) * 2048) = ga * acc[mw][nt]; }
        }
        zero_acc(acc);
        gemm_mainloop(od + (size_t)row0 * 512, 512, wbb + (size_t)bn * 128 * 512, 512, 512, acc, lds);
#pragma unroll
        for (int nt = 0; nt < 4; ++nt) {
            const size_t tok = (size_t)(row0 + 64 * wt + 16 * nt + fr);
            const bf16_t* gp = G + tok * 2048 + 1024 + ch0;
            unsigned w[8];
#pragma unroll
            for (int mw = 0; mw < 4; ++mw) { const u32x2 gu = *(const u32x2*)(gp + 4 * mw); const f32x4 gb = {bf_lo(gu[0]), bf_hi(gu[0]), bf_lo(gu[1]), bf_hi(gu[1])};
                const f32x4 o = *(const f32x4*)(sp + (size_t)(nt * 4 + mw) * 2048) + gb * acc[mw][nt]; w[2 * mw] = pk2(o[0], o[1]); w[2 * mw + 1] = pk2(o[2], o[3]); }
            bf16_t* mp = merged + tok * D + ch0;
            *(u32x4*)(mp) = (u32x4){w[0], w[1], w[2], w[3]};
            *(u32x4*)(mp + 8) = (u32x4){w[4], w[5], w[6], w[7]};
        }
    }
}

DI void phase_win(const Params& p, int l, char* lds) {
    const int tid_ = otid(), lane = tid_ & 63, wid = tid_ >> 6, wt = wid >> 1, wc = wid & 1, fr = lane & 15, fq = lane >> 4;
    const bf16_t* n = (const bf16_t*)(p.ws + OFF_N);
    const bf16_t* W = (const bf16_t*)(p.ws + OFF_WIN + l * SZ_WIN);
    bf16_t* Q = (bf16_t*)(p.ws + OFF_Q); bf16_t* QD = (bf16_t*)(p.ws + OFF_QD); bf16_t* KA = (bf16_t*)(p.ws + OFF_KA); bf16_t* VTA = (bf16_t*)(p.ws + OFF_VTA);
    bf16_t* KD = (bf16_t*)(p.ws + OFF_KD); bf16_t* VTD = (bf16_t*)(p.ws + OFF_VTD); bf16_t* G = (bf16_t*)(p.ws + OFF_G);
    const float* rope = (const float*)(p.ws + OFF_ROPE);
    constexpr int NTILES = 64 * (NIN / 128);
    for (int t = blockIdx.x; t < NTILES; t += gridDim.x) {
        const int bm = t & 63, bn = t >> 6, row0 = bm * 256;
        f32x4 acc[4][4]; zero_acc(acc);
        gemm_mainloop(n + (size_t)row0 * D, D, W + (size_t)bn * 128 * D, D, D, acc, lds);
        const int cw = bn * 128 + 64 * wc;
        if (cw < 640) {
            const bool isq = cw < 512;
            const float* gq = p.qk_g + l * 128 + (isq ? 0 : 64);
            f32x4 gv[4];
#pragma unroll
            for (int mw = 0; mw < 4; ++mw) gv[mw] = *(const f32x4*)(gq + 16 * mw + 4 * fq);
#pragma unroll
            for (int nt = 0; nt < 4; ++nt) {
                const int token = row0 + 64 * wt + 16 * nt + fr;
                float ss = 0.f;
#pragma unroll
                for (int mw = 0; mw < 4; ++mw) ss += acc[mw][nt][0] * acc[mw][nt][0] + acc[mw][nt][1] * acc[mw][nt][1] + acc[mw][nt][2] * acc[mw][nt][2] + acc[mw][nt][3] * acc[mw][nt][3];
                ss += __shfl_xor(ss, 16); ss += __shfl_xor(ss, 32);
                const float rstd = rsqrtf(ss * (1.0f / 64.0f) + 1e-6f);
                f32x4 y[4];
#pragma unroll
                for (int mw = 0; mw < 4; ++mw) y[mw] = acc[mw][nt] * rstd * gv[mw];
                const int prow = token >> 6, pcol = token & 63;
                const f32x4 cr = *(const f32x4*)(rope + prow * 16 + 4 * fq), sr = *(const f32x4*)(rope + 4096 + prow * 16 + 4 * fq);
                const f32x4 cc = *(const f32x4*)(rope + 8192 + pcol * 16 + 4 * fq), sc = *(const f32x4*)(rope + 9216 + pcol * 16 + 4 * fq);
                f32x4 o[4];
                o[0] = y[0] * cr - y[1] * sr; o[1] = y[1] * cr + y[0] * sr; o[2] = y[2] * cc - y[3] * sc; o[3] = y[3] * cc + y[2] * sc;
                const float qs = isq ? QSCALE : 1.0f;
                bf16_t* dst = isq ? (Q + (size_t)token * 512 + cw) : (KA + (size_t)token * 128 + (cw - 512));
#pragma unroll
                for (int mw = 0; mw < 4; ++mw) { const f32x4 z = o[mw] * qs; *(u32x2*)(dst + 16 * mw + 4 * fq) = (u32x2){pk2(z[0], z[1]), pk2(z[2], z[3])}; }
            }
        } else if (cw < 768 || (cw >= 1792 && cw < 2304)) {
            bf16_t* vt = cw < 768 ? (VTA + (size_t)(cw - 640) * S) : (VTD + (size_t)(cw - 1792) * S);
#pragma unroll
            for (int nt = 0; nt < 4; ++nt) {
                const int token = row0 + 64 * wt + 16 * nt + fr;
#pragma unroll
                for (int mw = 0; mw < 4; ++mw)
#pragma unroll
                    for (int r = 0; r < 4; ++r) vt[(size_t)(16 * mw + 4 * fq + r) * S + token] = (bf16_t)(pk2(acc[mw][nt][r], 0.f) & 0xffffu);
            }
        } else if (cw < 1792) {
            const bool isq = cw < 1280; const float qs = isq ? QSCALE : 1.0f;
            bf16_t* base = isq ? (QD + (cw - 768)) : (KD + (cw - 1280));
#pragma unroll
            for (int nt = 0; nt < 4; ++nt) {
                bf16_t* dst = base + (size_t)(row0 + 64 * wt + 16 * nt + fr) * 512;
#pragma unroll
                for (int mw = 0; mw < 4; ++mw) { const f32x4 z = acc[mw][nt] * qs; *(u32x2*)(dst + 16 * mw + 4 * fq) = (u32x2){pk2(z[0], z[1]), pk2(z[2], z[3])}; }
            }
            {
                float best = 0.f;
#pragma unroll
                for (int nt = 0; nt < 4; ++nt) {
                    float ss = 0.f;
#pragma unroll
                    for (int mw = 0; mw < 4; ++mw) { const f32x4 z = acc[mw][nt] * qs; ss += z[0] * z[0] + z[1] * z[1] + z[2] * z[2] + z[3] * z[3]; }
                    ss += __shfl_xor(ss, 16); ss += __shfl_xor(ss, 32);
                    best = __builtin_fmaxf(best, ss);
                }
#pragma unroll
                for (int o = 8; o > 0; o >>= 1) best = __builtin_fmaxf(best, __shfl_xor(best, o));
                if (lane == 0) atomicMax((unsigned*)(p.ws + OFF_STAT) + l * 16 + (isq ? 0 : 8) + ((cw - (isq ? 768 : 1280)) >> 6), __float_as_uint(best));
            }
        } else {
            const int gc = cw - 2304;
            const float* bg = p.b_gate + l * 2048 + gc;
            f32x4 bv[4];
#pragma unroll
            for (int mw = 0; mw < 4; ++mw) bv[mw] = *(const f32x4*)(bg + 16 * mw + 4 * fq);
#pragma unroll
            for (int nt = 0; nt < 4; ++nt) {
                bf16_t* dst = G + (size_t)(row0 + 64 * wt + 16 * nt + fr) * 2048 + gc;
#pragma unroll
                for (int mw = 0; mw < 4; ++mw) {
                    const f32x4 xx = acc[mw][nt] + bv[mw]; f32x4 z;
#pragma unroll
                    for (int r = 0; r < 4; ++r) z[r] = fast_rcp(1.0f + __expf(-xx[r]));
                    *(u32x2*)(dst + 16 * mw + 4 * fq) = (u32x2){pk2(z[0], z[1]), pk2(z[2], z[3])};
                }
            }
        }
    }
}

#define MFMA32(a, b, c) __builtin_amdgcn_mfma_f32_32x32x16_bf16((a), (b), (c), 0, 0, 0)
template <int DV, bool ALIBI>
DI void attn_pass(const bf16_t* __restrict__ Qp, const bf16_t* __restrict__ Kb, int kpitch, const bf16_t* __restrict__ Vtb, float slope2, int qpos, int t_lo, int t_hi, float m_init,
                  f32x16 (&o)[DV / 32], float& l_out, char* lds) {
    constexpr int NV = DV / 64, NDT = DV / 32, STAGE = 8192 + DV * 128, G = 1 + NV;
    const int tid = otid(), lane = tid & 63, r32 = lane & 31, h = lane >> 5;
    bf16x8 qf[4];
#pragma unroll
    for (int d0 = 0; d0 < 4; ++d0) qf[d0] = *(const bf16x8*)(Qp + 16 * d0 + 8 * h);
    const int srow = tid >> 3, sch = (tid & 7) ^ ((srow >> 1) & 7);
    const bf16_t* kg = Kb + (size_t)srow * kpitch + sch * 8;
    const bf16_t* vg = Vtb + (size_t)srow * S + sch * 8;
    char* const ld = lds + tid * 16;
#define A_ISSUE(t_, st_) do { char* sn_ = ld + (st_) * STAGE; glds16(kg + (size_t)(t_) * 64 * kpitch, sn_); \
        _Pragma("unroll") for (int i = 0; i < NV; ++i) glds16(vg + (size_t)(64 * i) * S + (t_) * 64, sn_ + 8192 + i * 8192); } while (0)
    waitv<0>();
    A_ISSUE(t_lo, 0);
    if (t_lo + 1 <= t_hi) A_ISSUE(t_lo + 1, 1);
    if (t_lo + 2 <= t_hi) A_ISSUE(t_lo + 2, 2);
    const int pi = (r32 & 0x13) | ((r32 & 4) << 1) | ((r32 & 8) >> 1);
    const int k_base = pi * 128, k_sw = (pi >> 1) & 7, v_base = 8192 + r32 * 128, v_sw = (r32 >> 1) & 7;
    float m = m_init, l = 0.f;
#pragma unroll
    for (int dt = 0; dt < NDT; ++dt)
#pragma unroll
        for (int r = 0; r < 16; ++r) o[dt][r] = 0.f;
    int cur = 0;
    for (int t = t_lo; t <= t_hi; ++t) {
        const int rem = t_hi - t;
        if (rem >= 2) waitv<2 * G>(); else if (rem == 1) waitv<G>(); else waitv<0>();
        rawbar();
        if (rem >= 3) A_ISSUE(t + 3, (cur + 3) & 3);
        const char* st = lds + cur * STAGE;
        cur = (cur + 1) & 3;
        bf16x8 kf[2][4];
#pragma unroll
        for (int kt = 0; kt < 2; ++kt)
#pragma unroll
            for (int d0 = 0; d0 < 4; ++d0) kf[kt][d0] = *(const bf16x8*)(st + kt * 4096 + k_base + (((2 * d0 + h) ^ k_sw) << 4));
        f32x16 sc[2];
        const float nm = -m;
#pragma unroll
        for (int kt = 0; kt < 2; ++kt)
#pragma unroll
            for (int r = 0; r < 16; ++r) sc[kt][r] = nm;
        SB();
        __builtin_amdgcn_s_setprio(1);
#pragma unroll
        for (int d0 = 0; d0 < 4; ++d0)
#pragma unroll
            for (int kt = 0; kt < 2; ++kt) sc[kt] = MFMA32(kf[kt][d0], qf[d0], sc[kt]);
        __builtin_amdgcn_s_setprio(0);
        bf16x8 vf[2][4];
        if (NDT == 2) {
#pragma unroll
            for (int dt = 0; dt < 2; ++dt)
#pragma unroll
                for (int ks = 0; ks < 4; ++ks) vf[dt][ks] = *(const bf16x8*)(st + v_base + dt * 4096 + (((2 * ks + h) ^ v_sw) << 4));
        }
        SB();
        if (ALIBI) {
#pragma unroll
            for (int kt = 0; kt < 2; ++kt) {
                const float dq = (float)(qpos - (64 * t + 32 * kt + 8 * h));
#pragma unroll
                for (int r = 0; r < 16; ++r) sc[kt][r] = __builtin_fmaf(-slope2, __builtin_fabsf(dq - (float)(16 * (r >> 3) + (r & 7))), sc[kt][r]);
            }
        }
        float mt = sc[0][0];
#pragma unroll
        for (int r = 1; r < 16; ++r) mt = __builtin_fmaxf(mt, sc[0][r]);
#pragma unroll
        for (int r = 0; r < 16; ++r) mt = __builtin_fmaxf(mt, sc[1][r]);
        mt = __builtin_fmaxf(mt, __shfl_xor(mt, 32));
        if (__any(mt > 8.0f)) {
            const float dl = __builtin_fmaxf(mt, 0.f), al = fast_exp2(-dl);
            l *= al; m += dl;
#pragma unroll
            for (int kt = 0; kt < 2; ++kt)
#pragma unroll
                for (int r = 0; r < 16; ++r) sc[kt][r] -= dl;
#pragma unroll
            for (int dt = 0; dt < NDT; ++dt)
#pragma unroll
                for (int r = 0; r < 16; ++r) o[dt][r] *= al;
        }
        float ps = 0.f;
#pragma unroll
        for (int kt = 0; kt < 2; ++kt)
#pragma unroll
            for (int r = 0; r < 16; ++r) { const float e = fast_exp2(sc[kt][r]); sc[kt][r] = e; ps += e; }
        l += ps;
        bf16x8 pf[4];
#pragma unroll
        for (int ks = 0; ks < 4; ++ks) {
            const int kt = ks >> 1, b = (ks & 1) * 8;
            u32x4 w = {pk2(sc[kt][b], sc[kt][b + 1]), pk2(sc[kt][b + 2], sc[kt][b + 3]), pk2(sc[kt][b + 4], sc[kt][b + 5]), pk2(sc[kt][b + 6], sc[kt][b + 7])};
            pf[ks] = __builtin_bit_cast(bf16x8, w);
        }
        SB();
        if (NDT == 4) {
#pragma unroll
            for (int gp = 0; gp < 2; ++gp) {
#pragma unroll
                for (int dt = 0; dt < 2; ++dt)
#pragma unroll
                    for (int ks = 0; ks < 4; ++ks) vf[dt][ks] = *(const bf16x8*)(st + v_base + (dt + 2 * gp) * 4096 + (((2 * ks + h) ^ v_sw) << 4));
                __builtin_amdgcn_s_setprio(1);
#pragma unroll
                for (int ks = 0; ks < 4; ++ks)
#pragma unroll
                    for (int dt = 0; dt < 2; ++dt) o[(dt + 2 * gp) % NDT] = MFMA32(vf[dt][ks], pf[ks], o[(dt + 2 * gp) % NDT]);
                __builtin_amdgcn_s_setprio(0);
                SB();
            }
        } else {
            __builtin_amdgcn_s_setprio(1);
#pragma unroll
            for (int ks = 0; ks < 4; ++ks)
#pragma unroll
                for (int dt = 0; dt < 2; ++dt) o[dt] = MFMA32(vf[dt][ks], pf[ks], o[dt]);
            __builtin_amdgcn_s_setprio(0);
        }
        SB();
    }
#undef A_ISSUE
    __syncthreads();
    l += __shfl_xor(l, 32);
    l_out = l;
}

DI void attn_pass_b(const bf16_t* __restrict__ Qp, const bf16_t* __restrict__ Kb, int kpitch, const bf16_t* __restrict__ Vtb, float slope2, int qpos, int t_lo, int t_hi, float mref,
                    f32x16 (&o)[4], float& l_out, char* lds) {
    constexpr int NV = 2, STAGE = 8192 + 128 * 128, G = 1 + NV;
    const int tid = otid(), lane = tid & 63, r32 = lane & 31, h = lane >> 5;
    const int qw0 = __builtin_amdgcn_readfirstlane(qpos - r32);
    bf16x8 qf[4];
#pragma unroll
    for (int d0 = 0; d0 < 4; ++d0) qf[d0] = *(const bf16x8*)(Qp + 16 * d0 + 8 * h);
    const int srow = tid >> 3, sch = (tid & 7) ^ ((srow >> 1) & 7);
    const bf16_t* kg = Kb + (size_t)srow * kpitch + sch * 8;
    const bf16_t* vg = Vtb + (size_t)srow * S + sch * 8;
    char* const ld = lds + tid * 16;
#define B_ISSUE(t_, st_) do { char* sn_ = ld + (st_) * STAGE; glds16(kg + (size_t)(t_) * 64 * kpitch, sn_); \
        _Pragma("unroll") for (int i = 0; i < NV; ++i) glds16(vg + (size_t)(64 * i) * S + (t_) * 64, sn_ + 8192 + i * 8192); } while (0)
    waitv<0>();
    B_ISSUE(t_lo, 0);
    if (t_lo + 1 <= t_hi) B_ISSUE(t_lo + 1, 1);
    if (t_lo + 2 <= t_hi) B_ISSUE(t_lo + 2, 2);
    const int pi = (r32 & 0x13) | ((r32 & 4) << 1) | ((r32 & 8) >> 1);
    const int k_base = pi * 128, k_sw = (pi >> 1) & 7, v_base = 8192 + r32 * 128, v_sw = (r32 >> 1) & 7;
    float l = 0.f;
    const float nm = -mref;
#pragma unroll
    for (int dt = 0; dt < 4; ++dt)
#pragma unroll
        for (int r = 0; r < 16; ++r) o[dt][r] = 0.f;
    int cur = 0;
    for (int t = t_lo; t <= t_hi; ++t) {
        const int rem = t_hi - t;
        if (rem >= 2) waitv<2 * G>(); else if (rem == 1) waitv<G>(); else waitv<0>();
        rawbar();
        if (rem >= 3) B_ISSUE(t + 3, (cur + 3) & 3);
        const char* st = lds + cur * STAGE;
        cur = (cur + 1) & 3;
        bf16x8 kf[2][4];
#pragma unroll
        for (int kt = 0; kt < 2; ++kt)
#pragma unroll
            for (int d0 = 0; d0 < 4; ++d0) kf[kt][d0] = *(const bf16x8*)(st + kt * 4096 + k_base + (((2 * d0 + h) ^ k_sw) << 4));
        const int side = (64 * t + 63 < qw0) ? 1 : ((64 * t > qw0 + 31) ? -1 : 0);
        f32x16 sc[2];
        if (side != 0) {
            const float ss = side > 0 ? slope2 : -slope2;
#pragma unroll
            for (int kt = 0; kt < 2; ++kt) {
                const float base = __builtin_fmaf(ss, (float)(64 * t + 32 * kt + 8 * h - qpos), nm);
#pragma unroll
                for (int r = 0; r < 16; ++r) sc[kt][r] = __builtin_fmaf(ss, (float)(16 * (r >> 3) + (r & 7)), base);
            }
        } else {
#pragma unroll
            for (int kt = 0; kt < 2; ++kt)
#pragma unroll
                for (int r = 0; r < 16; ++r) sc[kt][r] = nm;
        }
        SB();
        __builtin_amdgcn_s_setprio(1);
#pragma unroll
        for (int d0 = 0; d0 < 4; ++d0)
#pragma unroll
            for (int kt = 0; kt < 2; ++kt) sc[kt] = MFMA32(kf[kt][d0], qf[d0], sc[kt]);
        __builtin_amdgcn_s_setprio(0);
        SB();
        if (side == 0) {
#pragma unroll
            for (int kt = 0; kt < 2; ++kt) {
                const float dq = (float)(qpos - (64 * t + 32 * kt + 8 * h));
#pragma unroll
                for (int r = 0; r < 16; ++r) sc[kt][r] = __builtin_fmaf(-slope2, __builtin_fabsf(dq - (float)(16 * (r >> 3) + (r & 7))), sc[kt][r]);
            }
        }
        float ps = 0.f;
#pragma unroll
        for (int kt = 0; kt < 2; ++kt)
#pragma unroll
            for (int r = 0; r < 16; ++r) { const float e = fast_exp2(sc[kt][r]); sc[kt][r] = e; ps += e; }
        l += ps;
        bf16x8 pf[4];
#pragma unroll
        for (int ks = 0; ks < 4; ++ks) {
            const int kt = ks >> 1, b = (ks & 1) * 8;
            u32x4 w = {pk2(sc[kt][b], sc[kt][b + 1]), pk2(sc[kt][b + 2], sc[kt][b + 3]), pk2(sc[kt][b + 4], sc[kt][b + 5]), pk2(sc[kt][b + 6], sc[kt][b + 7])};
            pf[ks] = __builtin_bit_cast(bf16x8, w);
        }
        SB();
#pragma unroll
        for (int gp = 0; gp < 2; ++gp) {
            bf16x8 vf[2][4];
#pragma unroll
            for (int dt = 0; dt < 2; ++dt)
#pragma unroll
                for (int ks = 0; ks < 4; ++ks) vf[dt][ks] = *(const bf16x8*)(st + v_base + (dt + 2 * gp) * 4096 + (((2 * ks + h) ^ v_sw) << 4));
            __builtin_amdgcn_s_setprio(1);
#pragma unroll
            for (int ks = 0; ks < 4; ++ks)
#pragma unroll
                for (int dt = 0; dt < 2; ++dt) o[dt + 2 * gp] = MFMA32(vf[dt][ks], pf[ks], o[dt + 2 * gp]);
            __builtin_amdgcn_s_setprio(0);
            SB();
        }
    }
#undef B_ISSUE
    __syncthreads();
    l += __shfl_xor(l, 32);
    l_out = l;
}

DI void attn_pass_a(const bf16_t* __restrict__ Qp, const bf16_t* __restrict__ Kb, int kpitch, const bf16_t* __restrict__ Vtb, float mref, f32x16 (&o)[2], float& l_out, char* lds) {
    constexpr int STAGE = 16384, NTL = S / 64;
    const int tid = otid(), lane = tid & 63, r32 = lane & 31, h = lane >> 5;
    bf16x8 qf[4];
#pragma unroll
    for (int d0 = 0; d0 < 4; ++d0) qf[d0] = *(const bf16x8*)(Qp + 16 * d0 + 8 * h);
    const int srow = tid >> 3, sch = (tid & 7) ^ ((srow >> 1) & 7);
    const bf16_t* kg = Kb + (size_t)srow * kpitch + sch * 8;
    const bf16_t* vg = Vtb + (size_t)srow * S + sch * 8;
    char* const ld = lds + tid * 16;
#define AA_ISSUE(t_, st_) do { char* sn_ = ld + (st_) * STAGE; glds16(kg + (size_t)(t_) * 64 * kpitch, sn_); glds16(vg + (t_) * 64, sn_ + 8192); } while (0)
    waitv<0>();
    AA_ISSUE(0, 0); AA_ISSUE(1, 1); AA_ISSUE(2, 2);
    const int pi = (r32 & 0x13) | ((r32 & 4) << 1) | ((r32 & 8) >> 1);
    const int k_base = pi * 128, k_sw = (pi >> 1) & 7, v_base = 8192 + r32 * 128, v_sw = (r32 >> 1) & 7;
    f32x16 negm, lacc;
#pragma unroll
    for (int r = 0; r < 16; ++r) { negm[r] = -mref; lacc[r] = 0.f; o[0][r] = 0.f; o[1][r] = 0.f; }
    const bf16x8 ones = {(short)0x3F80, (short)0x3F80, (short)0x3F80, (short)0x3F80, (short)0x3F80, (short)0x3F80, (short)0x3F80, (short)0x3F80};
    f32x16 sA[2], sB[2];
#define AA_QK(DST, stp_) do { bf16x8 kf_[2][4]; \
        _Pragma("unroll") for (int kt = 0; kt < 2; ++kt) _Pragma("unroll") for (int d0 = 0; d0 < 4; ++d0) kf_[kt][d0] = *(const bf16x8*)((stp_) + kt * 4096 + k_base + (((2 * d0 + h) ^ k_sw) << 4)); \
        SB(); __builtin_amdgcn_s_setprio(1); \
        DST[0] = MFMA32(kf_[0][0], qf[0], negm); DST[1] = MFMA32(kf_[1][0], qf[0], negm); \
        _Pragma("unroll") for (int d0 = 1; d0 < 4; ++d0) { DST[0] = MFMA32(kf_[0][d0], qf[d0], DST[0]); DST[1] = MFMA32(kf_[1][d0], qf[d0], DST[1]); } \
        __builtin_amdgcn_s_setprio(0); } while (0)
    waitv<4>();
    rawbar();
    AA_QK(sA, lds);
#define AA_STEP(CUR, NXT, t_) do { const int t = (t_); \
        if (t + 2 < NTL) waitv<2>(); else waitv<0>();              \
        rawbar();                                                  \
        if (t + 3 < NTL) AA_ISSUE(t + 3, (t + 3) & 3); \
        const char* st = lds + (t & 3) * STAGE; \
        if (t + 1 < NTL) AA_QK(NXT, lds + ((t + 1) & 3) * STAGE); \
        bf16x8 vf[2][4]; \
        _Pragma("unroll") for (int dt = 0; dt < 2; ++dt) _Pragma("unroll") for (int ks = 0; ks < 4; ++ks) vf[dt][ks] = *(const bf16x8*)(st + v_base + dt * 4096 + (((2 * ks + h) ^ v_sw) << 4)); \
        SB(); \
        _Pragma("unroll") for (int kt = 0; kt < 2; ++kt) _Pragma("unroll") for (int r = 0; r < 16; ++r) CUR[kt][r] = fast_exp2(CUR[kt][r]); \
        bf16x8 pf[4]; \
        _Pragma("unroll") for (int ks = 0; ks < 4; ++ks) { const int kt = ks >> 1, b = (ks & 1) * 8; \
            u32x4 w = {pk2(CUR[kt][b], CUR[kt][b + 1]), pk2(CUR[kt][b + 2], CUR[kt][b + 3]), pk2(CUR[kt][b + 4], CUR[kt][b + 5]), pk2(CUR[kt][b + 6], CUR[kt][b + 7])}; \
            pf[ks] = __builtin_bit_cast(bf16x8, w); } \
        SB(); __builtin_amdgcn_s_setprio(1); \
        _Pragma("unroll") for (int ks = 0; ks < 4; ++ks) { _Pragma("unroll") for (int dt = 0; dt < 2; ++dt) o[dt] = MFMA32(vf[dt][ks], pf[ks], o[dt]); lacc = MFMA32(ones, pf[ks], lacc); } \
        __builtin_amdgcn_s_setprio(0); SB(); } while (0)
    for (int t2 = 0; t2 < NTL; t2 += 2) { AA_STEP(sA, sB, t2); AA_STEP(sB, sA, t2 + 1); }
#undef AA_STEP
#undef AA_QK
#undef AA_ISSUE
    __syncthreads();
    l_out = lacc[0];
}

DI void phase_attn(const Params& p, int l, int rep, char* lds) {
    const int tid = otid(), lane = tid & 63, wid = tid >> 6, r32 = lane & 31, h = lane >> 5;
    const bf16_t* Q = (const bf16_t*)(p.ws + OFF_Q); const bf16_t* QD = (const bf16_t*)(p.ws + OFF_QD); const bf16_t* KA = (const bf16_t*)(p.ws + OFF_KA);
    const bf16_t* VTA = (const bf16_t*)(p.ws + OFF_VTA); const bf16_t* KD = (const bf16_t*)(p.ws + OFF_KD); const bf16_t* VTD = (const bf16_t*)(p.ws + OFF_VTD);
    bf16_t* ATTA = (bf16_t*)(p.ws + OFF_ATTA); bf16_t* OD = (bf16_t*)(p.ws + OFF_OD); float* BO0 = (float*)(p.ws + OFF_N);
    const float lam = ((const float*)(p.ws + OFF_LAM))[l];
    const float oml = 1.0f - (l == 0 ? 0.2f : 0.35550906759096926f);
    float bA;
    { float gq = __builtin_fabsf(p.qk_g[l * 128 + lane]), gk = __builtin_fabsf(p.qk_g[l * 128 + 64 + lane]);
#pragma unroll
      for (int o_ = 32; o_ > 0; o_ >>= 1) { gq = __builtin_fmaxf(gq, __shfl_xor(gq, o_)); gk = __builtin_fmaxf(gk, __shfl_xor(gk, o_)); }
      bA = 64.0f * gq * gk * QSCALE * 1.01f; }
    unsigned* qcnt = (unsigned*)(p.ws + OFF_STAT) + 32 + l + 2 * rep;
    const unsigned* stat = (const unsigned*)(p.ws + OFF_STAT) + l * 16;
    volatile unsigned* lword = (volatile unsigned*)(lds + 147456 - 16);
    for (;;) {
        if (tid == 0) *lword = atomicAdd(qcnt, 1u);
        __syncthreads();
        const int u = (int)*lword;
        __syncthreads();
        if (u >= 768) break;
        if (PROBE_DUP == 5 && rep && (u < 128 || u >= 640)) continue;
        if (u < 128 || u >= 640) {
            const int hb = u < 64 ? 3 : (u < 128 ? 2 : (u < 704 ? 1 : 0)), qb = u & 63;
            const int token = 256 * qb + 32 * wid + r32;
            const float slope2 = exp2f(-2.0f * (float)(hb + 1)) * LOG2E;
            float* bo = BO0 + (size_t)token * 512 + hb * 128;
            f32x16 o[4]; float ls;
            int tl[2], th[2]; float mi[2];
#pragma unroll
            for (int mp = 0; mp < 2; ++mp) {
                const float qk = sqrtf(__uint_as_float(stat[mp * 4 + hb]) * __uint_as_float(stat[8 + mp * 4 + hb])) * 1.02f;
                const float R = __builtin_fminf((2.0f * qk + 150.0f) / slope2, 40000.0f);
                const int klo = 256 * qb - (int)R - 1, khi = 256 * qb + 255 + (int)R + 1;
                mi[mp] = -qk;
                tl[mp] = klo < 0 ? 0 : (klo >> 6); th[mp] = khi >= S ? (S / 64 - 1) : (khi >> 6);
            }
            if (-mi[0] <= 45.0f) attn_pass_b(QD + (size_t)token * 512 + hb * 64, KD + hb * 64, 512, VTD + (size_t)(hb * 128) * S, slope2, token, tl[0], th[0], -mi[0], o, ls, lds);
            else attn_pass<128, true>(QD + (size_t)token * 512 + hb * 64, KD + hb * 64, 512, VTD + (size_t)(hb * 128) * S, slope2, token, tl[0], th[0], mi[0], o, ls, lds);
            {
                const float inv = 1.0f / ls;
#pragma unroll
                for (int dt = 0; dt < 4; ++dt)
#pragma unroll
                    for (int g = 0; g < 4; ++g) *(f32x4*)(bo + 32 * dt + 8 * g + 4 * h) = (f32x4){o[dt][4 * g] * inv, o[dt][4 * g + 1] * inv, o[dt][4 * g + 2] * inv, o[dt][4 * g + 3] * inv};
            }
            if (-mi[1] <= 45.0f) attn_pass_b(QD + (size_t)token * 512 + 256 + hb * 64, KD + 256 + hb * 64, 512, VTD + (size_t)(hb * 128) * S, slope2, token, tl[1], th[1], -mi[1], o, ls, lds);
            else attn_pass<128, true>(QD + (size_t)token * 512 + 256 + hb * 64, KD + 256 + hb * 64, 512, VTD + (size_t)(hb * 128) * S, slope2, token, tl[1], th[1], mi[1], o, ls, lds);
            {
                const float inv = lam / ls; float ss = 0.f;
#pragma unroll
                for (int dt = 0; dt < 4; ++dt)
#pragma unroll
                    for (int g = 0; g < 4; ++g) {
                        const f32x4 a = *(const f32x4*)(bo + 32 * dt + 8 * g + 4 * h);
#pragma unroll
                        for (int j = 0; j < 4; ++j) { const float v = a[j] - o[dt][4 * g + j] * inv; o[dt][4 * g + j] = v; ss += v * v; }
                    }
                ss += __shfl_xor(ss, 32);
                const float rstd = rsqrtf(ss * (1.0f / 128.0f) + 1e-6f) * oml;
                const float* sg = p.subln_g + l * 128;
                bf16_t* dst = OD + (size_t)token * 512 + hb * 128;
#pragma unroll
                for (int dt = 0; dt < 4; ++dt)
#pragma unroll
                    for (int g = 0; g < 4; ++g) {
                        const int d = 32 * dt + 8 * g + 4 * h;
                        const f32x4 gg = *(const f32x4*)(sg + d);
                        *(u32x2*)(dst + d) = (u32x2){pk2(o[dt][4 * g] * rstd * gg[0], o[dt][4 * g + 1] * rstd * gg[1]), pk2(o[dt][4 * g + 2] * rstd * gg[2], o[dt][4 * g + 3] * rstd * gg[3])};
                    }
            }
        } else {
            const int v = u - 128, kv = v >> 8, hq = kv * 4 + (v & 3), qb = (v >> 2) & 63;
            const int token = 256 * qb + 32 * wid + r32;
            f32x16 o[2]; float ls;
            if (bA <= 40.0f) attn_pass_a(Q + (size_t)token * 512 + hq * 64, KA + kv * 64, 128, VTA + (size_t)(kv * 64) * S, bA, o, ls, lds);
            else attn_pass<64, false>(Q + (size_t)token * 512 + hq * 64, KA + kv * 64, 128, VTA + (size_t)(kv * 64) * S, 0.f, token, 0, S / 64 - 1, 0.f, o, ls, lds);
            const float inv = 1.0f / ls;
            bf16_t* dst = ATTA + (size_t)token * 512 + hq * 64;
#pragma unroll
            for (int dt = 0; dt < 2; ++dt)
#pragma unroll
                for (int g = 0; g < 4; ++g)
                    *(u32x2*)(dst + 32 * dt + 8 * g + 4 * h) = (u32x2){pk2(o[dt][4 * g] * inv, o[dt][4 * g + 1] * inv), pk2(o[dt][4 * g + 2] * inv, o[dt][4 * g + 3] * inv)};
        }
    }
}

__global__ void __launch_bounds__(512) mega(Params pin) {
    __shared__ __attribute__((aligned(16))) char lds[147456];
    cg::grid_group grid = cg::this_grid();
    int rep = 0;
    for (int ph = pin.ph_lo; ph < pin.ph_hi; ++ph) {
        Params p = pin;
        asm volatile("" : "+s"(p.ws), "+s"(p.out), "+s"(p.x));
        bf16_t* nbuf = (bf16_t*)(p.ws + OFF_N);
        bf16_t* act = (bf16_t*)(p.ws + OFF_ACT);
        if (ph == 0) phase_prologue(p, lds);
        else {
            const int l = ph == 23 ? 1 : (ph - 1) / 11, k = ph == 23 ? 11 : (ph - 1) % 11;
            const float* mod = (const float*)(p.ws + OFF_MOD) + l * 9216;
            switch (k) {
            case 0: case 3: case 8: case 11: {
                const int i = k == 0 ? 0 : (k == 3 ? 1 : 2);
                const float* hin = (ph == 1) ? p.x : p.out;
                if (k == 11) phase_norm(hin, p.final_g, nullptr, nullptr, nullptr, p.out);
                else phase_norm(hin, p.norm_g + (l * 3 + i) * D, mod + (3 * i) * D, mod + (3 * i + 1) * D, nbuf, nullptr);
            } break;
            case 1: case 9: {
                const int f = k == 1 ? 0 : 1;
                phase_gateup(nbuf, (const bf16_t*)(p.ws + OFF_WGU + (size_t)(l * 2 + f) * SZ_WGU), act, lds);
            } break;
            case 2: case 10: case 7: {
                if (k == 7) phase_resid((const bf16_t*)(p.ws + OFF_Q), D, (const bf16_t*)(p.ws + OFF_WO + l * SZ_WO), p.out, p.out, mod + 5 * D, rep ? 0.0f : 1.0f, lds);
                else {
                    const int f = k == 2 ? 0 : 1;
                    phase_resid(act, F, (const bf16_t*)(p.ws + OFF_WD + (size_t)(l * 2 + f) * SZ_WD), (ph == 3 && !rep) ? p.x : p.out, p.out, mod + (f == 0 ? 2 : 8) * D, rep ? 0.0f : 0.5f, lds);
                }
            } break;
            case 4: phase_win(p, l, lds); break;
            case 5: phase_attn(p, l, rep, lds); break;
            case 6: phase_merge((const bf16_t*)(p.ws + OFF_ATTA), (const bf16_t*)(p.ws + OFF_OD), (const bf16_t*)(p.ws + OFF_WBA + l * SZ_WB), (const bf16_t*)(p.ws + OFF_WBB + l * SZ_WB),
                                (const bf16_t*)(p.ws + OFF_G), (bf16_t*)(p.ws + OFF_Q), (float*)(p.ws + OFF_N), lds); break;
            default: break;
            }
        }
        if (ph + 1 < pin.ph_hi) grid.sync();
        if (PROBE_DUP >= 0 && rep == 0 && (ph == 0 ? PROBE_DUP == 100 : ((ph - 1) % 11 == PROBE_DUP && ph != 23))) { rep = 1; --ph; } else rep = 0;
    }
}

extern "C" void kernel_launch(void* const* d_in, const int* in_sizes, int n_in, void* d_out, int out_size, void* d_ws, size_t ws_size, hipStream_t stream) {
    if (n_in != 18 || out_size != S * D || ws_size < WS_END) { fprintf(stderr, "kernel_launch: unexpected shapes / workspace (n_in %d out %d ws %zu need %zu)\n", n_in, out_size, ws_size, (size_t)WS_END); return; }
    Params p{};
    const float** pp = (const float**)&p;
    for (int i = 0; i < 18; ++i) pp[i] = (const float*)d_in[i];
    p.out = (float*)d_out; p.ws = (unsigned char*)d_ws;
#if MK_MULTI
    for (int ph = 0; ph < NPH; ++ph) { p.ph_lo = ph; p.ph_hi = ph + 1; hipLaunchKernelGGL(mega, dim3(256), dim3(512), 0, stream, p); }
#else
    static int grid = 0;
    if (!grid) {
        int dev = 0, cus = 0, per_cu = 0;
        hipGetDevice(&dev); hipDeviceGetAttribute(&cus, hipDeviceAttributeMultiprocessorCount, dev);
        hipOccupancyMaxActiveBlocksPerMultiprocessor(&per_cu, (const void*)mega, 512, 0);
        if (per_cu < 1) { fprintf(stderr, "kernel_launch: occupancy query says %d blocks per CU\n", per_cu); per_cu = 1; }
        grid = cus;
    }
    p.ph_lo = 0; p.ph_hi = NPH;
    void* args[] = {&p};
    hipError_t e = hipLaunchCooperativeKernel((const void*)mega, dim3(grid), dim3(512), args, 0, stream);
    if (e != hipSuccess) fprintf(stderr, "cooperative launch failed: %s (grid %d)\n", hipGetErrorString(e), grid);
#endif
}
```

```cpp
#include <hip/hip_runtime.h>
#include <hip/hip_cooperative_groups.h>
#include <cstdio>
#include <cstdint>
namespace cg = cooperative_groups;

#ifndef MK_MULTI
#define MK_MULTI 0
#endif

#ifndef PROBE_DUP
#define PROBE_DUP -1
#endif
#define DI __device__ __forceinline__
typedef unsigned short bf16_t;
typedef short bf16x8 __attribute__((ext_vector_type(8)));
typedef float f32x4 __attribute__((ext_vector_type(4)));
typedef float f32x16 __attribute__((ext_vector_type(16)));
typedef unsigned u32x4 __attribute__((ext_vector_type(4)));
typedef unsigned u32x2 __attribute__((ext_vector_type(2)));

constexpr int S = 16384, D = 1024, F = 2816, NGU = 5632, NIN = 4352;
constexpr int NPH = 24;
constexpr float QSCALE = 0.125f * 1.4426950408889634f;
constexpr float LOG2E = 1.4426950408889634f;

constexpr size_t OFF_MOD = 0;
constexpr size_t OFF_LAM = 80000;
constexpr size_t OFF_STAT = 80128;
constexpr size_t OFF_ROPE = 81920;
constexpr size_t OFF_BAR = 131072;
constexpr size_t OFF_WGU = 1u << 20;
constexpr size_t SZ_WGU = (size_t)NGU * D * 2;
constexpr size_t OFF_WD = OFF_WGU + 4 * SZ_WGU;
constexpr size_t SZ_WD = (size_t)D * F * 2;
constexpr size_t OFF_WIN = OFF_WD + 4 * SZ_WD;
constexpr size_t SZ_WIN = (size_t)NIN * D * 2;
constexpr size_t OFF_WBA = OFF_WIN + 2 * SZ_WIN;
constexpr size_t SZ_WB = (size_t)D * 512 * 2;
constexpr size_t OFF_WBB = OFF_WBA + 2 * SZ_WB;
constexpr size_t OFF_WO = OFF_WBB + 2 * SZ_WB;
constexpr size_t SZ_WO = (size_t)D * D * 2;
constexpr size_t OFF_N = OFF_WO + 2 * SZ_WO;
constexpr size_t OFF_MIX = OFF_N + (size_t)S * D * 2;
constexpr size_t OFF_Q = OFF_MIX;
constexpr size_t OFF_QD = OFF_Q + (size_t)S * 512 * 2;
constexpr size_t OFF_KA = OFF_QD + (size_t)S * 512 * 2;
constexpr size_t OFF_VTA = OFF_KA + (size_t)S * 128 * 2;
constexpr size_t OFF_KD = OFF_VTA + (size_t)S * 128 * 2;
constexpr size_t OFF_VTD = OFF_KD + (size_t)S * 512 * 2;
constexpr size_t OFF_G = OFF_VTD + (size_t)S * 512 * 2;
constexpr size_t OFF_ATTA = OFF_G + (size_t)S * 2048 * 2;
constexpr size_t OFF_OD = OFF_ATTA + (size_t)S * 512 * 2;
constexpr size_t OFF_ACT = OFF_MIX;
constexpr size_t WS_END = OFF_OD + (size_t)S * 512 * 2;
static_assert((size_t)S * F * 2 <= WS_END - OFF_MIX, "act overlay");

struct Params {
    const float *x, *c, *ada_w, *ada_b, *norm_g, *ffn_wg, *ffn_wu, *ffn_wd, *w_in, *qk_g, *lam_p, *subln_g, *w_ba, *w_bb, *w_gate, *b_gate, *w_o, *final_g;
    float* out; unsigned char* ws; int ph_lo, ph_hi;
};

typedef __bf16 bf16v2 __attribute__((ext_vector_type(2)));
typedef float f32x2 __attribute__((ext_vector_type(2)));
DI unsigned pk2(float lo, float hi) { f32x2 v = {lo, hi}; bf16v2 b = __builtin_convertvector(v, bf16v2); return __builtin_bit_cast(unsigned, b); }
DI float bf_lo(unsigned u) { return __uint_as_float(u << 16); }
DI float bf_hi(unsigned u) { return __uint_as_float(u & 0xffff0000u); }
DI int lds_off(int row, int chunk) { return row * 128 + ((chunk ^ ((row >> 1) & 7)) << 4); }
DI float fast_exp2(float x) { return __builtin_amdgcn_exp2f(x); }
DI float fast_rcp(float x) { return __builtin_amdgcn_rcpf(x); }
DI int otid() { int t = threadIdx.x; asm volatile("" : "+v"(t)); return t; }
#define SB() __builtin_amdgcn_sched_barrier(0)

DI int perm64(int n) { return (n & ~63) | (((n >> 2) & 3) << 4) | (((n >> 4) & 3) << 2) | (n & 3); }
DI int gumap(int j) { return 128 * (j >> 6) + 64 * ((j >> 5) & 1) + 16 * ((j >> 2) & 1) + 4 * ((j >> 3) & 3) + (j & 3); }

struct TrDesc { const float* src; bf16_t* dst; int N, k0, n0, ldd, mode, roff; };
DI void tr_decode(const Params& p, int tt, TrDesc& d) {
    constexpr int N_TR_L = 5824;
    const int l = tt / N_TR_L, r = tt % N_TR_L;
    if (r < 4224) {
        const int f = r / 2112, r2 = r % 2112, which = r2 / 704, r3 = r2 % 704;
        const size_t lf = (size_t)(l * 2 + f);
        if (which < 2) { d.src = (which == 0 ? p.ffn_wg : p.ffn_wu) + lf * D * F; d.N = F; d.k0 = (r3 / 44) * 64; d.n0 = (r3 % 44) * 64; d.dst = (bf16_t*)(p.ws + OFF_WGU + lf * SZ_WGU); d.ldd = D; d.mode = 2; d.roff = which * 32; }
        else { d.src = p.ffn_wd + lf * F * D; d.N = D; d.k0 = (r3 / 16) * 64; d.n0 = (r3 % 16) * 64; d.dst = (bf16_t*)(p.ws + OFF_WD + lf * SZ_WD); d.ldd = F; d.mode = 1; d.roff = 0; }
    } else if (r < 4800) { const int r3 = r - 4224; d.src = p.w_in + (size_t)l * D * 2304; d.N = 2304; d.k0 = (r3 / 36) * 64; d.n0 = (r3 % 36) * 64; d.dst = (bf16_t*)(p.ws + OFF_WIN + l * SZ_WIN); d.ldd = D; d.mode = 0; d.roff = 0; }
    else if (r < 5312) { const int r3 = r - 4800; d.src = p.w_gate + (size_t)l * D * 2048; d.N = 2048; d.k0 = (r3 / 32) * 64; d.n0 = (r3 % 32) * 64; d.dst = (bf16_t*)(p.ws + OFF_WIN + l * SZ_WIN); d.ldd = D; d.mode = 0; d.roff = 2304; }
    else if (r < 5440) { const int r3 = r - 5312; d.src = p.w_ba + (size_t)l * 512 * D; d.N = D; d.k0 = (r3 / 16) * 64; d.n0 = (r3 % 16) * 64; d.dst = (bf16_t*)(p.ws + OFF_WBA + l * SZ_WB); d.ldd = 512; d.mode = 1; d.roff = 0; }
    else if (r < 5568) { const int r3 = r - 5440; d.src = p.w_bb + (size_t)l * 512 * D; d.N = D; d.k0 = (r3 / 16) * 64; d.n0 = (r3 % 16) * 64; d.dst = (bf16_t*)(p.ws + OFF_WBB + l * SZ_WB); d.ldd = 512; d.mode = 1; d.roff = 0; }
    else { const int r3 = r - 5568; d.src = p.w_o + (size_t)l * D * D; d.N = D; d.k0 = (r3 / 16) * 64; d.n0 = (r3 % 16) * 64; d.dst = (bf16_t*)(p.ws + OFF_WO + l * SZ_WO); d.ldd = D; d.mode = 1; d.roff = 0; }
}
DI void tr_load(const TrDesc& d, int tid, f32x4 (&v)[2]) {
    const int kk = tid >> 4, nn4 = (tid & 15) * 4;
#pragma unroll
    for (int ps = 0; ps < 2; ++ps) v[ps] = *(const f32x4*)(d.src + (size_t)(d.k0 + kk + 32 * ps) * d.N + d.n0 + nn4);
}
DI void tr_store(const TrDesc& d, int tid, const f32x4 (&v)[2], float* ldsf) {
    {
        const int kk = tid >> 4, nn4 = (tid & 15) * 4;
#pragma unroll
        for (int ps = 0; ps < 2; ++ps) { const int k = kk + 32 * ps; ldsf[k * 65 + nn4 + 0] = v[ps][0]; ldsf[k * 65 + nn4 + 1] = v[ps][1]; ldsf[k * 65 + nn4 + 2] = v[ps][2]; ldsf[k * 65 + nn4 + 3] = v[ps][3]; }
    }
    __syncthreads();
    {
        const int n = tid >> 3, ch = tid & 7, gn = d.n0 + n;
        int drow;
        if (d.mode == 0) drow = gn + d.roff; else if (d.mode == 1) drow = perm64(gn); else drow = gumap(gn) + d.roff;
        float w[8];
#pragma unroll
        for (int i = 0; i < 8; ++i) w[i] = ldsf[(ch * 8 + i) * 65 + n];
        u32x4 pk = {pk2(w[0], w[1]), pk2(w[2], w[3]), pk2(w[4], w[5]), pk2(w[6], w[7])};
        *(u32x4*)(d.dst + (size_t)drow * d.ldd + d.k0 + ch * 8) = pk;
    }
    __syncthreads();
}

DI void phase_prologue(const Params& p, char* lds) {
    const int tid = otid();
    float* ldsf = (float*)lds;
    constexpr int N_MOD = 288, N_TR = 2 * 5824;
    for (int it = blockIdx.x; it < N_MOD; it += gridDim.x) {
        const int l = it / 144, j0 = (it % 144) * 64, jj = tid & 15, ii = tid >> 4;
        float* cact = ldsf + 2048;
        for (int i = tid; i < 1024; i += 512) { const float cv = p.c[i]; cact[i] = cv / (1.f + expf(-cv)); }
        __syncthreads();
        f32x4 a = {0.f, 0.f, 0.f, 0.f};
        const float* wb = p.ada_w + (size_t)l * 1024 * 9216 + j0 + 4 * jj;
#pragma unroll 8
        for (int r = 0; r < 32; ++r) { const int i = ii + 32 * r; a += cact[i] * *(const f32x4*)(wb + (size_t)i * 9216); }
        *(f32x4*)(ldsf + ii * 64 + 4 * jj) = a;
        __syncthreads();
        if (tid < 64) {
            float sm = 0.f;
#pragma unroll
            for (int r = 0; r < 32; ++r) sm += ldsf[r * 64 + tid];
            ((float*)(p.ws + OFF_MOD))[l * 9216 + j0 + tid] = sm + p.ada_b[l * 9216 + j0 + tid];
        }
        __syncthreads();
    }
    if (blockIdx.x == gridDim.x - 1) {
        if (tid < 64) {
#pragma unroll
            for (int l = 0; l < 2; ++l) {
                const float* lp = p.lam_p + l * 256;
                float a = lp[tid] * lp[64 + tid], b = lp[128 + tid] * lp[192 + tid];
#pragma unroll
                for (int o = 32; o > 0; o >>= 1) { a += __shfl_xor(a, o); b += __shfl_xor(b, o); }
                const float li = l == 0 ? 0.2f : 0.35550906759096926f;
                if (tid == 0) ((float*)(p.ws + OFF_LAM))[l] = expf(a) - expf(b) + li;
            }
        }
        if (tid < 64) ((unsigned*)(p.ws + OFF_STAT))[tid] = 0u;
        float* rope = (float*)(p.ws + OFF_ROPE);
        for (int e = tid; e < 320 * 16; e += 512) {
            const int pi = e >> 4, i = e & 15;
            const int pos = pi < 256 ? pi - 128 : (pi - 256) - 32;
            const float inv = exp2f(-(float)i * (13.287712379549449f / 16.0f));
            const float angf = (float)pos * inv;
            double r = (double)angf; r -= rint(r * 0.15915494309189535) * 6.283185307179586;
            const double r2 = r * r;
            double sn = 0.0, cs = 0.0;
#pragma unroll 1
            for (int n = 14; n >= 1; --n) { sn = (sn + 1.0) * (-r2 / (double)((2 * n) * (2 * n + 1))); cs = (cs + 1.0) * (-r2 / (double)((2 * n - 1) * (2 * n))); }
            sn = (sn + 1.0) * r; cs = cs + 1.0;
            if (pi < 256) { rope[pi * 16 + i] = (float)cs; rope[4096 + pi * 16 + i] = (float)sn; }
            else { rope[8192 + (pi - 256) * 16 + i] = (float)cs; rope[9216 + (pi - 256) * 16 + i] = (float)sn; }
        }
    }
    {
        int tt = blockIdx.x;
        TrDesc d; f32x4 v[2];
        if (tt < N_TR) { tr_decode(p, tt, d); tr_load(d, tid, v); }
        while (tt < N_TR) {
            const int tn = tt + gridDim.x;
            TrDesc dn; f32x4 vn[2];
            if (tn < N_TR) { tr_decode(p, tn, dn); tr_load(dn, tid, vn); }
            tr_store(d, tid, v, ldsf);
            if (tn < N_TR) { d = dn; v[0] = vn[0]; v[1] = vn[1]; }
            tt = tn;
        }
    }
}

DI void phase_norm(const float* hin, const float* __restrict__ g, const float* __restrict__ sh, const float* __restrict__ sc, bf16_t* nout, float* fout) {
    const int tid_ = otid(), lane = tid_ & 63, wid = tid_ >> 6;
    const int nw = gridDim.x * 8;
    for (int row = blockIdx.x * 8 + wid; row < S; row += nw) {
        const float* hp = hin + (size_t)row * D;
        f32x4 v[4]; float ss = 0.f;
#pragma unroll
        for (int i = 0; i < 4; ++i) { v[i] = *(const f32x4*)(hp + (i * 64 + lane) * 4); ss += v[i][0] * v[i][0] + v[i][1] * v[i][1] + v[i][2] * v[i][2] + v[i][3] * v[i][3]; }
#pragma unroll
        for (int o = 32; o > 0; o >>= 1) ss += __shfl_xor(ss, o);
        const float rstd = rsqrtf(ss * (1.0f / 1024.0f) + 1e-6f);
#pragma unroll
        for (int i = 0; i < 4; ++i) {
            const int col = (i * 64 + lane) * 4;
            const f32x4 gv = *(const f32x4*)(g + col);
            f32x4 y = v[i] * rstd * gv;
            if (sc) { const f32x4 s1 = *(const f32x4*)(sc + col), s0 = *(const f32x4*)(sh + col); y = y * (1.0f + s1) + s0; }
            if (fout) *(f32x4*)(fout + (size_t)row * D + col) = y;
            else { u32x2 pk = {pk2(y[0], y[1]), pk2(y[2], y[3])}; *(u32x2*)(nout + (size_t)row * D + col) = pk; }
        }
    }
}

DI void glds16(const void* g, char* l) { __builtin_amdgcn_global_load_lds((const unsigned*)g, (unsigned*)l, 16, 0, 0); }
template <int N> DI void waitv() { asm volatile("s_waitcnt vmcnt(%0)" ::"n"(N) : "memory"); }
DI void rawbar() { __builtin_amdgcn_s_barrier(); }
constexpr int GST = 49152;
DI void gemm_mainloop(const bf16_t* __restrict__ A, int lda, const bf16_t* __restrict__ W, int ldw, int K, f32x4 (&acc)[4][4], char* lds) {
    const int tid = otid(), lane = tid & 63, wid = tid >> 6, wt = wid >> 1, wc = wid & 1;
    const int srow = tid >> 3, sch = (tid & 7) ^ ((srow >> 1) & 7);
    const bf16_t* ag = A + (size_t)srow * lda + sch * 8;
    const bf16_t* wg = W + (size_t)srow * ldw + sch * 8;
    char* const ld = lds + tid * 16;
    const int nk = K >> 6;
#define G_ISSUE(kt_, st_) do { const int ko_ = (kt_) * 64; char* sn_ = ld + (st_) * GST; \
        _Pragma("unroll") for (int i = 0; i < 4; ++i) glds16(ag + (size_t)(64 * i) * lda + ko_, sn_ + i * 8192); \
        _Pragma("unroll") for (int i = 0; i < 2; ++i) glds16(wg + (size_t)(64 * i) * ldw + ko_, sn_ + 32768 + i * 8192); } while (0)
    waitv<0>();
    G_ISSUE(0, 0); G_ISSUE(1, 1);
    const int fr = lane & 15, fq = lane >> 4, sw = (fr >> 1) & 7;
    const int a_base = (64 * wt + fr) * 128, w_base = 32768 + (64 * wc + fr) * 128;
    int cur = 0, nxt = 2;
    for (int kt = 0; kt < nk; ++kt) {
        if (kt + 1 < nk) waitv<6>(); else waitv<0>();
        rawbar();
        if (kt + 2 < nk) G_ISSUE(kt + 2, nxt);
        const char* st = lds + cur * GST;
#pragma unroll
        for (int kk = 0; kk < 2; ++kk) {
            const int co = ((kk * 4 + fq) ^ sw) << 4;
            bf16x8 af[4], wf[4];
#pragma unroll
            for (int i = 0; i < 4; ++i) af[i] = *(const bf16x8*)(st + a_base + i * 2048 + co);
#pragma unroll
            for (int i = 0; i < 4; ++i) wf[i] = *(const bf16x8*)(st + w_base + i * 2048 + co);
#pragma unroll
            for (int mw = 0; mw < 4; ++mw)
#pragma unroll
                for (int nt = 0; nt < 4; ++nt) acc[mw][nt] = __builtin_amdgcn_mfma_f32_16x16x32_bf16(wf[mw], af[nt], acc[mw][nt], 0, 0, 0);
        }
        cur = cur == 2 ? 0 : cur + 1; nxt = nxt == 2 ? 0 : nxt + 1;
    }
#undef G_ISSUE
    __syncthreads();
}
constexpr int GST2 = 65536;
DI void gemm_mainloop2(const bf16_t* __restrict__ A, int lda, const bf16_t* __restrict__ W, int ldw, int K, f32x4 (&acc)[4][8], char* lds) {
    const int tid = otid(), lane = tid & 63, wid = tid >> 6, wt = wid >> 2, wc = wid & 3;
    const int srow = tid >> 3, sch = (tid & 7) ^ ((srow >> 1) & 7);
    const bf16_t* ag = A + (size_t)srow * lda + sch * 8;
    const bf16_t* wg = W + (size_t)srow * ldw + sch * 8;
    char* const ld = lds + tid * 16;
    const int nk = K >> 6;
#define G2_ISSUE(kt_, st_) do { const int ko_ = (kt_) * 64; char* sn_ = ld + (st_) * GST2; \
        _Pragma("unroll") for (int i = 0; i < 4; ++i) glds16(ag + (size_t)(64 * i) * lda + ko_, sn_ + i * 8192); \
        _Pragma("unroll") for (int i = 0; i < 4; ++i) glds16(wg + (size_t)(64 * i) * ldw + ko_, sn_ + 32768 + i * 8192); } while (0)
    waitv<0>();
    G2_ISSUE(0, 0);
    const int fr = lane & 15, fq = lane >> 4, sw = (fr >> 1) & 7;
    const int a_base = (128 * wt + fr) * 128, w_base = 32768 + (64 * wc + fr) * 128;
    for (int kt = 0; kt < nk; ++kt) {
        waitv<0>();
        rawbar();
        if (kt + 1 < nk) G2_ISSUE(kt + 1, (kt + 1) & 1);
        const char* st = lds + (kt & 1) * GST2;
#pragma unroll
        for (int kk = 0; kk < 2; ++kk) {
            const int co = ((kk * 4 + fq) ^ sw) << 4;
            bf16x8 af[8], wf[4];
#pragma unroll
            for (int i = 0; i < 4; ++i) wf[i] = *(const bf16x8*)(st + w_base + i * 2048 + co);
#pragma unroll
            for (int i = 0; i < 8; ++i) af[i] = *(const bf16x8*)(st + a_base + i * 2048 + co);
            __builtin_amdgcn_s_setprio(1);
#pragma unroll
            for (int nt = 0; nt < 8; ++nt)
#pragma unroll
                for (int mw = 0; mw < 4; ++mw) acc[mw][nt] = __builtin_amdgcn_mfma_f32_16x16x32_bf16(wf[mw], af[nt], acc[mw][nt], 0, 0, 0);
            __builtin_amdgcn_s_setprio(0);
            SB();
        }
    }
#undef G2_ISSUE
    __syncthreads();
}
DI void zero_acc2(f32x4 (&acc)[4][8]) {
#pragma unroll
    for (int a = 0; a < 4; ++a)
#pragma unroll
        for (int b = 0; b < 8; ++b) acc[a][b] = (f32x4){0.f, 0.f, 0.f, 0.f};
}
DI void zero_acc(f32x4 (&acc)[4][4]) {
#pragma unroll
    for (int a = 0; a < 4; ++a)
#pragma unroll
        for (int b = 0; b < 4; ++b) acc[a][b] = (f32x4){0.f, 0.f, 0.f, 0.f};
}

DI void phase_gateup(const bf16_t* n, const bf16_t* wgu, bf16_t* act, char* lds) {
    const int tid_ = otid(), lane = tid_ & 63, wid = tid_ >> 6, wt = wid >> 2, wc = wid & 3, fr = lane & 15, fq = lane >> 4;
    constexpr int NTILES = 64 * (NGU / 256);
    for (int t = blockIdx.x; t < NTILES; t += gridDim.x) {
        const int bm = t & 63, bn = t >> 6, row0 = bm * 256;
        f32x4 acc[4][8]; zero_acc2(acc);
        gemm_mainloop2(n + (size_t)row0 * D, D, wgu + (size_t)bn * 256 * D, D, D, acc, lds);
#pragma unroll
        for (int nt = 0; nt < 8; ++nt) {
            const int token = row0 + 128 * wt + 16 * nt + fr;
            float v[8];
#pragma unroll
            for (int m = 0; m < 2; ++m)
#pragma unroll
                for (int r = 0; r < 4; ++r) { const float gg = acc[m][nt][r], uu = acc[m + 2][nt][r]; v[4 * m + r] = gg * fast_rcp(1.0f + __expf(-gg)) * uu; }
            u32x4 pk = {pk2(v[0], v[1]), pk2(v[2], v[3]), pk2(v[4], v[5]), pk2(v[6], v[7])};
            *(u32x4*)(act + (size_t)token * F + 32 * (4 * bn + wc) + 8 * fq) = pk;
        }
    }
}

DI void phase_resid(const bf16_t* A, int K, const bf16_t* W, const float* hin, float* hout, const float* __restrict__ gvec, float gs, char* lds) {
    const int tid_ = otid(), lane = tid_ & 63, wid = tid_ >> 6, wt = wid >> 2, wc = wid & 3, fr = lane & 15, fq = lane >> 4;
    constexpr int NTILES = 64 * 4;
    for (int t = blockIdx.x; t < NTILES; t += gridDim.x) {
        const int bm = t & 63, bn = t >> 6, row0 = bm * 256, ch0 = bn * 256 + 64 * wc + 16 * fq;
        f32x4 acc[4][8]; zero_acc2(acc);
        gemm_mainloop2(A + (size_t)row0 * K, K, W + (size_t)bn * 256 * K, K, K, acc, lds);
        f32x4 gv[4];
#pragma unroll
        for (int mw = 0; mw < 4; ++mw) gv[mw] = *(const f32x4*)(gvec + ch0 + 4 * mw) * gs;
#pragma unroll
        for (int nt = 0; nt < 8; ++nt) {
            const size_t off = (size_t)(row0 + 128 * wt + 16 * nt + fr) * D + ch0;
#pragma unroll
            for (int mw = 0; mw < 4; ++mw) { const f32x4 hv = *(const f32x4*)(hin + off + 4 * mw); *(f32x4*)(hout + off + 4 * mw) = hv + gv[mw] * acc[mw][nt]; }
            SB();
        }
    }
}

DI void phase_merge(const bf16_t* atta, const bf16_t* od, const bf16_t* wba, const bf16_t* wbb, const bf16_t* G, bf16_t* merged, float* spill, char* lds) {
    const int tid_ = otid(), lane = tid_ & 63, wid = tid_ >> 6, wt = wid >> 1, wc = wid & 1, fr = lane & 15, fq = lane >> 4;
    constexpr int NTILES = 64 * 8;
    for (int t = blockIdx.x; t < NTILES; t += gridDim.x) {
        const int bm = t & 63, bn = t >> 6, row0 = bm * 256, ch0 = bn * 128 + 64 * wc + 16 * fq;
        f32x4 acc[4][4]; zero_acc(acc);
        gemm_mainloop(atta + (size_t)row0 * 512, 512, wba + (size_t)bn * 128 * 512, 512, 512, acc, lds);
        float* sp = spill + ((size_t)blockIdx.x * 16 * 512 + tid_) * 4;
#pragma unroll
        for (int nt = 0; nt < 4; ++nt) {
            const bf16_t* gp = G + (size_t)(row0 + 64 * wt + 16 * nt + fr) * 2048 + ch0;
#pragma unroll
            for (int mw = 0; mw < 4; ++mw) { const u32x2 gu = *(const u32x2*)(gp + 4 * mw); const f32x4 ga = {bf_lo(gu[0]), bf_hi(gu[0]), bf_lo(gu[1]), bf_hi(gu[1])};
                *(f32x4*)(sp + (size_t)(nt * 4 + mw) * 2048) = ga * acc[mw][nt]; }
        }
        zero_acc(acc);
        gemm_mainloop(od + (size_t)row0 * 512, 512, wbb + (size_t)bn * 128 * 512, 512, 512, acc, lds);
#pragma unroll
        for (int nt = 0; nt < 4; ++nt) {
            const size_t tok = (size_t)(row0 + 64 * wt + 16 * nt + fr);
            const bf16_t* gp = G + tok * 2048 + 1024 + ch0;
            unsigned w[8];
#pragma unroll
            for (int mw = 0; mw < 4; ++mw) { const u32x2 gu = *(const u32x2*)(gp + 4 * mw); const f32x4 gb = {bf_lo(gu[0]), bf_hi(gu[0]), bf_lo(gu[1]), bf_hi(gu[1])};
                const f32x4 o = *(const f32x4*)(sp + (size_t)(nt * 4 + mw) * 2048) + gb * acc[mw][nt]; w[2 * mw] = pk2(o[0], o[1]); w[2 * mw + 1] = pk2(o[2], o[3]); }
            bf16_t* mp = merged + tok * D + ch0;
            *(u32x4*)(mp) = (u32x4){w[0], w[1], w[2], w[3]};
            *(u32x4*)(mp + 8) = (u32x4){w[4], w[5], w[6], w[7]};
        }
    }
}

DI void phase_win(const Params& p, int l, char* lds) {
    const int tid_ = otid(), lane = tid_ & 63, wid = tid_ >> 6, wt = wid >> 1, wc = wid & 1, fr = lane & 15, fq = lane >> 4;
    const bf16_t* n = (const bf16_t*)(p.ws + OFF_N);
    const bf16_t* W = (const bf16_t*)(p.ws + OFF_WIN + l * SZ_WIN);
    bf16_t* Q = (bf16_t*)(p.ws + OFF_Q); bf16_t* QD = (bf16_t*)(p.ws + OFF_QD); bf16_t* KA = (bf16_t*)(p.ws + OFF_KA); bf16_t* VTA = (bf16_t*)(p.ws + OFF_VTA);
    bf16_t* KD = (bf16_t*)(p.ws + OFF_KD); bf16_t* VTD = (bf16_t*)(p.ws + OFF_VTD); bf16_t* G = (bf16_t*)(p.ws + OFF_G);
    const float* rope = (const float*)(p.ws + OFF_ROPE);
    constexpr int NTILES = 64 * (NIN / 128);
    for (int t = blockIdx.x; t < NTILES; t += gridDim.x) {
        const int bm = t & 63, bn = t >> 6, row0 = bm * 256;
        f32x4 acc[4][4]; zero_acc(acc);
        gemm_mainloop(n + (size_t)row0 * D, D, W + (size_t)bn * 128 * D, D, D, acc, lds);
        const int cw = bn * 128 + 64 * wc;
        if (cw < 640) {
            const bool isq = cw < 512;
            const float* gq = p.qk_g + l * 128 + (isq ? 0 : 64);
            f32x4 gv[4];
#pragma unroll
            for (int mw = 0; mw < 4; ++mw) gv[mw] = *(const f32x4*)(gq + 16 * mw + 4 * fq);
#pragma unroll
            for (int nt = 0; nt < 4; ++nt) {
                const int token = row0 + 64 * wt + 16 * nt + fr;
                float ss = 0.f;
#pragma unroll
                for (int mw = 0; mw < 4; ++mw) ss += acc[mw][nt][0] * acc[mw][nt][0] + acc[mw][nt][1] * acc[mw][nt][1] + acc[mw][nt][2] * acc[mw][nt][2] + acc[mw][nt][3] * acc[mw][nt][3];
                ss += __shfl_xor(ss, 16); ss += __shfl_xor(ss, 32);
                const float rstd = rsqrtf(ss * (1.0f / 64.0f) + 1e-6f);
                f32x4 y[4];
#pragma unroll
                for (int mw = 0; mw < 4; ++mw) y[mw] = acc[mw][nt] * rstd * gv[mw];
                const int prow = token >> 6, pcol = token & 63;
                const f32x4 cr = *(const f32x4*)(rope + prow * 16 + 4 * fq), sr = *(const f32x4*)(rope + 4096 + prow * 16 + 4 * fq);
                const f32x4 cc = *(const f32x4*)(rope + 8192 + pcol * 16 + 4 * fq), sc = *(const f32x4*)(rope + 9216 + pcol * 16 + 4 * fq);
                f32x4 o[4];
                o[0] = y[0] * cr - y[1] * sr; o[1] = y[1] * cr + y[0] * sr; o[2] = y[2] * cc - y[3] * sc; o[3] = y[3] * cc + y[2] * sc;
                const float qs = isq ? QSCALE : 1.0f;
                bf16_t* dst = isq ? (Q + (size_t)token * 512 + cw) : (KA + (size_t)token * 128 + (cw - 512));
#pragma unroll
                for (int mw = 0; mw < 4; ++mw) { const f32x4 z = o[mw] * qs; *(u32x2*)(dst + 16 * mw + 4 * fq) = (u32x2){pk2(z[0], z[1]), pk2(z[2], z[3])}; }
            }
        } else if (cw < 768 || (cw >= 1792 && cw < 2304)) {
            bf16_t* vt = cw < 768 ? (VTA + (size_t)(cw - 640) * S) : (VTD + (size_t)(cw - 1792) * S);
#pragma unroll
            for (int nt = 0; nt < 4; ++nt) {
                const int token = row0 + 64 * wt + 16 * nt + fr;
#pragma unroll
                for (int mw = 0; mw < 4; ++mw)
#pragma unroll
                    for (int r = 0; r < 4; ++r) vt[(size_t)(16 * mw + 4 * fq + r) * S + token] = (bf16_t)(pk2(acc[mw][nt][r], 0.f) & 0xffffu);
            }
        } else if (cw < 1792) {
            const bool isq = cw < 1280; const float qs = isq ? QSCALE : 1.0f;
            bf16_t* base = isq ? (QD + (cw - 768)) : (KD + (cw - 1280));
#pragma unroll
            for (int nt = 0; nt < 4; ++nt) {
                bf16_t* dst = base + (size_t)(row0 + 64 * wt + 16 * nt + fr) * 512;
#pragma unroll
                for (int mw = 0; mw < 4; ++mw) { const f32x4 z = acc[mw][nt] * qs; *(u32x2*)(dst + 16 * mw + 4 * fq) = (u32x2){pk2(z[0], z[1]), pk2(z[2], z[3])}; }
            }
            {
                float best = 0.f;
#pragma unroll
                for (int nt = 0; nt < 4; ++nt) {
                    float ss = 0.f;
#pragma unroll
                    for (int mw = 0; mw < 4; ++mw) { const f32x4 z = acc[mw][nt] * qs; ss += z[0] * z[0] + z[1] * z[1] + z[2] * z[2] + z[3] * z[3]; }
                    ss += __shfl_xor(ss, 16); ss += __shfl_xor(ss, 32);
                    best = __builtin_fmaxf(best, ss);
                }
#pragma unroll
                for (int o = 8; o > 0; o >>= 1) best = __builtin_fmaxf(best, __shfl_xor(best, o));
                if (lane == 0) atomicMax((unsigned*)(p.ws + OFF_STAT) + l * 16 + (isq ? 0 : 8) + ((cw - (isq ? 768 : 1280)) >> 6), __float_as_uint(best));
            }
        } else {
            const int gc = cw - 2304;
            const float* bg = p.b_gate + l * 2048 + gc;
            f32x4 bv[4];
#pragma unroll
            for (int mw = 0; mw < 4; ++mw) bv[mw] = *(const f32x4*)(bg + 16 * mw + 4 * fq);
#pragma unroll
            for (int nt = 0; nt < 4; ++nt) {
                bf16_t* dst = G + (size_t)(row0 + 64 * wt + 16 * nt + fr) * 2048 + gc;
#pragma unroll
                for (int mw = 0; mw < 4; ++mw) {
                    const f32x4 xx = acc[mw][nt] + bv[mw]; f32x4 z;
#pragma unroll
                    for (int r = 0; r < 4; ++r) z[r] = fast_rcp(1.0f + __expf(-xx[r]));
                    *(u32x2*)(dst + 16 * mw + 4 * fq) = (u32x2){pk2(z[0], z[1]), pk2(z[2], z[3])};
                }
            }
        }
    }
}

#define MFMA32(a, b, c) __builtin_amdgcn_mfma_f32_32x32x16_bf16((a), (b), (c), 0, 0, 0)
template <int DV, bool ALIBI>
DI void attn_pass(const bf16_t* __restrict__ Qp, const bf16_t* __restrict__ Kb, int kpitch, const bf16_t* __restrict__ Vtb, float slope2, int qpos, int t_lo, int t_hi, float m_init,
                  f32x16 (&o)[DV / 32], float& l_out, char* lds) {
    constexpr int NV = DV / 64, NDT = DV / 32, STAGE = 8192 + DV * 128, G = 1 + NV;
    const int tid = otid(), lane = tid & 63, r32 = lane & 31, h = lane >> 5;
    bf16x8 qf[4];
#pragma unroll
    for (int d0 = 0; d0 < 4; ++d0) qf[d0] = *(const bf16x8*)(Qp + 16 * d0 + 8 * h);
    const int srow = tid >> 3, sch = (tid & 7) ^ ((srow >> 1) & 7);
    const bf16_t* kg = Kb + (size_t)srow * kpitch + sch * 8;
    const bf16_t* vg = Vtb + (size_t)srow * S + sch * 8;
    char* const ld = lds + tid * 16;
#define A_ISSUE(t_, st_) do { char* sn_ = ld + (st_) * STAGE; glds16(kg + (size_t)(t_) * 64 * kpitch, sn_); \
        _Pragma("unroll") for (int i = 0; i < NV; ++i) glds16(vg + (size_t)(64 * i) * S + (t_) * 64, sn_ + 8192 + i * 8192); } while (0)
    waitv<0>();
    A_ISSUE(t_lo, 0);
    if (t_lo + 1 <= t_hi) A_ISSUE(t_lo + 1, 1);
    if (t_lo + 2 <= t_hi) A_ISSUE(t_lo + 2, 2);
    const int pi = (r32 & 0x13) | ((r32 & 4) << 1) | ((r32 & 8) >> 1);
    const int k_base = pi * 128, k_sw = (pi >> 1) & 7, v_base = 8192 + r32 * 128, v_sw = (r32 >> 1) & 7;
    float m = m_init, l = 0.f;
#pragma unroll
    for (int dt = 0; dt < NDT; ++dt)
#pragma unroll
        for (int r = 0; r < 16; ++r) o[dt][r] = 0.f;
    int cur = 0;
    for (int t = t_lo; t <= t_hi; ++t) {
        const int rem = t_hi - t;
        if (rem >= 2) waitv<2 * G>(); else if (rem == 1) waitv<G>(); else waitv<0>();
        rawbar();
        if (rem >= 3) A_ISSUE(t + 3, (cur + 3) & 3);
        const char* st = lds + cur * STAGE;
        cur = (cur + 1) & 3;
        bf16x8 kf[2][4];
#pragma unroll
        for (int kt = 0; kt < 2; ++kt)
#pragma unroll
            for (int d0 = 0; d0 < 4; ++d0) kf[kt][d0] = *(const bf16x8*)(st + kt * 4096 + k_base + (((2 * d0 + h) ^ k_sw) << 4));
        f32x16 sc[2];
        const float nm = -m;
#pragma unroll
        for (int kt = 0; kt < 2; ++kt)
#pragma unroll
            for (int r = 0; r < 16; ++r) sc[kt][r] = nm;
        SB();
        __builtin_amdgcn_s_setprio(1);
#pragma unroll
        for (int d0 = 0; d0 < 4; ++d0)
#pragma unroll
            for (int kt = 0; kt < 2; ++kt) sc[kt] = MFMA32(kf[kt][d0], qf[d0], sc[kt]);
        __builtin_amdgcn_s_setprio(0);
        bf16x8 vf[2][4];
        if (NDT == 2) {
#pragma unroll
            for (int dt = 0; dt < 2; ++dt)
#pragma unroll
                for (int ks = 0; ks < 4; ++ks) vf[dt][ks] = *(const bf16x8*)(st + v_base + dt * 4096 + (((2 * ks + h) ^ v_sw) << 4));
        }
        SB();
        if (ALIBI) {
#pragma unroll
            for (int kt = 0; kt < 2; ++kt) {
                const float dq = (float)(qpos - (64 * t + 32 * kt + 8 * h));
#pragma unroll
                for (int r = 0; r < 16; ++r) sc[kt][r] = __builtin_fmaf(-slope2, __builtin_fabsf(dq - (float)(16 * (r >> 3) + (r & 7))), sc[kt][r]);
            }
        }
        float mt = sc[0][0];
#pragma unroll
        for (int r = 1; r < 16; ++r) mt = __builtin_fmaxf(mt, sc[0][r]);
#pragma unroll
        for (int r = 0; r < 16; ++r) mt = __builtin_fmaxf(mt, sc[1][r]);
        mt = __builtin_fmaxf(mt, __shfl_xor(mt, 32));
        if (__any(mt > 8.0f)) {
            const float dl = __builtin_fmaxf(mt, 0.f), al = fast_exp2(-dl);
            l *= al; m += dl;
#pragma unroll
            for (int kt = 0; kt < 2; ++kt)
#pragma unroll
                for (int r = 0; r < 16; ++r) sc[kt][r] -= dl;
#pragma unroll
            for (int dt = 0; dt < NDT; ++dt)
#pragma unroll
                for (int r = 0; r < 16; ++r) o[dt][r] *= al;
        }
        float ps = 0.f;
#pragma unroll
        for (int kt = 0; kt < 2; ++kt)
#pragma unroll
            for (int r = 0; r < 16; ++r) { const float e = fast_exp2(sc[kt][r]); sc[kt][r] = e; ps += e; }
        l += ps;
        bf16x8 pf[4];
#pragma unroll
        for (int ks = 0; ks < 4; ++ks) {
            const int kt = ks >> 1, b = (ks & 1) * 8;
            u32x4 w = {pk2(sc[kt][b], sc[kt][b + 1]), pk2(sc[kt][b + 2], sc[kt][b + 3]), pk2(sc[kt][b + 4], sc[kt][b + 5]), pk2(sc[kt][b + 6], sc[kt][b + 7])};
            pf[ks] = __builtin_bit_cast(bf16x8, w);
        }
        SB();
        if (NDT == 4) {
#pragma unroll
            for (int gp = 0; gp < 2; ++gp) {
#pragma unroll
                for (int dt = 0; dt < 2; ++dt)
#pragma unroll
                    for (int ks = 0; ks < 4; ++ks) vf[dt][ks] = *(const bf16x8*)(st + v_base + (dt + 2 * gp) * 4096 + (((2 * ks + h) ^ v_sw) << 4));
                __builtin_amdgcn_s_setprio(1);
#pragma unroll
                for (int ks = 0; ks < 4; ++ks)
#pragma unroll
                    for (int dt = 0; dt < 2; ++dt) o[(dt + 2 * gp) % NDT] = MFMA32(vf[dt][ks], pf[ks], o[(dt + 2 * gp) % NDT]);
                __builtin_amdgcn_s_setprio(0);
                SB();
            }
        } else {
            __builtin_amdgcn_s_setprio(1);
#pragma unroll
            for (int ks = 0; ks < 4; ++ks)
#pragma unroll
                for (int dt = 0; dt < 2; ++dt) o[dt] = MFMA32(vf[dt][ks], pf[ks], o[dt]);
            __builtin_amdgcn_s_setprio(0);
        }
        SB();
    }
#undef A_ISSUE
    __syncthreads();
    l += __shfl_xor(l, 32);
    l_out = l;
}

DI void attn_pass_b(const bf16_t* __restrict__ Qp, const bf16_t* __restrict__ Kb, int kpitch, const bf16_t* __restrict__ Vtb, float slope2, int qpos, int t_lo, int t_hi, float mref,
                    f32x16 (&o)[4], float& l_out, char* lds) {
    constexpr int NV = 2, STAGE = 8192 + 128 * 128, G = 1 + NV;
    const int tid = otid(), lane = tid & 63, r32 = lane & 31, h = lane >> 5;
    const int qw0 = __builtin_amdgcn_readfirstlane(qpos - r32);
    bf16x8 qf[4];
#pragma unroll
    for (int d0 = 0; d0 < 4; ++d0) qf[d0] = *(const bf16x8*)(Qp + 16 * d0 + 8 * h);
    const int srow = tid >> 3, sch = (tid & 7) ^ ((srow >> 1) & 7);
    const bf16_t* kg = Kb + (size_t)srow * kpitch + sch * 8;
    const bf16_t* vg = Vtb + (size_t)srow * S + sch * 8;
    char* const ld = lds + tid * 16;
#define B_ISSUE(t_, st_) do { char* sn_ = ld + (st_) * STAGE; glds16(kg + (size_t)(t_) * 64 * kpitch, sn_); \
        _Pragma("unroll") for (int i = 0; i < NV; ++i) glds16(vg + (size_t)(64 * i) * S + (t_) * 64, sn_ + 8192 + i * 8192); } while (0)
    waitv<0>();
    B_ISSUE(t_lo, 0);
    if (t_lo + 1 <= t_hi) B_ISSUE(t_lo + 1, 1);
    if (t_lo + 2 <= t_hi) B_ISSUE(t_lo + 2, 2);
    const int pi = (r32 & 0x13) | ((r32 & 4) << 1) | ((r32 & 8) >> 1);
    const int k_base = pi * 128, k_sw = (pi >> 1) & 7, v_base = 8192 + r32 * 128, v_sw = (r32 >> 1) & 7;
    float l = 0.f;
    const float nm = -mref;
#pragma unroll
    for (int dt = 0; dt < 4; ++dt)
#pragma unroll
        for (int r = 0; r < 16; ++r) o[dt][r] = 0.f;
    int cur = 0;
    for (int t = t_lo; t <= t_hi; ++t) {
        const int rem = t_hi - t;
        if (rem >= 2) waitv<2 * G>(); else if (rem == 1) waitv<G>(); else waitv<0>();
        rawbar();
        if (rem >= 3) B_ISSUE(t + 3, (cur + 3) & 3);
        const char* st = lds + cur * STAGE;
        cur = (cur + 1) & 3;
        bf16x8 kf[2][4];
#pragma unroll
        for (int kt = 0; kt < 2; ++kt)
#pragma unroll
            for (int d0 = 0; d0 < 4; ++d0) kf[kt][d0] = *(const bf16x8*)(st + kt * 4096 + k_base + (((2 * d0 + h) ^ k_sw) << 4));
        const int side = (64 * t + 63 < qw0) ? 1 : ((64 * t > qw0 + 31) ? -1 : 0);
        f32x16 sc[2];
        if (side != 0) {
            const float ss = side > 0 ? slope2 : -slope2;
#pragma unroll
            for (int kt = 0; kt < 2; ++kt) {
                const float base = __builtin_fmaf(ss, (float)(64 * t + 32 * kt + 8 * h - qpos), nm);
#pragma unroll
                for (int r = 0; r < 16; ++r) sc[kt][r] = __builtin_fmaf(ss, (float)(16 * (r >> 3) + (r & 7)), base);
            }
        } else {
#pragma unroll
            for (int kt = 0; kt < 2; ++kt)
#pragma unroll
                for (int r = 0; r < 16; ++r) sc[kt][r] = nm;
        }
        SB();
        __builtin_amdgcn_s_setprio(1);
#pragma unroll
        for (int d0 = 0; d0 < 4; ++d0)
#pragma unroll
            for (int kt = 0; kt < 2; ++kt) sc[kt] = MFMA32(kf[kt][d0], qf[d0], sc[kt]);
        __builtin_amdgcn_s_setprio(0);
        SB();
        if (side == 0) {
#pragma unroll
            for (int kt = 0; kt < 2; ++kt) {
                const float dq = (float)(qpos - (64 * t + 32 * kt + 8 * h));
#pragma unroll
                for (int r = 0; r < 16; ++r) sc[kt][r] = __builtin_fmaf(-slope2, __builtin_fabsf(dq - (float)(16 * (r >> 3) + (r & 7))), sc[kt][r]);
            }
        }
        float ps = 0.f;
#pragma unroll
        for (int kt = 0; kt < 2; ++kt)
#pragma unroll
            for (int r = 0; r < 16; ++r) { const float e = fast_exp2(sc[kt][r]); sc[kt][r] = e; ps += e; }
        l += ps;
        bf16x8 pf[4];
#pragma unroll
        for (int ks = 0; ks < 4; ++ks) {
            const int kt = ks >> 1, b = (ks & 1) * 8;
            u32x4 w = {pk2(sc[kt][b], sc[kt][b + 1]), pk2(sc[kt][b + 2], sc[kt][b + 3]), pk2(sc[kt][b + 4], sc[kt][b + 5]), pk2(sc[kt][b + 6], sc[kt][b + 7])};
            pf[ks] = __builtin_bit_cast(bf16x8, w);
        }
        SB();
#pragma unroll
        for (int gp = 0; gp < 2; ++gp) {
            bf16x8 vf[2][4];
#pragma unroll
            for (int dt = 0; dt < 2; ++dt)
#pragma unroll
                for (int ks = 0; ks < 4; ++ks) vf[dt][ks] = *(const bf16x8*)(st + v_base + (dt + 2 * gp) * 4096 + (((2 * ks + h) ^ v_sw) << 4));
            __builtin_amdgcn_s_setprio(1);
#pragma unroll
            for (int ks = 0; ks < 4; ++ks)
#pragma unroll
                for (int dt = 0; dt < 2; ++dt) o[dt + 2 * gp] = MFMA32(vf[dt][ks], pf[ks], o[dt + 2 * gp]);
            __builtin_amdgcn_s_setprio(0);
            SB();
        }
    }
#undef B_ISSUE
    __syncthreads();
    l += __shfl_xor(l, 32);
    l_out = l;
}

DI void attn_pass_a(const bf16_t* __restrict__ Qp, const bf16_t* __restrict__ Kb, int kpitch, const bf16_t* __restrict__ Vtb, float mref, f32x16 (&o)[2], float& l_out, char* lds) {
    constexpr int STAGE = 16384, NTL = S / 64;
    const int tid = otid(), lane = tid & 63, r32 = lane & 31, h = lane >> 5;
    bf16x8 qf[4];
#pragma unroll
    for (int d0 = 0; d0 < 4; ++d0) qf[d0] = *(const bf16x8*)(Qp + 16 * d0 + 8 * h);
    const int srow = tid >> 3, sch = (tid & 7) ^ ((srow >> 1) & 7);
    const bf16_t* kg = Kb + (size_t)srow * kpitch + sch * 8;
    const bf16_t* vg = Vtb + (size_t)srow * S + sch * 8;
    char* const ld = lds + tid * 16;
#define AA_ISSUE(t_, st_) do { char* sn_ = ld + (st_) * STAGE; glds16(kg + (size_t)(t_) * 64 * kpitch, sn_); glds16(vg + (t_) * 64, sn_ + 8192); } while (0)
    waitv<0>();
    AA_ISSUE(0, 0); AA_ISSUE(1, 1); AA_ISSUE(2, 2);
    const int pi = (r32 & 0x13) | ((r32 & 4) << 1) | ((r32 & 8) >> 1);
    const int k_base = pi * 128, k_sw = (pi >> 1) & 7, v_base = 8192 + r32 * 128, v_sw = (r32 >> 1) & 7;
    f32x16 negm, lacc;
#pragma unroll
    for (int r = 0; r < 16; ++r) { negm[r] = -mref; lacc[r] = 0.f; o[0][r] = 0.f; o[1][r] = 0.f; }
    const bf16x8 ones = {(short)0x3F80, (short)0x3F80, (short)0x3F80, (short)0x3F80, (short)0x3F80, (short)0x3F80, (short)0x3F80, (short)0x3F80};
    f32x16 sA[2], sB[2];
#define AA_QK(DST, stp_) do { bf16x8 kf_[2][4]; \
        _Pragma("unroll") for (int kt = 0; kt < 2; ++kt) _Pragma("unroll") for (int d0 = 0; d0 < 4; ++d0) kf_[kt][d0] = *(const bf16x8*)((stp_) + kt * 4096 + k_base + (((2 * d0 + h) ^ k_sw) << 4)); \
        SB(); __builtin_amdgcn_s_setprio(1); \
        DST[0] = MFMA32(kf_[0][0], qf[0], negm); DST[1] = MFMA32(kf_[1][0], qf[0], negm); \
        _Pragma("unroll") for (int d0 = 1; d0 < 4; ++d0) { DST[0] = MFMA32(kf_[0][d0], qf[d0], DST[0]); DST[1] = MFMA32(kf_[1][d0], qf[d0], DST[1]); } \
        __builtin_amdgcn_s_setprio(0); } while (0)
    waitv<4>();
    rawbar();
    AA_QK(sA, lds);
#define AA_STEP(CUR, NXT, t_) do { const int t = (t_); \
        if (t + 2 < NTL) waitv<2>(); else waitv<0>();              \
        rawbar();                                                  \
        if (t + 3 < NTL) AA_ISSUE(t + 3, (t + 3) & 3); \
        const char* st = lds + (t & 3) * STAGE; \
        if (t + 1 < NTL) AA_QK(NXT, lds + ((t + 1) & 3) * STAGE); \
        bf16x8 vf[2][4]; \
        _Pragma("unroll") for (int dt = 0; dt < 2; ++dt) _Pragma("unroll") for (int ks = 0; ks < 4; ++ks) vf[dt][ks] = *(const bf16x8*)(st + v_base + dt * 4096 + (((2 * ks + h) ^ v_sw) << 4)); \
        SB(); \
        _Pragma("unroll") for (int kt = 0; kt < 2; ++kt) _Pragma("unroll") for (int r = 0; r < 16; ++r) CUR[kt][r] = fast_exp2(CUR[kt][r]); \
        bf16x8 pf[4]; \
        _Pragma("unroll") for (int ks = 0; ks < 4; ++ks) { const int kt = ks >> 1, b = (ks & 1) * 8; \
            u32x4 w = {pk2(CUR[kt][b], CUR[kt][b + 1]), pk2(CUR[kt][b + 2], CUR[kt][b + 3]), pk2(CUR[kt][b + 4], CUR[kt][b + 5]), pk2(CUR[kt][b + 6], CUR[kt][b + 7])}; \
            pf[ks] = __builtin_bit_cast(bf16x8, w); } \
        SB(); __builtin_amdgcn_s_setprio(1); \
        _Pragma("unroll") for (int ks = 0; ks < 4; ++ks) { _Pragma("unroll") for (int dt = 0; dt < 2; ++dt) o[dt] = MFMA32(vf[dt][ks], pf[ks], o[dt]); lacc = MFMA32(ones, pf[ks], lacc); } \
        __builtin_amdgcn_s_setprio(0); SB(); } while (0)
    for (int t2 = 0; t2 < NTL; t2 += 2) { AA_STEP(sA, sB, t2); AA_STEP(sB, sA, t2 + 1); }
#undef AA_STEP
#undef AA_QK
#undef AA_ISSUE
    __syncthreads();
    l_out = lacc[0];
}

DI void phase_attn(const Params& p, int l, int rep, char* lds) {
    const int tid = otid(), lane = tid & 63, wid = tid >> 6, r32 = lane & 31, h = lane >> 5;
    const bf16_t* Q = (const bf16_t*)(p.ws + OFF_Q); const bf16_t* QD = (const bf16_t*)(p.ws + OFF_QD); const bf16_t* KA = (const bf16_t*)(p.ws + OFF_KA);
    const bf16_t* VTA = (const bf16_t*)(p.ws + OFF_VTA); const bf16_t* KD = (const bf16_t*)(p.ws + OFF_KD); const bf16_t* VTD = (const bf16_t*)(p.ws + OFF_VTD);
    bf16_t* ATTA = (bf16_t*)(p.ws + OFF_ATTA); bf16_t* OD = (bf16_t*)(p.ws + OFF_OD); float* BO0 = (float*)(p.ws + OFF_N);
    const float lam = ((const float*)(p.ws + OFF_LAM))[l];
    const float oml = 1.0f - (l == 0 ? 0.2f : 0.35550906759096926f);
    float bA;
    { float gq = __builtin_fabsf(p.qk_g[l * 128 + lane]), gk = __builtin_fabsf(p.qk_g[l * 128 + 64 + lane]);
#pragma unroll
      for (int o_ = 32; o_ > 0; o_ >>= 1) { gq = __builtin_fmaxf(gq, __shfl_xor(gq, o_)); gk = __builtin_fmaxf(gk, __shfl_xor(gk, o_)); }
      bA = 64.0f * gq * gk * QSCALE * 1.01f; }
    unsigned* qcnt = (unsigned*)(p.ws + OFF_STAT) + 32 + l + 2 * rep;
    const unsigned* stat = (const unsigned*)(p.ws + OFF_STAT) + l * 16;
    volatile unsigned* lword = (volatile unsigned*)(lds + 147456 + 16);
    for (;;) {
        if (tid == 0) *lword = atomicAdd(qcnt, 1u);
        __syncthreads();
        const int u = (int)*lword;
        __syncthreads();
        if (u >= 768) break;
        if (PROBE_DUP == 5 && rep && (u < 128 || u >= 640)) continue;
        if (u < 128 || u >= 640) {
            const int hb = u < 64 ? 3 : (u < 128 ? 2 : (u < 704 ? 1 : 0)), qb = u & 63;
            const int token = 256 * qb + 32 * wid + r32;
            const float slope2 = exp2f(-2.0f * (float)(hb + 1)) * LOG2E;
            float* bo = BO0 + (size_t)token * 512 + hb * 128;
            f32x16 o[4]; float ls;
            int tl[2], th[2]; float mi[2];
#pragma unroll
            for (int mp = 0; mp < 2; ++mp) {
                const float qk = sqrtf(__uint_as_float(stat[mp * 4 + hb]) * __uint_as_float(stat[8 + mp * 4 + hb])) * 1.02f;
                const float R = __builtin_fminf((2.0f * qk + 150.0f) / slope2, 40000.0f);
                const int klo = 256 * qb - (int)R - 1, khi = 256 * qb + 255 + (int)R + 1;
                mi[mp] = -qk;
                tl[mp] = klo < 0 ? 0 : (klo >> 6); th[mp] = khi >= S ? (S / 64 - 1) : (khi >> 6);
            }
            if (-mi[0] <= 45.0f) attn_pass_b(QD + (size_t)token * 512 + hb * 64, KD + hb * 64, 512, VTD + (size_t)(hb * 128) * S, slope2, token, tl[0], th[0], -mi[0], o, ls, lds);
            else attn_pass<128, true>(QD + (size_t)token * 512 + hb * 64, KD + hb * 64, 512, VTD + (size_t)(hb * 128) * S, slope2, token, tl[0], th[0], mi[0], o, ls, lds);
            {
                const float inv = 1.0f / ls;
#pragma unroll
                for (int dt = 0; dt < 4; ++dt)
#pragma unroll
                    for (int g = 0; g < 4; ++g) *(f32x4*)(bo + 32 * dt + 8 * g + 4 * h) = (f32x4){o[dt][4 * g] * inv, o[dt][4 * g + 1] * inv, o[dt][4 * g + 2] * inv, o[dt][4 * g + 3] * inv};
            }
            if (-mi[1] <= 45.0f) attn_pass_b(QD + (size_t)token * 512 + 256 + hb * 64, KD + 256 + hb * 64, 512, VTD + (size_t)(hb * 128) * S, slope2, token, tl[1], th[1], -mi[1], o, ls, lds);
            else attn_pass<128, true>(QD + (size_t)token * 512 + 256 + hb * 64, KD + 256 + hb * 64, 512, VTD + (size_t)(hb * 128) * S, slope2, token, tl[1], th[1], mi[1], o, ls, lds);
            {
                const float inv = lam / ls; float ss = 0.f;
#pragma unroll
                for (int dt = 0; dt < 4; ++dt)
#pragma unroll
                    for (int g = 0; g < 4; ++g) {
                        const f32x4 a = *(const f32x4*)(bo + 32 * dt + 8 * g + 4 * h);
#pragma unroll
                        for (int j = 0; j < 4; ++j) { const float v = a[j] - o[dt][4 * g + j] * inv; o[dt][4 * g + j] = v; ss += v * v; }
                    }
                ss += __shfl_xor(ss, 32);
                const float rstd = rsqrtf(ss * (1.0f / 128.0f) + 1e-6f) * oml;
                const float* sg = p.subln_g + l * 128;
                bf16_t* dst = OD + (size_t)token * 512 + hb * 128;
#pragma unroll
                for (int dt = 0; dt < 4; ++dt)
#pragma unroll
                    for (int g = 0; g < 4; ++g) {
                        const int d = 32 * dt + 8 * g + 4 * h;
                        const f32x4 gg = *(const f32x4*)(sg + d);
                        *(u32x2*)(dst + d) = (u32x2){pk2(o[dt][4 * g] * rstd * gg[0], o[dt][4 * g + 1] * rstd * gg[1]), pk2(o[dt][4 * g + 2] * rstd * gg[2], o[dt][4 * g + 3] * rstd * gg[3])};
                    }
            }
        } else {
            const int v = u - 128, kv = v >> 8, hq = kv * 4 + (v & 3), qb = (v >> 2) & 63;
            const int token = 256 * qb + 32 * wid + r32;
            f32x16 o[2]; float ls;
            if (bA <= 40.0f) attn_pass_a(Q + (size_t)token * 512 + hq * 64, KA + kv * 64, 128, VTA + (size_t)(kv * 64) * S, bA, o, ls, lds);
            else attn_pass<64, false>(Q + (size_t)token * 512 + hq * 64, KA + kv * 64, 128, VTA + (size_t)(kv * 64) * S, 0.f, token, 0, S / 64 - 1, 0.f, o, ls, lds);
            const float inv = 1.0f / ls;
            bf16_t* dst = ATTA + (size_t)token * 512 + hq * 64;
#pragma unroll
            for (int dt = 0; dt < 2; ++dt)
#pragma unroll
                for (int g = 0; g < 4; ++g)
                    *(u32x2*)(dst + 32 * dt + 8 * g + 4 * h) = (u32x2){pk2(o[dt][4 * g] * inv, o[dt][4 * g + 1] * inv), pk2(o[dt][4 * g + 2] * inv, o[dt][4 * g + 3] * inv)};
        }
    }
}

#define XB_TMO      128
#define XB_XCNT(j)  (256  + 64 * (j))
#define XB_XSUB(j)  (1280 + 64 * (j))
#define XB_XGEN(j)  (2304 + 64 * (j))
#define XB_TOP      3328
#define XB_TOPGEN   3392
#define XCD_BAR_WORDS 3456
#define XB_SPIN_CAP (1u << 18)
#define LAS __attribute__((address_space(3)))
DI unsigned xb_ld(unsigned* p) { return __hip_atomic_load(p, __ATOMIC_RELAXED, __HIP_MEMORY_SCOPE_AGENT); }
DI unsigned xb_add(unsigned* p, unsigned v) { return __hip_atomic_fetch_add(p, v, __ATOMIC_RELAXED, __HIP_MEMORY_SCOPE_AGENT); }
DI unsigned xb_xcc_id() { return (unsigned)__builtin_amdgcn_s_getreg((3 << 11) | 20) & 0xFu; }
#define XB_SPIN(cond, bar) do { unsigned _sp = 0; while (cond) { __builtin_amdgcn_s_sleep(1); \
    if ((++_sp & 255u) == 0u) { if (xb_ld(&(bar)[XB_TMO])) break; if (_sp > XB_SPIN_CAP) { atomicAdd(&(bar)[XB_TMO], 1u); break; } } } } while (0)
struct XcdBarrier { unsigned* bar; unsigned x; volatile LAS unsigned* st; };
DI XcdBarrier xcd_barrier_post(unsigned* bar, volatile LAS unsigned* st) {
    XcdBarrier b; b.bar = bar; b.x = xb_xcc_id(); b.st = st;
    if (threadIdx.x == 0) (void)xb_add(&bar[XB_XCNT(b.x)], 1u);
    return b;
}
DI void xcd_barrier_complete(unsigned* bar, unsigned x, unsigned& nloc, unsigned& nx) {
    const unsigned G = gridDim.x * gridDim.y * gridDim.z;
    unsigned sum, cnt, mine, sp = 0u;
    for (;;) {
        sum = 0u; cnt = 0u; mine = 0u;
#pragma unroll
        for (unsigned j = 0; j < 16; ++j) { const unsigned c = xb_ld(&bar[XB_XCNT(j)]); sum += c; cnt += (c > 0u) ? 1u : 0u; mine = (j == x) ? c : mine; }
        if (sum == G) break;
        __builtin_amdgcn_s_sleep(1);
        if ((++sp & 255u) == 0u) { if (xb_ld(&bar[XB_TMO])) break; if (sp > XB_SPIN_CAP) { atomicAdd(&bar[XB_TMO], 1u); break; } }
    }
    nloc = mine > 0u ? mine : 1u; nx = cnt > 0u ? cnt : 1u;
}
DI void xcd_barrier(const XcdBarrier& b) {
    asm volatile("s_waitcnt vmcnt(0)" ::: "memory");
    __syncthreads();
    if (threadIdx.x == 0) {
        unsigned* bar = b.bar;
        __builtin_amdgcn_s_waitcnt(0);
        unsigned nloc = b.st[0], nx = b.st[1];
        if (nloc == 0u) { xcd_barrier_complete(bar, b.x, nloc, nx); b.st[0] = nloc; b.st[1] = nx; }
        const unsigned old = xb_add(&bar[XB_XSUB(b.x)], 1u);
        const unsigned gen = old / nloc;
        if (old + 1u == (gen + 1u) * nloc) {
            __builtin_amdgcn_fence(__ATOMIC_RELEASE, "agent");
            asm volatile("s_waitcnt vmcnt(0)" ::: "memory");
            const unsigned og = xb_add(&bar[XB_TOP], 1u);
            const unsigned tg = og / nx;
            if (og + 1u == (tg + 1u) * nx) xb_add(&bar[XB_TOPGEN], 1u);
            else XB_SPIN(xb_ld(&bar[XB_TOPGEN]) == tg, bar);
            __builtin_amdgcn_fence(__ATOMIC_ACQUIRE, "agent");
            xb_add(&bar[XB_XGEN(b.x)], 1u);
            asm volatile("s_waitcnt vmcnt(0)" ::: "memory");
        } else {
            XB_SPIN(xb_ld(&bar[XB_XGEN(b.x)]) == gen, bar);
            __builtin_amdgcn_fence(__ATOMIC_ACQUIRE, "agent");
            asm volatile("s_waitcnt vmcnt(0)" ::: "memory");
        }
    }
    __syncthreads();
}

__global__ void __launch_bounds__(512) mega(Params pin) {
    __shared__ __attribute__((aligned(16))) char lds[147456 + 64];
    cg::grid_group grid = cg::this_grid();
    volatile LAS unsigned* xst = (volatile LAS unsigned*)(lds + 147456);
    if (threadIdx.x == 0) { xst[0] = 0u; xst[1] = 0u; }
    __syncthreads();
    const XcdBarrier xb = xcd_barrier_post((unsigned*)(pin.ws + OFF_BAR), xst);
    int rep = 0;
    for (int ph = pin.ph_lo; ph < pin.ph_hi; ++ph) {
        Params p = pin;
        asm volatile("" : "+s"(p.ws), "+s"(p.out), "+s"(p.x));
        bf16_t* nbuf = (bf16_t*)(p.ws + OFF_N);
        bf16_t* act = (bf16_t*)(p.ws + OFF_ACT);
        if (ph == 0) phase_prologue(p, lds);
        else {
            const int l = ph == 23 ? 1 : (ph - 1) / 11, k = ph == 23 ? 11 : (ph - 1) % 11;
            const float* mod = (const float*)(p.ws + OFF_MOD) + l * 9216;
            switch (k) {
            case 0: case 3: case 8: case 11: {
                const int i = k == 0 ? 0 : (k == 3 ? 1 : 2);
                const float* hin = (ph == 1) ? p.x : p.out;
                if (k == 11) phase_norm(hin, p.final_g, nullptr, nullptr, nullptr, p.out);
                else phase_norm(hin, p.norm_g + (l * 3 + i) * D, mod + (3 * i) * D, mod + (3 * i + 1) * D, nbuf, nullptr);
            } break;
            case 1: case 9: {
                const int f = k == 1 ? 0 : 1;
                phase_gateup(nbuf, (const bf16_t*)(p.ws + OFF_WGU + (size_t)(l * 2 + f) * SZ_WGU), act, lds);
            } break;
            case 2: case 10: case 7: {
                if (k == 7) phase_resid((const bf16_t*)(p.ws + OFF_Q), D, (const bf16_t*)(p.ws + OFF_WO + l * SZ_WO), p.out, p.out, mod + 5 * D, rep ? 0.0f : 1.0f, lds);
                else {
                    const int f = k == 2 ? 0 : 1;
                    phase_resid(act, F, (const bf16_t*)(p.ws + OFF_WD + (size_t)(l * 2 + f) * SZ_WD), (ph == 3 && !rep) ? p.x : p.out, p.out, mod + (f == 0 ? 2 : 8) * D, rep ? 0.0f : 0.5f, lds);
                }
            } break;
            case 4: phase_win(p, l, lds); break;
            case 5: phase_attn(p, l, rep, lds); break;
            case 6: phase_merge((const bf16_t*)(p.ws + OFF_ATTA), (const bf16_t*)(p.ws + OFF_OD), (const bf16_t*)(p.ws + OFF_WBA + l * SZ_WB), (const bf16_t*)(p.ws + OFF_WBB + l * SZ_WB),
                                (const bf16_t*)(p.ws + OFF_G), (bf16_t*)(p.ws + OFF_Q), (float*)(p.ws + OFF_N), lds); break;
            default: break;
            }
        }
        if (ph + 1 < pin.ph_hi) { if (ph == pin.ph_lo) grid.sync(); else xcd_barrier(xb); }
        if (PROBE_DUP >= 0 && rep == 0 && (ph == 0 ? PROBE_DUP == 100 : ((ph - 1) % 11 == PROBE_DUP && ph != 23))) { rep = 1; --ph; } else rep = 0;
    }
}

extern "C" void kernel_launch(void* const* d_in, const int* in_sizes, int n_in, void* d_out, int out_size, void* d_ws, size_t ws_size, hipStream_t stream) {
    if (n_in != 18 || out_size != S * D || ws_size < WS_END) { fprintf(stderr, "kernel_launch: unexpected shapes / workspace (n_in %d out %d ws %zu need %zu)\n", n_in, out_size, ws_size, (size_t)WS_END); return; }
    Params p{};
    const float** pp = (const float**)&p;
    for (int i = 0; i < 18; ++i) pp[i] = (const float*)d_in[i];
    p.out = (float*)d_out; p.ws = (unsigned char*)d_ws;
    if (hipMemsetAsync((char*)d_ws + OFF_BAR, 0, 3456 * 4, stream) != hipSuccess) { fprintf(stderr, "kernel_launch: hipMemsetAsync of the barrier words failed\n"); return; }
#if MK_MULTI
    for (int ph = 0; ph < NPH; ++ph) { p.ph_lo = ph; p.ph_hi = ph + 1; hipLaunchKernelGGL(mega, dim3(256), dim3(512), 0, stream, p); }
#else
    static int grid = 0;
    if (!grid) {
        int dev = 0, cus = 0, per_cu = 0;
        hipGetDevice(&dev); hipDeviceGetAttribute(&cus, hipDeviceAttributeMultiprocessorCount, dev);
        hipOccupancyMaxActiveBlocksPerMultiprocessor(&per_cu, (const void*)mega, 512, 0);
        if (per_cu < 1) { fprintf(stderr, "kernel_launch: occupancy query says %d blocks per CU\n", per_cu); per_cu = 1; }
        grid = cus;
    }
    p.ph_lo = 0; p.ph_hi = NPH;
    void* args[] = {&p};
    hipError_t e = hipLaunchCooperativeKernel((const void*)mega, dim3(grid), dim3(512), args, 0, stream);
    if (e != hipSuccess) fprintf(stderr, "cooperative launch failed: %s (grid %d)\n", hipGetErrorString(e), grid);
#endif
}
```

```cpp
#include <hip/hip_runtime.h>
#include <hip/hip_cooperative_groups.h>
#include <cstdio>
#include <cstdint>
namespace cg = cooperative_groups;

#ifndef MK_MULTI
#define MK_MULTI 0
#endif

#ifndef PROBE_DUP
#define PROBE_DUP -1
#endif
#define DI __device__ __forceinline__
typedef unsigned short bf16_t;
typedef short bf16x8 __attribute__((ext_vector_type(8)));
typedef float f32x4 __attribute__((ext_vector_type(4)));
typedef float f32x16 __attribute__((ext_vector_type(16)));
typedef unsigned u32x4 __attribute__((ext_vector_type(4)));
typedef unsigned u32x2 __attribute__((ext_vector_type(2)));

constexpr int S = 16384, D = 1024, F = 2816, NGU = 5632, NIN = 4352;
constexpr int NPH = 24;
constexpr float QSCALE = 0.125f * 1.4426950408889634f;
constexpr float LOG2E = 1.4426950408889634f;

constexpr size_t OFF_MOD = 0;
constexpr size_t OFF_LAM = 80000;
constexpr size_t OFF_STAT = 80128;
constexpr size_t OFF_ROPE = 81920;
constexpr size_t OFF_BAR = 131072;
constexpr size_t OFF_WGU = 1u << 20;
constexpr size_t SZ_WGU = (size_t)NGU * D * 2;
constexpr size_t OFF_WD = OFF_WGU + 4 * SZ_WGU;
constexpr size_t SZ_WD = (size_t)D * F * 2;
constexpr size_t OFF_WIN = OFF_WD + 4 * SZ_WD;
constexpr size_t SZ_WIN = (size_t)NIN * D * 2;
constexpr size_t OFF_WBA = OFF_WIN + 2 * SZ_WIN;
constexpr size_t SZ_WB = (size_t)D * 512 * 2;
constexpr size_t OFF_WBB = OFF_WBA + 2 * SZ_WB;
constexpr size_t OFF_WO = OFF_WBB + 2 * SZ_WB;
constexpr size_t SZ_WO = (size_t)D * D * 2;
constexpr size_t OFF_N = OFF_WO + 2 * SZ_WO;
constexpr size_t OFF_MIX = OFF_N + (size_t)S * D * 2;
constexpr size_t OFF_Q = OFF_MIX;
constexpr size_t OFF_QD = OFF_Q + (size_t)S * 512 * 2;
constexpr size_t OFF_KA = OFF_QD + (size_t)S * 512 * 2;
constexpr size_t OFF_VTA = OFF_KA + (size_t)S * 128 * 2;
constexpr size_t OFF_KD = OFF_VTA + (size_t)S * 128 * 2;
constexpr size_t OFF_VTD = OFF_KD + (size_t)S * 512 * 2;
constexpr size_t OFF_G = OFF_VTD + (size_t)S * 512 * 2;
constexpr size_t OFF_ATTA = OFF_G + (size_t)S * 2048 * 2;
constexpr size_t OFF_OD = OFF_ATTA + (size_t)S * 512 * 2;
constexpr size_t OFF_ACT = OFF_MIX;
constexpr size_t WS_END = OFF_OD + (size_t)S * 512 * 2;
static_assert((size_t)S * F * 2 <= WS_END - OFF_MIX, "act overlay");

struct Params {
    const float *x, *c, *ada_w, *ada_b, *norm_g, *ffn_wg, *ffn_wu, *ffn_wd, *w_in, *qk_g, *lam_p, *subln_g, *w_ba, *w_bb, *w_gate, *b_gate, *w_o, *final_g;
    float* out; unsigned char* ws; int ph_lo, ph_hi;
};

typedef __bf16 bf16v2 __attribute__((ext_vector_type(2)));
typedef float f32x2 __attribute__((ext_vector_type(2)));
DI unsigned pk2(float lo, float hi) { f32x2 v = {lo, hi}; bf16v2 b = __builtin_convertvector(v, bf16v2); return __builtin_bit_cast(unsigned, b); }
DI float bf_lo(unsigned u) { return __uint_as_float(u << 16); }
DI float bf_hi(unsigned u) { return __uint_as_float(u & 0xffff0000u); }
DI int lds_off(int row, int chunk) { return row * 128 + ((chunk ^ ((row >> 1) & 7)) << 4); }
DI float fast_exp2(float x) { return __builtin_amdgcn_exp2f(x); }
DI float fast_rcp(float x) { return __builtin_amdgcn_rcpf(x); }
DI int otid() { int t = threadIdx.x; asm volatile("" : "+v"(t)); return t; }
#define SB() __builtin_amdgcn_sched_barrier(0)

DI int perm64(int n) { return (n & ~63) | (((n >> 2) & 3) << 4) | (((n >> 4) & 3) << 2) | (n & 3); }
DI int gumap(int j) { return 128 * (j >> 6) + 64 * ((j >> 5) & 1) + 16 * ((j >> 2) & 1) + 4 * ((j >> 3) & 3) + (j & 3); }

struct TrDesc { const float* src; bf16_t* dst; int N, k0, n0, ldd, mode, roff; };
DI void tr_decode(const Params& p, int tt, TrDesc& d) {
    constexpr int N_TR_L = 5824;
    const int l = tt / N_TR_L, r = tt % N_TR_L;
    if (r < 4224) {
        const int f = r / 2112, r2 = r % 2112, which = r2 / 704, r3 = r2 % 704;
        const size_t lf = (size_t)(l * 2 + f);
        if (which < 2) { d.src = (which == 0 ? p.ffn_wg : p.ffn_wu) + lf * D * F; d.N = F; d.k0 = (r3 / 44) * 64; d.n0 = (r3 % 44) * 64; d.dst = (bf16_t*)(p.ws + OFF_WGU + lf * SZ_WGU); d.ldd = D; d.mode = 2; d.roff = which * 32; }
        else { d.src = p.ffn_wd + lf * F * D; d.N = D; d.k0 = (r3 / 16) * 64; d.n0 = (r3 % 16) * 64; d.dst = (bf16_t*)(p.ws + OFF_WD + lf * SZ_WD); d.ldd = F; d.mode = 1; d.roff = 0; }
    } else if (r < 4800) { const int r3 = r - 4224; d.src = p.w_in + (size_t)l * D * 2304; d.N = 2304; d.k0 = (r3 / 36) * 64; d.n0 = (r3 % 36) * 64; d.dst = (bf16_t*)(p.ws + OFF_WIN + l * SZ_WIN); d.ldd = D; d.mode = 0; d.roff = 0; }
    else if (r < 5312) { const int r3 = r - 4800; d.src = p.w_gate + (size_t)l * D * 2048; d.N = 2048; d.k0 = (r3 / 32) * 64; d.n0 = (r3 % 32) * 64; d.dst = (bf16_t*)(p.ws + OFF_WIN + l * SZ_WIN); d.ldd = D; d.mode = 0; d.roff = 2304; }
    else if (r < 5440) { const int r3 = r - 5312; d.src = p.w_ba + (size_t)l * 512 * D; d.N = D; d.k0 = (r3 / 16) * 64; d.n0 = (r3 % 16) * 64; d.dst = (bf16_t*)(p.ws + OFF_WBA + l * SZ_WB); d.ldd = 512; d.mode = 1; d.roff = 0; }
    else if (r < 5568) { const int r3 = r - 5440; d.src = p.w_bb + (size_t)l * 512 * D; d.N = D; d.k0 = (r3 / 16) * 64; d.n0 = (r3 % 16) * 64; d.dst = (bf16_t*)(p.ws + OFF_WBB + l * SZ_WB); d.ldd = 512; d.mode = 1; d.roff = 0; }
    else { const int r3 = r - 5568; d.src = p.w_o + (size_t)l * D * D; d.N = D; d.k0 = (r3 / 16) * 64; d.n0 = (r3 % 16) * 64; d.dst = (bf16_t*)(p.ws + OFF_WO + l * SZ_WO); d.ldd = D; d.mode = 1; d.roff = 0; }
}
DI void tr_load(const TrDesc& d, int tid, f32x4 (&v)[2]) {
    const int kk = tid >> 4, nn4 = (tid & 15) * 4;
#pragma unroll
    for (int ps = 0; ps < 2; ++ps) v[ps] = *(const f32x4*)(d.src + (size_t)(d.k0 + kk + 32 * ps) * d.N + d.n0 + nn4);
}
DI void tr_store(const TrDesc& d, int tid, const f32x4 (&v)[2], float* ldsf) {
    {
        const int kk = tid >> 4, nn4 = (tid & 15) * 4;
#pragma unroll
        for (int ps = 0; ps < 2; ++ps) { const int k = kk + 32 * ps; ldsf[k * 65 + nn4 + 0] = v[ps][0]; ldsf[k * 65 + nn4 + 1] = v[ps][1]; ldsf[k * 65 + nn4 + 2] = v[ps][2]; ldsf[k * 65 + nn4 + 3] = v[ps][3]; }
    }
    __syncthreads();
    {
        const int n = tid >> 3, ch = tid & 7, gn = d.n0 + n;
        int drow;
        if (d.mode == 0) drow = gn + d.roff; else if (d.mode == 1) drow = perm64(gn); else drow = gumap(gn) + d.roff;
        float w[8];
#pragma unroll
        for (int i = 0; i < 8; ++i) w[i] = ldsf[(ch * 8 + i) * 65 + n];
        u32x4 pk = {pk2(w[0], w[1]), pk2(w[2], w[3]), pk2(w[4], w[5]), pk2(w[6], w[7])};
        *(u32x4*)(d.dst + (size_t)drow * d.ldd + d.k0 + ch * 8) = pk;
    }
    __syncthreads();
}

DI void phase_prologue(const Params& p, char* lds) {
    const int tid = otid();
    float* ldsf = (float*)lds;
    constexpr int N_MOD = 288, N_TR = 2 * 5824;
    for (int it = blockIdx.x; it < N_MOD; it += gridDim.x) {
        const int l = it / 144, j0 = (it % 144) * 64, jj = tid & 15, ii = tid >> 4;
        float* cact = ldsf + 2048;
        for (int i = tid; i < 1024; i += 512) { const float cv = p.c[i]; cact[i] = cv / (1.f + expf(-cv)); }
        __syncthreads();
        f32x4 a = {0.f, 0.f, 0.f, 0.f};
        const float* wb = p.ada_w + (size_t)l * 1024 * 9216 + j0 + 4 * jj;
#pragma unroll 8
        for (int r = 0; r < 32; ++r) { const int i = ii + 32 * r; a += cact[i] * *(const f32x4*)(wb + (size_t)i * 9216); }
        *(f32x4*)(ldsf + ii * 64 + 4 * jj) = a;
        __syncthreads();
        if (tid < 64) {
            float sm = 0.f;
#pragma unroll
            for (int r = 0; r < 32; ++r) sm += ldsf[r * 64 + tid];
            ((float*)(p.ws + OFF_MOD))[l * 9216 + j0 + tid] = sm + p.ada_b[l * 9216 + j0 + tid];
        }
        __syncthreads();
    }
    if (blockIdx.x == gridDim.x - 1) {
        if (tid < 64) {
#pragma unroll
            for (int l = 0; l < 2; ++l) {
                const float* lp = p.lam_p + l * 256;
                float a = lp[tid] * lp[64 + tid], b = lp[128 + tid] * lp[192 + tid];
#pragma unroll
                for (int o = 32; o > 0; o >>= 1) { a += __shfl_xor(a, o); b += __shfl_xor(b, o); }
                const float li = l == 0 ? 0.2f : 0.35550906759096926f;
                if (tid == 0) ((float*)(p.ws + OFF_LAM))[l] = expf(a) - expf(b) + li;
            }
        }
        if (tid < 64) ((unsigned*)(p.ws + OFF_STAT))[tid] = 0u;
        float* rope = (float*)(p.ws + OFF_ROPE);
        for (int e = tid; e < 320 * 16; e += 512) {
            const int pi = e >> 4, i = e & 15;
            const int pos = pi < 256 ? pi - 128 : (pi - 256) - 32;
            const float inv = exp2f(-(float)i * (13.287712379549449f / 16.0f));
            const float angf = (float)pos * inv;
            double r = (double)angf; r -= rint(r * 0.15915494309189535) * 6.283185307179586;
            const double r2 = r * r;
            double sn = 0.0, cs = 0.0;
#pragma unroll 1
            for (int n = 14; n >= 1; --n) { sn = (sn + 1.0) * (-r2 / (double)((2 * n) * (2 * n + 1))); cs = (cs + 1.0) * (-r2 / (double)((2 * n - 1) * (2 * n))); }
            sn = (sn + 1.0) * r; cs = cs + 1.0;
            if (pi < 256) { rope[pi * 16 + i] = (float)cs; rope[4096 + pi * 16 + i] = (float)sn; }
            else { rope[8192 + (pi - 256) * 16 + i] = (float)cs; rope[9216 + (pi - 256) * 16 + i] = (float)sn; }
        }
    }
    {
        int tt = blockIdx.x;
        TrDesc d; f32x4 v[2];
        if (tt < N_TR) { tr_decode(p, tt, d); tr_load(d, tid, v); }
        while (tt < N_TR) {
            const int tn = tt + gridDim.x;
            TrDesc dn; f32x4 vn[2];
            if (tn < N_TR) { tr_decode(p, tn, dn); tr_load(dn, tid, vn); }
            tr_store(d, tid, v, ldsf);
            if (tn < N_TR) { d = dn; v[0] = vn[0]; v[1] = vn[1]; }
            tt = tn;
        }
    }
}

DI void phase_norm(const float* hin, const float* __restrict__ g, const float* __restrict__ sh, const float* __restrict__ sc, bf16_t* nout, float* fout) {
    const int tid_ = otid(), lane = tid_ & 63, wid = tid_ >> 6;
    const int nw = gridDim.x * 8;
    for (int row = blockIdx.x * 8 + wid; row < S; row += nw) {
        const float* hp = hin + (size_t)row * D;
        f32x4 v[4]; float ss = 0.f;
#pragma unroll
        for (int i = 0; i < 4; ++i) { v[i] = *(const f32x4*)(hp + (i * 64 + lane) * 4); ss += v[i][0] * v[i][0] + v[i][1] * v[i][1] + v[i][2] * v[i][2] + v[i][3] * v[i][3]; }
#pragma unroll
        for (int o = 32; o > 0; o >>= 1) ss += __shfl_xor(ss, o);
        const float rstd = rsqrtf(ss * (1.0f / 1024.0f) + 1e-6f);
#pragma unroll
        for (int i = 0; i < 4; ++i) {
            const int col = (i * 64 + lane) * 4;
            const f32x4 gv = *(const f32x4*)(g + col);
            f32x4 y = v[i] * rstd * gv;
            if (sc) { const f32x4 s1 = *(const f32x4*)(sc + col), s0 = *(const f32x4*)(sh + col); y = y * (1.0f + s1) + s0; }
            if (fout) *(f32x4*)(fout + (size_t)row * D + col) = y;
            else { u32x2 pk = {pk2(y[0], y[1]), pk2(y[2], y[3])}; *(u32x2*)(nout + (size_t)row * D + col) = pk; }
        }
    }
}

DI void glds16(const void* g, char* l) { __builtin_amdgcn_global_load_lds((const unsigned*)g, (unsigned*)l, 16, 0, 0); }
template <int N> DI void waitv() { asm volatile("s_waitcnt vmcnt(%0)" ::"n"(N) : "memory"); }
DI void rawbar() { __builtin_amdgcn_s_barrier(); }
constexpr int GST = 49152;
DI void gemm_mainloop(const bf16_t* __restrict__ A, int lda, const bf16_t* __restrict__ W, int ldw, int K, f32x4 (&acc)[4][4], char* lds) {
    const int tid = otid(), lane = tid & 63, wid = tid >> 6, wt = wid >> 1, wc = wid & 1;
    const int srow = tid >> 3, sch = (tid & 7) ^ ((srow >> 1) & 7);
    const bf16_t* ag = A + (size_t)srow * lda + sch * 8;
    const bf16_t* wg = W + (size_t)srow * ldw + sch * 8;
    char* const ld = lds + tid * 16;
    const int nk = K >> 6;
#define G_ISSUE(kt_, st_) do { const int ko_ = (kt_) * 64; char* sn_ = ld + (st_) * GST; \
        _Pragma("unroll") for (int i = 0; i < 4; ++i) glds16(ag + (size_t)(64 * i) * lda + ko_, sn_ + i * 8192); \
        _Pragma("unroll") for (int i = 0; i < 2; ++i) glds16(wg + (size_t)(64 * i) * ldw + ko_, sn_ + 32768 + i * 8192); } while (0)
    waitv<0>();
    G_ISSUE(0, 0); G_ISSUE(1, 1);
    const int fr = lane & 15, fq = lane >> 4, sw = (fr >> 1) & 7;
    const int a_base = (64 * wt + fr) * 128, w_base = 32768 + (64 * wc + fr) * 128;
    int cur = 0, nxt = 2;
    for (int kt = 0; kt < nk; ++kt) {
        if (kt + 1 < nk) waitv<6>(); else waitv<0>();
        rawbar();
        if (kt + 2 < nk) G_ISSUE(kt + 2, nxt);
        const char* st = lds + cur * GST;
#pragma unroll
        for (int kk = 0; kk < 2; ++kk) {
            const int co = ((kk * 4 + fq) ^ sw) << 4;
            bf16x8 af[4], wf[4];
#pragma unroll
            for (int i = 0; i < 4; ++i) af[i] = *(const bf16x8*)(st + a_base + i * 2048 + co);
#pragma unroll
            for (int i = 0; i < 4; ++i) wf[i] = *(const bf16x8*)(st + w_base + i * 2048 + co);
#pragma unroll
            for (int mw = 0; mw < 4; ++mw)
#pragma unroll
                for (int nt = 0; nt < 4; ++nt) acc[mw][nt] = __builtin_amdgcn_mfma_f32_16x16x32_bf16(wf[mw], af[nt], acc[mw][nt], 0, 0, 0);
        }
        cur = cur == 2 ? 0 : cur + 1; nxt = nxt == 2 ? 0 : nxt + 1;
    }
#undef G_ISSUE
    __syncthreads();
}
constexpr int GST2 = 65536;
DI void gemm_mainloop2(const bf16_t* __restrict__ A, int lda, const bf16_t* __restrict__ W, int ldw, int K, f32x4 (&acc)[4][8], char* lds) {
    const int tid = otid(), lane = tid & 63, wid = tid >> 6, wt = wid >> 2, wc = wid & 3;
    const int srow = tid >> 3, sch = (tid & 7) ^ ((srow >> 1) & 7);
    const bf16_t* ag = A + (size_t)srow * lda + sch * 8;
    const bf16_t* wg = W + (size_t)srow * ldw + sch * 8;
    char* const ld = lds + tid * 16;
    const int nk = K >> 6;
#define G2_ISSUE(kt_, st_) do { const int ko_ = (kt_) * 64; char* sn_ = ld + (st_) * GST2; \
        _Pragma("unroll") for (int i = 0; i < 4; ++i) glds16(ag + (size_t)(64 * i) * lda + ko_, sn_ + i * 8192); \
        _Pragma("unroll") for (int i = 0; i < 4; ++i) glds16(wg + (size_t)(64 * i) * ldw + ko_, sn_ + 32768 + i * 8192); } while (0)
    waitv<0>();
    G2_ISSUE(0, 0);
    const int fr = lane & 15, fq = lane >> 4, sw = (fr >> 1) & 7;
    const int a_base = (128 * wt + fr) * 128, w_base = 32768 + (64 * wc + fr) * 128;
    for (int kt = 0; kt < nk; ++kt) {
        waitv<0>();
        rawbar();
        if (kt + 1 < nk) G2_ISSUE(kt + 1, (kt + 1) & 1);
        const char* st = lds + (kt & 1) * GST2;
#pragma unroll
        for (int kk = 0; kk < 2; ++kk) {
            const int co = ((kk * 4 + fq) ^ sw) << 4;
            bf16x8 af[8], wf[4];
#pragma unroll
            for (int i = 0; i < 4; ++i) wf[i] = *(const bf16x8*)(st + w_base + i * 2048 + co);
#pragma unroll
            for (int i = 0; i < 8; ++i) af[i] = *(const bf16x8*)(st + a_base + i * 2048 + co);
            __builtin_amdgcn_s_setprio(1);
#pragma unroll
            for (int nt = 0; nt < 8; ++nt)
#pragma unroll
                for (int mw = 0; mw < 4; ++mw) acc[mw][nt] = __builtin_amdgcn_mfma_f32_16x16x32_bf16(wf[mw], af[nt], acc[mw][nt], 0, 0, 0);
            __builtin_amdgcn_s_setprio(0);
            SB();
        }
    }
#undef G2_ISSUE
    __syncthreads();
}
DI void zero_acc2(f32x4 (&acc)[4][8]) {
#pragma unroll
    for (int a = 0; a < 4; ++a)
#pragma unroll
        for (int b = 0; b < 8; ++b) acc[a][b] = (f32x4){0.f, 0.f, 0.f, 0.f};
}
DI void zero_acc(f32x4 (&acc)[4][4]) {
#pragma unroll
    for (int a = 0; a < 4; ++a)
#pragma unroll
        for (int b = 0; b < 4; ++b) acc[a][b] = (f32x4){0.f, 0.f, 0.f, 0.f};
}

DI void phase_gateup(const bf16_t* n, const bf16_t* wgu, bf16_t* act, char* lds) {
    const int tid_ = otid(), lane = tid_ & 63, wid = tid_ >> 6, wt = wid >> 2, wc = wid & 3, fr = lane & 15, fq = lane >> 4;
    constexpr int NTILES = 64 * (NGU / 256);
    for (int t = blockIdx.x; t < NTILES; t += gridDim.x) {
        const int bm = t & 63, bn = t >> 6, row0 = bm * 256;
        f32x4 acc[4][8]; zero_acc2(acc);
        gemm_mainloop2(n + (size_t)row0 * D, D, wgu + (size_t)bn * 256 * D, D, D, acc, lds);
#pragma unroll
        for (int nt = 0; nt < 8; ++nt) {
            const int token = row0 + 128 * wt + 16 * nt + fr;
            float v[8];
#pragma unroll
            for (int m = 0; m < 2; ++m)
#pragma unroll
                for (int r = 0; r < 4; ++r) { const float gg = acc[m][nt][r], uu = acc[m + 2][nt][r]; v[4 * m + r] = gg * fast_rcp(1.0f + __expf(-gg)) * uu; }
            u32x4 pk = {pk2(v[0], v[1]), pk2(v[2], v[3]), pk2(v[4], v[5]), pk2(v[6], v[7])};
            *(u32x4*)(act + (size_t)token * F + 32 * (4 * bn + wc) + 8 * fq) = pk;
        }
    }
}

DI void phase_resid(const bf16_t* A, int K, const bf16_t* W, const float* hin, float* hout, const float* __restrict__ gvec, float gs, char* lds) {
    const int tid_ = otid(), lane = tid_ & 63, wid = tid_ >> 6, wt = wid >> 2, wc = wid & 3, fr = lane & 15, fq = lane >> 4;
    constexpr int NTILES = 64 * 4;
    for (int t = blockIdx.x; t < NTILES; t += gridDim.x) {
        const int bm = t & 63, bn = t >> 6, row0 = bm * 256, ch0 = bn * 256 + 64 * wc + 16 * fq;
        f32x4 acc[4][8]; zero_acc2(acc);
        gemm_mainloop2(A + (size_t)row0 * K, K, W + (size_t)bn * 256 * K, K, K, acc, lds);
        f32x4 gv[4];
#pragma unroll
        for (int mw = 0; mw < 4; ++mw) gv[mw] = *(const f32x4*)(gvec + ch0 + 4 * mw) * gs;
#pragma unroll
        for (int nt = 0; nt < 8; ++nt) {
            const size_t off = (size_t)(row0 + 128 * wt + 16 * nt + fr) * D + ch0;
#pragma unroll
            for (int mw = 0; mw < 4; ++mw) { const f32x4 hv = *(const f32x4*)(hin + off + 4 * mw); *(f32x4*)(hout + off + 4 * mw) = hv + gv[mw] * acc[mw][nt]; }
            SB();
        }
    }
}

DI void phase_merge(const bf16_t* atta, const bf16_t* od, const bf16_t* wba, const bf16_t* wbb, const bf16_t* G, bf16_t* merged, float* spill, char* lds) {
    const int tid_ = otid(), lane = tid_ & 63, wid = tid_ >> 6, wt = wid >> 1, wc = wid & 1, fr = lane & 15, fq = lane >> 4;
    constexpr int NTILES = 64 * 8;
    for (int t = blockIdx.x; t < NTILES; t += gridDim.x) {
        const int bm = t & 63, bn = t >> 6, row0 = bm * 256, ch0 = bn * 128 + 64 * wc + 16 * fq;
        f32x4 acc[4][4]; zero_acc(acc);
        gemm_mainloop(atta + (size_t)row0 * 512, 512, wba + (size_t)bn * 128 * 512, 512, 512, acc, lds);
        float* sp = spill + ((size_t)blockIdx.x * 16 * 512 + tid_) * 4;
#pragma unroll
        for (int nt = 0; nt < 4; ++nt) {
            const bf16_t* gp = G + (size_t)(row0 + 64 * wt + 16 * nt + fr) * 2048 + ch0;
#pragma unroll
            for (int mw = 0; mw < 4; ++mw) { const u32x2 gu = *(const u32x2*)(gp + 4 * mw); const f32x4 ga = {bf_lo(gu[0]), bf_hi(gu[0]), bf_lo(gu[1]), bf_hi(gu[1])};
                *(f32x4*)(sp + (size_t)(nt * 4 + mw) * 2048) = ga * acc[mw][nt]; }
        }
        zero_acc(acc);
        gemm_mainloop(od + (size_t)row0 * 512, 512, wbb + (size_t)bn * 128 * 512, 512, 512, acc, lds);
#pragma unroll
        for (int nt = 0; nt < 4; ++nt) {
            const size_t tok = (size_t)(row0 + 64 * wt + 16 * nt + fr);
            const bf16_t* gp = G + tok * 2048 + 1024 + ch0;
            unsigned w[8];
#pragma unroll
            for (int mw = 0; mw < 4; ++mw) { const u32x2 gu = *(const u32x2*)(gp + 4 * mw); const f32x4 gb = {bf_lo(gu[0]), bf_hi(gu[0]), bf_lo(gu[1]), bf_hi(gu[1])};
                const f32x4 o = *(const f32x4*)(sp + (size_t)(nt * 4 + mw) * 2048) + gb * acc[mw][nt]; w[2 * mw] = pk2(o[0], o[1]); w[2 * mw + 1] = pk2(o[2], o[3]); }
            bf16_t* mp = merged + tok * D + ch0;
            *(u32x4*)(mp) = (u32x4){w[0], w[1], w[2], w[3]};
            *(u32x4*)(mp + 8) = (u32x4){w[4], w[5], w[6], w[7]};
        }
    }
}

DI void phase_win(const Params& p, int l, char* lds) {
    const int tid_ = otid(), lane = tid_ & 63, wid = tid_ >> 6, wt = wid >> 1, wc = wid & 1, fr = lane & 15, fq = lane >> 4;
    const bf16_t* n = (const bf16_t*)(p.ws + OFF_N);
    const bf16_t* W = (const bf16_t*)(p.ws + OFF_WIN + l * SZ_WIN);
    bf16_t* Q = (bf16_t*)(p.ws + OFF_Q); bf16_t* QD = (bf16_t*)(p.ws + OFF_QD); bf16_t* KA = (bf16_t*)(p.ws + OFF_KA); bf16_t* VTA = (bf16_t*)(p.ws + OFF_VTA);
    bf16_t* KD = (bf16_t*)(p.ws + OFF_KD); bf16_t* VTD = (bf16_t*)(p.ws + OFF_VTD); bf16_t* G = (bf16_t*)(p.ws + OFF_G);
    const float* rope = (const float*)(p.ws + OFF_ROPE);
    {
        const int wt2 = wid >> 2, wc2 = wid & 3;
        for (int t = blockIdx.x; t < 64 * 8; t += gridDim.x) {
            const int bm = t & 63, bg = t >> 6, row0 = bm * 256, gc = 256 * bg + 64 * wc2;
            f32x4 acc[4][8]; zero_acc2(acc);
            gemm_mainloop2(n + (size_t)row0 * D, D, W + (size_t)(2304 + 256 * bg) * D, D, D, acc, lds);
            const float* bg_ = p.b_gate + l * 2048 + gc;
            f32x4 bv[4];
#pragma unroll
            for (int mw = 0; mw < 4; ++mw) bv[mw] = *(const f32x4*)(bg_ + 16 * mw + 4 * fq);
#pragma unroll
            for (int nt = 0; nt < 8; ++nt) {
                bf16_t* dst = G + (size_t)(row0 + 128 * wt2 + 16 * nt + fr) * 2048 + gc;
#pragma unroll
                for (int mw = 0; mw < 4; ++mw) {
                    const f32x4 xx = acc[mw][nt] + bv[mw]; f32x4 z;
#pragma unroll
                    for (int r = 0; r < 4; ++r) z[r] = fast_rcp(1.0f + __expf(-xx[r]));
                    *(u32x2*)(dst + 16 * mw + 4 * fq) = (u32x2){pk2(z[0], z[1]), pk2(z[2], z[3])};
                }
            }
        }
    }
    constexpr int NTILES = 64 * (2304 / 128);
    for (int t = blockIdx.x; t < NTILES; t += gridDim.x) {
        const int bm = t & 63, bn = t >> 6, row0 = bm * 256;
        f32x4 acc[4][4]; zero_acc(acc);
        gemm_mainloop(n + (size_t)row0 * D, D, W + (size_t)bn * 128 * D, D, D, acc, lds);
        const int cw = bn * 128 + 64 * wc;
        if (cw < 640) {
            const bool isq = cw < 512;
            const float* gq = p.qk_g + l * 128 + (isq ? 0 : 64);
            f32x4 gv[4];
#pragma unroll
            for (int mw = 0; mw < 4; ++mw) gv[mw] = *(const f32x4*)(gq + 16 * mw + 4 * fq);
#pragma unroll
            for (int nt = 0; nt < 4; ++nt) {
                const int token = row0 + 64 * wt + 16 * nt + fr;
                float ss = 0.f;
#pragma unroll
                for (int mw = 0; mw < 4; ++mw) ss += acc[mw][nt][0] * acc[mw][nt][0] + acc[mw][nt][1] * acc[mw][nt][1] + acc[mw][nt][2] * acc[mw][nt][2] + acc[mw][nt][3] * acc[mw][nt][3];
                ss += __shfl_xor(ss, 16); ss += __shfl_xor(ss, 32);
                const float rstd = rsqrtf(ss * (1.0f / 64.0f) + 1e-6f);
                f32x4 y[4];
#pragma unroll
                for (int mw = 0; mw < 4; ++mw) y[mw] = acc[mw][nt] * rstd * gv[mw];
                const int prow = token >> 6, pcol = token & 63;
                const f32x4 cr = *(const f32x4*)(rope + prow * 16 + 4 * fq), sr = *(const f32x4*)(rope + 4096 + prow * 16 + 4 * fq);
                const f32x4 cc = *(const f32x4*)(rope + 8192 + pcol * 16 + 4 * fq), sc = *(const f32x4*)(rope + 9216 + pcol * 16 + 4 * fq);
                f32x4 o[4];
                o[0] = y[0] * cr - y[1] * sr; o[1] = y[1] * cr + y[0] * sr; o[2] = y[2] * cc - y[3] * sc; o[3] = y[3] * cc + y[2] * sc;
                const float qs = isq ? QSCALE : 1.0f;
                bf16_t* dst = isq ? (Q + (size_t)token * 512 + cw) : (KA + (size_t)token * 128 + (cw - 512));
#pragma unroll
                for (int mw = 0; mw < 4; ++mw) { const f32x4 z = o[mw] * qs; *(u32x2*)(dst + 16 * mw + 4 * fq) = (u32x2){pk2(z[0], z[1]), pk2(z[2], z[3])}; }
            }
        } else if (cw < 768 || (cw >= 1792 && cw < 2304)) {
            bf16_t* vt = cw < 768 ? (VTA + (size_t)(cw - 640) * S) : (VTD + (size_t)(cw - 1792) * S);
#pragma unroll
            for (int nt = 0; nt < 4; ++nt) {
                const int token = row0 + 64 * wt + 16 * nt + fr;
#pragma unroll
                for (int mw = 0; mw < 4; ++mw)
#pragma unroll
                    for (int r = 0; r < 4; ++r) vt[(size_t)(16 * mw + 4 * fq + r) * S + token] = (bf16_t)(pk2(acc[mw][nt][r], 0.f) & 0xffffu);
            }
        } else if (cw < 1792) {
            const bool isq = cw < 1280; const float qs = isq ? QSCALE : 1.0f;
            bf16_t* base = isq ? (QD + (cw - 768)) : (KD + (cw - 1280));
#pragma unroll
            for (int nt = 0; nt < 4; ++nt) {
                bf16_t* dst = base + (size_t)(row0 + 64 * wt + 16 * nt + fr) * 512;
#pragma unroll
                for (int mw = 0; mw < 4; ++mw) { const f32x4 z = acc[mw][nt] * qs; *(u32x2*)(dst + 16 * mw + 4 * fq) = (u32x2){pk2(z[0], z[1]), pk2(z[2], z[3])}; }
            }
            {
                float best = 0.f;
#pragma unroll
                for (int nt = 0; nt < 4; ++nt) {
                    float ss = 0.f;
#pragma unroll
                    for (int mw = 0; mw < 4; ++mw) { const f32x4 z = acc[mw][nt] * qs; ss += z[0] * z[0] + z[1] * z[1] + z[2] * z[2] + z[3] * z[3]; }
                    ss += __shfl_xor(ss, 16); ss += __shfl_xor(ss, 32);
                    best = __builtin_fmaxf(best, ss);
                }
#pragma unroll
                for (int o = 8; o > 0; o >>= 1) best = __builtin_fmaxf(best, __shfl_xor(best, o));
                if (lane == 0) atomicMax((unsigned*)(p.ws + OFF_STAT) + l * 16 + (isq ? 0 : 8) + ((cw - (isq ? 768 : 1280)) >> 6), __float_as_uint(best));
            }
        } else {
            const int gc = cw - 2304;
            const float* bg = p.b_gate + l * 2048 + gc;
            f32x4 bv[4];
#pragma unroll
            for (int mw = 0; mw < 4; ++mw) bv[mw] = *(const f32x4*)(bg + 16 * mw + 4 * fq);
#pragma unroll
            for (int nt = 0; nt < 4; ++nt) {
                bf16_t* dst = G + (size_t)(row0 + 64 * wt + 16 * nt + fr) * 2048 + gc;
#pragma unroll
                for (int mw = 0; mw < 4; ++mw) {
                    const f32x4 xx = acc[mw][nt] + bv[mw]; f32x4 z;
#pragma unroll
                    for (int r = 0; r < 4; ++r) z[r] = fast_rcp(1.0f + __expf(-xx[r]));
                    *(u32x2*)(dst + 16 * mw + 4 * fq) = (u32x2){pk2(z[0], z[1]), pk2(z[2], z[3])};
                }
            }
        }
    }
}

#define MFMA32(a, b, c) __builtin_amdgcn_mfma_f32_32x32x16_bf16((a), (b), (c), 0, 0, 0)
template <int DV, bool ALIBI>
DI void attn_pass(const bf16_t* __restrict__ Qp, const bf16_t* __restrict__ Kb, int kpitch, const bf16_t* __restrict__ Vtb, float slope2, int qpos, int t_lo, int t_hi, float m_init,
                  f32x16 (&o)[DV / 32], float& l_out, char* lds) {
    constexpr int NV = DV / 64, NDT = DV / 32, STAGE = 8192 + DV * 128, G = 1 + NV;
    const int tid = otid(), lane = tid & 63, r32 = lane & 31, h = lane >> 5;
    bf16x8 qf[4];
#pragma unroll
    for (int d0 = 0; d0 < 4; ++d0) qf[d0] = *(const bf16x8*)(Qp + 16 * d0 + 8 * h);
    const int srow = tid >> 3, sch = (tid & 7) ^ ((srow >> 1) & 7);
    const bf16_t* kg = Kb + (size_t)srow * kpitch + sch * 8;
    const bf16_t* vg = Vtb + (size_t)srow * S + sch * 8;
    char* const ld = lds + tid * 16;
#define A_ISSUE(t_, st_) do { char* sn_ = ld + (st_) * STAGE; glds16(kg + (size_t)(t_) * 64 * kpitch, sn_); \
        _Pragma("unroll") for (int i = 0; i < NV; ++i) glds16(vg + (size_t)(64 * i) * S + (t_) * 64, sn_ + 8192 + i * 8192); } while (0)
    waitv<0>();
    A_ISSUE(t_lo, 0);
    if (t_lo + 1 <= t_hi) A_ISSUE(t_lo + 1, 1);
    if (t_lo + 2 <= t_hi) A_ISSUE(t_lo + 2, 2);
    const int pi = (r32 & 0x13) | ((r32 & 4) << 1) | ((r32 & 8) >> 1);
    const int k_base = pi * 128, k_sw = (pi >> 1) & 7, v_base = 8192 + r32 * 128, v_sw = (r32 >> 1) & 7;
    float m = m_init, l = 0.f;
#pragma unroll
    for (int dt = 0; dt < NDT; ++dt)
#pragma unroll
        for (int r = 0; r < 16; ++r) o[dt][r] = 0.f;
    int cur = 0;
    for (int t = t_lo; t <= t_hi; ++t) {
        const int rem = t_hi - t;
        if (rem >= 2) waitv<2 * G>(); else if (rem == 1) waitv<G>(); else waitv<0>();
        rawbar();
        if (rem >= 3) A_ISSUE(t + 3, (cur + 3) & 3);
        const char* st = lds + cur * STAGE;
        cur = (cur + 1) & 3;
        bf16x8 kf[2][4];
#pragma unroll
        for (int kt = 0; kt < 2; ++kt)
#pragma unroll
            for (int d0 = 0; d0 < 4; ++d0) kf[kt][d0] = *(const bf16x8*)(st + kt * 4096 + k_base + (((2 * d0 + h) ^ k_sw) << 4));
        f32x16 sc[2];
        const float nm = -m;
#pragma unroll
        for (int kt = 0; kt < 2; ++kt)
#pragma unroll
            for (int r = 0; r < 16; ++r) sc[kt][r] = nm;
        SB();
        __builtin_amdgcn_s_setprio(1);
#pragma unroll
        for (int d0 = 0; d0 < 4; ++d0)
#pragma unroll
            for (int kt = 0; kt < 2; ++kt) sc[kt] = MFMA32(kf[kt][d0], qf[d0], sc[kt]);
        __builtin_amdgcn_s_setprio(0);
        bf16x8 vf[2][4];
        if (NDT == 2) {
#pragma unroll
            for (int dt = 0; dt < 2; ++dt)
#pragma unroll
                for (int ks = 0; ks < 4; ++ks) vf[dt][ks] = *(const bf16x8*)(st + v_base + dt * 4096 + (((2 * ks + h) ^ v_sw) << 4));
        }
        SB();
        if (ALIBI) {
#pragma unroll
            for (int kt = 0; kt < 2; ++kt) {
                const float dq = (float)(qpos - (64 * t + 32 * kt + 8 * h));
#pragma unroll
                for (int r = 0; r < 16; ++r) sc[kt][r] = __builtin_fmaf(-slope2, __builtin_fabsf(dq - (float)(16 * (r >> 3) + (r & 7))), sc[kt][r]);
            }
        }
        float mt = sc[0][0];
#pragma unroll
        for (int r = 1; r < 16; ++r) mt = __builtin_fmaxf(mt, sc[0][r]);
#pragma unroll
        for (int r = 0; r < 16; ++r) mt = __builtin_fmaxf(mt, sc[1][r]);
        mt = __builtin_fmaxf(mt, __shfl_xor(mt, 32));
        if (__any(mt > 8.0f)) {
            const float dl = __builtin_fmaxf(mt, 0.f), al = fast_exp2(-dl);
            l *= al; m += dl;
#pragma unroll
            for (int kt = 0; kt < 2; ++kt)
#pragma unroll
                for (int r = 0; r < 16; ++r) sc[kt][r] -= dl;
#pragma unroll
            for (int dt = 0; dt < NDT; ++dt)
#pragma unroll
                for (int r = 0; r < 16; ++r) o[dt][r] *= al;
        }
        float ps = 0.f;
#pragma unroll
        for (int kt = 0; kt < 2; ++kt)
#pragma unroll
            for (int r = 0; r < 16; ++r) { const float e = fast_exp2(sc[kt][r]); sc[kt][r] = e; ps += e; }
        l += ps;
        bf16x8 pf[4];
#pragma unroll
        for (int ks = 0; ks < 4; ++ks) {
            const int kt = ks >> 1, b = (ks & 1) * 8;
            u32x4 w = {pk2(sc[kt][b], sc[kt][b + 1]), pk2(sc[kt][b + 2], sc[kt][b + 3]), pk2(sc[kt][b + 4], sc[kt][b + 5]), pk2(sc[kt][b + 6], sc[kt][b + 7])};
            pf[ks] = __builtin_bit_cast(bf16x8, w);
        }
        SB();
        if (NDT == 4) {
#pragma unroll
            for (int gp = 0; gp < 2; ++gp) {
#pragma unroll
                for (int dt = 0; dt < 2; ++dt)
#pragma unroll
                    for (int ks = 0; ks < 4; ++ks) vf[dt][ks] = *(const bf16x8*)(st + v_base + (dt + 2 * gp) * 4096 + (((2 * ks + h) ^ v_sw) << 4));
                __builtin_amdgcn_s_setprio(1);
#pragma unroll
                for (int ks = 0; ks < 4; ++ks)
#pragma unroll
                    for (int dt = 0; dt < 2; ++dt) o[(dt + 2 * gp) % NDT] = MFMA32(vf[dt][ks], pf[ks], o[(dt + 2 * gp) % NDT]);
                __builtin_amdgcn_s_setprio(0);
                SB();
            }
        } else {
            __builtin_amdgcn_s_setprio(1);
#pragma unroll
            for (int ks = 0; ks < 4; ++ks)
#pragma unroll
                for (int dt = 0; dt < 2; ++dt) o[dt] = MFMA32(vf[dt][ks], pf[ks], o[dt]);
            __builtin_amdgcn_s_setprio(0);
        }
        SB();
    }
#undef A_ISSUE
    __syncthreads();
    l += __shfl_xor(l, 32);
    l_out = l;
}

DI void attn_pass_b(const bf16_t* __restrict__ Qp, const bf16_t* __restrict__ Kb, int kpitch, const bf16_t* __restrict__ Vtb, float slope2, int qpos, int t_lo, int t_hi, float mref,
                    f32x16 (&o)[4], float& l_out, char* lds) {
    constexpr int NV = 2, STAGE = 8192 + 128 * 128, G = 1 + NV;
    const int tid = otid(), lane = tid & 63, r32 = lane & 31, h = lane >> 5;
    const int qw0 = __builtin_amdgcn_readfirstlane(qpos - r32);
    bf16x8 qf[4];
#pragma unroll
    for (int d0 = 0; d0 < 4; ++d0) qf[d0] = *(const bf16x8*)(Qp + 16 * d0 + 8 * h);
    const int srow = tid >> 3, sch = (tid & 7) ^ ((srow >> 1) & 7);
    const bf16_t* kg = Kb + (size_t)srow * kpitch + sch * 8;
    const bf16_t* vg = Vtb + (size_t)srow * S + sch * 8;
    char* const ld = lds + tid * 16;
#define B_ISSUE(t_, st_) do { char* sn_ = ld + (st_) * STAGE; glds16(kg + (size_t)(t_) * 64 * kpitch, sn_); \
        _Pragma("unroll") for (int i = 0; i < NV; ++i) glds16(vg + (size_t)(64 * i) * S + (t_) * 64, sn_ + 8192 + i * 8192); } while (0)
    waitv<0>();
    B_ISSUE(t_lo, 0);
    if (t_lo + 1 <= t_hi) B_ISSUE(t_lo + 1, 1);
    if (t_lo + 2 <= t_hi) B_ISSUE(t_lo + 2, 2);
    const int pi = (r32 & 0x13) | ((r32 & 4) << 1) | ((r32 & 8) >> 1);
    const int k_base = pi * 128, k_sw = (pi >> 1) & 7, v_base = 8192 + r32 * 128, v_sw = (r32 >> 1) & 7;
    float l = 0.f;
    const float nm = -mref;
#pragma unroll
    for (int dt = 0; dt < 4; ++dt)
#pragma unroll
        for (int r = 0; r < 16; ++r) o[dt][r] = 0.f;
    int cur = 0;
    for (int t = t_lo; t <= t_hi; ++t) {
        const int rem = t_hi - t;
        if (rem >= 2) waitv<2 * G>(); else if (rem == 1) waitv<G>(); else waitv<0>();
        rawbar();
        if (rem >= 3) B_ISSUE(t + 3, (cur + 3) & 3);
        const char* st = lds + cur * STAGE;
        cur = (cur + 1) & 3;
        bf16x8 kf[2][4];
#pragma unroll
        for (int kt = 0; kt < 2; ++kt)
#pragma unroll
            for (int d0 = 0; d0 < 4; ++d0) kf[kt][d0] = *(const bf16x8*)(st + kt * 4096 + k_base + (((2 * d0 + h) ^ k_sw) << 4));
        const int side = (64 * t + 63 < qw0) ? 1 : ((64 * t > qw0 + 31) ? -1 : 0);
        f32x16 sc[2];
        if (side != 0) {
            const float ss = side > 0 ? slope2 : -slope2;
#pragma unroll
            for (int kt = 0; kt < 2; ++kt) {
                const float base = __builtin_fmaf(ss, (float)(64 * t + 32 * kt + 8 * h - qpos), nm);
#pragma unroll
                for (int r = 0; r < 16; ++r) sc[kt][r] = __builtin_fmaf(ss, (float)(16 * (r >> 3) + (r & 7)), base);
            }
        } else {
#pragma unroll
            for (int kt = 0; kt < 2; ++kt)
#pragma unroll
                for (int r = 0; r < 16; ++r) sc[kt][r] = nm;
        }
        SB();
        __builtin_amdgcn_s_setprio(1);
#pragma unroll
        for (int d0 = 0; d0 < 4; ++d0)
#pragma unroll
            for (int kt = 0; kt < 2; ++kt) sc[kt] = MFMA32(kf[kt][d0], qf[d0], sc[kt]);
        __builtin_amdgcn_s_setprio(0);
        SB();
        if (side == 0) {
#pragma unroll
            for (int kt = 0; kt < 2; ++kt) {
                const float dq = (float)(qpos - (64 * t + 32 * kt + 8 * h));
#pragma unroll
                for (int r = 0; r < 16; ++r) sc[kt][r] = __builtin_fmaf(-slope2, __builtin_fabsf(dq - (float)(16 * (r >> 3) + (r & 7))), sc[kt][r]);
            }
        }
        float ps = 0.f;
#pragma unroll
        for (int kt = 0; kt < 2; ++kt)
#pragma unroll
            for (int r = 0; r < 16; ++r) { const float e = fast_exp2(sc[kt][r]); sc[kt][r] = e; ps += e; }
        l += ps;
        bf16x8 pf[4];
#pragma unroll
        for (int ks = 0; ks < 4; ++ks) {
            const int kt = ks >> 1, b = (ks & 1) * 8;
            u32x4 w = {pk2(sc[kt][b], sc[kt][b + 1]), pk2(sc[kt][b + 2], sc[kt][b + 3]), pk2(sc[kt][b + 4], sc[kt][b + 5]), pk2(sc[kt][b + 6], sc[kt][b + 7])};
            pf[ks] = __builtin_bit_cast(bf16x8, w);
        }
        SB();
#pragma unroll
        for (int gp = 0; gp < 2; ++gp) {
            bf16x8 vf[2][4];
#pragma unroll
            for (int dt = 0; dt < 2; ++dt)
#pragma unroll
                for (int ks = 0; ks < 4; ++ks) vf[dt][ks] = *(const bf16x8*)(st + v_base + (dt + 2 * gp) * 4096 + (((2 * ks + h) ^ v_sw) << 4));
            __builtin_amdgcn_s_setprio(1);
#pragma unroll
            for (int ks = 0; ks < 4; ++ks)
#pragma unroll
                for (int dt = 0; dt < 2; ++dt) o[dt + 2 * gp] = MFMA32(vf[dt][ks], pf[ks], o[dt + 2 * gp]);
            __builtin_amdgcn_s_setprio(0);
            SB();
        }
    }
#undef B_ISSUE
    __syncthreads();
    l += __shfl_xor(l, 32);
    l_out = l;
}

DI void attn_pass_a(const bf16_t* __restrict__ Qp, const bf16_t* __restrict__ Kb, int kpitch, const bf16_t* __restrict__ Vtb, float mref, f32x16 (&o)[2], float& l_out, char* lds) {
    constexpr int STAGE = 16384, NTL = S / 64;
    const int tid = otid(), lane = tid & 63, r32 = lane & 31, h = lane >> 5;
    bf16x8 qf[4];
#pragma unroll
    for (int d0 = 0; d0 < 4; ++d0) qf[d0] = *(const bf16x8*)(Qp + 16 * d0 + 8 * h);
    const int srow = tid >> 3, sch = (tid & 7) ^ ((srow >> 1) & 7);
    const bf16_t* kg = Kb + (size_t)srow * kpitch + sch * 8;
    const bf16_t* vg = Vtb + (size_t)srow * S + sch * 8;
    char* const ld = lds + tid * 16;
#define AA_ISSUE(t_, st_) do { char* sn_ = ld + (st_) * STAGE; glds16(kg + (size_t)(t_) * 64 * kpitch, sn_); glds16(vg + (t_) * 64, sn_ + 8192); } while (0)
    waitv<0>();
    AA_ISSUE(0, 0); AA_ISSUE(1, 1); AA_ISSUE(2, 2);
    const int pi = (r32 & 0x13) | ((r32 & 4) << 1) | ((r32 & 8) >> 1);
    const int k_base = pi * 128, k_sw = (pi >> 1) & 7, v_base = 8192 + r32 * 128, v_sw = (r32 >> 1) & 7;
    f32x16 negm, lacc;
#pragma unroll
    for (int r = 0; r < 16; ++r) { negm[r] = -mref; lacc[r] = 0.f; o[0][r] = 0.f; o[1][r] = 0.f; }
    const bf16x8 ones = {(short)0x3F80, (short)0x3F80, (short)0x3F80, (short)0x3F80, (short)0x3F80, (short)0x3F80, (short)0x3F80, (short)0x3F80};
    f32x16 sA[2], sB[2];
#define AA_QK(DST, stp_) do { bf16x8 kf_[2][4]; \
        _Pragma("unroll") for (int kt = 0; kt < 2; ++kt) _Pragma("unroll") for (int d0 = 0; d0 < 4; ++d0) kf_[kt][d0] = *(const bf16x8*)((stp_) + kt * 4096 + k_base + (((2 * d0 + h) ^ k_sw) << 4)); \
        SB(); __builtin_amdgcn_s_setprio(1); \
        DST[0] = MFMA32(kf_[0][0], qf[0], negm); DST[1] = MFMA32(kf_[1][0], qf[0], negm); \
        _Pragma("unroll") for (int d0 = 1; d0 < 4; ++d0) { DST[0] = MFMA32(kf_[0][d0], qf[d0], DST[0]); DST[1] = MFMA32(kf_[1][d0], qf[d0], DST[1]); } \
        __builtin_amdgcn_s_setprio(0); } while (0)
    waitv<4>();
    rawbar();
    AA_QK(sA, lds);
#define AA_STEP(CUR, NXT, t_) do { const int t = (t_); \
        if (t + 2 < NTL) waitv<2>(); else waitv<0>();              \
        rawbar();                                                  \
        if (t + 3 < NTL) AA_ISSUE(t + 3, (t + 3) & 3); \
        const char* st = lds + (t & 3) * STAGE; \
        if (t + 1 < NTL) AA_QK(NXT, lds + ((t + 1) & 3) * STAGE); \
        bf16x8 vf[2][4]; \
        _Pragma("unroll") for (int dt = 0; dt < 2; ++dt) _Pragma("unroll") for (int ks = 0; ks < 4; ++ks) vf[dt][ks] = *(const bf16x8*)(st + v_base + dt * 4096 + (((2 * ks + h) ^ v_sw) << 4)); \
        SB(); \
        _Pragma("unroll") for (int kt = 0; kt < 2; ++kt) _Pragma("unroll") for (int r = 0; r < 16; ++r) CUR[kt][r] = fast_exp2(CUR[kt][r]); \
        bf16x8 pf[4]; \
        _Pragma("unroll") for (int ks = 0; ks < 4; ++ks) { const int kt = ks >> 1, b = (ks & 1) * 8; \
            u32x4 w = {pk2(CUR[kt][b], CUR[kt][b + 1]), pk2(CUR[kt][b + 2], CUR[kt][b + 3]), pk2(CUR[kt][b + 4], CUR[kt][b + 5]), pk2(CUR[kt][b + 6], CUR[kt][b + 7])}; \
            pf[ks] = __builtin_bit_cast(bf16x8, w); } \
        SB(); __builtin_amdgcn_s_setprio(1); \
        _Pragma("unroll") for (int ks = 0; ks < 4; ++ks) { _Pragma("unroll") for (int dt = 0; dt < 2; ++dt) o[dt] = MFMA32(vf[dt][ks], pf[ks], o[dt]); lacc = MFMA32(ones, pf[ks], lacc); } \
        __builtin_amdgcn_s_setprio(0); SB(); } while (0)
    for (int t2 = 0; t2 < NTL; t2 += 2) { AA_STEP(sA, sB, t2); AA_STEP(sB, sA, t2 + 1); }
#undef AA_STEP
#undef AA_QK
#undef AA_ISSUE
    __syncthreads();
    l_out = lacc[0];
}

DI void phase_attn(const Params& p, int l, int rep, char* lds) {
    const int tid = otid(), lane = tid & 63, wid = tid >> 6, r32 = lane & 31, h = lane >> 5;
    const bf16_t* Q = (const bf16_t*)(p.ws + OFF_Q); const bf16_t* QD = (const bf16_t*)(p.ws + OFF_QD); const bf16_t* KA = (const bf16_t*)(p.ws + OFF_KA);
    const bf16_t* VTA = (const bf16_t*)(p.ws + OFF_VTA); const bf16_t* KD = (const bf16_t*)(p.ws + OFF_KD); const bf16_t* VTD = (const bf16_t*)(p.ws + OFF_VTD);
    bf16_t* ATTA = (bf16_t*)(p.ws + OFF_ATTA); bf16_t* OD = (bf16_t*)(p.ws + OFF_OD); float* BO0 = (float*)(p.ws + OFF_N);
    const float lam = ((const float*)(p.ws + OFF_LAM))[l];
    const float oml = 1.0f - (l == 0 ? 0.2f : 0.35550906759096926f);
    float bA;
    { float gq = __builtin_fabsf(p.qk_g[l * 128 + lane]), gk = __builtin_fabsf(p.qk_g[l * 128 + 64 + lane]);
#pragma unroll
      for (int o_ = 32; o_ > 0; o_ >>= 1) { gq = __builtin_fmaxf(gq, __shfl_xor(gq, o_)); gk = __builtin_fmaxf(gk, __shfl_xor(gk, o_)); }
      bA = 64.0f * gq * gk * QSCALE * 1.01f; }
    unsigned* qcnt = (unsigned*)(p.ws + OFF_STAT) + 32 + l + 2 * rep;
    const unsigned* stat = (const unsigned*)(p.ws + OFF_STAT) + l * 16;
    volatile unsigned* lword = (volatile unsigned*)(lds + 147456 + 16);
    for (;;) {
        if (tid == 0) *lword = atomicAdd(qcnt, 1u);
        __syncthreads();
        const int u = (int)*lword;
        __syncthreads();
        if (u >= 768) break;
        if (PROBE_DUP == 5 && rep && (u < 128 || u >= 640)) continue;
        if (u < 128 || u >= 640) {
            const int hb = u < 64 ? 3 : (u < 128 ? 2 : (u < 704 ? 1 : 0)), qb = u & 63;
            const int token = 256 * qb + 32 * wid + r32;
            const float slope2 = exp2f(-2.0f * (float)(hb + 1)) * LOG2E;
            float* bo = BO0 + (size_t)token * 512 + hb * 128;
            f32x16 o[4]; float ls;
            int tl[2], th[2]; float mi[2];
#pragma unroll
            for (int mp = 0; mp < 2; ++mp) {
                const float qk = sqrtf(__uint_as_float(stat[mp * 4 + hb]) * __uint_as_float(stat[8 + mp * 4 + hb])) * 1.02f;
                const float R = __builtin_fminf((2.0f * qk + 150.0f) / slope2, 40000.0f);
                const int klo = 256 * qb - (int)R - 1, khi = 256 * qb + 255 + (int)R + 1;
                mi[mp] = -qk;
                tl[mp] = klo < 0 ? 0 : (klo >> 6); th[mp] = khi >= S ? (S / 64 - 1) : (khi >> 6);
            }
            if (-mi[0] <= 45.0f) attn_pass_b(QD + (size_t)token * 512 + hb * 64, KD + hb * 64, 512, VTD + (size_t)(hb * 128) * S, slope2, token, tl[0], th[0], -mi[0], o, ls, lds);
            else attn_pass<128, true>(QD + (size_t)token * 512 + hb * 64, KD + hb * 64, 512, VTD + (size_t)(hb * 128) * S, slope2, token, tl[0], th[0], mi[0], o, ls, lds);
            {
                const float inv = 1.0f / ls;
#pragma unroll
                for (int dt = 0; dt < 4; ++dt)
#pragma unroll
                    for (int g = 0; g < 4; ++g) *(f32x4*)(bo + 32 * dt + 8 * g + 4 * h) = (f32x4){o[dt][4 * g] * inv, o[dt][4 * g + 1] * inv, o[dt][4 * g + 2] * inv, o[dt][4 * g + 3] * inv};
            }
            if (-mi[1] <= 45.0f) attn_pass_b(QD + (size_t)token * 512 + 256 + hb * 64, KD + 256 + hb * 64, 512, VTD + (size_t)(hb * 128) * S, slope2, token, tl[1], th[1], -mi[1], o, ls, lds);
            else attn_pass<128, true>(QD + (size_t)token * 512 + 256 + hb * 64, KD + 256 + hb * 64, 512, VTD + (size_t)(hb * 128) * S, slope2, token, tl[1], th[1], mi[1], o, ls, lds);
            {
                const float inv = lam / ls; float ss = 0.f;
#pragma unroll
                for (int dt = 0; dt < 4; ++dt)
#pragma unroll
                    for (int g = 0; g < 4; ++g) {
                        const f32x4 a = *(const f32x4*)(bo + 32 * dt + 8 * g + 4 * h);
#pragma unroll
                        for (int j = 0; j < 4; ++j) { const float v = a[j] - o[dt][4 * g + j] * inv; o[dt][4 * g + j] = v; ss += v * v; }
                    }
                ss += __shfl_xor(ss, 32);
                const float rstd = rsqrtf(ss * (1.0f / 128.0f) + 1e-6f) * oml;
                const float* sg = p.subln_g + l * 128;
                bf16_t* dst = OD + (size_t)token * 512 + hb * 128;
#pragma unroll
                for (int dt = 0; dt < 4; ++dt)
#pragma unroll
                    for (int g = 0; g < 4; ++g) {
                        const int d = 32 * dt + 8 * g + 4 * h;
                        const f32x4 gg = *(const f32x4*)(sg + d);
                        *(u32x2*)(dst + d) = (u32x2){pk2(o[dt][4 * g] * rstd * gg[0], o[dt][4 * g + 1] * rstd * gg[1]), pk2(o[dt][4 * g + 2] * rstd * gg[2], o[dt][4 * g + 3] * rstd * gg[3])};
                    }
            }
        } else {
            const int v = u - 128, kv = v >> 8, hq = kv * 4 + (v & 3), qb = (v >> 2) & 63;
            const int token = 256 * qb + 32 * wid + r32;
            f32x16 o[2]; float ls;
            if (bA <= 40.0f) attn_pass_a(Q + (size_t)token * 512 + hq * 64, KA + kv * 64, 128, VTA + (size_t)(kv * 64) * S, bA, o, ls, lds);
            else attn_pass<64, false>(Q + (size_t)token * 512 + hq * 64, KA + kv * 64, 128, VTA + (size_t)(kv * 64) * S, 0.f, token, 0, S / 64 - 1, 0.f, o, ls, lds);
            const float inv = 1.0f / ls;
            bf16_t* dst = ATTA + (size_t)token * 512 + hq * 64;
#pragma unroll
            for (int dt = 0; dt < 2; ++dt)
#pragma unroll
                for (int g = 0; g < 4; ++g)
                    *(u32x2*)(dst + 32 * dt + 8 * g + 4 * h) = (u32x2){pk2(o[dt][4 * g] * inv, o[dt][4 * g + 1] * inv), pk2(o[dt][4 * g + 2] * inv, o[dt][4 * g + 3] * inv)};
        }
    }
}

#define XB_TMO      128
#define XB_XCNT(j)  (256  + 64 * (j))
#define XB_XSUB(j)  (1280 + 64 * (j))
#define XB_XGEN(j)  (2304 + 64 * (j))
#define XB_TOP      3328
#define XB_TOPGEN   3392
#define XCD_BAR_WORDS 3456
#define XB_SPIN_CAP (1u << 18)
#define LAS __attribute__((address_space(3)))
DI unsigned xb_ld(unsigned* p) { return __hip_atomic_load(p, __ATOMIC_RELAXED, __HIP_MEMORY_SCOPE_AGENT); }
DI unsigned xb_add(unsigned* p, unsigned v) { return __hip_atomic_fetch_add(p, v, __ATOMIC_RELAXED, __HIP_MEMORY_SCOPE_AGENT); }
DI unsigned xb_xcc_id() { return (unsigned)__builtin_amdgcn_s_getreg((3 << 11) | 20) & 0xFu; }
#define XB_SPIN(cond, bar) do { unsigned _sp = 0; while (cond) { __builtin_amdgcn_s_sleep(1); \
    if ((++_sp & 255u) == 0u) { if (xb_ld(&(bar)[XB_TMO])) break; if (_sp > XB_SPIN_CAP) { atomicAdd(&(bar)[XB_TMO], 1u); break; } } } } while (0)
struct XcdBarrier { unsigned* bar; unsigned x; volatile LAS unsigned* st; };
DI XcdBarrier xcd_barrier_post(unsigned* bar, volatile LAS unsigned* st) {
    XcdBarrier b; b.bar = bar; b.x = xb_xcc_id(); b.st = st;
    if (threadIdx.x == 0) (void)xb_add(&bar[XB_XCNT(b.x)], 1u);
    return b;
}
DI void xcd_barrier_complete(unsigned* bar, unsigned x, unsigned& nloc, unsigned& nx) {
    const unsigned G = gridDim.x * gridDim.y * gridDim.z;
    unsigned sum, cnt, mine, sp = 0u;
    for (;;) {
        sum = 0u; cnt = 0u; mine = 0u;
#pragma unroll
        for (unsigned j = 0; j < 16; ++j) { const unsigned c = xb_ld(&bar[XB_XCNT(j)]); sum += c; cnt += (c > 0u) ? 1u : 0u; mine = (j == x) ? c : mine; }
        if (sum == G) break;
        __builtin_amdgcn_s_sleep(1);
        if ((++sp & 255u) == 0u) { if (xb_ld(&bar[XB_TMO])) break; if (sp > XB_SPIN_CAP) { atomicAdd(&bar[XB_TMO], 1u); break; } }
    }
    nloc = mine > 0u ? mine : 1u; nx = cnt > 0u ? cnt : 1u;
}
DI void xcd_barrier(const XcdBarrier& b) {
    asm volatile("s_waitcnt vmcnt(0)" ::: "memory");
    __syncthreads();
    if (threadIdx.x == 0) {
        unsigned* bar = b.bar;
        __builtin_amdgcn_s_waitcnt(0);
        unsigned nloc = b.st[0], nx = b.st[1];
        if (nloc == 0u) { xcd_barrier_complete(bar, b.x, nloc, nx); b.st[0] = nloc; b.st[1] = nx; }
        const unsigned old = xb_add(&bar[XB_XSUB(b.x)], 1u);
        const unsigned gen = old / nloc;
        if (old + 1u == (gen + 1u) * nloc) {
            __builtin_amdgcn_fence(__ATOMIC_RELEASE, "agent");
            asm volatile("s_waitcnt vmcnt(0)" ::: "memory");
            const unsigned og = xb_add(&bar[XB_TOP], 1u);
            const unsigned tg = og / nx;
            if (og + 1u == (tg + 1u) * nx) xb_add(&bar[XB_TOPGEN], 1u);
            else XB_SPIN(xb_ld(&bar[XB_TOPGEN]) == tg, bar);
            __builtin_amdgcn_fence(__ATOMIC_ACQUIRE, "agent");
            xb_add(&bar[XB_XGEN(b.x)], 1u);
            asm volatile("s_waitcnt vmcnt(0)" ::: "memory");
        } else {
            XB_SPIN(xb_ld(&bar[XB_XGEN(b.x)]) == gen, bar);
            __builtin_amdgcn_fence(__ATOMIC_ACQUIRE, "agent");
            asm volatile("s_waitcnt vmcnt(0)" ::: "memory");
        }
    }
    __syncthreads();
}

__global__ void __launch_bounds__(512) mega(Params pin) {
    __shared__ __attribute__((aligned(16))) char lds[147456 + 64];
    cg::grid_group grid = cg::this_grid();
    volatile LAS unsigned* xst = (volatile LAS unsigned*)(lds + 147456);
    if (threadIdx.x == 0) { xst[0] = 0u; xst[1] = 0u; }
    __syncthreads();
    const XcdBarrier xb = xcd_barrier_post((unsigned*)(pin.ws + OFF_BAR), xst);
    int rep = 0;
    for (int ph = pin.ph_lo; ph < pin.ph_hi; ++ph) {
        Params p = pin;
        asm volatile("" : "+s"(p.ws), "+s"(p.out), "+s"(p.x));
        bf16_t* nbuf = (bf16_t*)(p.ws + OFF_N);
        bf16_t* act = (bf16_t*)(p.ws + OFF_ACT);
        if (ph == 0) phase_prologue(p, lds);
        else {
            const int l = ph == 23 ? 1 : (ph - 1) / 11, k = ph == 23 ? 11 : (ph - 1) % 11;
            const float* mod = (const float*)(p.ws + OFF_MOD) + l * 9216;
            switch (k) {
            case 0: case 3: case 8: case 11: {
                const int i = k == 0 ? 0 : (k == 3 ? 1 : 2);
                const float* hin = (ph == 1) ? p.x : p.out;
                if (k == 11) phase_norm(hin, p.final_g, nullptr, nullptr, nullptr, p.out);
                else phase_norm(hin, p.norm_g + (l * 3 + i) * D, mod + (3 * i) * D, mod + (3 * i + 1) * D, nbuf, nullptr);
            } break;
            case 1: case 9: {
                const int f = k == 1 ? 0 : 1;
                phase_gateup(nbuf, (const bf16_t*)(p.ws + OFF_WGU + (size_t)(l * 2 + f) * SZ_WGU), act, lds);
            } break;
            case 2: case 10: case 7: {
                if (k == 7) phase_resid((const bf16_t*)(p.ws + OFF_Q), D, (const bf16_t*)(p.ws + OFF_WO + l * SZ_WO), p.out, p.out, mod + 5 * D, rep ? 0.0f : 1.0f, lds);
                else {
                    const int f = k == 2 ? 0 : 1;
                    phase_resid(act, F, (const bf16_t*)(p.ws + OFF_WD + (size_t)(l * 2 + f) * SZ_WD), (ph == 3 && !rep) ? p.x : p.out, p.out, mod + (f == 0 ? 2 : 8) * D, rep ? 0.0f : 0.5f, lds);
                }
            } break;
            case 4: phase_win(p, l, lds); break;
            case 5: phase_attn(p, l, rep, lds); break;
            case 6: phase_merge((const bf16_t*)(p.ws + OFF_ATTA), (const bf16_t*)(p.ws + OFF_OD), (const bf16_t*)(p.ws + OFF_WBA + l * SZ_WB), (const bf16_t*)(p.ws + OFF_WBB + l * SZ_WB),
                                (const bf16_t*)(p.ws + OFF_G), (bf16_t*)(p.ws + OFF_Q), (float*)(p.ws + OFF_N), lds); break;
            default: break;
            }
        }
        if (ph + 1 < pin.ph_hi) { if (ph == pin.ph_lo) grid.sync(); else xcd_barrier(xb); }
        if (PROBE_DUP >= 0 && rep == 0 && (ph == 0 ? PROBE_DUP == 100 : ((ph - 1) % 11 == PROBE_DUP && ph != 23))) { rep = 1; --ph; } else rep = 0;
    }
}

extern "C" void kernel_launch(void* const* d_in, const int* in_sizes, int n_in, void* d_out, int out_size, void* d_ws, size_t ws_size, hipStream_t stream) {
    if (n_in != 18 || out_size != S * D || ws_size < WS_END) { fprintf(stderr, "kernel_launch: unexpected shapes / workspace (n_in %d out %d ws %zu need %zu)\n", n_in, out_size, ws_size, (size_t)WS_END); return; }
    Params p{};
    const float** pp = (const float**)&p;
    for (int i = 0; i < 18; ++i) pp[i] = (const float*)d_in[i];
    p.out = (float*)d_out; p.ws = (unsigned char*)d_ws;
    if (hipMemsetAsync((char*)d_ws + OFF_BAR, 0, 3456 * 4, stream) != hipSuccess) { fprintf(stderr, "kernel_launch: hipMemsetAsync of the barrier words failed\n"); return; }
#if MK_MULTI
    for (int ph = 0; ph < NPH; ++ph) { p.ph_lo = ph; p.ph_hi = ph + 1; hipLaunchKernelGGL(mega, dim3(256), dim3(512), 0, stream, p); }
#else
    static int grid = 0;
    if (!grid) {
        int dev = 0, cus = 0, per_cu = 0;
        hipGetDevice(&dev); hipDeviceGetAttribute(&cus, hipDeviceAttributeMultiprocessorCount, dev);
        hipOccupancyMaxActiveBlocksPerMultiprocessor(&per_cu, (const void*)mega, 512, 0);
        if (per_cu < 1) { fprintf(stderr, "kernel_launch: occupancy query says %d blocks per CU\n", per_cu); per_cu = 1; }
        grid = cus;
    }
    p.ph_lo = 0; p.ph_hi = NPH;
    void* args[] = {&p};
    hipError_t e = hipLaunchCooperativeKernel((const void*)mega, dim3(grid), dim3(512), args, 0, stream);
    if (e != hipSuccess) fprintf(stderr, "cooperative launch failed: %s (grid %d)\n", hipGetErrorString(e), grid);
#endif
}
```

```cpp
#include <hip/hip_runtime.h>
#include <hip/hip_cooperative_groups.h>
#include <cstdio>
#include <cstdint>
namespace cg = cooperative_groups;

#ifndef MK_MULTI
#define MK_MULTI 0
#endif

#ifndef PROBE_DUP
#define PROBE_DUP -1
#endif
#define DI __device__ __forceinline__
typedef unsigned short bf16_t;
typedef short bf16x8 __attribute__((ext_vector_type(8)));
typedef float f32x4 __attribute__((ext_vector_type(4)));
typedef float f32x16 __attribute__((ext_vector_type(16)));
typedef unsigned u32x4 __attribute__((ext_vector_type(4)));
typedef unsigned u32x2 __attribute__((ext_vector_type(2)));

constexpr int S = 16384, D = 1024, F = 2816, NGU = 5632, NIN = 4352;
constexpr int NPH = 24;
constexpr float QSCALE = 0.125f * 1.4426950408889634f;
constexpr float LOG2E = 1.4426950408889634f;

constexpr size_t OFF_MOD = 0;
constexpr size_t OFF_LAM = 80000;
constexpr size_t OFF_STAT = 80128;
constexpr size_t OFF_ROPE = 81920;
constexpr size_t OFF_BAR = 131072;
constexpr size_t OFF_WGU = 1u << 20;
constexpr size_t SZ_WGU = (size_t)NGU * D * 2;
constexpr size_t OFF_WD = OFF_WGU + 4 * SZ_WGU;
constexpr size_t SZ_WD = (size_t)D * F * 2;
constexpr size_t OFF_WIN = OFF_WD + 4 * SZ_WD;
constexpr size_t SZ_WIN = (size_t)NIN * D * 2;
constexpr size_t OFF_WBA = OFF_WIN + 2 * SZ_WIN;
constexpr size_t SZ_WB = (size_t)D * 512 * 2;
constexpr size_t OFF_WBB = OFF_WBA + 2 * SZ_WB;
constexpr size_t OFF_WO = OFF_WBB + 2 * SZ_WB;
constexpr size_t SZ_WO = (size_t)D * D * 2;
constexpr size_t OFF_N = OFF_WO + 2 * SZ_WO;
constexpr size_t OFF_MIX = OFF_N + (size_t)S * D * 2;
constexpr size_t OFF_Q = OFF_MIX;
constexpr size_t OFF_QD = OFF_Q + (size_t)S * 512 * 2;
constexpr size_t OFF_KA = OFF_QD + (size_t)S * 512 * 2;
constexpr size_t OFF_VTA = OFF_KA + (size_t)S * 128 * 2;
constexpr size_t OFF_KD = OFF_VTA + (size_t)S * 128 * 2;
constexpr size_t OFF_VTD = OFF_KD + (size_t)S * 512 * 2;
constexpr size_t OFF_G = OFF_VTD + (size_t)S * 512 * 2;
constexpr size_t OFF_ATTA = OFF_G + (size_t)S * 2048 * 2;
constexpr size_t OFF_OD = OFF_ATTA + (size_t)S * 512 * 2;
constexpr size_t OFF_ACT = OFF_MIX;
constexpr size_t WS_END = OFF_OD + (size_t)S * 512 * 2;
static_assert((size_t)S * F * 2 <= WS_END - OFF_MIX, "act overlay");

struct Params {
    const float *x, *c, *ada_w, *ada_b, *norm_g, *ffn_wg, *ffn_wu, *ffn_wd, *w_in, *qk_g, *lam_p, *subln_g, *w_ba, *w_bb, *w_gate, *b_gate, *w_o, *final_g;
    float* out; unsigned char* ws; int ph_lo, ph_hi;
};

typedef __bf16 bf16v2 __attribute__((ext_vector_type(2)));
typedef float f32x2 __attribute__((ext_vector_type(2)));
DI unsigned pk2(float lo, float hi) { f32x2 v = {lo, hi}; bf16v2 b = __builtin_convertvector(v, bf16v2); return __builtin_bit_cast(unsigned, b); }
DI float bf_lo(unsigned u) { return __uint_as_float(u << 16); }
DI float bf_hi(unsigned u) { return __uint_as_float(u & 0xffff0000u); }
DI int lds_off(int row, int chunk) { return row * 128 + ((chunk ^ ((row >> 1) & 7)) << 4); }
DI float fast_exp2(float x) { return __builtin_amdgcn_exp2f(x); }
DI float fast_rcp(float x) { return __builtin_amdgcn_rcpf(x); }
DI int otid() { int t = threadIdx.x; asm volatile("" : "+v"(t)); return t; }
#define SB() __builtin_amdgcn_sched_barrier(0)

DI int perm64(int n) { return (n & ~63) | (((n >> 2) & 3) << 4) | (((n >> 4) & 3) << 2) | (n & 3); }
DI int gumap(int j) { return 128 * (j >> 6) + 64 * ((j >> 5) & 1) + 16 * ((j >> 2) & 1) + 4 * ((j >> 3) & 3) + (j & 3); }

struct TrDesc { const float* src; bf16_t* dst; int N, k0, n0, ldd, mode, roff; };
DI void tr_decode(const Params& p, int tt, TrDesc& d) {
    constexpr int N_TR_L = 5824;
    const int l = tt / N_TR_L, r = tt % N_TR_L;
    if (r < 4224) {
        const int f = r / 2112, r2 = r % 2112, which = r2 / 704, r3 = r2 % 704;
        const size_t lf = (size_t)(l * 2 + f);
        if (which < 2) { d.src = (which == 0 ? p.ffn_wg : p.ffn_wu) + lf * D * F; d.N = F; d.k0 = (r3 / 44) * 64; d.n0 = (r3 % 44) * 64; d.dst = (bf16_t*)(p.ws + OFF_WGU + lf * SZ_WGU); d.ldd = D; d.mode = 2; d.roff = which * 32; }
        else { d.src = p.ffn_wd + lf * F * D; d.N = D; d.k0 = (r3 / 16) * 64; d.n0 = (r3 % 16) * 64; d.dst = (bf16_t*)(p.ws + OFF_WD + lf * SZ_WD); d.ldd = F; d.mode = 1; d.roff = 0; }
    } else if (r < 4800) { const int r3 = r - 4224; d.src = p.w_in + (size_t)l * D * 2304; d.N = 2304; d.k0 = (r3 / 36) * 64; d.n0 = (r3 % 36) * 64; d.dst = (bf16_t*)(p.ws + OFF_WIN + l * SZ_WIN); d.ldd = D; d.mode = 0; d.roff = 0; }
    else if (r < 5312) { const int r3 = r - 4800; d.src = p.w_gate + (size_t)l * D * 2048; d.N = 2048; d.k0 = (r3 / 32) * 64; d.n0 = (r3 % 32) * 64; d.dst = (bf16_t*)(p.ws + OFF_WIN + l * SZ_WIN); d.ldd = D; d.mode = 0; d.roff = 2304; }
    else if (r < 5440) { const int r3 = r - 5312; d.src = p.w_ba + (size_t)l * 512 * D; d.N = D; d.k0 = (r3 / 16) * 64; d.n0 = (r3 % 16) * 64; d.dst = (bf16_t*)(p.ws + OFF_WBA + l * SZ_WB); d.ldd = 512; d.mode = 1; d.roff = 0; }
    else if (r < 5568) { const int r3 = r - 5440; d.src = p.w_bb + (size_t)l * 512 * D; d.N = D; d.k0 = (r3 / 16) * 64; d.n0 = (r3 % 16) * 64; d.dst = (bf16_t*)(p.ws + OFF_WBB + l * SZ_WB); d.ldd = 512; d.mode = 1; d.roff = 0; }
    else { const int r3 = r - 5568; d.src = p.w_o + (size_t)l * D * D; d.N = D; d.k0 = (r3 / 16) * 64; d.n0 = (r3 % 16) * 64; d.dst = (bf16_t*)(p.ws + OFF_WO + l * SZ_WO); d.ldd = D; d.mode = 1; d.roff = 0; }
}
DI void tr_load(const TrDesc& d, int tid, f32x4 (&v)[2]) {
    const int kk = tid >> 4, nn4 = (tid & 15) * 4;
#pragma unroll
    for (int ps = 0; ps < 2; ++ps) v[ps] = *(const f32x4*)(d.src + (size_t)(d.k0 + kk + 32 * ps) * d.N + d.n0 + nn4);
}
DI void tr_store(const TrDesc& d, int tid, const f32x4 (&v)[2], float* ldsf) {
    {
        const int kk = tid >> 4, nn4 = (tid & 15) * 4;
#pragma unroll
        for (int ps = 0; ps < 2; ++ps) { const int k = kk + 32 * ps; ldsf[k * 65 + nn4 + 0] = v[ps][0]; ldsf[k * 65 + nn4 + 1] = v[ps][1]; ldsf[k * 65 + nn4 + 2] = v[ps][2]; ldsf[k * 65 + nn4 + 3] = v[ps][3]; }
    }
    __syncthreads();
    {
        const int n = tid >> 3, ch = tid & 7, gn = d.n0 + n;
        int drow;
        if (d.mode == 0) drow = gn + d.roff; else if (d.mode == 1) drow = perm64(gn); else drow = gumap(gn) + d.roff;
        float w[8];
#pragma unroll
        for (int i = 0; i < 8; ++i) w[i] = ldsf[(ch * 8 + i) * 65 + n];
        u32x4 pk = {pk2(w[0], w[1]), pk2(w[2], w[3]), pk2(w[4], w[5]), pk2(w[6], w[7])};
        *(u32x4*)(d.dst + (size_t)drow * d.ldd + d.k0 + ch * 8) = pk;
    }
    __syncthreads();
}

DI void phase_prologue(const Params& p, char* lds) {
    const int tid = otid();
    float* ldsf = (float*)lds;
    constexpr int N_MOD = 288, N_TR = 2 * 5824;
    for (int it = blockIdx.x; it < N_MOD; it += gridDim.x) {
        const int l = it / 144, j0 = (it % 144) * 64, jj = tid & 15, ii = tid >> 4;
        float* cact = ldsf + 2048;
        for (int i = tid; i < 1024; i += 512) { const float cv = p.c[i]; cact[i] = cv / (1.f + expf(-cv)); }
        __syncthreads();
        f32x4 a = {0.f, 0.f, 0.f, 0.f};
        const float* wb = p.ada_w + (size_t)l * 1024 * 9216 + j0 + 4 * jj;
#pragma unroll 8
        for (int r = 0; r < 32; ++r) { const int i = ii + 32 * r; a += cact[i] * *(const f32x4*)(wb + (size_t)i * 9216); }
        *(f32x4*)(ldsf + ii * 64 + 4 * jj) = a;
        __syncthreads();
        if (tid < 64) {
            float sm = 0.f;
#pragma unroll
            for (int r = 0; r < 32; ++r) sm += ldsf[r * 64 + tid];
            ((float*)(p.ws + OFF_MOD))[l * 9216 + j0 + tid] = sm + p.ada_b[l * 9216 + j0 + tid];
        }
        __syncthreads();
    }
    if (blockIdx.x == gridDim.x - 1) {
        if (tid < 64) {
#pragma unroll
            for (int l = 0; l < 2; ++l) {
                const float* lp = p.lam_p + l * 256;
                float a = lp[tid] * lp[64 + tid], b = lp[128 + tid] * lp[192 + tid];
#pragma unroll
                for (int o = 32; o > 0; o >>= 1) { a += __shfl_xor(a, o); b += __shfl_xor(b, o); }
                const float li = l == 0 ? 0.2f : 0.35550906759096926f;
                if (tid == 0) ((float*)(p.ws + OFF_LAM))[l] = expf(a) - expf(b) + li;
            }
        }
        if (tid < 64) ((unsigned*)(p.ws + OFF_STAT))[tid] = 0u;
        float* rope = (float*)(p.ws + OFF_ROPE);
        for (int e = tid; e < 320 * 16; e += 512) {
            const int pi = e >> 4, i = e & 15;
            const int pos = pi < 256 ? pi - 128 : (pi - 256) - 32;
            const float inv = exp2f(-(float)i * (13.287712379549449f / 16.0f));
            const float angf = (float)pos * inv;
            double r = (double)angf; r -= rint(r * 0.15915494309189535) * 6.283185307179586;
            const double r2 = r * r;
            double sn = 0.0, cs = 0.0;
#pragma unroll 1
            for (int n = 14; n >= 1; --n) { sn = (sn + 1.0) * (-r2 / (double)((2 * n) * (2 * n + 1))); cs = (cs + 1.0) * (-r2 / (double)((2 * n - 1) * (2 * n))); }
            sn = (sn + 1.0) * r; cs = cs + 1.0;
            if (pi < 256) { rope[pi * 16 + i] = (float)cs; rope[4096 + pi * 16 + i] = (float)sn; }
            else { rope[8192 + (pi - 256) * 16 + i] = (float)cs; rope[9216 + (pi - 256) * 16 + i] = (float)sn; }
        }
    }
    {
        int tt = blockIdx.x;
        TrDesc d; f32x4 v[2];
        if (tt < N_TR) { tr_decode(p, tt, d); tr_load(d, tid, v); }
        while (tt < N_TR) {
            const int tn = tt + gridDim.x;
            TrDesc dn; f32x4 vn[2];
            if (tn < N_TR) { tr_decode(p, tn, dn); tr_load(dn, tid, vn); }
            tr_store(d, tid, v, ldsf);
            if (tn < N_TR) { d = dn; v[0] = vn[0]; v[1] = vn[1]; }
            tt = tn;
        }
    }
}

DI void phase_norm(const float* hin, const float* __restrict__ g, const float* __restrict__ sh, const float* __restrict__ sc, bf16_t* nout, float* fout) {
    const int tid_ = otid(), lane = tid_ & 63, wid = tid_ >> 6;
    const int nw = gridDim.x * 8;
    for (int row = blockIdx.x * 8 + wid; row < S; row += nw) {
        const float* hp = hin + (size_t)row * D;
        f32x4 v[4]; float ss = 0.f;
#pragma unroll
        for (int i = 0; i < 4; ++i) { v[i] = *(const f32x4*)(hp + (i * 64 + lane) * 4); ss += v[i][0] * v[i][0] + v[i][1] * v[i][1] + v[i][2] * v[i][2] + v[i][3] * v[i][3]; }
#pragma unroll
        for (int o = 32; o > 0; o >>= 1) ss += __shfl_xor(ss, o);
        const float rstd = rsqrtf(ss * (1.0f / 1024.0f) + 1e-6f);
#pragma unroll
        for (int i = 0; i < 4; ++i) {
            const int col = (i * 64 + lane) * 4;
            const f32x4 gv = *(const f32x4*)(g + col);
            f32x4 y = v[i] * rstd * gv;
            if (sc) { const f32x4 s1 = *(const f32x4*)(sc + col), s0 = *(const f32x4*)(sh + col); y = y * (1.0f + s1) + s0; }
            if (fout) *(f32x4*)(fout + (size_t)row * D + col) = y;
            else { u32x2 pk = {pk2(y[0], y[1]), pk2(y[2], y[3])}; *(u32x2*)(nout + (size_t)row * D + col) = pk; }
        }
    }
}

DI void glds16(const void* g, char* l) { __builtin_amdgcn_global_load_lds((const unsigned*)g, (unsigned*)l, 16, 0, 0); }
template <int N> DI void waitv() { asm volatile("s_waitcnt vmcnt(%0)" ::"n"(N) : "memory"); }
DI void rawbar() { __builtin_amdgcn_s_barrier(); }
constexpr int GST = 49152;
DI void gemm_mainloop(const bf16_t* __restrict__ A, int lda, const bf16_t* __restrict__ W, int ldw, int K, f32x4 (&acc)[4][4], char* lds) {
    const int tid = otid(), lane = tid & 63, wid = tid >> 6, wt = wid >> 1, wc = wid & 1;
    const int srow = tid >> 3, sch = (tid & 7) ^ ((srow >> 1) & 7);
    const bf16_t* ag = A + (size_t)srow * lda + sch * 8;
    const bf16_t* wg = W + (size_t)srow * ldw + sch * 8;
    char* const ld = lds + tid * 16;
    const int nk = K >> 6;
#define G_ISSUE(kt_, st_) do { const int ko_ = (kt_) * 64; char* sn_ = ld + (st_) * GST; \
        _Pragma("unroll") for (int i = 0; i < 4; ++i) glds16(ag + (size_t)(64 * i) * lda + ko_, sn_ + i * 8192); \
        _Pragma("unroll") for (int i = 0; i < 2; ++i) glds16(wg + (size_t)(64 * i) * ldw + ko_, sn_ + 32768 + i * 8192); } while (0)
    waitv<0>();
    G_ISSUE(0, 0); G_ISSUE(1, 1);
    const int fr = lane & 15, fq = lane >> 4, sw = (fr >> 1) & 7;
    const int a_base = (64 * wt + fr) * 128, w_base = 32768 + (64 * wc + fr) * 128;
    int cur = 0, nxt = 2;
    for (int kt = 0; kt < nk; ++kt) {
        if (kt + 1 < nk) waitv<6>(); else waitv<0>();
        rawbar();
        if (kt + 2 < nk) G_ISSUE(kt + 2, nxt);
        const char* st = lds + cur * GST;
#pragma unroll
        for (int kk = 0; kk < 2; ++kk) {
            const int co = ((kk * 4 + fq) ^ sw) << 4;
            bf16x8 af[4], wf[4];
#pragma unroll
            for (int i = 0; i < 4; ++i) af[i] = *(const bf16x8*)(st + a_base + i * 2048 + co);
#pragma unroll
            for (int i = 0; i < 4; ++i) wf[i] = *(const bf16x8*)(st + w_base + i * 2048 + co);
#pragma unroll
            for (int mw = 0; mw < 4; ++mw)
#pragma unroll
                for (int nt = 0; nt < 4; ++nt) acc[mw][nt] = __builtin_amdgcn_mfma_f32_16x16x32_bf16(wf[mw], af[nt], acc[mw][nt], 0, 0, 0);
        }
        cur = cur == 2 ? 0 : cur + 1; nxt = nxt == 2 ? 0 : nxt + 1;
    }
#undef G_ISSUE
    __syncthreads();
}
constexpr int GST2 = 65536;
DI void gemm_mainloop2(const bf16_t* __restrict__ A, int lda, const bf16_t* __restrict__ W, int ldw, int K, f32x4 (&acc)[4][8], char* lds) {
    const int tid = otid(), lane = tid & 63, wid = tid >> 6, wt = wid >> 2, wc = wid & 3;
    const int srow = tid >> 3, sch = (tid & 7) ^ ((srow >> 1) & 7);
    const bf16_t* ag = A + (size_t)srow * lda + sch * 8;
    const bf16_t* wg = W + (size_t)srow * ldw + sch * 8;
    char* const ld = lds + tid * 16;
    const int nk = K >> 6;
#define G2_ISSUE(kt_, st_) do { const int ko_ = (kt_) * 64; char* sn_ = ld + (st_) * GST2; \
        _Pragma("unroll") for (int i = 0; i < 4; ++i) glds16(ag + (size_t)(64 * i) * lda + ko_, sn_ + i * 8192); \
        _Pragma("unroll") for (int i = 0; i < 4; ++i) glds16(wg + (size_t)(64 * i) * ldw + ko_, sn_ + 32768 + i * 8192); } while (0)
    waitv<0>();
    G2_ISSUE(0, 0);
    const int fr = lane & 15, fq = lane >> 4, sw = (fr >> 1) & 7;
    const int a_base = (128 * wt + fr) * 128, w_base = 32768 + (64 * wc + fr) * 128;
    for (int kt = 0; kt < nk; ++kt) {
        waitv<0>();
        rawbar();
        if (kt + 1 < nk) G2_ISSUE(kt + 1, (kt + 1) & 1);
        const char* st = lds + (kt & 1) * GST2;
#pragma unroll
        for (int kk = 0; kk < 2; ++kk) {
            const int co = ((kk * 4 + fq) ^ sw) << 4;
            bf16x8 wf[4], af[2][2];
#pragma unroll
            for (int i = 0; i < 4; ++i) wf[i] = *(const bf16x8*)(st + w_base + i * 2048 + co);
#pragma unroll
            for (int i = 0; i < 2; ++i) af[0][i] = *(const bf16x8*)(st + a_base + i * 2048 + co);
#pragma unroll
            for (int ip = 0; ip < 4; ++ip) {
                if (ip < 3) {
#pragma unroll
                    for (int i = 0; i < 2; ++i) af[(ip + 1) & 1][i] = *(const bf16x8*)(st + a_base + (2 * ip + 2 + i) * 2048 + co);
                }
                __builtin_amdgcn_s_setprio(1);
#pragma unroll
                for (int i = 0; i < 2; ++i)
#pragma unroll
                    for (int mw = 0; mw < 4; ++mw) acc[mw][2 * ip + i] = __builtin_amdgcn_mfma_f32_16x16x32_bf16(wf[mw], af[ip & 1][i], acc[mw][2 * ip + i], 0, 0, 0);
                __builtin_amdgcn_s_setprio(0);
                SB();
            }
        }
    }
#undef G2_ISSUE
    __syncthreads();
}
DI void zero_acc2(f32x4 (&acc)[4][8]) {
#pragma unroll
    for (int a = 0; a < 4; ++a)
#pragma unroll
        for (int b = 0; b < 8; ++b) acc[a][b] = (f32x4){0.f, 0.f, 0.f, 0.f};
}
DI void zero_acc(f32x4 (&acc)[4][4]) {
#pragma unroll
    for (int a = 0; a < 4; ++a)
#pragma unroll
        for (int b = 0; b < 4; ++b) acc[a][b] = (f32x4){0.f, 0.f, 0.f, 0.f};
}

DI void phase_gateup(const bf16_t* n, const bf16_t* wgu, bf16_t* act, char* lds) {
    const int tid_ = otid(), lane = tid_ & 63, wid = tid_ >> 6, wt = wid >> 2, wc = wid & 3, fr = lane & 15, fq = lane >> 4;
    constexpr int NTILES = 64 * (NGU / 256);
    for (int t = blockIdx.x; t < NTILES; t += gridDim.x) {
        const int bm = t & 63, bn = t >> 6, row0 = bm * 256;
        f32x4 acc[4][8]; zero_acc2(acc);
        gemm_mainloop2(n + (size_t)row0 * D, D, wgu + (size_t)bn * 256 * D, D, D, acc, lds);
#pragma unroll
        for (int nt = 0; nt < 8; ++nt) {
            const int token = row0 + 128 * wt + 16 * nt + fr;
            float v[8];
#pragma unroll
            for (int m = 0; m < 2; ++m)
#pragma unroll
                for (int r = 0; r < 4; ++r) { const float gg = acc[m][nt][r], uu = acc[m + 2][nt][r]; v[4 * m + r] = gg * fast_rcp(1.0f + __expf(-gg)) * uu; }
            u32x4 pk = {pk2(v[0], v[1]), pk2(v[2], v[3]), pk2(v[4], v[5]), pk2(v[6], v[7])};
            *(u32x4*)(act + (size_t)token * F + 32 * (4 * bn + wc) + 8 * fq) = pk;
        }
    }
}

DI void phase_resid(const bf16_t* A, int K, const bf16_t* W, const float* hin, float* hout, const float* __restrict__ gvec, float gs, char* lds) {
    const int tid_ = otid(), lane = tid_ & 63, wid = tid_ >> 6, wt = wid >> 2, wc = wid & 3, fr = lane & 15, fq = lane >> 4;
    constexpr int NTILES = 64 * 4;
    for (int t = blockIdx.x; t < NTILES; t += gridDim.x) {
        const int bm = t & 63, bn = t >> 6, row0 = bm * 256, ch0 = bn * 256 + 64 * wc + 16 * fq;
        f32x4 acc[4][8]; zero_acc2(acc);
        gemm_mainloop2(A + (size_t)row0 * K, K, W + (size_t)bn * 256 * K, K, K, acc, lds);
        f32x4 gv[4];
#pragma unroll
        for (int mw = 0; mw < 4; ++mw) gv[mw] = *(const f32x4*)(gvec + ch0 + 4 * mw) * gs;
#pragma unroll
        for (int nt = 0; nt < 8; ++nt) {
            const size_t off = (size_t)(row0 + 128 * wt + 16 * nt + fr) * D + ch0;
#pragma unroll
            for (int mw = 0; mw < 4; ++mw) { const f32x4 hv = *(const f32x4*)(hin + off + 4 * mw); *(f32x4*)(hout + off + 4 * mw) = hv + gv[mw] * acc[mw][nt]; }
            SB();
        }
    }
}

DI void phase_merge(const bf16_t* atta, const bf16_t* od, const bf16_t* wba, const bf16_t* wbb, const bf16_t* G, bf16_t* merged, float* spill, char* lds) {
    const int tid_ = otid(), lane = tid_ & 63, wid = tid_ >> 6, wt = wid >> 1, wc = wid & 1, fr = lane & 15, fq = lane >> 4;
    constexpr int NTILES = 64 * 8;
    for (int t = blockIdx.x; t < NTILES; t += gridDim.x) {
        const int bm = t & 63, bn = t >> 6, row0 = bm * 256, ch0 = bn * 128 + 64 * wc + 16 * fq;
        f32x4 acc[4][4]; zero_acc(acc);
        gemm_mainloop(atta + (size_t)row0 * 512, 512, wba + (size_t)bn * 128 * 512, 512, 512, acc, lds);
        float* sp = spill + ((size_t)blockIdx.x * 16 * 512 + tid_) * 4;
#pragma unroll
        for (int nt = 0; nt < 4; ++nt) {
            const bf16_t* gp = G + (size_t)(row0 + 64 * wt + 16 * nt + fr) * 2048 + ch0;
#pragma unroll
            for (int mw = 0; mw < 4; ++mw) { const u32x2 gu = *(const u32x2*)(gp + 4 * mw); const f32x4 ga = {bf_lo(gu[0]), bf_hi(gu[0]), bf_lo(gu[1]), bf_hi(gu[1])};
                *(f32x4*)(sp + (size_t)(nt * 4 + mw) * 2048) = ga * acc[mw][nt]; }
        }
        zero_acc(acc);
        gemm_mainloop(od + (size_t)row0 * 512, 512, wbb + (size_t)bn * 128 * 512, 512, 512, acc, lds);
#pragma unroll
        for (int nt = 0; nt < 4; ++nt) {
            const size_t tok = (size_t)(row0 + 64 * wt + 16 * nt + fr);
            const bf16_t* gp = G + tok * 2048 + 1024 + ch0;
            unsigned w[8];
#pragma unroll
            for (int mw = 0; mw < 4; ++mw) { const u32x2 gu = *(const u32x2*)(gp + 4 * mw); const f32x4 gb = {bf_lo(gu[0]), bf_hi(gu[0]), bf_lo(gu[1]), bf_hi(gu[1])};
                const f32x4 o = *(const f32x4*)(sp + (size_t)(nt * 4 + mw) * 2048) + gb * acc[mw][nt]; w[2 * mw] = pk2(o[0], o[1]); w[2 * mw + 1] = pk2(o[2], o[3]); }
            bf16_t* mp = merged + tok * D + ch0;
            *(u32x4*)(mp) = (u32x4){w[0], w[1], w[2], w[3]};
            *(u32x4*)(mp + 8) = (u32x4){w[4], w[5], w[6], w[7]};
        }
    }
}

DI void phase_win(const Params& p, int l, char* lds) {
    const int tid_ = otid(), lane = tid_ & 63, wid = tid_ >> 6, wt = wid >> 1, wc = wid & 1, fr = lane & 15, fq = lane >> 4;
    const bf16_t* n = (const bf16_t*)(p.ws + OFF_N);
    const bf16_t* W = (const bf16_t*)(p.ws + OFF_WIN + l * SZ_WIN);
    bf16_t* Q = (bf16_t*)(p.ws + OFF_Q); bf16_t* QD = (bf16_t*)(p.ws + OFF_QD); bf16_t* KA = (bf16_t*)(p.ws + OFF_KA); bf16_t* VTA = (bf16_t*)(p.ws + OFF_VTA);
    bf16_t* KD = (bf16_t*)(p.ws + OFF_KD); bf16_t* VTD = (bf16_t*)(p.ws + OFF_VTD); bf16_t* G = (bf16_t*)(p.ws + OFF_G);
    const float* rope = (const float*)(p.ws + OFF_ROPE);
    {
        const int wt2 = wid >> 2, wc2 = wid & 3;
        for (int t = blockIdx.x; t < 64 * 8; t += gridDim.x) {
            const int bm = t & 63, bg = t >> 6, row0 = bm * 256, gc = 256 * bg + 64 * wc2;
            f32x4 acc[4][8]; zero_acc2(acc);
            gemm_mainloop2(n + (size_t)row0 * D, D, W + (size_t)(2304 + 256 * bg) * D, D, D, acc, lds);
            const float* bg_ = p.b_gate + l * 2048 + gc;
            f32x4 bv[4];
#pragma unroll
            for (int mw = 0; mw < 4; ++mw) bv[mw] = *(const f32x4*)(bg_ + 16 * mw + 4 * fq);
#pragma unroll
            for (int nt = 0; nt < 8; ++nt) {
                bf16_t* dst = G + (size_t)(row0 + 128 * wt2 + 16 * nt + fr) * 2048 + gc;
#pragma unroll
                for (int mw = 0; mw < 4; ++mw) {
                    const f32x4 xx = acc[mw][nt] + bv[mw]; f32x4 z;
#pragma unroll
                    for (int r = 0; r < 4; ++r) z[r] = fast_rcp(1.0f + __expf(-xx[r]));
                    *(u32x2*)(dst + 16 * mw + 4 * fq) = (u32x2){pk2(z[0], z[1]), pk2(z[2], z[3])};
                }
            }
        }
    }
    constexpr int NTILES = 64 * (2304 / 128);
    for (int t = blockIdx.x; t < NTILES; t += gridDim.x) {
        const int bm = t & 63, bn = t >> 6, row0 = bm * 256;
        f32x4 acc[4][4]; zero_acc(acc);
        gemm_mainloop(n + (size_t)row0 * D, D, W + (size_t)bn * 128 * D, D, D, acc, lds);
        const int cw = bn * 128 + 64 * wc;
        if (cw < 640) {
            const bool isq = cw < 512;
            const float* gq = p.qk_g + l * 128 + (isq ? 0 : 64);
            f32x4 gv[4];
#pragma unroll
            for (int mw = 0; mw < 4; ++mw) gv[mw] = *(const f32x4*)(gq + 16 * mw + 4 * fq);
#pragma unroll
            for (int nt = 0; nt < 4; ++nt) {
                const int token = row0 + 64 * wt + 16 * nt + fr;
                float ss = 0.f;
#pragma unroll
                for (int mw = 0; mw < 4; ++mw) ss += acc[mw][nt][0] * acc[mw][nt][0] + acc[mw][nt][1] * acc[mw][nt][1] + acc[mw][nt][2] * acc[mw][nt][2] + acc[mw][nt][3] * acc[mw][nt][3];
                ss += __shfl_xor(ss, 16); ss += __shfl_xor(ss, 32);
                const float rstd = rsqrtf(ss * (1.0f / 64.0f) + 1e-6f);
                f32x4 y[4];
#pragma unroll
                for (int mw = 0; mw < 4; ++mw) y[mw] = acc[mw][nt] * rstd * gv[mw];
                const int prow = token >> 6, pcol = token & 63;
                const f32x4 cr = *(const f32x4*)(rope + prow * 16 + 4 * fq), sr = *(const f32x4*)(rope + 4096 + prow * 16 + 4 * fq);
                const f32x4 cc = *(const f32x4*)(rope + 8192 + pcol * 16 + 4 * fq), sc = *(const f32x4*)(rope + 9216 + pcol * 16 + 4 * fq);
                f32x4 o[4];
                o[0] = y[0] * cr - y[1] * sr; o[1] = y[1] * cr + y[0] * sr; o[2] = y[2] * cc - y[3] * sc; o[3] = y[3] * cc + y[2] * sc;
                const float qs = isq ? QSCALE : 1.0f;
                bf16_t* dst = isq ? (Q + (size_t)token * 512 + cw) : (KA + (size_t)token * 128 + (cw - 512));
#pragma unroll
                for (int mw = 0; mw < 4; ++mw) { const f32x4 z = o[mw] * qs; *(u32x2*)(dst + 16 * mw + 4 * fq) = (u32x2){pk2(z[0], z[1]), pk2(z[2], z[3])}; }
            }
        } else if (cw < 768 || (cw >= 1792 && cw < 2304)) {
            bf16_t* vt = cw < 768 ? (VTA + (size_t)(cw - 640) * S) : (VTD + (size_t)(cw - 1792) * S);
#pragma unroll
            for (int nt = 0; nt < 4; ++nt) {
                const int token = row0 + 64 * wt + 16 * nt + fr;
#pragma unroll
                for (int mw = 0; mw < 4; ++mw)
#pragma unroll
                    for (int r = 0; r < 4; ++r) vt[(size_t)(16 * mw + 4 * fq + r) * S + token] = (bf16_t)(pk2(acc[mw][nt][r], 0.f) & 0xffffu);
            }
        } else if (cw < 1792) {
            const bool isq = cw < 1280; const float qs = isq ? QSCALE : 1.0f;
            bf16_t* base = isq ? (QD + (cw - 768)) : (KD + (cw - 1280));
#pragma unroll
            for (int nt = 0; nt < 4; ++nt) {
                bf16_t* dst = base + (size_t)(row0 + 64 * wt + 16 * nt + fr) * 512;
#pragma unroll
                for (int mw = 0; mw < 4; ++mw) { const f32x4 z = acc[mw][nt] * qs; *(u32x2*)(dst + 16 * mw + 4 * fq) = (u32x2){pk2(z[0], z[1]), pk2(z[2], z[3])}; }
            }
            {
                float best = 0.f;
#pragma unroll
                for (int nt = 0; nt < 4; ++nt) {
                    float ss = 0.f;
#pragma unroll
                    for (int mw = 0; mw < 4; ++mw) { const f32x4 z = acc[mw][nt] * qs; ss += z[0] * z[0] + z[1] * z[1] + z[2] * z[2] + z[3] * z[3]; }
                    ss += __shfl_xor(ss, 16); ss += __shfl_xor(ss, 32);
                    best = __builtin_fmaxf(best, ss);
                }
#pragma unroll
                for (int o = 8; o > 0; o >>= 1) best = __builtin_fmaxf(best, __shfl_xor(best, o));
                if (lane == 0) atomicMax((unsigned*)(p.ws + OFF_STAT) + l * 16 + (isq ? 0 : 8) + ((cw - (isq ? 768 : 1280)) >> 6), __float_as_uint(best));
            }
        } else {
            const int gc = cw - 2304;
            const float* bg = p.b_gate + l * 2048 + gc;
            f32x4 bv[4];
#pragma unroll
            for (int mw = 0; mw < 4; ++mw) bv[mw] = *(const f32x4*)(bg + 16 * mw + 4 * fq);
#pragma unroll
            for (int nt = 0; nt < 4; ++nt) {
                bf16_t* dst = G + (size_t)(row0 + 64 * wt + 16 * nt + fr) * 2048 + gc;
#pragma unroll
                for (int mw = 0; mw < 4; ++mw) {
                    const f32x4 xx = acc[mw][nt] + bv[mw]; f32x4 z;
#pragma unroll
                    for (int r = 0; r < 4; ++r) z[r] = fast_rcp(1.0f + __expf(-xx[r]));
                    *(u32x2*)(dst + 16 * mw + 4 * fq) = (u32x2){pk2(z[0], z[1]), pk2(z[2], z[3])};
                }
            }
        }
    }
}

#define MFMA32(a, b, c) __builtin_amdgcn_mfma_f32_32x32x16_bf16((a), (b), (c), 0, 0, 0)
template <int DV, bool ALIBI>
DI void attn_pass(const bf16_t* __restrict__ Qp, const bf16_t* __restrict__ Kb, int kpitch, const bf16_t* __restrict__ Vtb, float slope2, int qpos, int t_lo, int t_hi, float m_init,
                  f32x16 (&o)[DV / 32], float& l_out, char* lds) {
    constexpr int NV = DV / 64, NDT = DV / 32, STAGE = 8192 + DV * 128, G = 1 + NV;
    const int tid = otid(), lane = tid & 63, r32 = lane & 31, h = lane >> 5;
    bf16x8 qf[4];
#pragma unroll
    for (int d0 = 0; d0 < 4; ++d0) qf[d0] = *(const bf16x8*)(Qp + 16 * d0 + 8 * h);
    const int srow = tid >> 3, sch = (tid & 7) ^ ((srow >> 1) & 7);
    const bf16_t* kg = Kb + (size_t)srow * kpitch + sch * 8;
    const bf16_t* vg = Vtb + (size_t)srow * S + sch * 8;
    char* const ld = lds + tid * 16;
#define A_ISSUE(t_, st_) do { char* sn_ = ld + (st_) * STAGE; glds16(kg + (size_t)(t_) * 64 * kpitch, sn_); \
        _Pragma("unroll") for (int i = 0; i < NV; ++i) glds16(vg + (size_t)(64 * i) * S + (t_) * 64, sn_ + 8192 + i * 8192); } while (0)
    waitv<0>();
    A_ISSUE(t_lo, 0);
    if (t_lo + 1 <= t_hi) A_ISSUE(t_lo + 1, 1);
    if (t_lo + 2 <= t_hi) A_ISSUE(t_lo + 2, 2);
    const int pi = (r32 & 0x13) | ((r32 & 4) << 1) | ((r32 & 8) >> 1);
    const int k_base = pi * 128, k_sw = (pi >> 1) & 7, v_base = 8192 + r32 * 128, v_sw = (r32 >> 1) & 7;
    float m = m_init, l = 0.f;
#pragma unroll
    for (int dt = 0; dt < NDT; ++dt)
#pragma unroll
        for (int r = 0; r < 16; ++r) o[dt][r] = 0.f;
    int cur = 0;
    for (int t = t_lo; t <= t_hi; ++t) {
        const int rem = t_hi - t;
        if (rem >= 2) waitv<2 * G>(); else if (rem == 1) waitv<G>(); else waitv<0>();
        rawbar();
        if (rem >= 3) A_ISSUE(t + 3, (cur + 3) & 3);
        const char* st = lds + cur * STAGE;
        cur = (cur + 1) & 3;
        bf16x8 kf[2][4];
#pragma unroll
        for (int kt = 0; kt < 2; ++kt)
#pragma unroll
            for (int d0 = 0; d0 < 4; ++d0) kf[kt][d0] = *(const bf16x8*)(st + kt * 4096 + k_base + (((2 * d0 + h) ^ k_sw) << 4));
        f32x16 sc[2];
        const float nm = -m;
#pragma unroll
        for (int kt = 0; kt < 2; ++kt)
#pragma unroll
            for (int r = 0; r < 16; ++r) sc[kt][r] = nm;
        SB();
        __builtin_amdgcn_s_setprio(1);
#pragma unroll
        for (int d0 = 0; d0 < 4; ++d0)
#pragma unroll
            for (int kt = 0; kt < 2; ++kt) sc[kt] = MFMA32(kf[kt][d0], qf[d0], sc[kt]);
        __builtin_amdgcn_s_setprio(0);
        bf16x8 vf[2][4];
        if (NDT == 2) {
#pragma unroll
            for (int dt = 0; dt < 2; ++dt)
#pragma unroll
                for (int ks = 0; ks < 4; ++ks) vf[dt][ks] = *(const bf16x8*)(st + v_base + dt * 4096 + (((2 * ks + h) ^ v_sw) << 4));
        }
        SB();
        if (ALIBI) {
#pragma unroll
            for (int kt = 0; kt < 2; ++kt) {
                const float dq = (float)(qpos - (64 * t + 32 * kt + 8 * h));
#pragma unroll
                for (int r = 0; r < 16; ++r) sc[kt][r] = __builtin_fmaf(-slope2, __builtin_fabsf(dq - (float)(16 * (r >> 3) + (r & 7))), sc[kt][r]);
            }
        }
        float mt = sc[0][0];
#pragma unroll
        for (int r = 1; r < 16; ++r) mt = __builtin_fmaxf(mt, sc[0][r]);
#pragma unroll
        for (int r = 0; r < 16; ++r) mt = __builtin_fmaxf(mt, sc[1][r]);
        mt = __builtin_fmaxf(mt, __shfl_xor(mt, 32));
        if (__any(mt > 8.0f)) {
            const float dl = __builtin_fmaxf(mt, 0.f), al = fast_exp2(-dl);
            l *= al; m += dl;
#pragma unroll
            for (int kt = 0; kt < 2; ++kt)
#pragma unroll
                for (int r = 0; r < 16; ++r) sc[kt][r] -= dl;
#pragma unroll
            for (int dt = 0; dt < NDT; ++dt)
#pragma unroll
                for (int r = 0; r < 16; ++r) o[dt][r] *= al;
        }
        float ps = 0.f;
#pragma unroll
        for (int kt = 0; kt < 2; ++kt)
#pragma unroll
            for (int r = 0; r < 16; ++r) { const float e = fast_exp2(sc[kt][r]); sc[kt][r] = e; ps += e; }
        l += ps;
        bf16x8 pf[4];
#pragma unroll
        for (int ks = 0; ks < 4; ++ks) {
            const int kt = ks >> 1, b = (ks & 1) * 8;
            u32x4 w = {pk2(sc[kt][b], sc[kt][b + 1]), pk2(sc[kt][b + 2], sc[kt][b + 3]), pk2(sc[kt][b + 4], sc[kt][b + 5]), pk2(sc[kt][b + 6], sc[kt][b + 7])};
            pf[ks] = __builtin_bit_cast(bf16x8, w);
        }
        SB();
        if (NDT == 4) {
#pragma unroll
            for (int gp = 0; gp < 2; ++gp) {
#pragma unroll
                for (int dt = 0; dt < 2; ++dt)
#pragma unroll
                    for (int ks = 0; ks < 4; ++ks) vf[dt][ks] = *(const bf16x8*)(st + v_base + (dt + 2 * gp) * 4096 + (((2 * ks + h) ^ v_sw) << 4));
                __builtin_amdgcn_s_setprio(1);
#pragma unroll
                for (int ks = 0; ks < 4; ++ks)
#pragma unroll
                    for (int dt = 0; dt < 2; ++dt) o[(dt + 2 * gp) % NDT] = MFMA32(vf[dt][ks], pf[ks], o[(dt + 2 * gp) % NDT]);
                __builtin_amdgcn_s_setprio(0);
                SB();
            }
        } else {
            __builtin_amdgcn_s_setprio(1);
#pragma unroll
            for (int ks = 0; ks < 4; ++ks)
#pragma unroll
                for (int dt = 0; dt < 2; ++dt) o[dt] = MFMA32(vf[dt][ks], pf[ks], o[dt]);
            __builtin_amdgcn_s_setprio(0);
        }
        SB();
    }
#undef A_ISSUE
    __syncthreads();
    l += __shfl_xor(l, 32);
    l_out = l;
}

DI void attn_pass_b(const bf16_t* __restrict__ Qp, const bf16_t* __restrict__ Kb, int kpitch, const bf16_t* __restrict__ Vtb, float slope2, int qpos, int t_lo, int t_hi, float mref,
                    f32x16 (&o)[4], float& l_out, char* lds) {
    constexpr int NV = 2, STAGE = 8192 + 128 * 128, G = 1 + NV;
    const int tid = otid(), lane = tid & 63, r32 = lane & 31, h = lane >> 5;
    const int qw0 = __builtin_amdgcn_readfirstlane(qpos - r32);
    bf16x8 qf[4];
#pragma unroll
    for (int d0 = 0; d0 < 4; ++d0) qf[d0] = *(const bf16x8*)(Qp + 16 * d0 + 8 * h);
    const int srow = tid >> 3, sch = (tid & 7) ^ ((srow >> 1) & 7);
    const bf16_t* kg = Kb + (size_t)srow * kpitch + sch * 8;
    const bf16_t* vg = Vtb + (size_t)srow * S + sch * 8;
    char* const ld = lds + tid * 16;
#define B_ISSUE(t_, st_) do { char* sn_ = ld + (st_) * STAGE; glds16(kg + (size_t)(t_) * 64 * kpitch, sn_); \
        _Pragma("unroll") for (int i = 0; i < NV; ++i) glds16(vg + (size_t)(64 * i) * S + (t_) * 64, sn_ + 8192 + i * 8192); } while (0)
    waitv<0>();
    B_ISSUE(t_lo, 0);
    if (t_lo + 1 <= t_hi) B_ISSUE(t_lo + 1, 1);
    if (t_lo + 2 <= t_hi) B_ISSUE(t_lo + 2, 2);
    const int pi = (r32 & 0x13) | ((r32 & 4) << 1) | ((r32 & 8) >> 1);
    const int k_base = pi * 128, k_sw = (pi >> 1) & 7, v_base = 8192 + r32 * 128, v_sw = (r32 >> 1) & 7;
    float l = 0.f;
    const float nm = -mref;
#pragma unroll
    for (int dt = 0; dt < 4; ++dt)
#pragma unroll
        for (int r = 0; r < 16; ++r) o[dt][r] = 0.f;
    int cur = 0;
    for (int t = t_lo; t <= t_hi; ++t) {
        const int rem = t_hi - t;
        if (rem >= 2) waitv<2 * G>(); else if (rem == 1) waitv<G>(); else waitv<0>();
        rawbar();
        if (rem >= 3) B_ISSUE(t + 3, (cur + 3) & 3);
        const char* st = lds + cur * STAGE;
        cur = (cur + 1) & 3;
        bf16x8 kf[2][4];
#pragma unroll
        for (int kt = 0; kt < 2; ++kt)
#pragma unroll
            for (int d0 = 0; d0 < 4; ++d0) kf[kt][d0] = *(const bf16x8*)(st + kt * 4096 + k_base + (((2 * d0 + h) ^ k_sw) << 4));
        const int side = (64 * t + 63 < qw0) ? 1 : ((64 * t > qw0 + 31) ? -1 : 0);
        f32x16 sc[2];
        if (side != 0) {
            const float ss = side > 0 ? slope2 : -slope2;
#pragma unroll
            for (int kt = 0; kt < 2; ++kt) {
                const float base = __builtin_fmaf(ss, (float)(64 * t + 32 * kt + 8 * h - qpos), nm);
#pragma unroll
                for (int r = 0; r < 16; ++r) sc[kt][r] = __builtin_fmaf(ss, (float)(16 * (r >> 3) + (r & 7)), base);
            }
        } else {
#pragma unroll
            for (int kt = 0; kt < 2; ++kt)
#pragma unroll
                for (int r = 0; r < 16; ++r) sc[kt][r] = nm;
        }
        SB();
        __builtin_amdgcn_s_setprio(1);
#pragma unroll
        for (int d0 = 0; d0 < 4; ++d0)
#pragma unroll
            for (int kt = 0; kt < 2; ++kt) sc[kt] = MFMA32(kf[kt][d0], qf[d0], sc[kt]);
        __builtin_amdgcn_s_setprio(0);
        SB();
        if (side == 0) {
#pragma unroll
            for (int kt = 0; kt < 2; ++kt) {
                const float dq = (float)(qpos - (64 * t + 32 * kt + 8 * h));
#pragma unroll
                for (int r = 0; r < 16; ++r) sc[kt][r] = __builtin_fmaf(-slope2, __builtin_fabsf(dq - (float)(16 * (r >> 3) + (r & 7))), sc[kt][r]);
            }
        }
        float ps = 0.f;
#pragma unroll
        for (int kt = 0; kt < 2; ++kt)
#pragma unroll
            for (int r = 0; r < 16; ++r) { const float e = fast_exp2(sc[kt][r]); sc[kt][r] = e; ps += e; }
        l += ps;
        bf16x8 pf[4];
#pragma unroll
        for (int ks = 0; ks < 4; ++ks) {
            const int kt = ks >> 1, b = (ks & 1) * 8;
            u32x4 w = {pk2(sc[kt][b], sc[kt][b + 1]), pk2(sc[kt][b + 2], sc[kt][b + 3]), pk2(sc[kt][b + 4], sc[kt][b + 5]), pk2(sc[kt][b + 6], sc[kt][b + 7])};
            pf[ks] = __builtin_bit_cast(bf16x8, w);
        }
        SB();
#pragma unroll
        for (int gp = 0; gp < 2; ++gp) {
            bf16x8 vf[2][4];
#pragma unroll
            for (int dt = 0; dt < 2; ++dt)
#pragma unroll
                for (int ks = 0; ks < 4; ++ks) vf[dt][ks] = *(const bf16x8*)(st + v_base + (dt + 2 * gp) * 4096 + (((2 * ks + h) ^ v_sw) << 4));
            __builtin_amdgcn_s_setprio(1);
#pragma unroll
            for (int ks = 0; ks < 4; ++ks)
#pragma unroll
                for (int dt = 0; dt < 2; ++dt) o[dt + 2 * gp] = MFMA32(vf[dt][ks], pf[ks], o[dt + 2 * gp]);
            __builtin_amdgcn_s_setprio(0);
            SB();
        }
    }
#undef B_ISSUE
    __syncthreads();
    l += __shfl_xor(l, 32);
    l_out = l;
}

DI void attn_pass_a(const bf16_t* __restrict__ Qp, const bf16_t* __restrict__ Kb, int kpitch, const bf16_t* __restrict__ Vtb, float mref, f32x16 (&o)[2], float& l_out, char* lds) {
    constexpr int STAGE = 16384, NTL = S / 64;
    const int tid = otid(), lane = tid & 63, r32 = lane & 31, h = lane >> 5;
    bf16x8 qf[4];
#pragma unroll
    for (int d0 = 0; d0 < 4; ++d0) qf[d0] = *(const bf16x8*)(Qp + 16 * d0 + 8 * h);
    const int srow = tid >> 3, sch = (tid & 7) ^ ((srow >> 1) & 7);
    const bf16_t* kg = Kb + (size_t)srow * kpitch + sch * 8;
    const bf16_t* vg = Vtb + (size_t)srow * S + sch * 8;
    char* const ld = lds + tid * 16;
#define AA_ISSUE(t_, st_) do { char* sn_ = ld + (st_) * STAGE; glds16(kg + (size_t)(t_) * 64 * kpitch, sn_); glds16(vg + (t_) * 64, sn_ + 8192); } while (0)
    waitv<0>();
    AA_ISSUE(0, 0); AA_ISSUE(1, 1); AA_ISSUE(2, 2);
    const int pi = (r32 & 0x13) | ((r32 & 4) << 1) | ((r32 & 8) >> 1);
    const int k_base = pi * 128, k_sw = (pi >> 1) & 7, v_base = 8192 + r32 * 128, v_sw = (r32 >> 1) & 7;
    f32x16 negm, lacc;
#pragma unroll
    for (int r = 0; r < 16; ++r) { negm[r] = -mref; lacc[r] = 0.f; o[0][r] = 0.f; o[1][r] = 0.f; }
    const bf16x8 ones = {(short)0x3F80, (short)0x3F80, (short)0x3F80, (short)0x3F80, (short)0x3F80, (short)0x3F80, (short)0x3F80, (short)0x3F80};
    f32x16 sA[2], sB[2];
#define AA_QK(DST, stp_) do { bf16x8 kf_[2][4]; \
        _Pragma("unroll") for (int kt = 0; kt < 2; ++kt) _Pragma("unroll") for (int d0 = 0; d0 < 4; ++d0) kf_[kt][d0] = *(const bf16x8*)((stp_) + kt * 4096 + k_base + (((2 * d0 + h) ^ k_sw) << 4)); \
        SB(); __builtin_amdgcn_s_setprio(1); \
        DST[0] = MFMA32(kf_[0][0], qf[0], negm); DST[1] = MFMA32(kf_[1][0], qf[0], negm); \
        _Pragma("unroll") for (int d0 = 1; d0 < 4; ++d0) { DST[0] = MFMA32(kf_[0][d0], qf[d0], DST[0]); DST[1] = MFMA32(kf_[1][d0], qf[d0], DST[1]); } \
        __builtin_amdgcn_s_setprio(0); } while (0)
    waitv<4>();
    rawbar();
    AA_QK(sA, lds);
#define AA_STEP(CUR, NXT, t_) do { const int t = (t_); \
        if (t + 2 < NTL) waitv<2>(); else waitv<0>();              \
        rawbar();                                                  \
        if (t + 3 < NTL) AA_ISSUE(t + 3, (t + 3) & 3); \
        const char* st = lds + (t & 3) * STAGE; \
        if (t + 1 < NTL) AA_QK(NXT, lds + ((t + 1) & 3) * STAGE); \
        bf16x8 vf[2][4]; \
        _Pragma("unroll") for (int dt = 0; dt < 2; ++dt) _Pragma("unroll") for (int ks = 0; ks < 4; ++ks) vf[dt][ks] = *(const bf16x8*)(st + v_base + dt * 4096 + (((2 * ks + h) ^ v_sw) << 4)); \
        SB(); \
        _Pragma("unroll") for (int kt = 0; kt < 2; ++kt) _Pragma("unroll") for (int r = 0; r < 16; ++r) CUR[kt][r] = fast_exp2(CUR[kt][r]); \
        bf16x8 pf[4]; \
        _Pragma("unroll") for (int ks = 0; ks < 4; ++ks) { const int kt = ks >> 1, b = (ks & 1) * 8; \
            u32x4 w = {pk2(CUR[kt][b], CUR[kt][b + 1]), pk2(CUR[kt][b + 2], CUR[kt][b + 3]), pk2(CUR[kt][b + 4], CUR[kt][b + 5]), pk2(CUR[kt][b + 6], CUR[kt][b + 7])}; \
            pf[ks] = __builtin_bit_cast(bf16x8, w); } \
        SB(); __builtin_amdgcn_s_setprio(1); \
        _Pragma("unroll") for (int ks = 0; ks < 4; ++ks) { _Pragma("unroll") for (int dt = 0; dt < 2; ++dt) o[dt] = MFMA32(vf[dt][ks], pf[ks], o[dt]); lacc = MFMA32(ones, pf[ks], lacc); } \
        __builtin_amdgcn_s_setprio(0); SB(); } while (0)
    for (int t2 = 0; t2 < NTL; t2 += 2) { AA_STEP(sA, sB, t2); AA_STEP(sB, sA, t2 + 1); }
#undef AA_STEP
#undef AA_QK
#undef AA_ISSUE
    __syncthreads();
    l_out = lacc[0];
}

DI void phase_attn(const Params& p, int l, int rep, char* lds) {
    const int tid = otid(), lane = tid & 63, wid = tid >> 6, r32 = lane & 31, h = lane >> 5;
    const bf16_t* Q = (const bf16_t*)(p.ws + OFF_Q); const bf16_t* QD = (const bf16_t*)(p.ws + OFF_QD); const bf16_t* KA = (const bf16_t*)(p.ws + OFF_KA);
    const bf16_t* VTA = (const bf16_t*)(p.ws + OFF_VTA); const bf16_t* KD = (const bf16_t*)(p.ws + OFF_KD); const bf16_t* VTD = (const bf16_t*)(p.ws + OFF_VTD);
    bf16_t* ATTA = (bf16_t*)(p.ws + OFF_ATTA); bf16_t* OD = (bf16_t*)(p.ws + OFF_OD); float* BO0 = (float*)(p.ws + OFF_N);
    const float lam = ((const float*)(p.ws + OFF_LAM))[l];
    const float oml = 1.0f - (l == 0 ? 0.2f : 0.35550906759096926f);
    float bA;
    { float gq = __builtin_fabsf(p.qk_g[l * 128 + lane]), gk = __builtin_fabsf(p.qk_g[l * 128 + 64 + lane]);
#pragma unroll
      for (int o_ = 32; o_ > 0; o_ >>= 1) { gq = __builtin_fmaxf(gq, __shfl_xor(gq, o_)); gk = __builtin_fmaxf(gk, __shfl_xor(gk, o_)); }
      bA = 64.0f * gq * gk * QSCALE * 1.01f; }
    unsigned* qcnt = (unsigned*)(p.ws + OFF_STAT) + 32 + l + 2 * rep;
    const unsigned* stat = (const unsigned*)(p.ws + OFF_STAT) + l * 16;
    volatile unsigned* lword = (volatile unsigned*)(lds + 147456 + 16);
    for (;;) {
        if (tid == 0) *lword = atomicAdd(qcnt, 1u);
        __syncthreads();
        const int u = (int)*lword;
        __syncthreads();
        if (u >= 768) break;
        if (PROBE_DUP == 5 && rep && (u < 128 || u >= 640)) continue;
        if (u < 128 || u >= 640) {
            const int hb = u < 64 ? 3 : (u < 128 ? 2 : (u < 704 ? 1 : 0)), qb = u & 63;
            const int token = 256 * qb + 32 * wid + r32;
            const float slope2 = exp2f(-2.0f * (float)(hb + 1)) * LOG2E;
            float* bo = BO0 + (size_t)token * 512 + hb * 128;
            f32x16 o[4]; float ls;
            int tl[2], th[2]; float mi[2];
#pragma unroll
            for (int mp = 0; mp < 2; ++mp) {
                const float qk = sqrtf(__uint_as_float(stat[mp * 4 + hb]) * __uint_as_float(stat[8 + mp * 4 + hb])) * 1.02f;
                const float R = __builtin_fminf((2.0f * qk + 150.0f) / slope2, 40000.0f);
                const int klo = 256 * qb - (int)R - 1, khi = 256 * qb + 255 + (int)R + 1;
                mi[mp] = -qk;
                tl[mp] = klo < 0 ? 0 : (klo >> 6); th[mp] = khi >= S ? (S / 64 - 1) : (khi >> 6);
            }
            if (-mi[0] <= 45.0f) attn_pass_b(QD + (size_t)token * 512 + hb * 64, KD + hb * 64, 512, VTD + (size_t)(hb * 128) * S, slope2, token, tl[0], th[0], -mi[0], o, ls, lds);
            else attn_pass<128, true>(QD + (size_t)token * 512 + hb * 64, KD + hb * 64, 512, VTD + (size_t)(hb * 128) * S, slope2, token, tl[0], th[0], mi[0], o, ls, lds);
            {
                const float inv = 1.0f / ls;
#pragma unroll
                for (int dt = 0; dt < 4; ++dt)
#pragma unroll
                    for (int g = 0; g < 4; ++g) *(f32x4*)(bo + 32 * dt + 8 * g + 4 * h) = (f32x4){o[dt][4 * g] * inv, o[dt][4 * g + 1] * inv, o[dt][4 * g + 2] * inv, o[dt][4 * g + 3] * inv};
            }
            if (-mi[1] <= 45.0f) attn_pass_b(QD + (size_t)token * 512 + 256 + hb * 64, KD + 256 + hb * 64, 512, VTD + (size_t)(hb * 128) * S, slope2, token, tl[1], th[1], -mi[1], o, ls, lds);
            else attn_pass<128, true>(QD + (size_t)token * 512 + 256 + hb * 64, KD + 256 + hb * 64, 512, VTD + (size_t)(hb * 128) * S, slope2, token, tl[1], th[1], mi[1], o, ls, lds);
            {
                const float inv = lam / ls; float ss = 0.f;
#pragma unroll
                for (int dt = 0; dt < 4; ++dt)
#pragma unroll
                    for (int g = 0; g < 4; ++g) {
                        const f32x4 a = *(const f32x4*)(bo + 32 * dt + 8 * g + 4 * h);
#pragma unroll
                        for (int j = 0; j < 4; ++j) { const float v = a[j] - o[dt][4 * g + j] * inv; o[dt][4 * g + j] = v; ss += v * v; }
                    }
                ss += __shfl_xor(ss, 32);
                const float rstd = rsqrtf(ss * (1.0f / 128.0f) + 1e-6f) * oml;
                const float* sg = p.subln_g + l * 128;
                bf16_t* dst = OD + (size_t)token * 512 + hb * 128;
#pragma unroll
                for (int dt = 0; dt < 4; ++dt)
#pragma unroll
                    for (int g = 0; g < 4; ++g) {
                        const int d = 32 * dt + 8 * g + 4 * h;
                        const f32x4 gg = *(const f32x4*)(sg + d);
                        *(u32x2*)(dst + d) = (u32x2){pk2(o[dt][4 * g] * rstd * gg[0], o[dt][4 * g + 1] * rstd * gg[1]), pk2(o[dt][4 * g + 2] * rstd * gg[2], o[dt][4 * g + 3] * rstd * gg[3])};
                    }
            }
        } else {
            const int v = u - 128, kv = v >> 8, hq = kv * 4 + (v & 3), qb = (v >> 2) & 63;
            const int token = 256 * qb + 32 * wid + r32;
            f32x16 o[2]; float ls;
            if (bA <= 40.0f) attn_pass_a(Q + (size_t)token * 512 + hq * 64, KA + kv * 64, 128, VTA + (size_t)(kv * 64) * S, bA, o, ls, lds);
            else attn_pass<64, false>(Q + (size_t)token * 512 + hq * 64, KA + kv * 64, 128, VTA + (size_t)(kv * 64) * S, 0.f, token, 0, S / 64 - 1, 0.f, o, ls, lds);
            const float inv = 1.0f / ls;
            bf16_t* dst = ATTA + (size_t)token * 512 + hq * 64;
#pragma unroll
            for (int dt = 0; dt < 2; ++dt)
#pragma unroll
                for (int g = 0; g < 4; ++g)
                    *(u32x2*)(dst + 32 * dt + 8 * g + 4 * h) = (u32x2){pk2(o[dt][4 * g] * inv, o[dt][4 * g + 1] * inv), pk2(o[dt][4 * g + 2] * inv, o[dt][4 * g + 3] * inv)};
        }
    }
}

#define XB_TMO      128
#define XB_XCNT(j)  (256  + 64 * (j))
#define XB_XSUB(j)  (1280 + 64 * (j))
#define XB_XGEN(j)  (2304 + 64 * (j))
#define XB_TOP      3328
#define XB_TOPGEN   3392
#define XCD_BAR_WORDS 3456
#define XB_SPIN_CAP (1u << 22)
#define LAS __attribute__((address_space(3)))
DI unsigned xb_ld(unsigned* p) { return __hip_atomic_load(p, __ATOMIC_RELAXED, __HIP_MEMORY_SCOPE_AGENT); }
DI unsigned xb_add(unsigned* p, unsigned v) { return __hip_atomic_fetch_add(p, v, __ATOMIC_RELAXED, __HIP_MEMORY_SCOPE_AGENT); }
DI unsigned xb_xcc_id() { return (unsigned)__builtin_amdgcn_s_getreg((3 << 11) | 20) & 0xFu; }
#define XB_SPIN(cond, bar) do { unsigned _sp = 0; while (cond) { __builtin_amdgcn_s_sleep(1); \
    if ((++_sp & 255u) == 0u) { if (xb_ld(&(bar)[XB_TMO])) break; if (_sp > XB_SPIN_CAP) { atomicAdd(&(bar)[XB_TMO], 1u); break; } } } } while (0)
struct XcdBarrier { unsigned* bar; unsigned x; volatile LAS unsigned* st; };
DI XcdBarrier xcd_barrier_post(unsigned* bar, volatile LAS unsigned* st) {
    XcdBarrier b; b.bar = bar; b.x = xb_xcc_id(); b.st = st;
    if (threadIdx.x == 0) (void)xb_add(&bar[XB_XCNT(b.x)], 1u);
    return b;
}
DI void xcd_barrier_complete(unsigned* bar, unsigned x, unsigned& nloc, unsigned& nx) {
    const unsigned G = gridDim.x * gridDim.y * gridDim.z;
    unsigned sum, cnt, mine, sp = 0u;
    for (;;) {
        sum = 0u; cnt = 0u; mine = 0u;
#pragma unroll
        for (unsigned j = 0; j < 16; ++j) { const unsigned c = xb_ld(&bar[XB_XCNT(j)]); sum += c; cnt += (c > 0u) ? 1u : 0u; mine = (j == x) ? c : mine; }
        if (sum == G) break;
        __builtin_amdgcn_s_sleep(1);
        if ((++sp & 255u) == 0u) { if (xb_ld(&bar[XB_TMO])) break; if (sp > XB_SPIN_CAP) { atomicAdd(&bar[XB_TMO], 1u); break; } }
    }
    nloc = mine > 0u ? mine : 1u; nx = cnt > 0u ? cnt : 1u;
}
DI void xcd_barrier(const XcdBarrier& b) {
    asm volatile("s_waitcnt vmcnt(0)" ::: "memory");
    __syncthreads();
    if (threadIdx.x == 0) {
        unsigned* bar = b.bar;
        __builtin_amdgcn_s_waitcnt(0);
        unsigned nloc = b.st[0], nx = b.st[1];
        if (nloc == 0u) { xcd_barrier_complete(bar, b.x, nloc, nx); b.st[0] = nloc; b.st[1] = nx; }
        const unsigned old = xb_add(&bar[XB_XSUB(b.x)], 1u);
        const unsigned gen = old / nloc;
        if (old + 1u == (gen + 1u) * nloc) {
            __builtin_amdgcn_fence(__ATOMIC_RELEASE, "agent");
            asm volatile("s_waitcnt vmcnt(0)" ::: "memory");
            const unsigned og = xb_add(&bar[XB_TOP], 1u);
            const unsigned tg = og / nx;
            if (og + 1u == (tg + 1u) * nx) xb_add(&bar[XB_TOPGEN], 1u);
            else XB_SPIN(xb_ld(&bar[XB_TOPGEN]) == tg, bar);
            __builtin_amdgcn_fence(__ATOMIC_ACQUIRE, "agent");
            xb_add(&bar[XB_XGEN(b.x)], 1u);
            asm volatile("s_waitcnt vmcnt(0)" ::: "memory");
        } else {
            XB_SPIN(xb_ld(&bar[XB_XGEN(b.x)]) == gen, bar);
            __builtin_amdgcn_fence(__ATOMIC_ACQUIRE, "agent");
            asm volatile("s_waitcnt vmcnt(0)" ::: "memory");
        }
    }
    __syncthreads();
}

__global__ void __launch_bounds__(512) mega(Params pin) {
    __shared__ __attribute__((aligned(16))) char lds[147456 + 64];
    cg::grid_group grid = cg::this_grid();
    volatile LAS unsigned* xst = (volatile LAS unsigned*)(lds + 147456);
    if (threadIdx.x == 0) { xst[0] = 0u; xst[1] = 0u; }
    __syncthreads();
    const XcdBarrier xb = xcd_barrier_post((unsigned*)(pin.ws + OFF_BAR), xst);
    int rep = 0;
    for (int ph = pin.ph_lo; ph < pin.ph_hi; ++ph) {
        Params p = pin;
        asm volatile("" : "+s"(p.ws), "+s"(p.out), "+s"(p.x));
        bf16_t* nbuf = (bf16_t*)(p.ws + OFF_N);
        bf16_t* act = (bf16_t*)(p.ws + OFF_ACT);
        if (ph == 0) phase_prologue(p, lds);
        else {
            const int l = ph == 23 ? 1 : (ph - 1) / 11, k = ph == 23 ? 11 : (ph - 1) % 11;
            const float* mod = (const float*)(p.ws + OFF_MOD) + l * 9216;
            switch (k) {
            case 0: case 3: case 8: case 11: {
                const int i = k == 0 ? 0 : (k == 3 ? 1 : 2);
                const float* hin = (ph == 1) ? p.x : p.out;
                if (k == 11) phase_norm(hin, p.final_g, nullptr, nullptr, nullptr, p.out);
                else phase_norm(hin, p.norm_g + (l * 3 + i) * D, mod + (3 * i) * D, mod + (3 * i + 1) * D, nbuf, nullptr);
            } break;
            case 1: case 9: {
                const int f = k == 1 ? 0 : 1;
                phase_gateup(nbuf, (const bf16_t*)(p.ws + OFF_WGU + (size_t)(l * 2 + f) * SZ_WGU), act, lds);
            } break;
            case 2: case 10: case 7: {
                if (k == 7) phase_resid((const bf16_t*)(p.ws + OFF_Q), D, (const bf16_t*)(p.ws + OFF_WO + l * SZ_WO), p.out, p.out, mod + 5 * D, rep ? 0.0f : 1.0f, lds);
                else {
                    const int f = k == 2 ? 0 : 1;
                    phase_resid(act, F, (const bf16_t*)(p.ws + OFF_WD + (size_t)(l * 2 + f) * SZ_WD), (ph == 3 && !rep) ? p.x : p.out, p.out, mod + (f == 0 ? 2 : 8) * D, rep ? 0.0f : 0.5f, lds);
                }
            } break;
            case 4: phase_win(p, l, lds); break;
            case 5: phase_attn(p, l, rep, lds); break;
            case 6: phase_merge((const bf16_t*)(p.ws + OFF_ATTA), (const bf16_t*)(p.ws + OFF_OD), (const bf16_t*)(p.ws + OFF_WBA + l * SZ_WB), (const bf16_t*)(p.ws + OFF_WBB + l * SZ_WB),
                                (const bf16_t*)(p.ws + OFF_G), (bf16_t*)(p.ws + OFF_Q), (float*)(p.ws + OFF_N), lds); break;
            default: break;
            }
        }
        if (ph + 1 < pin.ph_hi) { if (ph == pin.ph_lo) grid.sync(); else xcd_barrier(xb); }
        if (PROBE_DUP >= 0 && rep == 0 && (ph == 0 ? PROBE_DUP == 100 : ((ph - 1) % 11 == PROBE_DUP && ph != 23))) { rep = 1; --ph; } else rep = 0;
    }
}

extern "C" void kernel_launch(void* const* d_in, const int* in_sizes, int n_in, void* d_out, int out_size, void* d_ws, size_t ws_size, hipStream_t stream) {
    if (n_in != 18 || out_size != S * D || ws_size < WS_END) { fprintf(stderr, "kernel_launch: unexpected shapes / workspace (n_in %d out %d ws %zu need %zu)\n", n_in, out_size, ws_size, (size_t)WS_END); return; }
    Params p{};
    const float** pp = (const float**)&p;
    for (int i = 0; i < 18; ++i) pp[i] = (const float*)d_in[i];
    p.out = (float*)d_out; p.ws = (unsigned char*)d_ws;
    if (hipMemsetAsync((char*)d_ws + OFF_BAR, 0, 3456 * 4, stream) != hipSuccess) { fprintf(stderr, "kernel_launch: hipMemsetAsync of the barrier words failed\n"); return; }
#if MK_MULTI
    for (int ph = 0; ph < NPH; ++ph) { p.ph_lo = ph; p.ph_hi = ph + 1; hipLaunchKernelGGL(mega, dim3(256), dim3(512), 0, stream, p); }
#else
    static int grid = 0;
    if (!grid) {
        int dev = 0, cus = 0, per_cu = 0;
        hipGetDevice(&dev); hipDeviceGetAttribute(&cus, hipDeviceAttributeMultiprocessorCount, dev);
        hipOccupancyMaxActiveBlocksPerMultiprocessor(&per_cu, (const void*)mega, 512, 0);
        if (per_cu < 1) { fprintf(stderr, "kernel_launch: occupancy query says %d blocks per CU\n", per_cu); per_cu = 1; }
        grid = cus;
    }
    p.ph_lo = 0; p.ph_hi = NPH;
    void* args[] = {&p};
    hipError_t e = hipLaunchCooperativeKernel((const void*)mega, dim3(grid), dim3(512), args, 0, stream);
    if (e != hipSuccess) fprintf(stderr, "cooperative launch failed: %s (grid %d)\n", hipGetErrorString(e), grid);
#endif
}
```

```cpp
#include <hip/hip_runtime.h>
#include <hip/hip_cooperative_groups.h>
#include <cstdio>
#include <cstdint>
namespace cg = cooperative_groups;

#ifndef MK_MULTI
#define MK_MULTI 0
#endif

#ifndef PROBE_DUP
#define PROBE_DUP -1
#endif
#define DI __device__ __forceinline__
typedef unsigned short bf16_t;
typedef short bf16x8 __attribute__((ext_vector_type(8)));
typedef float f32x4 __attribute__((ext_vector_type(4)));
typedef float f32x16 __attribute__((ext_vector_type(16)));
typedef unsigned u32x4 __attribute__((ext_vector_type(4)));
typedef unsigned u32x2 __attribute__((ext_vector_type(2)));

constexpr int S = 16384, D = 1024, F = 2816, NGU = 5632, NIN = 4352;
constexpr int NPH = 24;
constexpr float QSCALE = 0.125f * 1.4426950408889634f;
constexpr float LOG2E = 1.4426950408889634f;

constexpr size_t OFF_MOD = 0;
constexpr size_t OFF_LAM = 80000;
constexpr size_t OFF_STAT = 80128;
constexpr size_t OFF_ROPE = 81920;
constexpr size_t OFF_BAR = 131072;
constexpr size_t OFF_WGU = 1u << 20;
constexpr size_t SZ_WGU = (size_t)NGU * D * 2;
constexpr size_t OFF_WD = OFF_WGU + 4 * SZ_WGU;
constexpr size_t SZ_WD = (size_t)D * F * 2;
constexpr size_t OFF_WIN = OFF_WD + 4 * SZ_WD;
constexpr size_t SZ_WIN = (size_t)NIN * D * 2;
constexpr size_t OFF_WBA = OFF_WIN + 2 * SZ_WIN;
constexpr size_t SZ_WB = (size_t)D * 512 * 2;
constexpr size_t OFF_WBB = OFF_WBA + 2 * SZ_WB;
constexpr size_t OFF_WO = OFF_WBB + 2 * SZ_WB;
constexpr size_t SZ_WO = (size_t)D * D * 2;
constexpr size_t OFF_N = OFF_WO + 2 * SZ_WO;
constexpr size_t OFF_MIX = OFF_N + (size_t)S * D * 2;
constexpr size_t OFF_Q = OFF_MIX;
constexpr size_t OFF_QD = OFF_Q + (size_t)S * 512 * 2;
constexpr size_t OFF_KA = OFF_QD + (size_t)S * 512 * 2;
constexpr size_t OFF_VTA = OFF_KA + (size_t)S * 128 * 2;
constexpr size_t OFF_KD = OFF_VTA + (size_t)S * 128 * 2;
constexpr size_t OFF_VTD = OFF_KD + (size_t)S * 512 * 2;
constexpr size_t OFF_G = OFF_VTD + (size_t)S * 512 * 2;
constexpr size_t OFF_ATTA = OFF_G + (size_t)S * 2048 * 2;
constexpr size_t OFF_OD = OFF_ATTA + (size_t)S * 512 * 2;
constexpr size_t OFF_ACT = OFF_MIX;
constexpr size_t WS_END = OFF_OD + (size_t)S * 512 * 2;
static_assert((size_t)S * F * 2 <= WS_END - OFF_MIX, "act overlay");

struct Params {
    const float *x, *c, *ada_w, *ada_b, *norm_g, *ffn_wg, *ffn_wu, *ffn_wd, *w_in, *qk_g, *lam_p, *subln_g, *w_ba, *w_bb, *w_gate, *b_gate, *w_o, *final_g;
    float* out; unsigned char* ws; int ph_lo, ph_hi;
};

typedef __bf16 bf16v2 __attribute__((ext_vector_type(2)));
typedef float f32x2 __attribute__((ext_vector_type(2)));
DI unsigned pk2(float lo, float hi) { f32x2 v = {lo, hi}; bf16v2 b = __builtin_convertvector(v, bf16v2); return __builtin_bit_cast(unsigned, b); }
DI float bf_lo(unsigned u) { return __uint_as_float(u << 16); }
DI float bf_hi(unsigned u) { return __uint_as_float(u & 0xffff0000u); }
DI int lds_off(int row, int chunk) { return row * 128 + ((chunk ^ ((row >> 1) & 7)) << 4); }
DI float fast_exp2(float x) { return __builtin_amdgcn_exp2f(x); }
DI float fast_rcp(float x) { return __builtin_amdgcn_rcpf(x); }
DI int otid() { int t = threadIdx.x; asm volatile("" : "+v"(t)); return t; }
#define SB() __builtin_amdgcn_sched_barrier(0)

DI int perm64(int n) { return (n & ~63) | (((n >> 2) & 3) << 4) | (((n >> 4) & 3) << 2) | (n & 3); }
DI int gumap(int j) { return 128 * (j >> 6) + 64 * ((j >> 5) & 1) + 16 * ((j >> 2) & 1) + 4 * ((j >> 3) & 3) + (j & 3); }

struct TrDesc { const float* src; bf16_t* dst; int N, k0, n0, ldd, mode, roff; };
DI void tr_decode(const Params& p, int tt, TrDesc& d) {
    constexpr int N_TR_L = 5824;
    const int l = tt / N_TR_L, r = tt % N_TR_L;
    if (r < 4224) {
        const int f = r / 2112, r2 = r % 2112, which = r2 / 704, r3 = r2 % 704;
        const size_t lf = (size_t)(l * 2 + f);
        if (which < 2) { d.src = (which == 0 ? p.ffn_wg : p.ffn_wu) + lf * D * F; d.N = F; d.k0 = (r3 / 44) * 64; d.n0 = (r3 % 44) * 64; d.dst = (bf16_t*)(p.ws + OFF_WGU + lf * SZ_WGU); d.ldd = D; d.mode = 3; d.roff = which * 128; }
        else { d.src = p.ffn_wd + lf * F * D; d.N = D; d.k0 = (r3 / 16) * 64; d.n0 = (r3 % 16) * 64; d.dst = (bf16_t*)(p.ws + OFF_WD + lf * SZ_WD); d.ldd = F; d.mode = 0; d.roff = 0; }
    } else if (r < 4800) { const int r3 = r - 4224; d.src = p.w_in + (size_t)l * D * 2304; d.N = 2304; d.k0 = (r3 / 36) * 64; d.n0 = (r3 % 36) * 64; d.dst = (bf16_t*)(p.ws + OFF_WIN + l * SZ_WIN); d.ldd = D; d.mode = 0; d.roff = 0; }
    else if (r < 5312) { const int r3 = r - 4800; d.src = p.w_gate + (size_t)l * D * 2048; d.N = 2048; d.k0 = (r3 / 32) * 64; d.n0 = (r3 % 32) * 64; d.dst = (bf16_t*)(p.ws + OFF_WIN + l * SZ_WIN); d.ldd = D; d.mode = 0; d.roff = 2304; }
    else if (r < 5440) { const int r3 = r - 5312; d.src = p.w_ba + (size_t)l * 512 * D; d.N = D; d.k0 = (r3 / 16) * 64; d.n0 = (r3 % 16) * 64; d.dst = (bf16_t*)(p.ws + OFF_WBA + l * SZ_WB); d.ldd = 512; d.mode = 1; d.roff = 0; }
    else if (r < 5568) { const int r3 = r - 5440; d.src = p.w_bb + (size_t)l * 512 * D; d.N = D; d.k0 = (r3 / 16) * 64; d.n0 = (r3 % 16) * 64; d.dst = (bf16_t*)(p.ws + OFF_WBB + l * SZ_WB); d.ldd = 512; d.mode = 1; d.roff = 0; }
    else { const int r3 = r - 5568; d.src = p.w_o + (size_t)l * D * D; d.N = D; d.k0 = (r3 / 16) * 64; d.n0 = (r3 % 16) * 64; d.dst = (bf16_t*)(p.ws + OFF_WO + l * SZ_WO); d.ldd = D; d.mode = 0; d.roff = 0; }
}
DI void tr_load(const TrDesc& d, int tid, f32x4 (&v)[2]) {
    const int kk = tid >> 4, nn4 = (tid & 15) * 4;
#pragma unroll
    for (int ps = 0; ps < 2; ++ps) v[ps] = *(const f32x4*)(d.src + (size_t)(d.k0 + kk + 32 * ps) * d.N + d.n0 + nn4);
}
DI void tr_store(const TrDesc& d, int tid, const f32x4 (&v)[2], float* ldsf) {
    {
        const int kk = tid >> 4, nn4 = (tid & 15) * 4;
#pragma unroll
        for (int ps = 0; ps < 2; ++ps) { const int k = kk + 32 * ps; ldsf[k * 65 + nn4 + 0] = v[ps][0]; ldsf[k * 65 + nn4 + 1] = v[ps][1]; ldsf[k * 65 + nn4 + 2] = v[ps][2]; ldsf[k * 65 + nn4 + 3] = v[ps][3]; }
    }
    __syncthreads();
    {
        const int n = tid >> 3, ch = tid & 7, gn = d.n0 + n;
        int drow;
        if (d.mode == 0) drow = gn + d.roff; else if (d.mode == 1) drow = perm64(gn); else drow = 256 * (gn >> 7) + (gn & 127) + d.roff;
        float w[8];
#pragma unroll
        for (int i = 0; i < 8; ++i) w[i] = ldsf[(ch * 8 + i) * 65 + n];
        u32x4 pk = {pk2(w[0], w[1]), pk2(w[2], w[3]), pk2(w[4], w[5]), pk2(w[6], w[7])};
        *(u32x4*)(d.dst + (size_t)drow * d.ldd + d.k0 + ch * 8) = pk;
    }
    __syncthreads();
}

DI void phase_prologue(const Params& p, char* lds) {
    const int tid = otid();
    float* ldsf = (float*)lds;
    constexpr int N_MOD = 288, N_TR = 2 * 5824;
    for (int it = blockIdx.x; it < N_MOD; it += gridDim.x) {
        const int l = it / 144, j0 = (it % 144) * 64, jj = tid & 15, ii = tid >> 4;
        float* cact = ldsf + 2048;
        for (int i = tid; i < 1024; i += 512) { const float cv = p.c[i]; cact[i] = cv / (1.f + expf(-cv)); }
        __syncthreads();
        f32x4 a = {0.f, 0.f, 0.f, 0.f};
        const float* wb = p.ada_w + (size_t)l * 1024 * 9216 + j0 + 4 * jj;
#pragma unroll 8
        for (int r = 0; r < 32; ++r) { const int i = ii + 32 * r; a += cact[i] * *(const f32x4*)(wb + (size_t)i * 9216); }
        *(f32x4*)(ldsf + ii * 64 + 4 * jj) = a;
        __syncthreads();
        if (tid < 64) {
            float sm = 0.f;
#pragma unroll
            for (int r = 0; r < 32; ++r) sm += ldsf[r * 64 + tid];
            ((float*)(p.ws + OFF_MOD))[l * 9216 + j0 + tid] = sm + p.ada_b[l * 9216 + j0 + tid];
        }
        __syncthreads();
    }
    if (blockIdx.x == gridDim.x - 1) {
        if (tid < 64) {
#pragma unroll
            for (int l = 0; l < 2; ++l) {
                const float* lp = p.lam_p + l * 256;
                float a = lp[tid] * lp[64 + tid], b = lp[128 + tid] * lp[192 + tid];
#pragma unroll
                for (int o = 32; o > 0; o >>= 1) { a += __shfl_xor(a, o); b += __shfl_xor(b, o); }
                const float li = l == 0 ? 0.2f : 0.35550906759096926f;
                if (tid == 0) ((float*)(p.ws + OFF_LAM))[l] = expf(a) - expf(b) + li;
            }
        }
        if (tid < 64) ((unsigned*)(p.ws + OFF_STAT))[tid] = 0u;
        float* rope = (float*)(p.ws + OFF_ROPE);
        for (int e = tid; e < 320 * 16; e += 512) {
            const int pi = e >> 4, i = e & 15;
            const int pos = pi < 256 ? pi - 128 : (pi - 256) - 32;
            const float inv = exp2f(-(float)i * (13.287712379549449f / 16.0f));
            const float angf = (float)pos * inv;
            double r = (double)angf; r -= rint(r * 0.15915494309189535) * 6.283185307179586;
            const double r2 = r * r;
            double sn = 0.0, cs = 0.0;
#pragma unroll 1
            for (int n = 14; n >= 1; --n) { sn = (sn + 1.0) * (-r2 / (double)((2 * n) * (2 * n + 1))); cs = (cs + 1.0) * (-r2 / (double)((2 * n - 1) * (2 * n))); }
            sn = (sn + 1.0) * r; cs = cs + 1.0;
            if (pi < 256) { rope[pi * 16 + i] = (float)cs; rope[4096 + pi * 16 + i] = (float)sn; }
            else { rope[8192 + (pi - 256) * 16 + i] = (float)cs; rope[9216 + (pi - 256) * 16 + i] = (float)sn; }
        }
    }
    {
        int tt = blockIdx.x;
        TrDesc d; f32x4 v[2];
        if (tt < N_TR) { tr_decode(p, tt, d); tr_load(d, tid, v); }
        while (tt < N_TR) {
            const int tn = tt + gridDim.x;
            TrDesc dn; f32x4 vn[2];
            if (tn < N_TR) { tr_decode(p, tn, dn); tr_load(dn, tid, vn); }
            tr_store(d, tid, v, ldsf);
            if (tn < N_TR) { d = dn; v[0] = vn[0]; v[1] = vn[1]; }
            tt = tn;
        }
    }
}

DI void phase_norm(const float* hin, const float* __restrict__ g, const float* __restrict__ sh, const float* __restrict__ sc, bf16_t* nout, float* fout) {
    const int tid_ = otid(), lane = tid_ & 63, wid = tid_ >> 6;
    const int nw = gridDim.x * 8;
    for (int row = blockIdx.x * 8 + wid; row < S; row += nw) {
        const float* hp = hin + (size_t)row * D;
        f32x4 v[4]; float ss = 0.f;
#pragma unroll
        for (int i = 0; i < 4; ++i) { v[i] = *(const f32x4*)(hp + (i * 64 + lane) * 4); ss += v[i][0] * v[i][0] + v[i][1] * v[i][1] + v[i][2] * v[i][2] + v[i][3] * v[i][3]; }
#pragma unroll
        for (int o = 32; o > 0; o >>= 1) ss += __shfl_xor(ss, o);
        const float rstd = rsqrtf(ss * (1.0f / 1024.0f) + 1e-6f);
#pragma unroll
        for (int i = 0; i < 4; ++i) {
            const int col = (i * 64 + lane) * 4;
            const f32x4 gv = *(const f32x4*)(g + col);
            f32x4 y = v[i] * rstd * gv;
            if (sc) { const f32x4 s1 = *(const f32x4*)(sc + col), s0 = *(const f32x4*)(sh + col); y = y * (1.0f + s1) + s0; }
            if (fout) *(f32x4*)(fout + (size_t)row * D + col) = y;
            else { u32x2 pk = {pk2(y[0], y[1]), pk2(y[2], y[3])}; *(u32x2*)(nout + (size_t)row * D + col) = pk; }
        }
    }
}

DI void glds16(const void* g, char* l) { __builtin_amdgcn_global_load_lds((const unsigned*)g, (unsigned*)l, 16, 0, 0); }
template <int N> DI void waitv() { asm volatile("s_waitcnt vmcnt(%0)" ::"n"(N) : "memory"); }
DI void rawbar() { __builtin_amdgcn_s_barrier(); }
constexpr int GST = 49152;
DI void gemm_mainloop(const bf16_t* __restrict__ A, int lda, const bf16_t* __restrict__ W, int ldw, int K, f32x4 (&acc)[4][4], char* lds) {
    const int tid = otid(), lane = tid & 63, wid = tid >> 6, wt = wid >> 1, wc = wid & 1;
    const int srow = tid >> 3, sch = (tid & 7) ^ ((srow >> 1) & 7);
    const bf16_t* ag = A + (size_t)srow * lda + sch * 8;
    const bf16_t* wg = W + (size_t)srow * ldw + sch * 8;
    char* const ld = lds + tid * 16;
    const int nk = K >> 6;
#define G_ISSUE(kt_, st_) do { const int ko_ = (kt_) * 64; char* sn_ = ld + (st_) * GST; \
        _Pragma("unroll") for (int i = 0; i < 4; ++i) glds16(ag + (size_t)(64 * i) * lda + ko_, sn_ + i * 8192); \
        _Pragma("unroll") for (int i = 0; i < 2; ++i) glds16(wg + (size_t)(64 * i) * ldw + ko_, sn_ + 32768 + i * 8192); } while (0)
    waitv<0>();
    G_ISSUE(0, 0); G_ISSUE(1, 1);
    const int fr = lane & 15, fq = lane >> 4, sw = (fr >> 1) & 7;
    const int a_base = (64 * wt + fr) * 128, w_base = 32768 + (64 * wc + fr) * 128;
    int cur = 0, nxt = 2;
    for (int kt = 0; kt < nk; ++kt) {
        if (kt + 1 < nk) waitv<6>(); else waitv<0>();
        rawbar();
        if (kt + 2 < nk) G_ISSUE(kt + 2, nxt);
        const char* st = lds + cur * GST;
#pragma unroll
        for (int kk = 0; kk < 2; ++kk) {
            const int co = ((kk * 4 + fq) ^ sw) << 4;
            bf16x8 af[4], wf[4];
#pragma unroll
            for (int i = 0; i < 4; ++i) af[i] = *(const bf16x8*)(st + a_base + i * 2048 + co);
#pragma unroll
            for (int i = 0; i < 4; ++i) wf[i] = *(const bf16x8*)(st + w_base + i * 2048 + co);
#pragma unroll
            for (int mw = 0; mw < 4; ++mw)
#pragma unroll
                for (int nt = 0; nt < 4; ++nt) acc[mw][nt] = __builtin_amdgcn_mfma_f32_16x16x32_bf16(wf[mw], af[nt], acc[mw][nt], 0, 0, 0);
        }
        cur = cur == 2 ? 0 : cur + 1; nxt = nxt == 2 ? 0 : nxt + 1;
    }
#undef G_ISSUE
    __syncthreads();
}
constexpr int GST2 = 65536;
DI void gemm_mainloop2(const bf16_t* __restrict__ A, int lda, const bf16_t* __restrict__ W, int ldw, int K, f32x4 (&acc)[4][8], char* lds) {
    const int tid = otid(), lane = tid & 63, wid = tid >> 6, wt = wid >> 2, wc = wid & 3;
    const int srow = tid >> 3, sch = (tid & 7) ^ ((srow >> 1) & 7);
    const bf16_t* ag = A + (size_t)srow * lda + sch * 8;
    const bf16_t* wg = W + (size_t)srow * ldw + sch * 8;
    char* const ld = lds + tid * 16;
    const int nk = K >> 6;
#define G2_ISSUE(kt_, st_) do { const int ko_ = (kt_) * 64; char* sn_ = ld + (st_) * GST2; \
        _Pragma("unroll") for (int i = 0; i < 4; ++i) glds16(ag + (size_t)(64 * i) * lda + ko_, sn_ + i * 8192); \
        _Pragma("unroll") for (int i = 0; i < 4; ++i) glds16(wg + (size_t)(64 * i) * ldw + ko_, sn_ + 32768 + i * 8192); } while (0)
    waitv<0>();
    G2_ISSUE(0, 0);
    const int fr = lane & 15, fq = lane >> 4, sw = (fr >> 1) & 7;
    const int a_base = (128 * wt + fr) * 128, w_base = 32768 + (64 * wc + fr) * 128;
    for (int kt = 0; kt < nk; ++kt) {
        waitv<0>();
        rawbar();
        if (kt + 1 < nk) G2_ISSUE(kt + 1, (kt + 1) & 1);
        const char* st = lds + (kt & 1) * GST2;
#pragma unroll
        for (int kk = 0; kk < 2; ++kk) {
            const int co = ((kk * 4 + fq) ^ sw) << 4;
            bf16x8 wf[4], af[2][2];
#pragma unroll
            for (int i = 0; i < 4; ++i) wf[i] = *(const bf16x8*)(st + w_base + i * 2048 + co);
#pragma unroll
            for (int i = 0; i < 2; ++i) af[0][i] = *(const bf16x8*)(st + a_base + i * 2048 + co);
#pragma unroll
            for (int ip = 0; ip < 4; ++ip) {
                if (ip < 3) {
#pragma unroll
                    for (int i = 0; i < 2; ++i) af[(ip + 1) & 1][i] = *(const bf16x8*)(st + a_base + (2 * ip + 2 + i) * 2048 + co);
                }
                __builtin_amdgcn_s_setprio(1);
#pragma unroll
                for (int i = 0; i < 2; ++i)
#pragma unroll
                    for (int mw = 0; mw < 4; ++mw) acc[mw][2 * ip + i] = __builtin_amdgcn_mfma_f32_16x16x32_bf16(wf[mw], af[ip & 1][i], acc[mw][2 * ip + i], 0, 0, 0);
                __builtin_amdgcn_s_setprio(0);
                SB();
            }
        }
    }
#undef G2_ISSUE
    __syncthreads();
}
DI void zero_acc2(f32x4 (&acc)[4][8]) {
#pragma unroll
    for (int a = 0; a < 4; ++a)
#pragma unroll
        for (int b = 0; b < 8; ++b) acc[a][b] = (f32x4){0.f, 0.f, 0.f, 0.f};
}
DI void zero_acc(f32x4 (&acc)[4][4]) {
#pragma unroll
    for (int a = 0; a < 4; ++a)
#pragma unroll
        for (int b = 0; b < 4; ++b) acc[a][b] = (f32x4){0.f, 0.f, 0.f, 0.f};
}

namespace pg8 {
#define PG8_LAS __attribute__((address_space(3)))
constexpr int BM = 256, BK = 64, HALF = 128, HTB = HALF * BK * 2  , STAGE_BYTES = 8 * HTB, NXCD = 8, WGM = 8;

__host__ __device__ __forceinline__ int lds_byte(int r, int c) { const int st = (r >> 4) * 2 + (c >> 5), rr = r & 15, cc = c & 31, ob = rr * 64 + cc * 2; return st * 1024 + (ob ^ (((ob >> 9) & 1) << 5)); }
__host__ __device__ __forceinline__ void stage_rc(int b, int& R, int& C) { const int st = b / 1024, sb = b % 1024, swz = sb ^ (((sb >> 9) & 1) << 5); R = (st >> 1) * 16 + swz / 64; C = (st & 1) * 32 + (swz % 64) / 2; }
__host__ __device__ __forceinline__ int perm32(int rho) { const int n = rho >> 4, i = rho & 15; return 8 * (i >> 2) + 4 * n + (i & 3); }

struct Unit { int pm, pn; };
struct Gemm { const bf16_t* A; const bf16_t* Bt; int M, N, K; };

struct StaticOrder {
    int nM, nN, nwg, G, c;
    __host__ __device__ void init(int M, int N, int G_, int c_) { nM = M / BM; nN = N / BM; nwg = nM * nN; G = G_; c = c_; }
    __host__ __device__ bool next(int i, Unit& u) const {
        const long L = (long)i * G + c; if (L >= nwg) return false;
        int wgid = (int)L; { const int q = nwg / NXCD, r = nwg % NXCD, xcd = wgid % NXCD, off = wgid / NXCD; wgid = (xcd < r ? xcd * (q + 1) : r * (q + 1) + (xcd - r) * q) + off; }
        const int nig = WGM * nN, gid = wgid / nig, fm = gid * WGM, gsz = (nM - fm) < WGM ? (nM - fm) : WGM;
        u.pm = fm + ((wgid % nig) % gsz); u.pn = (wgid % nig) / gsz; return true;
    }
    __device__ __forceinline__ void a_ready(const Unit&) const {}
    __device__ __forceinline__ void done(const Unit&) const {}
};
template <class Epi, class Sched, bool ALIGN_EPI = false, bool SP2 = false>
__device__ __forceinline__ void gemm_phase(PG8_LAS unsigned char* lds, const Gemm g, const Sched& S, const Epi& E) {
    const int tid = ::otid(), wid = __builtin_amdgcn_readfirstlane(tid >> 6), lane = tid & 63, wr = wid >> 2, wc = wid & 3, fr = lane & 15, fq = lane >> 4;
    const int K = g.K, nt = K / BK;
    unsigned voffA[2], voffB[2];
#pragma unroll
    for (int i = 0; i < 2; ++i) { int R, C; stage_rc(tid * 16 + i * 8192, R, C); const int Rb = Epi::PERM ? ((R & ~31) + perm32(R & 31)) : R;
        voffA[i] = (unsigned)(R * K + C) * 2u; voffB[i] = (unsigned)(Rb * K + C) * 2u; }
    const size_t kstep = (size_t)(BK * 2);
    const size_t hstep = (size_t)HALF * K * 2;
    const size_t tstep = 2 * hstep;
    const unsigned ldsw = (unsigned)wid * 1024u;
    const int aoff = lds_byte(wr * 64 + fr, fq * 8), boff = lds_byte(wc * 32 + fr, fq * 8);
#define PG8_SA(b, h) (((b) * 2 + (h)) * HTB)
#define PG8_SB(b, h) ((4 + (b) * 2 + (h)) * HTB)
#define PG8_STAGE(bufoff, gbase, voff) do { _Pragma("unroll") for (int _i = 0; _i < 2; ++_i) \
        __builtin_amdgcn_global_load_lds((const unsigned*)((const char*)(gbase) + (voff)[_i]), (PG8_LAS unsigned*)(lds + (bufoff) + ldsw + _i * 8192), 16, 0, 0); } while (0)
#define PG8_LDA(dst, b, h) do { _Pragma("unroll") for (int m = 0; m < 4; ++m) _Pragma("unroll") for (int k = 0; k < 2; ++k) dst[m][k] = *(const PG8_LAS bf16x8*)(lds + PG8_SA(b, h) + aoff + m * 2048 + k * 1024); } while (0)
#define PG8_LDB(dst, b, h) do { _Pragma("unroll") for (int n = 0; n < 2; ++n) _Pragma("unroll") for (int k = 0; k < 2; ++k) dst[n][k] = *(const PG8_LAS bf16x8*)(lds + PG8_SB(b, h) + boff + n * 2048 + k * 1024); } while (0)
#define PG8_MMA(ai, bj, At, Bt) do { __builtin_amdgcn_s_setprio(1); _Pragma("unroll") for (int m = 0; m < 4; ++m) _Pragma("unroll") for (int n = 0; n < 2; ++n) _Pragma("unroll") for (int k = 0; k < 2; ++k) \
        acc[ai][bj][m][n] = __builtin_amdgcn_mfma_f32_16x16x32_bf16(Bt[n][k], At[m][k], acc[ai][bj][m][n], 0, 0, 0); __builtin_amdgcn_s_setprio(0); } while (0)
#define PG8_WAIT_V(n) asm volatile("s_waitcnt vmcnt(" #n ")" ::: "memory")
#define PG8_WAIT_L(n) asm volatile("s_waitcnt lgkmcnt(" #n ")" ::: "memory")
#define PG8_BAR __builtin_amdgcn_s_barrier()
#define PG8_SCHED __builtin_amdgcn_sched_barrier(0)
    Unit cur, nxt; int ui = 0;
    if (!S.next(0, cur)) return;
    f32x4 acc[2][2][4][2];
#pragma unroll
    for (int a = 0; a < 2; ++a)
#pragma unroll
        for (int b = 0; b < 2; ++b)
#pragma unroll
            for (int m = 0; m < 4; ++m)
#pragma unroll
                for (int n = 0; n < 2; ++n) acc[a][b][m][n] = (f32x4){0.f, 0.f, 0.f, 0.f};
    bf16x8 At[4][2], B0[2][2], B1[2][2];
    const char* cA = (const char*)g.A + (size_t)cur.pm * tstep; const char* cB = (const char*)g.Bt + (size_t)cur.pn * tstep;
    S.a_ready(cur);
    if constexpr (SP2) {
        PG8_STAGE(PG8_SB(0, 0), cB, voffB); PG8_STAGE(PG8_SB(0, 1), cB + hstep, voffB); PG8_STAGE(PG8_SA(0, 0), cA, voffA); PG8_STAGE(PG8_SA(0, 1), cA + hstep, voffA);
        if (wr == 1) PG8_BAR;
        PG8_WAIT_V(2); PG8_BAR;
        PG8_STAGE(PG8_SB(1, 0), cB + kstep, voffB); PG8_STAGE(PG8_SA(1, 0), cA + kstep, voffA); PG8_STAGE(PG8_SB(1, 1), cB + hstep + kstep, voffB);
        PG8_WAIT_V(6); PG8_BAR;
    } else {
        PG8_STAGE(PG8_SB(0, 0), cB, voffB); PG8_STAGE(PG8_SA(0, 0), cA, voffA); PG8_STAGE(PG8_SB(0, 1), cB + hstep, voffB); PG8_STAGE(PG8_SA(0, 1), cA + hstep, voffA);
        if (wr == 1) PG8_BAR;
        PG8_WAIT_V(4); PG8_BAR;
        PG8_STAGE(PG8_SB(1, 0), cB + kstep, voffB); PG8_STAGE(PG8_SA(1, 0), cA + kstep, voffA); PG8_STAGE(PG8_SB(1, 1), cB + hstep + kstep, voffB);
        PG8_WAIT_V(6); PG8_BAR;
    }
    for (;;) {
        const bool has_next = S.next(ui + 1, nxt);
        const char* nA = has_next ? (const char*)g.A + (size_t)nxt.pm * tstep : cA; const char* nB = has_next ? (const char*)g.Bt + (size_t)nxt.pn * tstep : cB;
        for (int t = 0; t < nt; t += 2) {
            const bool last = (t == nt - 2);
            const char* a1 = cA + (size_t)(t + 1) * kstep;
            const char* a2 = last ? nA : cA + (size_t)(t + 2) * kstep; const char* b2 = last ? nB : cB + (size_t)(t + 2) * kstep;
            const char* a3 = a2 + kstep; const char* b3 = b2 + kstep;
            if (last && has_next) S.a_ready(nxt);
            if constexpr (SP2) {
            PG8_LDB(B0, 0, 0); PG8_LDB(B1, 0, 1); PG8_SCHED; PG8_LDA(At, 0, 0); PG8_STAGE(PG8_SA(1, 1), a1 + hstep, voffA);
            PG8_WAIT_V(8); PG8_WAIT_L(0); PG8_BAR; PG8_MMA(0, 0, At, B0); PG8_MMA(0, 1, At, B1); PG8_BAR; PG8_SCHED;
            PG8_LDA(At, 0, 1); PG8_STAGE(PG8_SB(0, 0), b2, voffB); PG8_STAGE(PG8_SB(0, 1), b2 + hstep, voffB); PG8_STAGE(PG8_SA(0, 0), a2, voffA);
            PG8_WAIT_V(8); PG8_WAIT_L(0); PG8_BAR; PG8_MMA(1, 0, At, B0); PG8_MMA(1, 1, At, B1); PG8_BAR; PG8_SCHED;
            PG8_LDB(B0, 1, 0); PG8_LDB(B1, 1, 1); PG8_SCHED; PG8_LDA(At, 1, 0); PG8_STAGE(PG8_SA(0, 1), a2 + hstep, voffA);
            PG8_WAIT_V(8); PG8_WAIT_L(0); PG8_BAR; PG8_MMA(0, 0, At, B0); PG8_MMA(0, 1, At, B1); PG8_BAR; PG8_SCHED;
            PG8_LDA(At, 1, 1); PG8_STAGE(PG8_SB(1, 0), b3, voffB); PG8_STAGE(PG8_SB(1, 1), b3 + hstep, voffB); PG8_STAGE(PG8_SA(1, 0), a3, voffA);
            PG8_WAIT_V(8); PG8_WAIT_L(0); PG8_BAR; PG8_MMA(1, 0, At, B0); PG8_MMA(1, 1, At, B1); PG8_BAR; PG8_SCHED;
            } else {
            PG8_LDB(B0, 0, 0); PG8_SCHED; PG8_LDA(At, 0, 0); PG8_STAGE(PG8_SA(1, 1), a1 + hstep, voffA);
            PG8_WAIT_L(8); PG8_BAR; PG8_WAIT_L(0); PG8_MMA(0, 0, At, B0); PG8_BAR; PG8_SCHED;
            PG8_LDB(B1, 0, 1); PG8_STAGE(PG8_SB(0, 0), b2, voffB);
            PG8_BAR; PG8_WAIT_L(0); PG8_MMA(0, 1, At, B1); PG8_BAR;
            PG8_LDA(At, 0, 1); PG8_STAGE(PG8_SA(0, 0), a2, voffA);
            PG8_BAR; PG8_WAIT_L(0); PG8_MMA(1, 0, At, B0); PG8_BAR; PG8_SCHED;
            PG8_STAGE(PG8_SB(0, 1), b2 + hstep, voffB);
            PG8_WAIT_V(6); PG8_BAR; PG8_MMA(1, 1, At, B1); PG8_BAR;
            PG8_LDB(B0, 1, 0); PG8_SCHED; PG8_LDA(At, 1, 0); PG8_STAGE(PG8_SA(0, 1), a2 + hstep, voffA);
            PG8_WAIT_L(8); PG8_BAR; PG8_WAIT_L(0); PG8_MMA(0, 0, At, B0); PG8_BAR; PG8_SCHED;
            PG8_LDB(B1, 1, 1); PG8_STAGE(PG8_SB(1, 0), b3, voffB);
            PG8_BAR; PG8_WAIT_L(0); PG8_MMA(0, 1, At, B1); PG8_BAR;
            PG8_LDA(At, 1, 1); PG8_STAGE(PG8_SA(1, 0), a3, voffA);
            PG8_BAR; PG8_WAIT_L(0); PG8_MMA(1, 0, At, B0); PG8_BAR; PG8_SCHED;
            PG8_STAGE(PG8_SB(1, 1), b3 + hstep, voffB);
            PG8_WAIT_V(6); PG8_BAR; PG8_MMA(1, 1, At, B1); PG8_BAR;
            }
        }
        if constexpr (ALIGN_EPI) { if (wr == 0) PG8_BAR; }
        if constexpr (!Epi::AFTER_DRAIN) { E(acc, cur, wr, wc, fr, fq); S.done(cur); }
        if (!has_next) break;
#pragma unroll
        for (int a = 0; a < 2; ++a)
#pragma unroll
            for (int b = 0; b < 2; ++b)
#pragma unroll
                for (int m = 0; m < 4; ++m)
#pragma unroll
                    for (int n = 0; n < 2; ++n) acc[a][b][m][n] = (f32x4){0.f, 0.f, 0.f, 0.f};
        cur = nxt; cA = nA; cB = nB; ++ui;
        if constexpr (ALIGN_EPI) { if (wr == 1) PG8_BAR; }
    }
    PG8_WAIT_V(0);
    if constexpr (!ALIGN_EPI) { if (wr == 0) PG8_BAR; }
    PG8_BAR;
    if constexpr (Epi::AFTER_DRAIN) { E.fused(acc, cur, wr, wc, fr, fq, lds, wid, lane); S.done(cur); }
#undef PG8_SA
#undef PG8_SB
#undef PG8_STAGE
#undef PG8_LDA
#undef PG8_LDB
#undef PG8_MMA
#undef PG8_WAIT_V
#undef PG8_WAIT_L
#undef PG8_BAR
#undef PG8_SCHED
}
}

struct EpiGateUp {
    static constexpr bool PERM = true, AFTER_DRAIN = false;
    bf16_t* act;
    DI void operator()(const f32x4 (&acc)[2][2][4][2], const pg8::Unit& u, int wr, int wc, int fr, int fq) const {
#pragma unroll
        for (int ai = 0; ai < 2; ++ai)
#pragma unroll
            for (int m = 0; m < 4; ++m) {
                const int token = u.pm * 256 + ai * 128 + wr * 64 + m * 16 + fr;
                float v[8];
#pragma unroll
                for (int n = 0; n < 2; ++n)
#pragma unroll
                    for (int i = 0; i < 4; ++i) { const float gg = acc[ai][0][m][n][i], uu = acc[ai][1][m][n][i]; v[4 * n + i] = gg * fast_rcp(1.0f + __expf(-gg)) * uu; }
                *(u32x4*)(act + (size_t)token * F + 128 * u.pn + 32 * wc + 8 * fq) = (u32x4){pk2(v[0], v[1]), pk2(v[2], v[3]), pk2(v[4], v[5]), pk2(v[6], v[7])};
            }
    }
};
struct EpiResid {
    static constexpr bool PERM = true, AFTER_DRAIN = false;
    const float* hin; float* hout; const float* gvec; float gs;
    DI void operator()(const f32x4 (&acc)[2][2][4][2], const pg8::Unit& u, int wr, int wc, int fr, int fq) const {
        f32x4 gv[2][2];
#pragma unroll
        for (int bj = 0; bj < 2; ++bj)
#pragma unroll
            for (int n = 0; n < 2; ++n) gv[bj][n] = *(const f32x4*)(gvec + u.pn * 256 + bj * 128 + wc * 32 + 8 * fq + 4 * n) * gs;
#pragma unroll
        for (int ai = 0; ai < 2; ++ai)
#pragma unroll
            for (int m = 0; m < 4; ++m) {
                const size_t off = (size_t)(u.pm * 256 + ai * 128 + wr * 64 + m * 16 + fr) * D + u.pn * 256 + wc * 32 + 8 * fq;
#pragma unroll
                for (int bj = 0; bj < 2; ++bj)
#pragma unroll
                    for (int n = 0; n < 2; ++n) { const f32x4 hv = *(const f32x4*)(hin + off + bj * 128 + 4 * n); *(f32x4*)(hout + off + bj * 128 + 4 * n) = hv + gv[bj][n] * acc[ai][bj][m][n]; }
                SB();
            }
    }
};
struct EpiGates {
    static constexpr bool PERM = true, AFTER_DRAIN = false;
    bf16_t* G; const float* bias;
    DI void operator()(const f32x4 (&acc)[2][2][4][2], const pg8::Unit& u, int wr, int wc, int fr, int fq) const {
#pragma unroll
        for (int bj = 0; bj < 2; ++bj) {
            const int gc = u.pn * 256 + bj * 128 + wc * 32 + 8 * fq;
            const f32x4 b0 = *(const f32x4*)(bias + gc), b1 = *(const f32x4*)(bias + gc + 4);
#pragma unroll
            for (int ai = 0; ai < 2; ++ai)
#pragma unroll
                for (int m = 0; m < 4; ++m) {
                    const int token = u.pm * 256 + ai * 128 + wr * 64 + m * 16 + fr;
                    const f32x4 x0 = acc[ai][bj][m][0] + b0, x1 = acc[ai][bj][m][1] + b1; float z[8];
#pragma unroll
                    for (int i = 0; i < 4; ++i) { z[i] = fast_rcp(1.0f + __expf(-x0[i])); z[4 + i] = fast_rcp(1.0f + __expf(-x1[i])); }
                    *(u32x4*)(G + (size_t)token * 2048 + gc) = (u32x4){pk2(z[0], z[1]), pk2(z[2], z[3]), pk2(z[4], z[5]), pk2(z[6], z[7])};
                }
        }
    }
};
template <class Epi> DI void run_pg8(const bf16_t* A, const bf16_t* Bt, int N, int K, const Epi& E, char* lds) {
    pg8::Gemm g; g.A = A; g.Bt = Bt; g.M = S; g.N = N; g.K = K;
    pg8::StaticOrder so; so.init(S, N, (int)gridDim.x, (int)blockIdx.x);
    pg8::gemm_phase<Epi, pg8::StaticOrder, true, true>((PG8_LAS unsigned char*)lds, g, so, E);
}

DI void phase_gateup(const bf16_t* n, const bf16_t* wgu, bf16_t* act, char* lds) {
    EpiGateUp E; E.act = act;
    run_pg8(n, wgu, NGU, D, E, lds);
}

DI void phase_resid(const bf16_t* A, int K, const bf16_t* W, const float* hin, float* hout, const float* __restrict__ gvec, float gs, char* lds) {
    EpiResid E; E.hin = hin; E.hout = hout; E.gvec = gvec; E.gs = gs;
    run_pg8(A, W, D, K, E, lds);
}

DI void phase_merge(const bf16_t* atta, const bf16_t* od, const bf16_t* wba, const bf16_t* wbb, const bf16_t* G, bf16_t* merged, float* spill, char* lds) {
    const int tid_ = otid(), lane = tid_ & 63, wid = tid_ >> 6, wt = wid >> 1, wc = wid & 1, fr = lane & 15, fq = lane >> 4;
    constexpr int NTILES = 64 * 8;
    for (int t = blockIdx.x; t < NTILES; t += gridDim.x) {
        const int bm = t & 63, bn = t >> 6, row0 = bm * 256, ch0 = bn * 128 + 64 * wc + 16 * fq;
        f32x4 acc[4][4]; zero_acc(acc);
        gemm_mainloop(atta + (size_t)row0 * 512, 512, wba + (size_t)bn * 128 * 512, 512, 512, acc, lds);
        float* sp = spill + ((size_t)blockIdx.x * 16 * 512 + tid_) * 4;
#pragma unroll
        for (int nt = 0; nt < 4; ++nt) {
            const bf16_t* gp = G + (size_t)(row0 + 64 * wt + 16 * nt + fr) * 2048 + ch0;
#pragma unroll
            for (int mw = 0; mw < 4; ++mw) { const u32x2 gu = *(const u32x2*)(gp + 4 * mw); const f32x4 ga = {bf_lo(gu[0]), bf_hi(gu[0]), bf_lo(gu[1]), bf_hi(gu[1])};
                *(f32x4*)(sp + (size_t)(nt * 4 + mw) * 2048) = ga * acc[mw][nt]; }
        }
        zero_acc(acc);
        gemm_mainloop(od + (size_t)row0 * 512, 512, wbb + (size_t)bn * 128 * 512, 512, 512, acc, lds);
#pragma unroll
        for (int nt = 0; nt < 4; ++nt) {
            const size_t tok = (size_t)(row0 + 64 * wt + 16 * nt + fr);
            const bf16_t* gp = G + tok * 2048 + 1024 + ch0;
            unsigned w[8];
#pragma unroll
            for (int mw = 0; mw < 4; ++mw) { const u32x2 gu = *(const u32x2*)(gp + 4 * mw); const f32x4 gb = {bf_lo(gu[0]), bf_hi(gu[0]), bf_lo(gu[1]), bf_hi(gu[1])};
                const f32x4 o = *(const f32x4*)(sp + (size_t)(nt * 4 + mw) * 2048) + gb * acc[mw][nt]; w[2 * mw] = pk2(o[0], o[1]); w[2 * mw + 1] = pk2(o[2], o[3]); }
            bf16_t* mp = merged + tok * D + ch0;
            *(u32x4*)(mp) = (u32x4){w[0], w[1], w[2], w[3]};
            *(u32x4*)(mp + 8) = (u32x4){w[4], w[5], w[6], w[7]};
        }
    }
}

DI void phase_win(const Params& p, int l, char* lds) {
    const int tid_ = otid(), lane = tid_ & 63, wid = tid_ >> 6, wt = wid >> 1, wc = wid & 1, fr = lane & 15, fq = lane >> 4;
    const bf16_t* n = (const bf16_t*)(p.ws + OFF_N);
    const bf16_t* W = (const bf16_t*)(p.ws + OFF_WIN + l * SZ_WIN);
    bf16_t* Q = (bf16_t*)(p.ws + OFF_Q); bf16_t* QD = (bf16_t*)(p.ws + OFF_QD); bf16_t* KA = (bf16_t*)(p.ws + OFF_KA); bf16_t* VTA = (bf16_t*)(p.ws + OFF_VTA);
    bf16_t* KD = (bf16_t*)(p.ws + OFF_KD); bf16_t* VTD = (bf16_t*)(p.ws + OFF_VTD); bf16_t* G = (bf16_t*)(p.ws + OFF_G);
    const float* rope = (const float*)(p.ws + OFF_ROPE);
    { EpiGates E; E.G = G; E.bias = p.b_gate + l * 2048; run_pg8(n, W + (size_t)2304 * D, 2048, D, E, lds); }
    constexpr int NTILES = 64 * (2304 / 128);
    for (int t = blockIdx.x; t < NTILES; t += gridDim.x) {
        const int bm = t & 63, bn = t >> 6, row0 = bm * 256;
        f32x4 acc[4][4]; zero_acc(acc);
        gemm_mainloop(n + (size_t)row0 * D, D, W + (size_t)bn * 128 * D, D, D, acc, lds);
        const int cw = bn * 128 + 64 * wc;
        if (cw < 640) {
            const bool isq = cw < 512;
            const float* gq = p.qk_g + l * 128 + (isq ? 0 : 64);
            f32x4 gv[4];
#pragma unroll
            for (int mw = 0; mw < 4; ++mw) gv[mw] = *(const f32x4*)(gq + 16 * mw + 4 * fq);
#pragma unroll
            for (int nt = 0; nt < 4; ++nt) {
                const int token = row0 + 64 * wt + 16 * nt + fr;
                float ss = 0.f;
#pragma unroll
                for (int mw = 0; mw < 4; ++mw) ss += acc[mw][nt][0] * acc[mw][nt][0] + acc[mw][nt][1] * acc[mw][nt][1] + acc[mw][nt][2] * acc[mw][nt][2] + acc[mw][nt][3] * acc[mw][nt][3];
                ss += __shfl_xor(ss, 16); ss += __shfl_xor(ss, 32);
                const float rstd = rsqrtf(ss * (1.0f / 64.0f) + 1e-6f);
                f32x4 y[4];
#pragma unroll
                for (int mw = 0; mw < 4; ++mw) y[mw] = acc[mw][nt] * rstd * gv[mw];
                const int prow = token >> 6, pcol = token & 63;
                const f32x4 cr = *(const f32x4*)(rope + prow * 16 + 4 * fq), sr = *(const f32x4*)(rope + 4096 + prow * 16 + 4 * fq);
                const f32x4 cc = *(const f32x4*)(rope + 8192 + pcol * 16 + 4 * fq), sc = *(const f32x4*)(rope + 9216 + pcol * 16 + 4 * fq);
                f32x4 o[4];
                o[0] = y[0] * cr - y[1] * sr; o[1] = y[1] * cr + y[0] * sr; o[2] = y[2] * cc - y[3] * sc; o[3] = y[3] * cc + y[2] * sc;
                const float qs = isq ? QSCALE : 1.0f;
                bf16_t* dst = isq ? (Q + (size_t)token * 512 + cw) : (KA + (size_t)token * 128 + (cw - 512));
#pragma unroll
                for (int mw = 0; mw < 4; ++mw) { const f32x4 z = o[mw] * qs; *(u32x2*)(dst + 16 * mw + 4 * fq) = (u32x2){pk2(z[0], z[1]), pk2(z[2], z[3])}; }
            }
        } else if (cw < 768 || (cw >= 1792 && cw < 2304)) {
            bf16_t* vt = cw < 768 ? (VTA + (size_t)(cw - 640) * S) : (VTD + (size_t)(cw - 1792) * S);
#pragma unroll
            for (int nt = 0; nt < 4; ++nt) {
                const int token = row0 + 64 * wt + 16 * nt + fr;
#pragma unroll
                for (int mw = 0; mw < 4; ++mw)
#pragma unroll
                    for (int r = 0; r < 4; ++r) vt[(size_t)(16 * mw + 4 * fq + r) * S + token] = (bf16_t)(pk2(acc[mw][nt][r], 0.f) & 0xffffu);
            }
        } else if (cw < 1792) {
            const bool isq = cw < 1280; const float qs = isq ? QSCALE : 1.0f;
            bf16_t* base = isq ? (QD + (cw - 768)) : (KD + (cw - 1280));
#pragma unroll
            for (int nt = 0; nt < 4; ++nt) {
                bf16_t* dst = base + (size_t)(row0 + 64 * wt + 16 * nt + fr) * 512;
#pragma unroll
                for (int mw = 0; mw < 4; ++mw) { const f32x4 z = acc[mw][nt] * qs; *(u32x2*)(dst + 16 * mw + 4 * fq) = (u32x2){pk2(z[0], z[1]), pk2(z[2], z[3])}; }
            }
            {
                float best = 0.f;
#pragma unroll
                for (int nt = 0; nt < 4; ++nt) {
                    float ss = 0.f;
#pragma unroll
                    for (int mw = 0; mw < 4; ++mw) { const f32x4 z = acc[mw][nt] * qs; ss += z[0] * z[0] + z[1] * z[1] + z[2] * z[2] + z[3] * z[3]; }
                    ss += __shfl_xor(ss, 16); ss += __shfl_xor(ss, 32);
                    best = __builtin_fmaxf(best, ss);
                }
#pragma unroll
                for (int o = 8; o > 0; o >>= 1) best = __builtin_fmaxf(best, __shfl_xor(best, o));
                if (lane == 0) atomicMax((unsigned*)(p.ws + OFF_STAT) + l * 16 + (isq ? 0 : 8) + ((cw - (isq ? 768 : 1280)) >> 6), __float_as_uint(best));
            }
        } else {
            const int gc = cw - 2304;
            const float* bg = p.b_gate + l * 2048 + gc;
            f32x4 bv[4];
#pragma unroll
            for (int mw = 0; mw < 4; ++mw) bv[mw] = *(const f32x4*)(bg + 16 * mw + 4 * fq);
#pragma unroll
            for (int nt = 0; nt < 4; ++nt) {
                bf16_t* dst = G + (size_t)(row0 + 64 * wt + 16 * nt + fr) * 2048 + gc;
#pragma unroll
                for (int mw = 0; mw < 4; ++mw) {
                    const f32x4 xx = acc[mw][nt] + bv[mw]; f32x4 z;
#pragma unroll
                    for (int r = 0; r < 4; ++r) z[r] = fast_rcp(1.0f + __expf(-xx[r]));
                    *(u32x2*)(dst + 16 * mw + 4 * fq) = (u32x2){pk2(z[0], z[1]), pk2(z[2], z[3])};
                }
            }
        }
    }
}

#define MFMA32(a, b, c) __builtin_amdgcn_mfma_f32_32x32x16_bf16((a), (b), (c), 0, 0, 0)
template <int DV, bool ALIBI>
DI void attn_pass(const bf16_t* __restrict__ Qp, const bf16_t* __restrict__ Kb, int kpitch, const bf16_t* __restrict__ Vtb, float slope2, int qpos, int t_lo, int t_hi, float m_init,
                  f32x16 (&o)[DV / 32], float& l_out, char* lds) {
    constexpr int NV = DV / 64, NDT = DV / 32, STAGE = 8192 + DV * 128, G = 1 + NV;
    const int tid = otid(), lane = tid & 63, r32 = lane & 31, h = lane >> 5;
    bf16x8 qf[4];
#pragma unroll
    for (int d0 = 0; d0 < 4; ++d0) qf[d0] = *(const bf16x8*)(Qp + 16 * d0 + 8 * h);
    const int srow = tid >> 3, sch = (tid & 7) ^ ((srow >> 1) & 7);
    const bf16_t* kg = Kb + (size_t)srow * kpitch + sch * 8;
    const bf16_t* vg = Vtb + (size_t)srow * S + sch * 8;
    char* const ld = lds + tid * 16;
#define A_ISSUE(t_, st_) do { char* sn_ = ld + (st_) * STAGE; glds16(kg + (size_t)(t_) * 64 * kpitch, sn_); \
        _Pragma("unroll") for (int i = 0; i < NV; ++i) glds16(vg + (size_t)(64 * i) * S + (t_) * 64, sn_ + 8192 + i * 8192); } while (0)
    waitv<0>();
    A_ISSUE(t_lo, 0);
    if (t_lo + 1 <= t_hi) A_ISSUE(t_lo + 1, 1);
    if (t_lo + 2 <= t_hi) A_ISSUE(t_lo + 2, 2);
    const int pi = (r32 & 0x13) | ((r32 & 4) << 1) | ((r32 & 8) >> 1);
    const int k_base = pi * 128, k_sw = (pi >> 1) & 7, v_base = 8192 + r32 * 128, v_sw = (r32 >> 1) & 7;
    float m = m_init, l = 0.f;
#pragma unroll
    for (int dt = 0; dt < NDT; ++dt)
#pragma unroll
        for (int r = 0; r < 16; ++r) o[dt][r] = 0.f;
    int cur = 0;
    for (int t = t_lo; t <= t_hi; ++t) {
        const int rem = t_hi - t;
        if (rem >= 2) waitv<2 * G>(); else if (rem == 1) waitv<G>(); else waitv<0>();
        rawbar();
        if (rem >= 3) A_ISSUE(t + 3, (cur + 3) & 3);
        const char* st = lds + cur * STAGE;
        cur = (cur + 1) & 3;
        bf16x8 kf[2][4];
#pragma unroll
        for (int kt = 0; kt < 2; ++kt)
#pragma unroll
            for (int d0 = 0; d0 < 4; ++d0) kf[kt][d0] = *(const bf16x8*)(st + kt * 4096 + k_base + (((2 * d0 + h) ^ k_sw) << 4));
        f32x16 sc[2];
        const float nm = -m;
#pragma unroll
        for (int kt = 0; kt < 2; ++kt)
#pragma unroll
            for (int r = 0; r < 16; ++r) sc[kt][r] = nm;
        SB();
        __builtin_amdgcn_s_setprio(1);
#pragma unroll
        for (int d0 = 0; d0 < 4; ++d0)
#pragma unroll
            for (int kt = 0; kt < 2; ++kt) sc[kt] = MFMA32(kf[kt][d0], qf[d0], sc[kt]);
        __builtin_amdgcn_s_setprio(0);
        bf16x8 vf[2][4];
        if (NDT == 2) {
#pragma unroll
            for (int dt = 0; dt < 2; ++dt)
#pragma unroll
                for (int ks = 0; ks < 4; ++ks) vf[dt][ks] = *(const bf16x8*)(st + v_base + dt * 4096 + (((2 * ks + h) ^ v_sw) << 4));
        }
        SB();
        if (ALIBI) {
#pragma unroll
            for (int kt = 0; kt < 2; ++kt) {
                const float dq = (float)(qpos - (64 * t + 32 * kt + 8 * h));
#pragma unroll
                for (int r = 0; r < 16; ++r) sc[kt][r] = __builtin_fmaf(-slope2, __builtin_fabsf(dq - (float)(16 * (r >> 3) + (r & 7))), sc[kt][r]);
            }
        }
        float mt = sc[0][0];
#pragma unroll
        for (int r = 1; r < 16; ++r) mt = __builtin_fmaxf(mt, sc[0][r]);
#pragma unroll
        for (int r = 0; r < 16; ++r) mt = __builtin_fmaxf(mt, sc[1][r]);
        mt = __builtin_fmaxf(mt, __shfl_xor(mt, 32));
        if (__any(mt > 8.0f)) {
            const float dl = __builtin_fmaxf(mt, 0.f), al = fast_exp2(-dl);
            l *= al; m += dl;
#pragma unroll
            for (int kt = 0; kt < 2; ++kt)
#pragma unroll
                for (int r = 0; r < 16; ++r) sc[kt][r] -= dl;
#pragma unroll
            for (int dt = 0; dt < NDT; ++dt)
#pragma unroll
                for (int r = 0; r < 16; ++r) o[dt][r] *= al;
        }
        float ps = 0.f;
#pragma unroll
        for (int kt = 0; kt < 2; ++kt)
#pragma unroll
            for (int r = 0; r < 16; ++r) { const float e = fast_exp2(sc[kt][r]); sc[kt][r] = e; ps += e; }
        l += ps;
        bf16x8 pf[4];
#pragma unroll
        for (int ks = 0; ks < 4; ++ks) {
            const int kt = ks >> 1, b = (ks & 1) * 8;
            u32x4 w = {pk2(sc[kt][b], sc[kt][b + 1]), pk2(sc[kt][b + 2], sc[kt][b + 3]), pk2(sc[kt][b + 4], sc[kt][b + 5]), pk2(sc[kt][b + 6], sc[kt][b + 7])};
            pf[ks] = __builtin_bit_cast(bf16x8, w);
        }
        SB();
        if (NDT == 4) {
#pragma unroll
            for (int gp = 0; gp < 2; ++gp) {
#pragma unroll
                for (int dt = 0; dt < 2; ++dt)
#pragma unroll
                    for (int ks = 0; ks < 4; ++ks) vf[dt][ks] = *(const bf16x8*)(st + v_base + (dt + 2 * gp) * 4096 + (((2 * ks + h) ^ v_sw) << 4));
                __builtin_amdgcn_s_setprio(1);
#pragma unroll
                for (int ks = 0; ks < 4; ++ks)
#pragma unroll
                    for (int dt = 0; dt < 2; ++dt) o[(dt + 2 * gp) % NDT] = MFMA32(vf[dt][ks], pf[ks], o[(dt + 2 * gp) % NDT]);
                __builtin_amdgcn_s_setprio(0);
                SB();
            }
        } else {
            __builtin_amdgcn_s_setprio(1);
#pragma unroll
            for (int ks = 0; ks < 4; ++ks)
#pragma unroll
                for (int dt = 0; dt < 2; ++dt) o[dt] = MFMA32(vf[dt][ks], pf[ks], o[dt]);
            __builtin_amdgcn_s_setprio(0);
        }
        SB();
    }
#undef A_ISSUE
    __syncthreads();
    l += __shfl_xor(l, 32);
    l_out = l;
}

DI void attn_pass_b(const bf16_t* __restrict__ Qp, const bf16_t* __restrict__ Kb, int kpitch, const bf16_t* __restrict__ Vtb, float slope2, int qpos, int t_lo, int t_hi, float mref,
                    f32x16 (&o)[4], float& l_out, char* lds) {
    constexpr int NV = 2, STAGE = 8192 + 128 * 128, G = 1 + NV;
    const int tid = otid(), lane = tid & 63, r32 = lane & 31, h = lane >> 5;
    const int qw0 = __builtin_amdgcn_readfirstlane(qpos - r32);
    bf16x8 qf[4];
#pragma unroll
    for (int d0 = 0; d0 < 4; ++d0) qf[d0] = *(const bf16x8*)(Qp + 16 * d0 + 8 * h);
    const int srow = tid >> 3, sch = (tid & 7) ^ ((srow >> 1) & 7);
    const bf16_t* kg = Kb + (size_t)srow * kpitch + sch * 8;
    const bf16_t* vg = Vtb + (size_t)srow * S + sch * 8;
    char* const ld = lds + tid * 16;
#define B_ISSUE(t_, st_) do { char* sn_ = ld + (st_) * STAGE; glds16(kg + (size_t)(t_) * 64 * kpitch, sn_); \
        _Pragma("unroll") for (int i = 0; i < NV; ++i) glds16(vg + (size_t)(64 * i) * S + (t_) * 64, sn_ + 8192 + i * 8192); } while (0)
    waitv<0>();
    B_ISSUE(t_lo, 0);
    if (t_lo + 1 <= t_hi) B_ISSUE(t_lo + 1, 1);
    if (t_lo + 2 <= t_hi) B_ISSUE(t_lo + 2, 2);
    const int pi = (r32 & 0x13) | ((r32 & 4) << 1) | ((r32 & 8) >> 1);
    const int k_base = pi * 128, k_sw = (pi >> 1) & 7, v_base = 8192 + r32 * 128, v_sw = (r32 >> 1) & 7;
    float l = 0.f;
    const float nm = -mref;
#pragma unroll
    for (int dt = 0; dt < 4; ++dt)
#pragma unroll
        for (int r = 0; r < 16; ++r) o[dt][r] = 0.f;
    int cur = 0;
    for (int t = t_lo; t <= t_hi; ++t) {
        const int rem = t_hi - t;
        if (rem >= 2) waitv<2 * G>(); else if (rem == 1) waitv<G>(); else waitv<0>();
        rawbar();
        if (rem >= 3) B_ISSUE(t + 3, (cur + 3) & 3);
        const char* st = lds + cur * STAGE;
        cur = (cur + 1) & 3;
        bf16x8 kf[2][4];
#pragma unroll
        for (int kt = 0; kt < 2; ++kt)
#pragma unroll
            for (int d0 = 0; d0 < 4; ++d0) kf[kt][d0] = *(const bf16x8*)(st + kt * 4096 + k_base + (((2 * d0 + h) ^ k_sw) << 4));
        const int side = (64 * t + 63 < qw0) ? 1 : ((64 * t > qw0 + 31) ? -1 : 0);
        f32x16 sc[2];
        if (side != 0) {
            const float ss = side > 0 ? slope2 : -slope2;
#pragma unroll
            for (int kt = 0; kt < 2; ++kt) {
                const float base = __builtin_fmaf(ss, (float)(64 * t + 32 * kt + 8 * h - qpos), nm);
#pragma unroll
                for (int r = 0; r < 16; ++r) sc[kt][r] = __builtin_fmaf(ss, (float)(16 * (r >> 3) + (r & 7)), base);
            }
        } else {
#pragma unroll
            for (int kt = 0; kt < 2; ++kt)
#pragma unroll
                for (int r = 0; r < 16; ++r) sc[kt][r] = nm;
        }
        SB();
        __builtin_amdgcn_s_setprio(1);
#pragma unroll
        for (int d0 = 0; d0 < 4; ++d0)
#pragma unroll
            for (int kt = 0; kt < 2; ++kt) sc[kt] = MFMA32(kf[kt][d0], qf[d0], sc[kt]);
        __builtin_amdgcn_s_setprio(0);
        SB();
        if (side == 0) {
#pragma unroll
            for (int kt = 0; kt < 2; ++kt) {
                const float dq = (float)(qpos - (64 * t + 32 * kt + 8 * h));
#pragma unroll
                for (int r = 0; r < 16; ++r) sc[kt][r] = __builtin_fmaf(-slope2, __builtin_fabsf(dq - (float)(16 * (r >> 3) + (r & 7))), sc[kt][r]);
            }
        }
        float ps = 0.f;
#pragma unroll
        for (int kt = 0; kt < 2; ++kt)
#pragma unroll
            for (int r = 0; r < 16; ++r) { const float e = fast_exp2(sc[kt][r]); sc[kt][r] = e; ps += e; }
        l += ps;
        bf16x8 pf[4];
#pragma unroll
        for (int ks = 0; ks < 4; ++ks) {
            const int kt = ks >> 1, b = (ks & 1) * 8;
            u32x4 w = {pk2(sc[kt][b], sc[kt][b + 1]), pk2(sc[kt][b + 2], sc[kt][b + 3]), pk2(sc[kt][b + 4], sc[kt][b + 5]), pk2(sc[kt][b + 6], sc[kt][b + 7])};
            pf[ks] = __builtin_bit_cast(bf16x8, w);
        }
        SB();
#pragma unroll
        for (int gp = 0; gp < 2; ++gp) {
            bf16x8 vf[2][4];
#pragma unroll
            for (int dt = 0; dt < 2; ++dt)
#pragma unroll
                for (int ks = 0; ks < 4; ++ks) vf[dt][ks] = *(const bf16x8*)(st + v_base + (dt + 2 * gp) * 4096 + (((2 * ks + h) ^ v_sw) << 4));
            __builtin_amdgcn_s_setprio(1);
#pragma unroll
            for (int ks = 0; ks < 4; ++ks)
#pragma unroll
                for (int dt = 0; dt < 2; ++dt) o[dt + 2 * gp] = MFMA32(vf[dt][ks], pf[ks], o[dt + 2 * gp]);
            __builtin_amdgcn_s_setprio(0);
            SB();
        }
    }
#undef B_ISSUE
    __syncthreads();
    l += __shfl_xor(l, 32);
    l_out = l;
}

DI void attn_pass_a(const bf16_t* __restrict__ Qp, const bf16_t* __restrict__ Kb, int kpitch, const bf16_t* __restrict__ Vtb, float mref, f32x16 (&o)[2], float& l_out, char* lds) {
    constexpr int STAGE = 16384, NTL = S / 64;
    const int tid = otid(), lane = tid & 63, r32 = lane & 31, h = lane >> 5;
    bf16x8 qf[4];
#pragma unroll
    for (int d0 = 0; d0 < 4; ++d0) qf[d0] = *(const bf16x8*)(Qp + 16 * d0 + 8 * h);
    const int srow = tid >> 3, sch = (tid & 7) ^ ((srow >> 1) & 7);
    const bf16_t* kg = Kb + (size_t)srow * kpitch + sch * 8;
    const bf16_t* vg = Vtb + (size_t)srow * S + sch * 8;
    char* const ld = lds + tid * 16;
#define AA_ISSUE(t_, st_) do { char* sn_ = ld + (st_) * STAGE; glds16(kg + (size_t)(t_) * 64 * kpitch, sn_); glds16(vg + (t_) * 64, sn_ + 8192); } while (0)
    waitv<0>();
    AA_ISSUE(0, 0); AA_ISSUE(1, 1); AA_ISSUE(2, 2);
    const int pi = (r32 & 0x13) | ((r32 & 4) << 1) | ((r32 & 8) >> 1);
    const int k_base = pi * 128, k_sw = (pi >> 1) & 7, v_base = 8192 + r32 * 128, v_sw = (r32 >> 1) & 7;
    f32x16 negm, lacc;
#pragma unroll
    for (int r = 0; r < 16; ++r) { negm[r] = -mref; lacc[r] = 0.f; o[0][r] = 0.f; o[1][r] = 0.f; }
    const bf16x8 ones = {(short)0x3F80, (short)0x3F80, (short)0x3F80, (short)0x3F80, (short)0x3F80, (short)0x3F80, (short)0x3F80, (short)0x3F80};
    f32x16 sA[2], sB[2];
#define AA_QK(DST, stp_) do { bf16x8 kf_[2][4]; \
        _Pragma("unroll") for (int kt = 0; kt < 2; ++kt) _Pragma("unroll") for (int d0 = 0; d0 < 4; ++d0) kf_[kt][d0] = *(const bf16x8*)((stp_) + kt * 4096 + k_base + (((2 * d0 + h) ^ k_sw) << 4)); \
        SB(); __builtin_amdgcn_s_setprio(1); \
        DST[0] = MFMA32(kf_[0][0], qf[0], negm); DST[1] = MFMA32(kf_[1][0], qf[0], negm); \
        _Pragma("unroll") for (int d0 = 1; d0 < 4; ++d0) { DST[0] = MFMA32(kf_[0][d0], qf[d0], DST[0]); DST[1] = MFMA32(kf_[1][d0], qf[d0], DST[1]); } \
        __builtin_amdgcn_s_setprio(0); } while (0)
    waitv<4>();
    rawbar();
    AA_QK(sA, lds);
#define AA_STEP(CUR, NXT, t_) do { const int t = (t_); \
        if (t + 2 < NTL) waitv<2>(); else waitv<0>();              \
        rawbar();                                                  \
        if (t + 3 < NTL) AA_ISSUE(t + 3, (t + 3) & 3); \
        const char* st = lds + (t & 3) * STAGE; \
        if (t + 1 < NTL) AA_QK(NXT, lds + ((t + 1) & 3) * STAGE); \
        bf16x8 vf[2][4]; \
        _Pragma("unroll") for (int dt = 0; dt < 2; ++dt) _Pragma("unroll") for (int ks = 0; ks < 4; ++ks) vf[dt][ks] = *(const bf16x8*)(st + v_base + dt * 4096 + (((2 * ks + h) ^ v_sw) << 4)); \
        SB(); \
        _Pragma("unroll") for (int kt = 0; kt < 2; ++kt) _Pragma("unroll") for (int r = 0; r < 16; ++r) CUR[kt][r] = fast_exp2(CUR[kt][r]); \
        bf16x8 pf[4]; \
        _Pragma("unroll") for (int ks = 0; ks < 4; ++ks) { const int kt = ks >> 1, b = (ks & 1) * 8; \
            u32x4 w = {pk2(CUR[kt][b], CUR[kt][b + 1]), pk2(CUR[kt][b + 2], CUR[kt][b + 3]), pk2(CUR[kt][b + 4], CUR[kt][b + 5]), pk2(CUR[kt][b + 6], CUR[kt][b + 7])}; \
            pf[ks] = __builtin_bit_cast(bf16x8, w); } \
        SB(); __builtin_amdgcn_s_setprio(1); \
        _Pragma("unroll") for (int ks = 0; ks < 4; ++ks) { _Pragma("unroll") for (int dt = 0; dt < 2; ++dt) o[dt] = MFMA32(vf[dt][ks], pf[ks], o[dt]); lacc = MFMA32(ones, pf[ks], lacc); } \
        __builtin_amdgcn_s_setprio(0); SB(); } while (0)
    for (int t2 = 0; t2 < NTL; t2 += 2) { AA_STEP(sA, sB, t2); AA_STEP(sB, sA, t2 + 1); }
#undef AA_STEP
#undef AA_QK
#undef AA_ISSUE
    __syncthreads();
    l_out = lacc[0];
}

DI void phase_attn(const Params& p, int l, int rep, char* lds) {
    const int tid = otid(), lane = tid & 63, wid = tid >> 6, r32 = lane & 31, h = lane >> 5;
    const bf16_t* Q = (const bf16_t*)(p.ws + OFF_Q); const bf16_t* QD = (const bf16_t*)(p.ws + OFF_QD); const bf16_t* KA = (const bf16_t*)(p.ws + OFF_KA);
    const bf16_t* VTA = (const bf16_t*)(p.ws + OFF_VTA); const bf16_t* KD = (const bf16_t*)(p.ws + OFF_KD); const bf16_t* VTD = (const bf16_t*)(p.ws + OFF_VTD);
    bf16_t* ATTA = (bf16_t*)(p.ws + OFF_ATTA); bf16_t* OD = (bf16_t*)(p.ws + OFF_OD); float* BO0 = (float*)(p.ws + OFF_N);
    const float lam = ((const float*)(p.ws + OFF_LAM))[l];
    const float oml = 1.0f - (l == 0 ? 0.2f : 0.35550906759096926f);
    float bA;
    { float gq = __builtin_fabsf(p.qk_g[l * 128 + lane]), gk = __builtin_fabsf(p.qk_g[l * 128 + 64 + lane]);
#pragma unroll
      for (int o_ = 32; o_ > 0; o_ >>= 1) { gq = __builtin_fmaxf(gq, __shfl_xor(gq, o_)); gk = __builtin_fmaxf(gk, __shfl_xor(gk, o_)); }
      bA = 64.0f * gq * gk * QSCALE * 1.01f; }
    unsigned* qcnt = (unsigned*)(p.ws + OFF_STAT) + 32 + l + 2 * rep;
    const unsigned* stat = (const unsigned*)(p.ws + OFF_STAT) + l * 16;
    volatile unsigned* lword = (volatile unsigned*)(lds + 147456 + 16);
    for (;;) {
        if (tid == 0) *lword = atomicAdd(qcnt, 1u);
        __syncthreads();
        const int u = (int)*lword;
        __syncthreads();
        if (u >= 768) break;
        if (PROBE_DUP == 5 && rep && (u < 128 || u >= 640)) continue;
        if (u < 128 || u >= 640) {
            const int hb = u < 64 ? 3 : (u < 128 ? 2 : (u < 704 ? 1 : 0)), qb = u & 63;
            const int token = 256 * qb + 32 * wid + r32;
            const float slope2 = exp2f(-2.0f * (float)(hb + 1)) * LOG2E;
            float* bo = BO0 + (size_t)token * 512 + hb * 128;
            f32x16 o[4]; float ls;
            int tl[2], th[2]; float mi[2];
#pragma unroll
            for (int mp = 0; mp < 2; ++mp) {
                const float qk = sqrtf(__uint_as_float(stat[mp * 4 + hb]) * __uint_as_float(stat[8 + mp * 4 + hb])) * 1.02f;
                const float R = __builtin_fminf((2.0f * qk + 150.0f) / slope2, 40000.0f);
                const int klo = 256 * qb - (int)R - 1, khi = 256 * qb + 255 + (int)R + 1;
                mi[mp] = -qk;
                tl[mp] = klo < 0 ? 0 : (klo >> 6); th[mp] = khi >= S ? (S / 64 - 1) : (khi >> 6);
            }
            if (-mi[0] <= 45.0f) attn_pass_b(QD + (size_t)token * 512 + hb * 64, KD + hb * 64, 512, VTD + (size_t)(hb * 128) * S, slope2, token, tl[0], th[0], -mi[0], o, ls, lds);
            else attn_pass<128, true>(QD + (size_t)token * 512 + hb * 64, KD + hb * 64, 512, VTD + (size_t)(hb * 128) * S, slope2, token, tl[0], th[0], mi[0], o, ls, lds);
            {
                const float inv = 1.0f / ls;
#pragma unroll
                for (int dt = 0; dt < 4; ++dt)
#pragma unroll
                    for (int g = 0; g < 4; ++g) *(f32x4*)(bo + 32 * dt + 8 * g + 4 * h) = (f32x4){o[dt][4 * g] * inv, o[dt][4 * g + 1] * inv, o[dt][4 * g + 2] * inv, o[dt][4 * g + 3] * inv};
            }
            if (-mi[1] <= 45.0f) attn_pass_b(QD + (size_t)token * 512 + 256 + hb * 64, KD + 256 + hb * 64, 512, VTD + (size_t)(hb * 128) * S, slope2, token, tl[1], th[1], -mi[1], o, ls, lds);
            else attn_pass<128, true>(QD + (size_t)token * 512 + 256 + hb * 64, KD + 256 + hb * 64, 512, VTD + (size_t)(hb * 128) * S, slope2, token, tl[1], th[1], mi[1], o, ls, lds);
            {
                const float inv = lam / ls; float ss = 0.f;
#pragma unroll
                for (int dt = 0; dt < 4; ++dt)
#pragma unroll
                    for (int g = 0; g < 4; ++g) {
                        const f32x4 a = *(const f32x4*)(bo + 32 * dt + 8 * g + 4 * h);
#pragma unroll
                        for (int j = 0; j < 4; ++j) { const float v = a[j] - o[dt][4 * g + j] * inv; o[dt][4 * g + j] = v; ss += v * v; }
                    }
                ss += __shfl_xor(ss, 32);
                const float rstd = rsqrtf(ss * (1.0f / 128.0f) + 1e-6f) * oml;
                const float* sg = p.subln_g + l * 128;
                bf16_t* dst = OD + (size_t)token * 512 + hb * 128;
#pragma unroll
                for (int dt = 0; dt < 4; ++dt)
#pragma unroll
                    for (int g = 0; g < 4; ++g) {
                        const int d = 32 * dt + 8 * g + 4 * h;
                        const f32x4 gg = *(const f32x4*)(sg + d);
                        *(u32x2*)(dst + d) = (u32x2){pk2(o[dt][4 * g] * rstd * gg[0], o[dt][4 * g + 1] * rstd * gg[1]), pk2(o[dt][4 * g + 2] * rstd * gg[2], o[dt][4 * g + 3] * rstd * gg[3])};
                    }
            }
        } else {
            const int v = u - 128, kv = v >> 8, hq = kv * 4 + (v & 3), qb = (v >> 2) & 63;
            const int token = 256 * qb + 32 * wid + r32;
            f32x16 o[2]; float ls;
            if (bA <= 40.0f) attn_pass_a(Q + (size_t)token * 512 + hq * 64, KA + kv * 64, 128, VTA + (size_t)(kv * 64) * S, bA, o, ls, lds);
            else attn_pass<64, false>(Q + (size_t)token * 512 + hq * 64, KA + kv * 64, 128, VTA + (size_t)(kv * 64) * S, 0.f, token, 0, S / 64 - 1, 0.f, o, ls, lds);
            const float inv = 1.0f / ls;
            bf16_t* dst = ATTA + (size_t)token * 512 + hq * 64;
#pragma unroll
            for (int dt = 0; dt < 2; ++dt)
#pragma unroll
                for (int g = 0; g < 4; ++g)
                    *(u32x2*)(dst + 32 * dt + 8 * g + 4 * h) = (u32x2){pk2(o[dt][4 * g] * inv, o[dt][4 * g + 1] * inv), pk2(o[dt][4 * g + 2] * inv, o[dt][4 * g + 3] * inv)};
        }
    }
}

#define XB_TMO      128
#define XB_XCNT(j)  (256  + 64 * (j))
#define XB_XSUB(j)  (1280 + 64 * (j))
#define XB_XGEN(j)  (2304 + 64 * (j))
#define XB_TOP      3328
#define XB_TOPGEN   3392
#define XCD_BAR_WORDS 3456
#define XB_SPIN_CAP (1u << 22)
#define LAS __attribute__((address_space(3)))
DI unsigned xb_ld(unsigned* p) { return __hip_atomic_load(p, __ATOMIC_RELAXED, __HIP_MEMORY_SCOPE_AGENT); }
DI unsigned xb_add(unsigned* p, unsigned v) { return __hip_atomic_fetch_add(p, v, __ATOMIC_RELAXED, __HIP_MEMORY_SCOPE_AGENT); }
DI unsigned xb_xcc_id() { return (unsigned)__builtin_amdgcn_s_getreg((3 << 11) | 20) & 0xFu; }
#define XB_SPIN(cond, bar) do { unsigned _sp = 0; while (cond) { __builtin_amdgcn_s_sleep(1); \
    if ((++_sp & 255u) == 0u) { if (xb_ld(&(bar)[XB_TMO])) break; if (_sp > XB_SPIN_CAP) { atomicAdd(&(bar)[XB_TMO], 1u); break; } } } } while (0)
struct XcdBarrier { unsigned* bar; unsigned x; volatile LAS unsigned* st; };
DI XcdBarrier xcd_barrier_post(unsigned* bar, volatile LAS unsigned* st) {
    XcdBarrier b; b.bar = bar; b.x = xb_xcc_id(); b.st = st;
    if (threadIdx.x == 0) (void)xb_add(&bar[XB_XCNT(b.x)], 1u);
    return b;
}
DI void xcd_barrier_complete(unsigned* bar, unsigned x, unsigned& nloc, unsigned& nx) {
    const unsigned G = gridDim.x * gridDim.y * gridDim.z;
    unsigned sum, cnt, mine, sp = 0u;
    for (;;) {
        sum = 0u; cnt = 0u; mine = 0u;
#pragma unroll
        for (unsigned j = 0; j < 16; ++j) { const unsigned c = xb_ld(&bar[XB_XCNT(j)]); sum += c; cnt += (c > 0u) ? 1u : 0u; mine = (j == x) ? c : mine; }
        if (sum == G) break;
        __builtin_amdgcn_s_sleep(1);
        if ((++sp & 255u) == 0u) { if (xb_ld(&bar[XB_TMO])) break; if (sp > XB_SPIN_CAP) { atomicAdd(&bar[XB_TMO], 1u); break; } }
    }
    nloc = mine > 0u ? mine : 1u; nx = cnt > 0u ? cnt : 1u;
}
DI void xcd_barrier(const XcdBarrier& b) {
    asm volatile("s_waitcnt vmcnt(0)" ::: "memory");
    __syncthreads();
    if (threadIdx.x == 0) {
        unsigned* bar = b.bar;
        __builtin_amdgcn_s_waitcnt(0);
        unsigned nloc = b.st[0], nx = b.st[1];
        if (nloc == 0u) { xcd_barrier_complete(bar, b.x, nloc, nx); b.st[0] = nloc; b.st[1] = nx; }
        const unsigned old = xb_add(&bar[XB_XSUB(b.x)], 1u);
        const unsigned gen = old / nloc;
        if (old + 1u == (gen + 1u) * nloc) {
            __builtin_amdgcn_fence(__ATOMIC_RELEASE, "agent");
            asm volatile("s_waitcnt vmcnt(0)" ::: "memory");
            const unsigned og = xb_add(&bar[XB_TOP], 1u);
            const unsigned tg = og / nx;
            if (og + 1u == (tg + 1u) * nx) xb_add(&bar[XB_TOPGEN], 1u);
            else XB_SPIN(xb_ld(&bar[XB_TOPGEN]) == tg, bar);
            __builtin_amdgcn_fence(__ATOMIC_ACQUIRE, "agent");
            xb_add(&bar[XB_XGEN(b.x)], 1u);
            asm volatile("s_waitcnt vmcnt(0)" ::: "memory");
        } else {
            XB_SPIN(xb_ld(&bar[XB_XGEN(b.x)]) == gen, bar);
            __builtin_amdgcn_fence(__ATOMIC_ACQUIRE, "agent");
            asm volatile("s_waitcnt vmcnt(0)" ::: "memory");
        }
    }
    __syncthreads();
}

__global__ void __launch_bounds__(512) mega(Params pin) {
    __shared__ __attribute__((aligned(16))) char lds[147456 + 64];
    cg::grid_group grid = cg::this_grid();
    volatile LAS unsigned* xst = (volatile LAS unsigned*)(lds + 147456);
    if (threadIdx.x == 0) { xst[0] = 0u; xst[1] = 0u; }
    __syncthreads();
    const XcdBarrier xb = xcd_barrier_post((unsigned*)(pin.ws + OFF_BAR), xst);
    int rep = 0;
    for (int ph = pin.ph_lo; ph < pin.ph_hi; ++ph) {
        Params p = pin;
        asm volatile("" : "+s"(p.ws), "+s"(p.out), "+s"(p.x));
        bf16_t* nbuf = (bf16_t*)(p.ws + OFF_N);
        bf16_t* act = (bf16_t*)(p.ws + OFF_ACT);
        if (ph == 0) phase_prologue(p, lds);
        else {
            const int l = ph == 23 ? 1 : (ph - 1) / 11, k = ph == 23 ? 11 : (ph - 1) % 11;
            const float* mod = (const float*)(p.ws + OFF_MOD) + l * 9216;
            switch (k) {
            case 0: case 3: case 8: case 11: {
                const int i = k == 0 ? 0 : (k == 3 ? 1 : 2);
                const float* hin = (ph == 1) ? p.x : p.out;
                if (k == 11) phase_norm(hin, p.final_g, nullptr, nullptr, nullptr, p.out);
                else phase_norm(hin, p.norm_g + (l * 3 + i) * D, mod + (3 * i) * D, mod + (3 * i + 1) * D, nbuf, nullptr);
            } break;
            case 1: case 9: {
                const int f = k == 1 ? 0 : 1;
                phase_gateup(nbuf, (const bf16_t*)(p.ws + OFF_WGU + (size_t)(l * 2 + f) * SZ_WGU), act, lds);
            } break;
            case 2: case 10: case 7: {
                if (k == 7) phase_resid((const bf16_t*)(p.ws + OFF_Q), D, (const bf16_t*)(p.ws + OFF_WO + l * SZ_WO), p.out, p.out, mod + 5 * D, rep ? 0.0f : 1.0f, lds);
                else {
                    const int f = k == 2 ? 0 : 1;
                    phase_resid(act, F, (const bf16_t*)(p.ws + OFF_WD + (size_t)(l * 2 + f) * SZ_WD), (ph == 3 && !rep) ? p.x : p.out, p.out, mod + (f == 0 ? 2 : 8) * D, rep ? 0.0f : 0.5f, lds);
                }
            } break;
            case 4: phase_win(p, l, lds); break;
            case 5: phase_attn(p, l, rep, lds); break;
            case 6: phase_merge((const bf16_t*)(p.ws + OFF_ATTA), (const bf16_t*)(p.ws + OFF_OD), (const bf16_t*)(p.ws + OFF_WBA + l * SZ_WB), (const bf16_t*)(p.ws + OFF_WBB + l * SZ_WB),
                                (const bf16_t*)(p.ws + OFF_G), (bf16_t*)(p.ws + OFF_Q), (float*)(p.ws + OFF_N), lds); break;
            default: break;
            }
        }
        if (ph + 1 < pin.ph_hi) { if (ph == pin.ph_lo) grid.sync(); else xcd_barrier(xb); }
        if (PROBE_DUP >= 0 && rep == 0 && (ph == 0 ? PROBE_DUP == 100 : ((ph - 1) % 11 == PROBE_DUP && ph != 23))) { rep = 1; --ph; } else rep = 0;
    }
}

extern "C" void kernel_launch(void* const* d_in, const int* in_sizes, int n_in, void* d_out, int out_size, void* d_ws, size_t ws_size, hipStream_t stream) {
    if (n_in != 18 || out_size != S * D || ws_size < WS_END) { fprintf(stderr, "kernel_launch: unexpected shapes / workspace (n_in %d out %d ws %zu need %zu)\n", n_in, out_size, ws_size, (size_t)WS_END); return; }
    Params p{};
    const float** pp = (const float**)&p;
    for (int i = 0; i < 18; ++i) pp[i] = (const float*)d_in[i];
    p.out = (float*)d_out; p.ws = (unsigned char*)d_ws;
    if (hipMemsetAsync((char*)d_ws + OFF_BAR, 0, 3456 * 4, stream) != hipSuccess) { fprintf(stderr, "kernel_launch: hipMemsetAsync of the barrier words failed\n"); return; }
#if MK_MULTI
    for (int ph = 0; ph < NPH; ++ph) { p.ph_lo = ph; p.ph_hi = ph + 1; hipLaunchKernelGGL(mega, dim3(256), dim3(512), 0, stream, p); }
#else
    static int grid = 0;
    if (!grid) {
        int dev = 0, cus = 0, per_cu = 0;
        hipGetDevice(&dev); hipDeviceGetAttribute(&cus, hipDeviceAttributeMultiprocessorCount, dev);
        hipOccupancyMaxActiveBlocksPerMultiprocessor(&per_cu, (const void*)mega, 512, 0);
        if (per_cu < 1) { fprintf(stderr, "kernel_launch: occupancy query says %d blocks per CU\n", per_cu); per_cu = 1; }
        grid = cus;
    }
    p.ph_lo = 0; p.ph_hi = NPH;
    void* args[] = {&p};
    hipError_t e = hipLaunchCooperativeKernel((const void*)mega, dim3(grid), dim3(512), args, 0, stream);
    if (e != hipSuccess) fprintf(stderr, "cooperative launch failed: %s (grid %d)\n", hipGetErrorString(e), grid);
#endif
}
```

```cpp
#include <hip/hip_runtime.h>
#include <hip/hip_cooperative_groups.h>
#include <cstdio>
#include <cstdint>
namespace cg = cooperative_groups;

#ifndef MK_MULTI
#define MK_MULTI 0
#endif

#ifndef PROBE_DUP
#define PROBE_DUP -1
#endif
#define DI __device__ __forceinline__
typedef unsigned short bf16_t;
typedef short bf16x8 __attribute__((ext_vector_type(8)));
typedef float f32x4 __attribute__((ext_vector_type(4)));
typedef float f32x16 __attribute__((ext_vector_type(16)));
typedef unsigned u32x4 __attribute__((ext_vector_type(4)));
typedef unsigned u32x2 __attribute__((ext_vector_type(2)));

constexpr int S = 16384, D = 1024, F = 2816, NGU = 5632, NIN = 4352;
constexpr int NPH = 24;
constexpr float QSCALE = 0.125f * 1.4426950408889634f;
constexpr float LOG2E = 1.4426950408889634f;

constexpr size_t OFF_MOD = 0;
constexpr size_t OFF_LAM = 80000;
constexpr size_t OFF_STAT = 80128;
constexpr size_t OFF_ROPE = 81920;
constexpr size_t OFF_BAR = 131072;
constexpr size_t OFF_WGU = 1u << 20;
constexpr size_t SZ_WGU = (size_t)NGU * D * 2;
constexpr size_t OFF_WD = OFF_WGU + 4 * SZ_WGU;
constexpr size_t SZ_WD = (size_t)D * F * 2;
constexpr size_t OFF_WIN = OFF_WD + 4 * SZ_WD;
constexpr size_t SZ_WIN = (size_t)NIN * D * 2;
constexpr size_t OFF_WBA = OFF_WIN + 2 * SZ_WIN;
constexpr size_t SZ_WB = (size_t)D * 512 * 2;
constexpr size_t OFF_WBB = OFF_WBA + 2 * SZ_WB;
constexpr size_t OFF_WO = OFF_WBB + 2 * SZ_WB;
constexpr size_t SZ_WO = (size_t)D * D * 2;
constexpr size_t OFF_N = OFF_WO + 2 * SZ_WO;
constexpr size_t OFF_MIX = OFF_N + (size_t)S * D * 2;
constexpr size_t OFF_Q = OFF_MIX;
constexpr size_t OFF_QD = OFF_Q + (size_t)S * 512 * 2;
constexpr size_t OFF_KA = OFF_QD + (size_t)S * 512 * 2;
constexpr size_t OFF_VTA = OFF_KA + (size_t)S * 128 * 2;
constexpr size_t OFF_KD = OFF_VTA + (size_t)S * 128 * 2;
constexpr size_t OFF_VTD = OFF_KD + (size_t)S * 512 * 2;
constexpr size_t OFF_G = OFF_VTD + (size_t)S * 512 * 2;
constexpr size_t OFF_ATTA = OFF_G + (size_t)S * 2048 * 2;
constexpr size_t OFF_OD = OFF_ATTA + (size_t)S * 512 * 2;
constexpr size_t OFF_ACT = OFF_MIX;
constexpr size_t WS_END = OFF_OD + (size_t)S * 512 * 2;
static_assert((size_t)S * F * 2 <= WS_END - OFF_MIX, "act overlay");

struct Params {
    const float *x, *c, *ada_w, *ada_b, *norm_g, *ffn_wg, *ffn_wu, *ffn_wd, *w_in, *qk_g, *lam_p, *subln_g, *w_ba, *w_bb, *w_gate, *b_gate, *w_o, *final_g;
    float* out; unsigned char* ws; int ph_lo, ph_hi;
};

typedef __bf16 bf16v2 __attribute__((ext_vector_type(2)));
typedef float f32x2 __attribute__((ext_vector_type(2)));
DI unsigned pk2(float lo, float hi) { f32x2 v = {lo, hi}; bf16v2 b = __builtin_convertvector(v, bf16v2); return __builtin_bit_cast(unsigned, b); }
DI float bf_lo(unsigned u) { return __uint_as_float(u << 16); }
DI float bf_hi(unsigned u) { return __uint_as_float(u & 0xffff0000u); }
DI int lds_off(int row, int chunk) { return row * 128 + ((chunk ^ ((row >> 1) & 7)) << 4); }
DI float fast_exp2(float x) { return __builtin_amdgcn_exp2f(x); }
DI float fast_rcp(float x) { return __builtin_amdgcn_rcpf(x); }
DI int otid() { int t = threadIdx.x; asm volatile("" : "+v"(t)); return t; }
#define SB() __builtin_amdgcn_sched_barrier(0)

DI int perm64(int n) { return (n & ~63) | (((n >> 2) & 3) << 4) | (((n >> 4) & 3) << 2) | (n & 3); }
DI int gumap(int j) { return 128 * (j >> 6) + 64 * ((j >> 5) & 1) + 16 * ((j >> 2) & 1) + 4 * ((j >> 3) & 3) + (j & 3); }

struct TrDesc { const float* src; bf16_t* dst; int N, k0, n0, ldd, mode, roff; };
DI void tr_decode(const Params& p, int tt, TrDesc& d) {
    constexpr int N_TR_L = 5824;
    const int l = tt / N_TR_L, r = tt % N_TR_L;
    if (r < 4224) {
        const int f = r / 2112, r2 = r % 2112, which = r2 / 704, r3 = r2 % 704;
        const size_t lf = (size_t)(l * 2 + f);
        if (which < 2) { d.src = (which == 0 ? p.ffn_wg : p.ffn_wu) + lf * D * F; d.N = F; d.k0 = (r3 / 44) * 64; d.n0 = (r3 % 44) * 64; d.dst = (bf16_t*)(p.ws + OFF_WGU + lf * SZ_WGU); d.ldd = D; d.mode = 3; d.roff = which * 128; }
        else { d.src = p.ffn_wd + lf * F * D; d.N = D; d.k0 = (r3 / 16) * 64; d.n0 = (r3 % 16) * 64; d.dst = (bf16_t*)(p.ws + OFF_WD + lf * SZ_WD); d.ldd = F; d.mode = 0; d.roff = 0; }
    } else if (r < 4800) { const int r3 = r - 4224; d.src = p.w_in + (size_t)l * D * 2304; d.N = 2304; d.k0 = (r3 / 36) * 64; d.n0 = (r3 % 36) * 64; d.dst = (bf16_t*)(p.ws + OFF_WIN + l * SZ_WIN); d.ldd = D; d.mode = 0; d.roff = 0; }
    else if (r < 5312) { const int r3 = r - 4800; d.src = p.w_gate + (size_t)l * D * 2048; d.N = 2048; d.k0 = (r3 / 32) * 64; d.n0 = (r3 % 32) * 64; d.dst = (bf16_t*)(p.ws + OFF_WIN + l * SZ_WIN); d.ldd = D; d.mode = 0; d.roff = 2304; }
    else if (r < 5440) { const int r3 = r - 5312; d.src = p.w_ba + (size_t)l * 512 * D; d.N = D; d.k0 = (r3 / 16) * 64; d.n0 = (r3 % 16) * 64; d.dst = (bf16_t*)(p.ws + OFF_WBA + l * SZ_WB); d.ldd = 512; d.mode = 0; d.roff = 0; }
    else if (r < 5568) { const int r3 = r - 5440; d.src = p.w_bb + (size_t)l * 512 * D; d.N = D; d.k0 = (r3 / 16) * 64; d.n0 = (r3 % 16) * 64; d.dst = (bf16_t*)(p.ws + OFF_WBB + l * SZ_WB); d.ldd = 512; d.mode = 0; d.roff = 0; }
    else { const int r3 = r - 5568; d.src = p.w_o + (size_t)l * D * D; d.N = D; d.k0 = (r3 / 16) * 64; d.n0 = (r3 % 16) * 64; d.dst = (bf16_t*)(p.ws + OFF_WO + l * SZ_WO); d.ldd = D; d.mode = 0; d.roff = 0; }
}
DI void tr_load(const TrDesc& d, int tid, f32x4 (&v)[2]) {
    const int kk = tid >> 4, nn4 = (tid & 15) * 4;
#pragma unroll
    for (int ps = 0; ps < 2; ++ps) v[ps] = *(const f32x4*)(d.src + (size_t)(d.k0 + kk + 32 * ps) * d.N + d.n0 + nn4);
}
DI void tr_store(const TrDesc& d, int tid, const f32x4 (&v)[2], float* ldsf) {
    {
        const int kk = tid >> 4, nn4 = (tid & 15) * 4;
#pragma unroll
        for (int ps = 0; ps < 2; ++ps) { const int k = kk + 32 * ps; ldsf[k * 65 + nn4 + 0] = v[ps][0]; ldsf[k * 65 + nn4 + 1] = v[ps][1]; ldsf[k * 65 + nn4 + 2] = v[ps][2]; ldsf[k * 65 + nn4 + 3] = v[ps][3]; }
    }
    __syncthreads();
    {
        const int n = tid >> 3, ch = tid & 7, gn = d.n0 + n;
        int drow;
        if (d.mode == 0) drow = gn + d.roff; else if (d.mode == 1) drow = perm64(gn); else drow = 256 * (gn >> 7) + (gn & 127) + d.roff;
        float w[8];
#pragma unroll
        for (int i = 0; i < 8; ++i) w[i] = ldsf[(ch * 8 + i) * 65 + n];
        u32x4 pk = {pk2(w[0], w[1]), pk2(w[2], w[3]), pk2(w[4], w[5]), pk2(w[6], w[7])};
        *(u32x4*)(d.dst + (size_t)drow * d.ldd + d.k0 + ch * 8) = pk;
    }
    __syncthreads();
}

DI void phase_prologue(const Params& p, char* lds) {
    const int tid = otid();
    float* ldsf = (float*)lds;
    constexpr int N_MOD = 288, N_TR = 2 * 5824;
    for (int it = blockIdx.x; it < N_MOD; it += gridDim.x) {
        const int l = it / 144, j0 = (it % 144) * 64, jj = tid & 15, ii = tid >> 4;
        float* cact = ldsf + 2048;
        for (int i = tid; i < 1024; i += 512) { const float cv = p.c[i]; cact[i] = cv / (1.f + expf(-cv)); }
        __syncthreads();
        f32x4 a = {0.f, 0.f, 0.f, 0.f};
        const float* wb = p.ada_w + (size_t)l * 1024 * 9216 + j0 + 4 * jj;
#pragma unroll 8
        for (int r = 0; r < 32; ++r) { const int i = ii + 32 * r; a += cact[i] * *(const f32x4*)(wb + (size_t)i * 9216); }
        *(f32x4*)(ldsf + ii * 64 + 4 * jj) = a;
        __syncthreads();
        if (tid < 64) {
            float sm = 0.f;
#pragma unroll
            for (int r = 0; r < 32; ++r) sm += ldsf[r * 64 + tid];
            ((float*)(p.ws + OFF_MOD))[l * 9216 + j0 + tid] = sm + p.ada_b[l * 9216 + j0 + tid];
        }
        __syncthreads();
    }
    if (blockIdx.x == gridDim.x - 1) {
        if (tid < 64) {
#pragma unroll
            for (int l = 0; l < 2; ++l) {
                const float* lp = p.lam_p + l * 256;
                float a = lp[tid] * lp[64 + tid], b = lp[128 + tid] * lp[192 + tid];
#pragma unroll
                for (int o = 32; o > 0; o >>= 1) { a += __shfl_xor(a, o); b += __shfl_xor(b, o); }
                const float li = l == 0 ? 0.2f : 0.35550906759096926f;
                if (tid == 0) ((float*)(p.ws + OFF_LAM))[l] = expf(a) - expf(b) + li;
            }
        }
        if (tid < 64) ((unsigned*)(p.ws + OFF_STAT))[tid] = 0u;
        float* rope = (float*)(p.ws + OFF_ROPE);
        for (int e = tid; e < 320 * 16; e += 512) {
            const int pi = e >> 4, i = e & 15;
            const int pos = pi < 256 ? pi - 128 : (pi - 256) - 32;
            const float inv = exp2f(-(float)i * (13.287712379549449f / 16.0f));
            const float angf = (float)pos * inv;
            double r = (double)angf; r -= rint(r * 0.15915494309189535) * 6.283185307179586;
            const double r2 = r * r;
            double sn = 0.0, cs = 0.0;
#pragma unroll 1
            for (int n = 14; n >= 1; --n) { sn = (sn + 1.0) * (-r2 / (double)((2 * n) * (2 * n + 1))); cs = (cs + 1.0) * (-r2 / (double)((2 * n - 1) * (2 * n))); }
            sn = (sn + 1.0) * r; cs = cs + 1.0;
            if (pi < 256) { rope[pi * 16 + i] = (float)cs; rope[4096 + pi * 16 + i] = (float)sn; }
            else { rope[8192 + (pi - 256) * 16 + i] = (float)cs; rope[9216 + (pi - 256) * 16 + i] = (float)sn; }
        }
    }
    {
        int tt = blockIdx.x;
        TrDesc d; f32x4 v[2];
        if (tt < N_TR) { tr_decode(p, tt, d); tr_load(d, tid, v); }
        while (tt < N_TR) {
            const int tn = tt + gridDim.x;
            TrDesc dn; f32x4 vn[2];
            if (tn < N_TR) { tr_decode(p, tn, dn); tr_load(dn, tid, vn); }
            tr_store(d, tid, v, ldsf);
            if (tn < N_TR) { d = dn; v[0] = vn[0]; v[1] = vn[1]; }
            tt = tn;
        }
    }
}

DI void phase_norm(const float* hin, const float* __restrict__ g, const float* __restrict__ sh, const float* __restrict__ sc, bf16_t* nout, float* fout) {
    const int tid_ = otid(), lane = tid_ & 63, wid = tid_ >> 6;
    const int nw = gridDim.x * 8;
    for (int row = blockIdx.x * 8 + wid; row < S; row += nw) {
        const float* hp = hin + (size_t)row * D;
        f32x4 v[4]; float ss = 0.f;
#pragma unroll
        for (int i = 0; i < 4; ++i) { v[i] = *(const f32x4*)(hp + (i * 64 + lane) * 4); ss += v[i][0] * v[i][0] + v[i][1] * v[i][1] + v[i][2] * v[i][2] + v[i][3] * v[i][3]; }
#pragma unroll
        for (int o = 32; o > 0; o >>= 1) ss += __shfl_xor(ss, o);
        const float rstd = rsqrtf(ss * (1.0f / 1024.0f) + 1e-6f);
#pragma unroll
        for (int i = 0; i < 4; ++i) {
            const int col = (i * 64 + lane) * 4;
            const f32x4 gv = *(const f32x4*)(g + col);
            f32x4 y = v[i] * rstd * gv;
            if (sc) { const f32x4 s1 = *(const f32x4*)(sc + col), s0 = *(const f32x4*)(sh + col); y = y * (1.0f + s1) + s0; }
            if (fout) *(f32x4*)(fout + (size_t)row * D + col) = y;
            else { u32x2 pk = {pk2(y[0], y[1]), pk2(y[2], y[3])}; *(u32x2*)(nout + (size_t)row * D + col) = pk; }
        }
    }
}

DI void glds16(const void* g, char* l) { __builtin_amdgcn_global_load_lds((const unsigned*)g, (unsigned*)l, 16, 0, 0); }
template <int N> DI void waitv() { asm volatile("s_waitcnt vmcnt(%0)" ::"n"(N) : "memory"); }
DI void rawbar() { __builtin_amdgcn_s_barrier(); }
constexpr int GST = 49152;
DI void gemm_mainloop(const bf16_t* __restrict__ A, int lda, const bf16_t* __restrict__ W, int ldw, int K, f32x4 (&acc)[4][4], char* lds) {
    const int tid = otid(), lane = tid & 63, wid = tid >> 6, wt = wid >> 1, wc = wid & 1;
    const int srow = tid >> 3, sch = (tid & 7) ^ ((srow >> 1) & 7);
    const bf16_t* ag = A + (size_t)srow * lda + sch * 8;
    const bf16_t* wg = W + (size_t)srow * ldw + sch * 8;
    char* const ld = lds + tid * 16;
    const int nk = K >> 6;
#define G_ISSUE(kt_, st_) do { const int ko_ = (kt_) * 64; char* sn_ = ld + (st_) * GST; \
        _Pragma("unroll") for (int i = 0; i < 4; ++i) glds16(ag + (size_t)(64 * i) * lda + ko_, sn_ + i * 8192); \
        _Pragma("unroll") for (int i = 0; i < 2; ++i) glds16(wg + (size_t)(64 * i) * ldw + ko_, sn_ + 32768 + i * 8192); } while (0)
    waitv<0>();
    G_ISSUE(0, 0); G_ISSUE(1, 1);
    const int fr = lane & 15, fq = lane >> 4, sw = (fr >> 1) & 7;
    const int a_base = (64 * wt + fr) * 128, w_base = 32768 + (64 * wc + fr) * 128;
    int cur = 0, nxt = 2;
    for (int kt = 0; kt < nk; ++kt) {
        if (kt + 1 < nk) waitv<6>(); else waitv<0>();
        rawbar();
        if (kt + 2 < nk) G_ISSUE(kt + 2, nxt);
        const char* st = lds + cur * GST;
#pragma unroll
        for (int kk = 0; kk < 2; ++kk) {
            const int co = ((kk * 4 + fq) ^ sw) << 4;
            bf16x8 af[4], wf[4];
#pragma unroll
            for (int i = 0; i < 4; ++i) af[i] = *(const bf16x8*)(st + a_base + i * 2048 + co);
#pragma unroll
            for (int i = 0; i < 4; ++i) wf[i] = *(const bf16x8*)(st + w_base + i * 2048 + co);
#pragma unroll
            for (int mw = 0; mw < 4; ++mw)
#pragma unroll
                for (int nt = 0; nt < 4; ++nt) acc[mw][nt] = __builtin_amdgcn_mfma_f32_16x16x32_bf16(wf[mw], af[nt], acc[mw][nt], 0, 0, 0);
        }
        cur = cur == 2 ? 0 : cur + 1; nxt = nxt == 2 ? 0 : nxt + 1;
    }
#undef G_ISSUE
    __syncthreads();
}
constexpr int GST2 = 65536;
DI void gemm_mainloop2(const bf16_t* __restrict__ A, int lda, const bf16_t* __restrict__ W, int ldw, int K, f32x4 (&acc)[4][8], char* lds) {
    const int tid = otid(), lane = tid & 63, wid = tid >> 6, wt = wid >> 2, wc = wid & 3;
    const int srow = tid >> 3, sch = (tid & 7) ^ ((srow >> 1) & 7);
    const bf16_t* ag = A + (size_t)srow * lda + sch * 8;
    const bf16_t* wg = W + (size_t)srow * ldw + sch * 8;
    char* const ld = lds + tid * 16;
    const int nk = K >> 6;
#define G2_ISSUE(kt_, st_) do { const int ko_ = (kt_) * 64; char* sn_ = ld + (st_) * GST2; \
        _Pragma("unroll") for (int i = 0; i < 4; ++i) glds16(ag + (size_t)(64 * i) * lda + ko_, sn_ + i * 8192); \
        _Pragma("unroll") for (int i = 0; i < 4; ++i) glds16(wg + (size_t)(64 * i) * ldw + ko_, sn_ + 32768 + i * 8192); } while (0)
    waitv<0>();
    G2_ISSUE(0, 0);
    const int fr = lane & 15, fq = lane >> 4, sw = (fr >> 1) & 7;
    const int a_base = (128 * wt + fr) * 128, w_base = 32768 + (64 * wc + fr) * 128;
    for (int kt = 0; kt < nk; ++kt) {
        waitv<0>();
        rawbar();
        if (kt + 1 < nk) G2_ISSUE(kt + 1, (kt + 1) & 1);
        const char* st = lds + (kt & 1) * GST2;
#pragma unroll
        for (int kk = 0; kk < 2; ++kk) {
            const int co = ((kk * 4 + fq) ^ sw) << 4;
            bf16x8 wf[4], af[2][2];
#pragma unroll
            for (int i = 0; i < 4; ++i) wf[i] = *(const bf16x8*)(st + w_base + i * 2048 + co);
#pragma unroll
            for (int i = 0; i < 2; ++i) af[0][i] = *(const bf16x8*)(st + a_base + i * 2048 + co);
#pragma unroll
            for (int ip = 0; ip < 4; ++ip) {
                if (ip < 3) {
#pragma unroll
                    for (int i = 0; i < 2; ++i) af[(ip + 1) & 1][i] = *(const bf16x8*)(st + a_base + (2 * ip + 2 + i) * 2048 + co);
                }
                __builtin_amdgcn_s_setprio(1);
#pragma unroll
                for (int i = 0; i < 2; ++i)
#pragma unroll
                    for (int mw = 0; mw < 4; ++mw) acc[mw][2 * ip + i] = __builtin_amdgcn_mfma_f32_16x16x32_bf16(wf[mw], af[ip & 1][i], acc[mw][2 * ip + i], 0, 0, 0);
                __builtin_amdgcn_s_setprio(0);
                SB();
            }
        }
    }
#undef G2_ISSUE
    __syncthreads();
}
DI void zero_acc2(f32x4 (&acc)[4][8]) {
#pragma unroll
    for (int a = 0; a < 4; ++a)
#pragma unroll
        for (int b = 0; b < 8; ++b) acc[a][b] = (f32x4){0.f, 0.f, 0.f, 0.f};
}
DI void zero_acc(f32x4 (&acc)[4][4]) {
#pragma unroll
    for (int a = 0; a < 4; ++a)
#pragma unroll
        for (int b = 0; b < 4; ++b) acc[a][b] = (f32x4){0.f, 0.f, 0.f, 0.f};
}

namespace pg8 {
#define PG8_LAS __attribute__((address_space(3)))
constexpr int BM = 256, BK = 64, HALF = 128, HTB = HALF * BK * 2  , STAGE_BYTES = 8 * HTB, NXCD = 8, WGM = 8;

__host__ __device__ __forceinline__ int lds_byte(int r, int c) { const int st = (r >> 4) * 2 + (c >> 5), rr = r & 15, cc = c & 31, ob = rr * 64 + cc * 2; return st * 1024 + (ob ^ (((ob >> 9) & 1) << 5)); }
__host__ __device__ __forceinline__ void stage_rc(int b, int& R, int& C) { const int st = b / 1024, sb = b % 1024, swz = sb ^ (((sb >> 9) & 1) << 5); R = (st >> 1) * 16 + swz / 64; C = (st & 1) * 32 + (swz % 64) / 2; }
__host__ __device__ __forceinline__ int perm32(int rho) { const int n = rho >> 4, i = rho & 15; return 8 * (i >> 2) + 4 * n + (i & 3); }

struct Unit { int pm, pn; };
struct Gemm { const bf16_t* A; const bf16_t* Bt; int M, N, K; };

struct StaticOrder {
    int nM, nN, nwg, G, c;
    __host__ __device__ void init(int M, int N, int G_, int c_) { nM = M / BM; nN = N / BM; nwg = nM * nN; G = G_; c = c_; }
    __host__ __device__ bool next(int i, Unit& u) const {
        const long L = (long)i * G + c; if (L >= nwg) return false;
        int wgid = (int)L; { const int q = nwg / NXCD, r = nwg % NXCD, xcd = wgid % NXCD, off = wgid / NXCD; wgid = (xcd < r ? xcd * (q + 1) : r * (q + 1) + (xcd - r) * q) + off; }
        const int nig = WGM * nN, gid = wgid / nig, fm = gid * WGM, gsz = (nM - fm) < WGM ? (nM - fm) : WGM;
        u.pm = fm + ((wgid % nig) % gsz); u.pn = (wgid % nig) / gsz; return true;
    }
    __device__ __forceinline__ void a_ready(const Unit&) const {}
    __device__ __forceinline__ void done(const Unit&) const {}
};
template <class Epi, class Sched, bool ALIGN_EPI = false, bool SP2 = false>
__device__ __forceinline__ void gemm_phase(PG8_LAS unsigned char* lds, const Gemm g, const Sched& S, const Epi& E) {
    const int tid = ::otid(), wid = __builtin_amdgcn_readfirstlane(tid >> 6), lane = tid & 63, wr = wid >> 2, wc = wid & 3, fr = lane & 15, fq = lane >> 4;
    const int K = g.K, nt = K / BK;
    unsigned voffA[2], voffB[2];
#pragma unroll
    for (int i = 0; i < 2; ++i) { int R, C; stage_rc(tid * 16 + i * 8192, R, C); const int Rb = Epi::PERM ? ((R & ~31) + perm32(R & 31)) : R;
        voffA[i] = (unsigned)(R * K + C) * 2u; voffB[i] = (unsigned)(Rb * K + C) * 2u; }
    const size_t kstep = (size_t)(BK * 2);
    const size_t hstep = (size_t)HALF * K * 2;
    const size_t tstep = 2 * hstep;
    const unsigned ldsw = (unsigned)wid * 1024u;
    const int aoff = lds_byte(wr * 64 + fr, fq * 8), boff = lds_byte(wc * 32 + fr, fq * 8);
#define PG8_SA(b, h) (((b) * 2 + (h)) * HTB)
#define PG8_SB(b, h) ((4 + (b) * 2 + (h)) * HTB)
#define PG8_STAGE(bufoff, gbase, voff) do { _Pragma("unroll") for (int _i = 0; _i < 2; ++_i) \
        __builtin_amdgcn_global_load_lds((const unsigned*)((const char*)(gbase) + (voff)[_i]), (PG8_LAS unsigned*)(lds + (bufoff) + ldsw + _i * 8192), 16, 0, 0); } while (0)
#define PG8_LDA(dst, b, h) do { _Pragma("unroll") for (int m = 0; m < 4; ++m) _Pragma("unroll") for (int k = 0; k < 2; ++k) dst[m][k] = *(const PG8_LAS bf16x8*)(lds + PG8_SA(b, h) + aoff + m * 2048 + k * 1024); } while (0)
#define PG8_LDB(dst, b, h) do { _Pragma("unroll") for (int n = 0; n < 2; ++n) _Pragma("unroll") for (int k = 0; k < 2; ++k) dst[n][k] = *(const PG8_LAS bf16x8*)(lds + PG8_SB(b, h) + boff + n * 2048 + k * 1024); } while (0)
#define PG8_MMA(ai, bj, At, Bt) do { __builtin_amdgcn_s_setprio(1); _Pragma("unroll") for (int m = 0; m < 4; ++m) _Pragma("unroll") for (int n = 0; n < 2; ++n) _Pragma("unroll") for (int k = 0; k < 2; ++k) \
        acc[ai][bj][m][n] = __builtin_amdgcn_mfma_f32_16x16x32_bf16(Bt[n][k], At[m][k], acc[ai][bj][m][n], 0, 0, 0); __builtin_amdgcn_s_setprio(0); } while (0)
#define PG8_WAIT_V(n) asm volatile("s_waitcnt vmcnt(" #n ")" ::: "memory")
#define PG8_WAIT_L(n) asm volatile("s_waitcnt lgkmcnt(" #n ")" ::: "memory")
#define PG8_BAR __builtin_amdgcn_s_barrier()
#define PG8_SCHED __builtin_amdgcn_sched_barrier(0)
    Unit cur, nxt; int ui = 0;
    if (!S.next(0, cur)) return;
    f32x4 acc[2][2][4][2];
#pragma unroll
    for (int a = 0; a < 2; ++a)
#pragma unroll
        for (int b = 0; b < 2; ++b)
#pragma unroll
            for (int m = 0; m < 4; ++m)
#pragma unroll
                for (int n = 0; n < 2; ++n) acc[a][b][m][n] = (f32x4){0.f, 0.f, 0.f, 0.f};
    bf16x8 At[4][2], B0[2][2], B1[2][2];
    const char* cA = (const char*)g.A + (size_t)cur.pm * tstep; const char* cB = (const char*)g.Bt + (size_t)cur.pn * tstep;
    S.a_ready(cur);
    if constexpr (SP2) {
        PG8_STAGE(PG8_SB(0, 0), cB, voffB); PG8_STAGE(PG8_SB(0, 1), cB + hstep, voffB); PG8_STAGE(PG8_SA(0, 0), cA, voffA); PG8_STAGE(PG8_SA(0, 1), cA + hstep, voffA);
        if (wr == 1) PG8_BAR;
        PG8_WAIT_V(2); PG8_BAR;
        PG8_STAGE(PG8_SB(1, 0), cB + kstep, voffB); PG8_STAGE(PG8_SA(1, 0), cA + kstep, voffA); PG8_STAGE(PG8_SB(1, 1), cB + hstep + kstep, voffB);
        PG8_WAIT_V(6); PG8_BAR;
    } else {
        PG8_STAGE(PG8_SB(0, 0), cB, voffB); PG8_STAGE(PG8_SA(0, 0), cA, voffA); PG8_STAGE(PG8_SB(0, 1), cB + hstep, voffB); PG8_STAGE(PG8_SA(0, 1), cA + hstep, voffA);
        if (wr == 1) PG8_BAR;
        PG8_WAIT_V(4); PG8_BAR;
        PG8_STAGE(PG8_SB(1, 0), cB + kstep, voffB); PG8_STAGE(PG8_SA(1, 0), cA + kstep, voffA); PG8_STAGE(PG8_SB(1, 1), cB + hstep + kstep, voffB);
        PG8_WAIT_V(6); PG8_BAR;
    }
    for (;;) {
        const bool has_next = S.next(ui + 1, nxt);
        const char* nA = has_next ? (const char*)g.A + (size_t)nxt.pm * tstep : cA; const char* nB = has_next ? (const char*)g.Bt + (size_t)nxt.pn * tstep : cB;
        for (int t = 0; t < nt; t += 2) {
            const bool last = (t == nt - 2);
            const char* a1 = cA + (size_t)(t + 1) * kstep;
            const char* a2 = last ? nA : cA + (size_t)(t + 2) * kstep; const char* b2 = last ? nB : cB + (size_t)(t + 2) * kstep;
            const char* a3 = a2 + kstep; const char* b3 = b2 + kstep;
            if (last && has_next) S.a_ready(nxt);
            if constexpr (SP2) {
            PG8_LDB(B0, 0, 0); PG8_LDB(B1, 0, 1); PG8_SCHED; PG8_LDA(At, 0, 0); PG8_STAGE(PG8_SA(1, 1), a1 + hstep, voffA);
            PG8_WAIT_V(8); PG8_WAIT_L(0); PG8_BAR; PG8_MMA(0, 0, At, B0); PG8_MMA(0, 1, At, B1); PG8_BAR; PG8_SCHED;
            PG8_LDA(At, 0, 1); PG8_STAGE(PG8_SB(0, 0), b2, voffB); PG8_STAGE(PG8_SB(0, 1), b2 + hstep, voffB); PG8_STAGE(PG8_SA(0, 0), a2, voffA);
            PG8_WAIT_V(8); PG8_WAIT_L(0); PG8_BAR; PG8_MMA(1, 0, At, B0); PG8_MMA(1, 1, At, B1); PG8_BAR; PG8_SCHED;
            PG8_LDB(B0, 1, 0); PG8_LDB(B1, 1, 1); PG8_SCHED; PG8_LDA(At, 1, 0); PG8_STAGE(PG8_SA(0, 1), a2 + hstep, voffA);
            PG8_WAIT_V(8); PG8_WAIT_L(0); PG8_BAR; PG8_MMA(0, 0, At, B0); PG8_MMA(0, 1, At, B1); PG8_BAR; PG8_SCHED;
            PG8_LDA(At, 1, 1); PG8_STAGE(PG8_SB(1, 0), b3, voffB); PG8_STAGE(PG8_SB(1, 1), b3 + hstep, voffB); PG8_STAGE(PG8_SA(1, 0), a3, voffA);
            PG8_WAIT_V(8); PG8_WAIT_L(0); PG8_BAR; PG8_MMA(1, 0, At, B0); PG8_MMA(1, 1, At, B1); PG8_BAR; PG8_SCHED;
            } else {
            PG8_LDB(B0, 0, 0); PG8_SCHED; PG8_LDA(At, 0, 0); PG8_STAGE(PG8_SA(1, 1), a1 + hstep, voffA);
            PG8_WAIT_L(8); PG8_BAR; PG8_WAIT_L(0); PG8_MMA(0, 0, At, B0); PG8_BAR; PG8_SCHED;
            PG8_LDB(B1, 0, 1); PG8_STAGE(PG8_SB(0, 0), b2, voffB);
            PG8_BAR; PG8_WAIT_L(0); PG8_MMA(0, 1, At, B1); PG8_BAR;
            PG8_LDA(At, 0, 1); PG8_STAGE(PG8_SA(0, 0), a2, voffA);
            PG8_BAR; PG8_WAIT_L(0); PG8_MMA(1, 0, At, B0); PG8_BAR; PG8_SCHED;
            PG8_STAGE(PG8_SB(0, 1), b2 + hstep, voffB);
            PG8_WAIT_V(6); PG8_BAR; PG8_MMA(1, 1, At, B1); PG8_BAR;
            PG8_LDB(B0, 1, 0); PG8_SCHED; PG8_LDA(At, 1, 0); PG8_STAGE(PG8_SA(0, 1), a2 + hstep, voffA);
            PG8_WAIT_L(8); PG8_BAR; PG8_WAIT_L(0); PG8_MMA(0, 0, At, B0); PG8_BAR; PG8_SCHED;
            PG8_LDB(B1, 1, 1); PG8_STAGE(PG8_SB(1, 0), b3, voffB);
            PG8_BAR; PG8_WAIT_L(0); PG8_MMA(0, 1, At, B1); PG8_BAR;
            PG8_LDA(At, 1, 1); PG8_STAGE(PG8_SA(1, 0), a3, voffA);
            PG8_BAR; PG8_WAIT_L(0); PG8_MMA(1, 0, At, B0); PG8_BAR; PG8_SCHED;
            PG8_STAGE(PG8_SB(1, 1), b3 + hstep, voffB);
            PG8_WAIT_V(6); PG8_BAR; PG8_MMA(1, 1, At, B1); PG8_BAR;
            }
        }
        if constexpr (ALIGN_EPI) { if (wr == 0) PG8_BAR; }
        if constexpr (!Epi::AFTER_DRAIN) { E(acc, cur, wr, wc, fr, fq); S.done(cur); }
        if (!has_next) break;
#pragma unroll
        for (int a = 0; a < 2; ++a)
#pragma unroll
            for (int b = 0; b < 2; ++b)
#pragma unroll
                for (int m = 0; m < 4; ++m)
#pragma unroll
                    for (int n = 0; n < 2; ++n) acc[a][b][m][n] = (f32x4){0.f, 0.f, 0.f, 0.f};
        cur = nxt; cA = nA; cB = nB; ++ui;
        if constexpr (ALIGN_EPI) { if (wr == 1) PG8_BAR; }
    }
    PG8_WAIT_V(0);
    if constexpr (!ALIGN_EPI) { if (wr == 0) PG8_BAR; }
    PG8_BAR;
    if constexpr (Epi::AFTER_DRAIN) { E.fused(acc, cur, wr, wc, fr, fq, lds, wid, lane); S.done(cur); }
#undef PG8_SA
#undef PG8_SB
#undef PG8_STAGE
#undef PG8_LDA
#undef PG8_LDB
#undef PG8_MMA
#undef PG8_WAIT_V
#undef PG8_WAIT_L
#undef PG8_BAR
#undef PG8_SCHED
}
}

struct EpiGateUp {
    static constexpr bool PERM = true, AFTER_DRAIN = false;
    bf16_t* act;
    DI void operator()(const f32x4 (&acc)[2][2][4][2], const pg8::Unit& u, int wr, int wc, int fr, int fq) const {
#pragma unroll
        for (int ai = 0; ai < 2; ++ai)
#pragma unroll
            for (int m = 0; m < 4; ++m) {
                const int token = u.pm * 256 + ai * 128 + wr * 64 + m * 16 + fr;
                float v[8];
#pragma unroll
                for (int n = 0; n < 2; ++n)
#pragma unroll
                    for (int i = 0; i < 4; ++i) { const float gg = acc[ai][0][m][n][i], uu = acc[ai][1][m][n][i]; v[4 * n + i] = gg * fast_rcp(1.0f + __expf(-gg)) * uu; }
                *(u32x4*)(act + (size_t)token * F + 128 * u.pn + 32 * wc + 8 * fq) = (u32x4){pk2(v[0], v[1]), pk2(v[2], v[3]), pk2(v[4], v[5]), pk2(v[6], v[7])};
            }
    }
};
struct EpiResid {
    static constexpr bool PERM = true, AFTER_DRAIN = false;
    const float* hin; float* hout; const float* gvec; float gs;
    DI void operator()(const f32x4 (&acc)[2][2][4][2], const pg8::Unit& u, int wr, int wc, int fr, int fq) const {
        f32x4 gv[2][2];
#pragma unroll
        for (int bj = 0; bj < 2; ++bj)
#pragma unroll
            for (int n = 0; n < 2; ++n) gv[bj][n] = *(const f32x4*)(gvec + u.pn * 256 + bj * 128 + wc * 32 + 8 * fq + 4 * n) * gs;
#pragma unroll
        for (int ai = 0; ai < 2; ++ai)
#pragma unroll
            for (int m = 0; m < 4; ++m) {
                const size_t off = (size_t)(u.pm * 256 + ai * 128 + wr * 64 + m * 16 + fr) * D + u.pn * 256 + wc * 32 + 8 * fq;
#pragma unroll
                for (int bj = 0; bj < 2; ++bj)
#pragma unroll
                    for (int n = 0; n < 2; ++n) { const f32x4 hv = *(const f32x4*)(hin + off + bj * 128 + 4 * n); *(f32x4*)(hout + off + bj * 128 + 4 * n) = hv + gv[bj][n] * acc[ai][bj][m][n]; }
                SB();
            }
    }
};
struct EpiGates {
    static constexpr bool PERM = true, AFTER_DRAIN = false;
    bf16_t* G; const float* bias;
    DI void operator()(const f32x4 (&acc)[2][2][4][2], const pg8::Unit& u, int wr, int wc, int fr, int fq) const {
#pragma unroll
        for (int bj = 0; bj < 2; ++bj) {
            const int gc = u.pn * 256 + bj * 128 + wc * 32 + 8 * fq;
            const f32x4 b0 = *(const f32x4*)(bias + gc), b1 = *(const f32x4*)(bias + gc + 4);
#pragma unroll
            for (int ai = 0; ai < 2; ++ai)
#pragma unroll
                for (int m = 0; m < 4; ++m) {
                    const int token = u.pm * 256 + ai * 128 + wr * 64 + m * 16 + fr;
                    const f32x4 x0 = acc[ai][bj][m][0] + b0, x1 = acc[ai][bj][m][1] + b1; float z[8];
#pragma unroll
                    for (int i = 0; i < 4; ++i) { z[i] = fast_rcp(1.0f + __expf(-x0[i])); z[4 + i] = fast_rcp(1.0f + __expf(-x1[i])); }
                    *(u32x4*)(G + (size_t)token * 2048 + gc) = (u32x4){pk2(z[0], z[1]), pk2(z[2], z[3]), pk2(z[4], z[5]), pk2(z[6], z[7])};
                }
        }
    }
};
constexpr long TMP_HI_DELTA = (long)((OFF_KA - OFF_N) / 4) - (long)8192 * D;
struct EpiMerge1 {
    static constexpr bool PERM = true, AFTER_DRAIN = false;
    const bf16_t* G; float* tlo;
    DI void operator()(const f32x4 (&acc)[2][2][4][2], const pg8::Unit& u, int wr, int wc, int fr, int fq) const {
#pragma unroll
        for (int ai = 0; ai < 2; ++ai)
#pragma unroll
            for (int m = 0; m < 4; ++m) {
                const int token = u.pm * 256 + ai * 128 + wr * 64 + m * 16 + fr;
                float* tp = tlo + (size_t)token * D + (token < 8192 ? 0 : TMP_HI_DELTA);
#pragma unroll
                for (int bj = 0; bj < 2; ++bj) {
                    const int ch = u.pn * 256 + bj * 128 + wc * 32 + 8 * fq;
                    const u32x4 gu = *(const u32x4*)(G + (size_t)token * 2048 + ch);
                    *(f32x4*)(tp + ch) = (f32x4){bf_lo(gu[0]), bf_hi(gu[0]), bf_lo(gu[1]), bf_hi(gu[1])} * acc[ai][bj][m][0];
                    *(f32x4*)(tp + ch + 4) = (f32x4){bf_lo(gu[2]), bf_hi(gu[2]), bf_lo(gu[3]), bf_hi(gu[3])} * acc[ai][bj][m][1];
                }
            }
    }
};
struct EpiMerge2 {
    static constexpr bool PERM = true, AFTER_DRAIN = false;
    const bf16_t* G; const float* tlo; bf16_t* merged;
    DI void operator()(const f32x4 (&acc)[2][2][4][2], const pg8::Unit& u, int wr, int wc, int fr, int fq) const {
#pragma unroll
        for (int ai = 0; ai < 2; ++ai)
#pragma unroll
            for (int m = 0; m < 4; ++m) {
                const int token = u.pm * 256 + ai * 128 + wr * 64 + m * 16 + fr;
                const float* tp = tlo + (size_t)token * D + (token < 8192 ? 0 : TMP_HI_DELTA);
#pragma unroll
                for (int bj = 0; bj < 2; ++bj) {
                    const int ch = u.pn * 256 + bj * 128 + wc * 32 + 8 * fq;
                    const u32x4 gu = *(const u32x4*)(G + (size_t)token * 2048 + 1024 + ch);
                    const f32x4 o0 = *(const f32x4*)(tp + ch) + (f32x4){bf_lo(gu[0]), bf_hi(gu[0]), bf_lo(gu[1]), bf_hi(gu[1])} * acc[ai][bj][m][0];
                    const f32x4 o1 = *(const f32x4*)(tp + ch + 4) + (f32x4){bf_lo(gu[2]), bf_hi(gu[2]), bf_lo(gu[3]), bf_hi(gu[3])} * acc[ai][bj][m][1];
                    *(u32x4*)(merged + (size_t)token * D + ch) = (u32x4){pk2(o0[0], o0[1]), pk2(o0[2], o0[3]), pk2(o1[0], o1[1]), pk2(o1[2], o1[3])};
                }
            }
    }
};
template <class Epi> DI void run_pg8(const bf16_t* A, const bf16_t* Bt, int N, int K, const Epi& E, char* lds) {
    pg8::Gemm g; g.A = A; g.Bt = Bt; g.M = S; g.N = N; g.K = K;
    int bid_ = (int)blockIdx.x; asm volatile("" : "+s"(bid_));
    pg8::StaticOrder so; so.init(S, N, (int)gridDim.x, bid_);
    pg8::gemm_phase<Epi, pg8::StaticOrder, true, true>((PG8_LAS unsigned char*)lds, g, so, E);
}

DI void phase_gateup(const bf16_t* n, const bf16_t* wgu, bf16_t* act, char* lds) {
    EpiGateUp E; E.act = act;
    run_pg8(n, wgu, NGU, D, E, lds);
}

DI void phase_resid(const bf16_t* A, int K, const bf16_t* W, const float* hin, float* hout, const float* __restrict__ gvec, float gs, char* lds) {
    EpiResid E; E.hin = hin; E.hout = hout; E.gvec = gvec; E.gs = gs;
    run_pg8(A, W, D, K, E, lds);
}

DI void phase_merge(const bf16_t* atta, const bf16_t* od, const bf16_t* wba, const bf16_t* wbb, const bf16_t* G, bf16_t* merged, float* tlo, char* lds) {
    { EpiMerge1 E; E.G = G; E.tlo = tlo; run_pg8(atta, wba, D, 512, E, lds); }
    asm volatile("s_waitcnt vmcnt(0)" ::: "memory");
    { EpiMerge2 E; E.G = G; E.tlo = tlo; E.merged = merged; run_pg8(od, wbb, D, 512, E, lds); }
}

DI void phase_win(const Params& p, int l, char* lds) {
    const int tid_ = otid(), lane = tid_ & 63, wid = tid_ >> 6, wt = wid >> 1, wc = wid & 1, fr = lane & 15, fq = lane >> 4;
    const bf16_t* n = (const bf16_t*)(p.ws + OFF_N);
    const bf16_t* W = (const bf16_t*)(p.ws + OFF_WIN + l * SZ_WIN);
    bf16_t* Q = (bf16_t*)(p.ws + OFF_Q); bf16_t* QD = (bf16_t*)(p.ws + OFF_QD); bf16_t* KA = (bf16_t*)(p.ws + OFF_KA); bf16_t* VTA = (bf16_t*)(p.ws + OFF_VTA);
    bf16_t* KD = (bf16_t*)(p.ws + OFF_KD); bf16_t* VTD = (bf16_t*)(p.ws + OFF_VTD); bf16_t* G = (bf16_t*)(p.ws + OFF_G);
    const float* rope = (const float*)(p.ws + OFF_ROPE);
    { EpiGates E; E.G = G; E.bias = p.b_gate + l * 2048; run_pg8(n, W + (size_t)2304 * D, 2048, D, E, lds); }
    constexpr int NTILES = 64 * (2304 / 128);
    for (int t = blockIdx.x; t < NTILES; t += gridDim.x) {
        const int bm = t & 63, bn = t >> 6, row0 = bm * 256;
        f32x4 acc[4][4]; zero_acc(acc);
        gemm_mainloop(n + (size_t)row0 * D, D, W + (size_t)bn * 128 * D, D, D, acc, lds);
        const int cw = bn * 128 + 64 * wc;
        if (cw < 640) {
            const bool isq = cw < 512;
            const float* gq = p.qk_g + l * 128 + (isq ? 0 : 64);
            f32x4 gv[4];
#pragma unroll
            for (int mw = 0; mw < 4; ++mw) gv[mw] = *(const f32x4*)(gq + 16 * mw + 4 * fq);
#pragma unroll
            for (int nt = 0; nt < 4; ++nt) {
                const int token = row0 + 64 * wt + 16 * nt + fr;
                float ss = 0.f;
#pragma unroll
                for (int mw = 0; mw < 4; ++mw) ss += acc[mw][nt][0] * acc[mw][nt][0] + acc[mw][nt][1] * acc[mw][nt][1] + acc[mw][nt][2] * acc[mw][nt][2] + acc[mw][nt][3] * acc[mw][nt][3];
                ss += __shfl_xor(ss, 16); ss += __shfl_xor(ss, 32);
                const float rstd = rsqrtf(ss * (1.0f / 64.0f) + 1e-6f);
                f32x4 y[4];
#pragma unroll
                for (int mw = 0; mw < 4; ++mw) y[mw] = acc[mw][nt] * rstd * gv[mw];
                const int prow = token >> 6, pcol = token & 63;
                const f32x4 cr = *(const f32x4*)(rope + prow * 16 + 4 * fq), sr = *(const f32x4*)(rope + 4096 + prow * 16 + 4 * fq);
                const f32x4 cc = *(const f32x4*)(rope + 8192 + pcol * 16 + 4 * fq), sc = *(const f32x4*)(rope + 9216 + pcol * 16 + 4 * fq);
                f32x4 o[4];
                o[0] = y[0] * cr - y[1] * sr; o[1] = y[1] * cr + y[0] * sr; o[2] = y[2] * cc - y[3] * sc; o[3] = y[3] * cc + y[2] * sc;
                const float qs = isq ? QSCALE : 1.0f;
                bf16_t* dst = isq ? (Q + (size_t)token * 512 + cw) : (KA + (size_t)token * 128 + (cw - 512));
#pragma unroll
                for (int mw = 0; mw < 4; ++mw) { const f32x4 z = o[mw] * qs; *(u32x2*)(dst + 16 * mw + 4 * fq) = (u32x2){pk2(z[0], z[1]), pk2(z[2], z[3])}; }
            }
        } else if (cw < 768 || (cw >= 1792 && cw < 2304)) {
            bf16_t* vt = cw < 768 ? (VTA + (size_t)(cw - 640) * S) : (VTD + (size_t)(cw - 1792) * S);
#pragma unroll
            for (int nt = 0; nt < 4; ++nt) {
                const int token = row0 + 64 * wt + 16 * nt + fr;
#pragma unroll
                for (int mw = 0; mw < 4; ++mw)
#pragma unroll
                    for (int r = 0; r < 4; ++r) vt[(size_t)(16 * mw + 4 * fq + r) * S + token] = (bf16_t)(pk2(acc[mw][nt][r], 0.f) & 0xffffu);
            }
        } else if (cw < 1792) {
            const bool isq = cw < 1280; const float qs = isq ? QSCALE : 1.0f;
            bf16_t* base = isq ? (QD + (cw - 768)) : (KD + (cw - 1280));
#pragma unroll
            for (int nt = 0; nt < 4; ++nt) {
                bf16_t* dst = base + (size_t)(row0 + 64 * wt + 16 * nt + fr) * 512;
#pragma unroll
                for (int mw = 0; mw < 4; ++mw) { const f32x4 z = acc[mw][nt] * qs; *(u32x2*)(dst + 16 * mw + 4 * fq) = (u32x2){pk2(z[0], z[1]), pk2(z[2], z[3])}; }
            }
            {
                float best = 0.f;
#pragma unroll
                for (int nt = 0; nt < 4; ++nt) {
                    float ss = 0.f;
#pragma unroll
                    for (int mw = 0; mw < 4; ++mw) { const f32x4 z = acc[mw][nt] * qs; ss += z[0] * z[0] + z[1] * z[1] + z[2] * z[2] + z[3] * z[3]; }
                    ss += __shfl_xor(ss, 16); ss += __shfl_xor(ss, 32);
                    best = __builtin_fmaxf(best, ss);
                }
#pragma unroll
                for (int o = 8; o > 0; o >>= 1) best = __builtin_fmaxf(best, __shfl_xor(best, o));
                if (lane == 0) atomicMax((unsigned*)(p.ws + OFF_STAT) + l * 16 + (isq ? 0 : 8) + ((cw - (isq ? 768 : 1280)) >> 6), __float_as_uint(best));
            }
        } else {
            const int gc = cw - 2304;
            const float* bg = p.b_gate + l * 2048 + gc;
            f32x4 bv[4];
#pragma unroll
            for (int mw = 0; mw < 4; ++mw) bv[mw] = *(const f32x4*)(bg + 16 * mw + 4 * fq);
#pragma unroll
            for (int nt = 0; nt < 4; ++nt) {
                bf16_t* dst = G + (size_t)(row0 + 64 * wt + 16 * nt + fr) * 2048 + gc;
#pragma unroll
                for (int mw = 0; mw < 4; ++mw) {
                    const f32x4 xx = acc[mw][nt] + bv[mw]; f32x4 z;
#pragma unroll
                    for (int r = 0; r < 4; ++r) z[r] = fast_rcp(1.0f + __expf(-xx[r]));
                    *(u32x2*)(dst + 16 * mw + 4 * fq) = (u32x2){pk2(z[0], z[1]), pk2(z[2], z[3])};
                }
            }
        }
    }
}

#define MFMA32(a, b, c) __builtin_amdgcn_mfma_f32_32x32x16_bf16((a), (b), (c), 0, 0, 0)
template <int DV, bool ALIBI>
DI void attn_pass(const bf16_t* __restrict__ Qp, const bf16_t* __restrict__ Kb, int kpitch, const bf16_t* __restrict__ Vtb, float slope2, int qpos, int t_lo, int t_hi, float m_init,
                  f32x16 (&o)[DV / 32], float& l_out, char* lds) {
    constexpr int NV = DV / 64, NDT = DV / 32, STAGE = 8192 + DV * 128, G = 1 + NV;
    const int tid = otid(), lane = tid & 63, r32 = lane & 31, h = lane >> 5;
    bf16x8 qf[4];
#pragma unroll
    for (int d0 = 0; d0 < 4; ++d0) qf[d0] = *(const bf16x8*)(Qp + 16 * d0 + 8 * h);
    const int srow = tid >> 3, sch = (tid & 7) ^ ((srow >> 1) & 7);
    const bf16_t* kg = Kb + (size_t)srow * kpitch + sch * 8;
    const bf16_t* vg = Vtb + (size_t)srow * S + sch * 8;
    char* const ld = lds + tid * 16;
#define A_ISSUE(t_, st_) do { char* sn_ = ld + (st_) * STAGE; glds16(kg + (size_t)(t_) * 64 * kpitch, sn_); \
        _Pragma("unroll") for (int i = 0; i < NV; ++i) glds16(vg + (size_t)(64 * i) * S + (t_) * 64, sn_ + 8192 + i * 8192); } while (0)
    waitv<0>();
    A_ISSUE(t_lo, 0);
    if (t_lo + 1 <= t_hi) A_ISSUE(t_lo + 1, 1);
    if (t_lo + 2 <= t_hi) A_ISSUE(t_lo + 2, 2);
    const int pi = (r32 & 0x13) | ((r32 & 4) << 1) | ((r32 & 8) >> 1);
    const int k_base = pi * 128, k_sw = (pi >> 1) & 7, v_base = 8192 + r32 * 128, v_sw = (r32 >> 1) & 7;
    float m = m_init, l = 0.f;
#pragma unroll
    for (int dt = 0; dt < NDT; ++dt)
#pragma unroll
        for (int r = 0; r < 16; ++r) o[dt][r] = 0.f;
    int cur = 0;
    for (int t = t_lo; t <= t_hi; ++t) {
        const int rem = t_hi - t;
        if (rem >= 2) waitv<2 * G>(); else if (rem == 1) waitv<G>(); else waitv<0>();
        rawbar();
        if (rem >= 3) A_ISSUE(t + 3, (cur + 3) & 3);
        const char* st = lds + cur * STAGE;
        cur = (cur + 1) & 3;
        bf16x8 kf[2][4];
#pragma unroll
        for (int kt = 0; kt < 2; ++kt)
#pragma unroll
            for (int d0 = 0; d0 < 4; ++d0) kf[kt][d0] = *(const bf16x8*)(st + kt * 4096 + k_base + (((2 * d0 + h) ^ k_sw) << 4));
        f32x16 sc[2];
        const float nm = -m;
#pragma unroll
        for (int kt = 0; kt < 2; ++kt)
#pragma unroll
            for (int r = 0; r < 16; ++r) sc[kt][r] = nm;
        SB();
        __builtin_amdgcn_s_setprio(1);
#pragma unroll
        for (int d0 = 0; d0 < 4; ++d0)
#pragma unroll
            for (int kt = 0; kt < 2; ++kt) sc[kt] = MFMA32(kf[kt][d0], qf[d0], sc[kt]);
        __builtin_amdgcn_s_setprio(0);
        bf16x8 vf[2][4];
        if (NDT == 2) {
#pragma unroll
            for (int dt = 0; dt < 2; ++dt)
#pragma unroll
                for (int ks = 0; ks < 4; ++ks) vf[dt][ks] = *(const bf16x8*)(st + v_base + dt * 4096 + (((2 * ks + h) ^ v_sw) << 4));
        }
        SB();
        if (ALIBI) {
#pragma unroll
            for (int kt = 0; kt < 2; ++kt) {
                const float dq = (float)(qpos - (64 * t + 32 * kt + 8 * h));
#pragma unroll
                for (int r = 0; r < 16; ++r) sc[kt][r] = __builtin_fmaf(-slope2, __builtin_fabsf(dq - (float)(16 * (r >> 3) + (r & 7))), sc[kt][r]);
            }
        }
        float mt = sc[0][0];
#pragma unroll
        for (int r = 1; r < 16; ++r) mt = __builtin_fmaxf(mt, sc[0][r]);
#pragma unroll
        for (int r = 0; r < 16; ++r) mt = __builtin_fmaxf(mt, sc[1][r]);
        mt = __builtin_fmaxf(mt, __shfl_xor(mt, 32));
        if (__any(mt > 8.0f)) {
            const float dl = __builtin_fmaxf(mt, 0.f), al = fast_exp2(-dl);
            l *= al; m += dl;
#pragma unroll
            for (int kt = 0; kt < 2; ++kt)
#pragma unroll
                for (int r = 0; r < 16; ++r) sc[kt][r] -= dl;
#pragma unroll
            for (int dt = 0; dt < NDT; ++dt)
#pragma unroll
                for (int r = 0; r < 16; ++r) o[dt][r] *= al;
        }
        float ps = 0.f;
#pragma unroll
        for (int kt = 0; kt < 2; ++kt)
#pragma unroll
            for (int r = 0; r < 16; ++r) { const float e = fast_exp2(sc[kt][r]); sc[kt][r] = e; ps += e; }
        l += ps;
        bf16x8 pf[4];
#pragma unroll
        for (int ks = 0; ks < 4; ++ks) {
            const int kt = ks >> 1, b = (ks & 1) * 8;
            u32x4 w = {pk2(sc[kt][b], sc[kt][b + 1]), pk2(sc[kt][b + 2], sc[kt][b + 3]), pk2(sc[kt][b + 4], sc[kt][b + 5]), pk2(sc[kt][b + 6], sc[kt][b + 7])};
            pf[ks] = __builtin_bit_cast(bf16x8, w);
        }
        SB();
        if (NDT == 4) {
#pragma unroll
            for (int gp = 0; gp < 2; ++gp) {
#pragma unroll
                for (int dt = 0; dt < 2; ++dt)
#pragma unroll
                    for (int ks = 0; ks < 4; ++ks) vf[dt][ks] = *(const bf16x8*)(st + v_base + (dt + 2 * gp) * 4096 + (((2 * ks + h) ^ v_sw) << 4));
                __builtin_amdgcn_s_setprio(1);
#pragma unroll
                for (int ks = 0; ks < 4; ++ks)
#pragma unroll
                    for (int dt = 0; dt < 2; ++dt) o[(dt + 2 * gp) % NDT] = MFMA32(vf[dt][ks], pf[ks], o[(dt + 2 * gp) % NDT]);
                __builtin_amdgcn_s_setprio(0);
                SB();
            }
        } else {
            __builtin_amdgcn_s_setprio(1);
#pragma unroll
            for (int ks = 0; ks < 4; ++ks)
#pragma unroll
                for (int dt = 0; dt < 2; ++dt) o[dt] = MFMA32(vf[dt][ks], pf[ks], o[dt]);
            __builtin_amdgcn_s_setprio(0);
        }
        SB();
    }
#undef A_ISSUE
    __syncthreads();
    l += __shfl_xor(l, 32);
    l_out = l;
}

DI void attn_pass_b(const bf16_t* __restrict__ Qp, const bf16_t* __restrict__ Kb, int kpitch, const bf16_t* __restrict__ Vtb, float slope2, int qpos, int t_lo, int t_hi, float mref,
                    f32x16 (&o)[4], float& l_out, char* lds) {
    constexpr int NV = 2, STAGE = 8192 + 128 * 128, G = 1 + NV;
    const int tid = otid(), lane = tid & 63, r32 = lane & 31, h = lane >> 5;
    const int qw0 = __builtin_amdgcn_readfirstlane(qpos - r32);
    bf16x8 qf[4];
#pragma unroll
    for (int d0 = 0; d0 < 4; ++d0) qf[d0] = *(const bf16x8*)(Qp + 16 * d0 + 8 * h);
    const int srow = tid >> 3, sch = (tid & 7) ^ ((srow >> 1) & 7);
    const bf16_t* kg = Kb + (size_t)srow * kpitch + sch * 8;
    const bf16_t* vg = Vtb + (size_t)srow * S + sch * 8;
    char* const ld = lds + tid * 16;
#define B_ISSUE(t_, st_) do { char* sn_ = ld + (st_) * STAGE; glds16(kg + (size_t)(t_) * 64 * kpitch, sn_); \
        _Pragma("unroll") for (int i = 0; i < NV; ++i) glds16(vg + (size_t)(64 * i) * S + (t_) * 64, sn_ + 8192 + i * 8192); } while (0)
    waitv<0>();
    B_ISSUE(t_lo, 0);
    if (t_lo + 1 <= t_hi) B_ISSUE(t_lo + 1, 1);
    if (t_lo + 2 <= t_hi) B_ISSUE(t_lo + 2, 2);
    const int pi = (r32 & 0x13) | ((r32 & 4) << 1) | ((r32 & 8) >> 1);
    const int k_base = pi * 128, k_sw = (pi >> 1) & 7, v_base = 8192 + r32 * 128, v_sw = (r32 >> 1) & 7;
    float l = 0.f;
    const float nm = -mref;
#pragma unroll
    for (int dt = 0; dt < 4; ++dt)
#pragma unroll
        for (int r = 0; r < 16; ++r) o[dt][r] = 0.f;
    int cur = 0;
    for (int t = t_lo; t <= t_hi; ++t) {
        const int rem = t_hi - t;
        if (rem >= 2) waitv<2 * G>(); else if (rem == 1) waitv<G>(); else waitv<0>();
        rawbar();
        if (rem >= 3) B_ISSUE(t + 3, (cur + 3) & 3);
        const char* st = lds + cur * STAGE;
        cur = (cur + 1) & 3;
        bf16x8 kf[2][4];
#pragma unroll
        for (int kt = 0; kt < 2; ++kt)
#pragma unroll
            for (int d0 = 0; d0 < 4; ++d0) kf[kt][d0] = *(const bf16x8*)(st + kt * 4096 + k_base + (((2 * d0 + h) ^ k_sw) << 4));
        const int side = (64 * t + 63 < qw0) ? 1 : ((64 * t > qw0 + 31) ? -1 : 0);
        f32x16 sc[2];
        if (side != 0) {
            const float ss = side > 0 ? slope2 : -slope2;
#pragma unroll
            for (int kt = 0; kt < 2; ++kt) {
                const float base = __builtin_fmaf(ss, (float)(64 * t + 32 * kt + 8 * h - qpos), nm);
#pragma unroll
                for (int r = 0; r < 16; ++r) sc[kt][r] = __builtin_fmaf(ss, (float)(16 * (r >> 3) + (r & 7)), base);
            }
        } else {
#pragma unroll
            for (int kt = 0; kt < 2; ++kt)
#pragma unroll
                for (int r = 0; r < 16; ++r) sc[kt][r] = nm;
        }
        SB();
        __builtin_amdgcn_s_setprio(1);
#pragma unroll
        for (int d0 = 0; d0 < 4; ++d0)
#pragma unroll
            for (int kt = 0; kt < 2; ++kt) sc[kt] = MFMA32(kf[kt][d0], qf[d0], sc[kt]);
        __builtin_amdgcn_s_setprio(0);
        SB();
        if (side == 0) {
#pragma unroll
            for (int kt = 0; kt < 2; ++kt) {
                const float dq = (float)(qpos - (64 * t + 32 * kt + 8 * h));
#pragma unroll
                for (int r = 0; r < 16; ++r) sc[kt][r] = __builtin_fmaf(-slope2, __builtin_fabsf(dq - (float)(16 * (r >> 3) + (r & 7))), sc[kt][r]);
            }
        }
        float ps = 0.f;
#pragma unroll
        for (int kt = 0; kt < 2; ++kt)
#pragma unroll
            for (int r = 0; r < 16; ++r) { const float e = fast_exp2(sc[kt][r]); sc[kt][r] = e; ps += e; }
        l += ps;
        bf16x8 pf[4];
#pragma unroll
        for (int ks = 0; ks < 4; ++ks) {
            const int kt = ks >> 1, b = (ks & 1) * 8;
            u32x4 w = {pk2(sc[kt][b], sc[kt][b + 1]), pk2(sc[kt][b + 2], sc[kt][b + 3]), pk2(sc[kt][b + 4], sc[kt][b + 5]), pk2(sc[kt][b + 6], sc[kt][b + 7])};
            pf[ks] = __builtin_bit_cast(bf16x8, w);
        }
        SB();
#pragma unroll
        for (int gp = 0; gp < 2; ++gp) {
            bf16x8 vf[2][4];
#pragma unroll
            for (int dt = 0; dt < 2; ++dt)
#pragma unroll
                for (int ks = 0; ks < 4; ++ks) vf[dt][ks] = *(const bf16x8*)(st + v_base + (dt + 2 * gp) * 4096 + (((2 * ks + h) ^ v_sw) << 4));
            __builtin_amdgcn_s_setprio(1);
#pragma unroll
            for (int ks = 0; ks < 4; ++ks)
#pragma unroll
                for (int dt = 0; dt < 2; ++dt) o[dt + 2 * gp] = MFMA32(vf[dt][ks], pf[ks], o[dt + 2 * gp]);
            __builtin_amdgcn_s_setprio(0);
            SB();
        }
    }
#undef B_ISSUE
    __syncthreads();
    l += __shfl_xor(l, 32);
    l_out = l;
}

DI void attn_pass_a(const bf16_t* __restrict__ Qp, const bf16_t* __restrict__ Kb, int kpitch, const bf16_t* __restrict__ Vtb, float mref, f32x16 (&o)[2], float& l_out, char* lds) {
    constexpr int STAGE = 16384, NTL = S / 64;
    const int tid = otid(), lane = tid & 63, r32 = lane & 31, h = lane >> 5;
    bf16x8 qf[4];
#pragma unroll
    for (int d0 = 0; d0 < 4; ++d0) qf[d0] = *(const bf16x8*)(Qp + 16 * d0 + 8 * h);
    const int srow = tid >> 3, sch = (tid & 7) ^ ((srow >> 1) & 7);
    const bf16_t* kg = Kb + (size_t)srow * kpitch + sch * 8;
    const bf16_t* vg = Vtb + (size_t)srow * S + sch * 8;
    char* const ld = lds + tid * 16;
#define AA_ISSUE(t_, st_) do { char* sn_ = ld + (st_) * STAGE; glds16(kg + (size_t)(t_) * 64 * kpitch, sn_); glds16(vg + (t_) * 64, sn_ + 8192); } while (0)
    waitv<0>();
    AA_ISSUE(0, 0); AA_ISSUE(1, 1); AA_ISSUE(2, 2);
    const int pi = (r32 & 0x13) | ((r32 & 4) << 1) | ((r32 & 8) >> 1);
    const int k_base = pi * 128, k_sw = (pi >> 1) & 7, v_base = 8192 + r32 * 128, v_sw = (r32 >> 1) & 7;
    f32x16 negm, lacc;
#pragma unroll
    for (int r = 0; r < 16; ++r) { negm[r] = -mref; lacc[r] = 0.f; o[0][r] = 0.f; o[1][r] = 0.f; }
    const bf16x8 ones = {(short)0x3F80, (short)0x3F80, (short)0x3F80, (short)0x3F80, (short)0x3F80, (short)0x3F80, (short)0x3F80, (short)0x3F80};
    f32x16 sA[2], sB[2];
#define AA_QK(DST, stp_) do { bf16x8 kf_[2][4]; \
        _Pragma("unroll") for (int kt = 0; kt < 2; ++kt) _Pragma("unroll") for (int d0 = 0; d0 < 4; ++d0) kf_[kt][d0] = *(const bf16x8*)((stp_) + kt * 4096 + k_base + (((2 * d0 + h) ^ k_sw) << 4)); \
        SB(); __builtin_amdgcn_s_setprio(1); \
        DST[0] = MFMA32(kf_[0][0], qf[0], negm); DST[1] = MFMA32(kf_[1][0], qf[0], negm); \
        _Pragma("unroll") for (int d0 = 1; d0 < 4; ++d0) { DST[0] = MFMA32(kf_[0][d0], qf[d0], DST[0]); DST[1] = MFMA32(kf_[1][d0], qf[d0], DST[1]); } \
        __builtin_amdgcn_s_setprio(0); } while (0)
    waitv<4>();
    rawbar();
    AA_QK(sA, lds);
#define AA_STEP(CUR, NXT, t_) do { const int t = (t_); \
        if (t + 2 < NTL) waitv<2>(); else waitv<0>();              \
        rawbar();                                                  \
        if (t + 3 < NTL) AA_ISSUE(t + 3, (t + 3) & 3); \
        const char* st = lds + (t & 3) * STAGE; \
        if (t + 1 < NTL) AA_QK(NXT, lds + ((t + 1) & 3) * STAGE); \
        bf16x8 vf[2][4]; \
        _Pragma("unroll") for (int dt = 0; dt < 2; ++dt) _Pragma("unroll") for (int ks = 0; ks < 4; ++ks) vf[dt][ks] = *(const bf16x8*)(st + v_base + dt * 4096 + (((2 * ks + h) ^ v_sw) << 4)); \
        SB(); \
        _Pragma("unroll") for (int kt = 0; kt < 2; ++kt) _Pragma("unroll") for (int r = 0; r < 16; ++r) CUR[kt][r] = fast_exp2(CUR[kt][r]); \
        bf16x8 pf[4]; \
        _Pragma("unroll") for (int ks = 0; ks < 4; ++ks) { const int kt = ks >> 1, b = (ks & 1) * 8; \
            u32x4 w = {pk2(CUR[kt][b], CUR[kt][b + 1]), pk2(CUR[kt][b + 2], CUR[kt][b + 3]), pk2(CUR[kt][b + 4], CUR[kt][b + 5]), pk2(CUR[kt][b + 6], CUR[kt][b + 7])}; \
            pf[ks] = __builtin_bit_cast(bf16x8, w); } \
        SB(); __builtin_amdgcn_s_setprio(1); \
        _Pragma("unroll") for (int ks = 0; ks < 4; ++ks) { _Pragma("unroll") for (int dt = 0; dt < 2; ++dt) o[dt] = MFMA32(vf[dt][ks], pf[ks], o[dt]); lacc = MFMA32(ones, pf[ks], lacc); } \
        __builtin_amdgcn_s_setprio(0); SB(); } while (0)
    for (int t2 = 0; t2 < NTL; t2 += 2) { AA_STEP(sA, sB, t2); AA_STEP(sB, sA, t2 + 1); }
#undef AA_STEP
#undef AA_QK
#undef AA_ISSUE
    __syncthreads();
    l_out = lacc[0];
}

DI void phase_attn(const Params& p, int l, int rep, char* lds) {
    const int tid = otid(), lane = tid & 63, wid = tid >> 6, r32 = lane & 31, h = lane >> 5;
    const bf16_t* Q = (const bf16_t*)(p.ws + OFF_Q); const bf16_t* QD = (const bf16_t*)(p.ws + OFF_QD); const bf16_t* KA = (const bf16_t*)(p.ws + OFF_KA);
    const bf16_t* VTA = (const bf16_t*)(p.ws + OFF_VTA); const bf16_t* KD = (const bf16_t*)(p.ws + OFF_KD); const bf16_t* VTD = (const bf16_t*)(p.ws + OFF_VTD);
    bf16_t* ATTA = (bf16_t*)(p.ws + OFF_ATTA); bf16_t* OD = (bf16_t*)(p.ws + OFF_OD); float* BO0 = (float*)(p.ws + OFF_N);
    const float lam = ((const float*)(p.ws + OFF_LAM))[l];
    const float oml = 1.0f - (l == 0 ? 0.2f : 0.35550906759096926f);
    float bA;
    { float gq = __builtin_fabsf(p.qk_g[l * 128 + lane]), gk = __builtin_fabsf(p.qk_g[l * 128 + 64 + lane]);
#pragma unroll
      for (int o_ = 32; o_ > 0; o_ >>= 1) { gq = __builtin_fmaxf(gq, __shfl_xor(gq, o_)); gk = __builtin_fmaxf(gk, __shfl_xor(gk, o_)); }
      bA = 64.0f * gq * gk * QSCALE * 1.01f; }
    unsigned* qcnt = (unsigned*)(p.ws + OFF_STAT) + 32 + l + 2 * rep;
    const unsigned* stat = (const unsigned*)(p.ws + OFF_STAT) + l * 16;
    volatile unsigned* lword = (volatile unsigned*)(lds + 147456 + 16);
    for (;;) {
        if (tid == 0) *lword = atomicAdd(qcnt, 1u);
        __syncthreads();
        const int u = (int)*lword;
        __syncthreads();
        if (u >= 768) break;
        if (PROBE_DUP == 5 && rep && (u < 128 || u >= 640)) continue;
        if (u < 128 || u >= 640) {
            const int hb = u < 64 ? 3 : (u < 128 ? 2 : (u < 704 ? 1 : 0)), qb = u & 63;
            const int token = 256 * qb + 32 * wid + r32;
            const float slope2 = exp2f(-2.0f * (float)(hb + 1)) * LOG2E;
            float* bo = BO0 + (size_t)token * 512 + hb * 128;
            f32x16 o[4]; float ls;
            int tl[2], th[2]; float mi[2];
#pragma unroll
            for (int mp = 0; mp < 2; ++mp) {
                const float qk = sqrtf(__uint_as_float(stat[mp * 4 + hb]) * __uint_as_float(stat[8 + mp * 4 + hb])) * 1.02f;
                const float R = __builtin_fminf((2.0f * qk + 150.0f) / slope2, 40000.0f);
                const int klo = 256 * qb - (int)R - 1, khi = 256 * qb + 255 + (int)R + 1;
                mi[mp] = -qk;
                tl[mp] = klo < 0 ? 0 : (klo >> 6); th[mp] = khi >= S ? (S / 64 - 1) : (khi >> 6);
            }
            if (-mi[0] <= 45.0f) attn_pass_b(QD + (size_t)token * 512 + hb * 64, KD + hb * 64, 512, VTD + (size_t)(hb * 128) * S, slope2, token, tl[0], th[0], -mi[0], o, ls, lds);
            else attn_pass<128, true>(QD + (size_t)token * 512 + hb * 64, KD + hb * 64, 512, VTD + (size_t)(hb * 128) * S, slope2, token, tl[0], th[0], mi[0], o, ls, lds);
            {
                const float inv = 1.0f / ls;
#pragma unroll
                for (int dt = 0; dt < 4; ++dt)
#pragma unroll
                    for (int g = 0; g < 4; ++g) *(f32x4*)(bo + 32 * dt + 8 * g + 4 * h) = (f32x4){o[dt][4 * g] * inv, o[dt][4 * g + 1] * inv, o[dt][4 * g + 2] * inv, o[dt][4 * g + 3] * inv};
            }
            if (-mi[1] <= 45.0f) attn_pass_b(QD + (size_t)token * 512 + 256 + hb * 64, KD + 256 + hb * 64, 512, VTD + (size_t)(hb * 128) * S, slope2, token, tl[1], th[1], -mi[1], o, ls, lds);
            else attn_pass<128, true>(QD + (size_t)token * 512 + 256 + hb * 64, KD + 256 + hb * 64, 512, VTD + (size_t)(hb * 128) * S, slope2, token, tl[1], th[1], mi[1], o, ls, lds);
            {
                const float inv = lam / ls; float ss = 0.f;
#pragma unroll
                for (int dt = 0; dt < 4; ++dt)
#pragma unroll
                    for (int g = 0; g < 4; ++g) {
                        const f32x4 a = *(const f32x4*)(bo + 32 * dt + 8 * g + 4 * h);
#pragma unroll
                        for (int j = 0; j < 4; ++j) { const float v = a[j] - o[dt][4 * g + j] * inv; o[dt][4 * g + j] = v; ss += v * v; }
                    }
                ss += __shfl_xor(ss, 32);
                const float rstd = rsqrtf(ss * (1.0f / 128.0f) + 1e-6f) * oml;
                const float* sg = p.subln_g + l * 128;
                bf16_t* dst = OD + (size_t)token * 512 + hb * 128;
#pragma unroll
                for (int dt = 0; dt < 4; ++dt)
#pragma unroll
                    for (int g = 0; g < 4; ++g) {
                        const int d = 32 * dt + 8 * g + 4 * h;
                        const f32x4 gg = *(const f32x4*)(sg + d);
                        *(u32x2*)(dst + d) = (u32x2){pk2(o[dt][4 * g] * rstd * gg[0], o[dt][4 * g + 1] * rstd * gg[1]), pk2(o[dt][4 * g + 2] * rstd * gg[2], o[dt][4 * g + 3] * rstd * gg[3])};
                    }
            }
        } else {
            const int v = u - 128, kv = v >> 8, hq = kv * 4 + (v & 3), qb = (v >> 2) & 63;
            const int token = 256 * qb + 32 * wid + r32;
            f32x16 o[2]; float ls;
            if (bA <= 40.0f) attn_pass_a(Q + (size_t)token * 512 + hq * 64, KA + kv * 64, 128, VTA + (size_t)(kv * 64) * S, bA, o, ls, lds);
            else attn_pass<64, false>(Q + (size_t)token * 512 + hq * 64, KA + kv * 64, 128, VTA + (size_t)(kv * 64) * S, 0.f, token, 0, S / 64 - 1, 0.f, o, ls, lds);
            const float inv = 1.0f / ls;
            bf16_t* dst = ATTA + (size_t)token * 512 + hq * 64;
#pragma unroll
            for (int dt = 0; dt < 2; ++dt)
#pragma unroll
                for (int g = 0; g < 4; ++g)
                    *(u32x2*)(dst + 32 * dt + 8 * g + 4 * h) = (u32x2){pk2(o[dt][4 * g] * inv, o[dt][4 * g + 1] * inv), pk2(o[dt][4 * g + 2] * inv, o[dt][4 * g + 3] * inv)};
        }
    }
}

#define XB_TMO      128
#define XB_XCNT(j)  (256  + 64 * (j))
#define XB_XSUB(j)  (1280 + 64 * (j))
#define XB_XGEN(j)  (2304 + 64 * (j))
#define XB_TOP      3328
#define XB_TOPGEN   3392
#define XCD_BAR_WORDS 3456
#define XB_SPIN_CAP (1u << 22)
#define LAS __attribute__((address_space(3)))
DI unsigned xb_ld(unsigned* p) { return __hip_atomic_load(p, __ATOMIC_RELAXED, __HIP_MEMORY_SCOPE_AGENT); }
DI unsigned xb_add(unsigned* p, unsigned v) { return __hip_atomic_fetch_add(p, v, __ATOMIC_RELAXED, __HIP_MEMORY_SCOPE_AGENT); }
DI unsigned xb_xcc_id() { return (unsigned)__builtin_amdgcn_s_getreg((3 << 11) | 20) & 0xFu; }
#define XB_SPIN(cond, bar) do { unsigned _sp = 0; while (cond) { __builtin_amdgcn_s_sleep(1); \
    if ((++_sp & 255u) == 0u) { if (xb_ld(&(bar)[XB_TMO])) break; if (_sp > XB_SPIN_CAP) { atomicAdd(&(bar)[XB_TMO], 1u); break; } } } } while (0)
struct XcdBarrier { unsigned* bar; unsigned x; volatile LAS unsigned* st; };
DI XcdBarrier xcd_barrier_post(unsigned* bar, volatile LAS unsigned* st) {
    XcdBarrier b; b.bar = bar; b.x = xb_xcc_id(); b.st = st;
    if (threadIdx.x == 0) (void)xb_add(&bar[XB_XCNT(b.x)], 1u);
    return b;
}
DI void xcd_barrier_complete(unsigned* bar, unsigned x, unsigned& nloc, unsigned& nx) {
    const unsigned G = gridDim.x * gridDim.y * gridDim.z;
    unsigned sum, cnt, mine, sp = 0u;
    for (;;) {
        sum = 0u; cnt = 0u; mine = 0u;
#pragma unroll
        for (unsigned j = 0; j < 16; ++j) { const unsigned c = xb_ld(&bar[XB_XCNT(j)]); sum += c; cnt += (c > 0u) ? 1u : 0u; mine = (j == x) ? c : mine; }
        if (sum == G) break;
        __builtin_amdgcn_s_sleep(1);
        if ((++sp & 255u) == 0u) { if (xb_ld(&bar[XB_TMO])) break; if (sp > XB_SPIN_CAP) { atomicAdd(&bar[XB_TMO], 1u); break; } }
    }
    nloc = mine > 0u ? mine : 1u; nx = cnt > 0u ? cnt : 1u;
}
DI void xcd_barrier(const XcdBarrier& b) {
    asm volatile("s_waitcnt vmcnt(0)" ::: "memory");
    __syncthreads();
    if (otid() == 0) {
        unsigned* bar = b.bar;
        __builtin_amdgcn_s_waitcnt(0);
        unsigned nloc = b.st[0], nx = b.st[1];
        if (nloc == 0u) { xcd_barrier_complete(bar, b.x, nloc, nx); b.st[0] = nloc; b.st[1] = nx; }
        const unsigned old = xb_add(&bar[XB_XSUB(b.x)], 1u);
        const unsigned gen = old / nloc;
        if (old + 1u == (gen + 1u) * nloc) {
            __builtin_amdgcn_fence(__ATOMIC_RELEASE, "agent");
            asm volatile("s_waitcnt vmcnt(0)" ::: "memory");
            const unsigned og = xb_add(&bar[XB_TOP], 1u);
            const unsigned tg = og / nx;
            if (og + 1u == (tg + 1u) * nx) xb_add(&bar[XB_TOPGEN], 1u);
            else XB_SPIN(xb_ld(&bar[XB_TOPGEN]) == tg, bar);
            __builtin_amdgcn_fence(__ATOMIC_ACQUIRE, "agent");
            xb_add(&bar[XB_XGEN(b.x)], 1u);
            asm volatile("s_waitcnt vmcnt(0)" ::: "memory");
        } else {
            XB_SPIN(xb_ld(&bar[XB_XGEN(b.x)]) == gen, bar);
            __builtin_amdgcn_fence(__ATOMIC_ACQUIRE, "agent");
            asm volatile("s_waitcnt vmcnt(0)" ::: "memory");
        }
    }
    __syncthreads();
}

__global__ void __launch_bounds__(512) mega(Params pin) {
    __shared__ __attribute__((aligned(16))) char lds[147456 + 64];
    cg::grid_group grid = cg::this_grid();
    volatile LAS unsigned* xst = (volatile LAS unsigned*)(lds + 147456);
    if (threadIdx.x == 0) { xst[0] = 0u; xst[1] = 0u; }
    __syncthreads();
    const XcdBarrier xb = xcd_barrier_post((unsigned*)(pin.ws + OFF_BAR), xst);
    int rep = 0;
    for (int ph = pin.ph_lo; ph < pin.ph_hi; ++ph) {
        Params p = pin;
        asm volatile("" : "+s"(p.ws), "+s"(p.out), "+s"(p.x));
        bf16_t* nbuf = (bf16_t*)(p.ws + OFF_N);
        bf16_t* act = (bf16_t*)(p.ws + OFF_ACT);
        if (ph == 0) phase_prologue(p, lds);
        else {
            const int l = ph == 23 ? 1 : (ph - 1) / 11, k = ph == 23 ? 11 : (ph - 1) % 11;
            const float* mod = (const float*)(p.ws + OFF_MOD) + l * 9216;
            switch (k) {
            case 0: case 3: case 8: case 11: {
                const int i = k == 0 ? 0 : (k == 3 ? 1 : 2);
                const float* hin = (ph == 1) ? p.x : p.out;
                if (k == 11) phase_norm(hin, p.final_g, nullptr, nullptr, nullptr, p.out);
                else phase_norm(hin, p.norm_g + (l * 3 + i) * D, mod + (3 * i) * D, mod + (3 * i + 1) * D, nbuf, nullptr);
            } break;
            case 1: case 9: {
                const int f = k == 1 ? 0 : 1;
                phase_gateup(nbuf, (const bf16_t*)(p.ws + OFF_WGU + (size_t)(l * 2 + f) * SZ_WGU), act, lds);
            } break;
            case 2: case 10: case 7: {
                if (k == 7) phase_resid((const bf16_t*)(p.ws + OFF_Q), D, (const bf16_t*)(p.ws + OFF_WO + l * SZ_WO), p.out, p.out, mod + 5 * D, rep ? 0.0f : 1.0f, lds);
                else {
                    const int f = k == 2 ? 0 : 1;
                    phase_resid(act, F, (const bf16_t*)(p.ws + OFF_WD + (size_t)(l * 2 + f) * SZ_WD), (ph == 3 && !rep) ? p.x : p.out, p.out, mod + (f == 0 ? 2 : 8) * D, rep ? 0.0f : 0.5f, lds);
                }
            } break;
            case 4: phase_win(p, l, lds); break;
            case 5: phase_attn(p, l, rep, lds); break;
            case 6: phase_merge((const bf16_t*)(p.ws + OFF_ATTA), (const bf16_t*)(p.ws + OFF_OD), (const bf16_t*)(p.ws + OFF_WBA + l * SZ_WB), (const bf16_t*)(p.ws + OFF_WBB + l * SZ_WB),
                                (const bf16_t*)(p.ws + OFF_G), (bf16_t*)(p.ws + OFF_Q), (float*)(p.ws + OFF_N), lds); break;
            default: break;
            }
        }
        if (ph + 1 < pin.ph_hi) { if (ph == 0) grid.sync(); else xcd_barrier(xb); }
        if (PROBE_DUP >= 0 && rep == 0 && (ph == 0 ? PROBE_DUP == 100 : ((ph - 1) % 11 == PROBE_DUP && ph != 23))) { rep = 1; --ph; } else rep = 0;
    }
}

extern "C" void kernel_launch(void* const* d_in, const int* in_sizes, int n_in, void* d_out, int out_size, void* d_ws, size_t ws_size, hipStream_t stream) {
    if (n_in != 18 || out_size != S * D || ws_size < WS_END) { fprintf(stderr, "kernel_launch: unexpected shapes / workspace (n_in %d out %d ws %zu need %zu)\n", n_in, out_size, ws_size, (size_t)WS_END); return; }
    Params p{};
    const float** pp = (const float**)&p;
    for (int i = 0; i < 18; ++i) pp[i] = (const float*)d_in[i];
    p.out = (float*)d_out; p.ws = (unsigned char*)d_ws;
    if (hipMemsetAsync((char*)d_ws + OFF_BAR, 0, 3456 * 4, stream) != hipSuccess) { fprintf(stderr, "kernel_launch: hipMemsetAsync of the barrier words failed\n"); return; }
#if MK_MULTI
    for (int ph = 0; ph < NPH; ++ph) { p.ph_lo = ph; p.ph_hi = ph + 1; hipLaunchKernelGGL(mega, dim3(256), dim3(512), 0, stream, p); }
#else
    static int grid = 0;
    if (!grid) {
        int dev = 0, cus = 0, per_cu = 0;
        hipGetDevice(&dev); hipDeviceGetAttribute(&cus, hipDeviceAttributeMultiprocessorCount, dev);
        hipOccupancyMaxActiveBlocksPerMultiprocessor(&per_cu, (const void*)mega, 512, 0);
        if (per_cu < 1) { fprintf(stderr, "kernel_launch: occupancy query says %d blocks per CU\n", per_cu); per_cu = 1; }
        grid = cus;
    }
    p.ph_lo = 0; p.ph_hi = NPH;
    void* args[] = {&p};
    hipError_t e = hipLaunchCooperativeKernel((const void*)mega, dim3(grid), dim3(512), args, 0, stream);
    if (e != hipSuccess) fprintf(stderr, "cooperative launch failed: %s (grid %d)\n", hipGetErrorString(e), grid);
#endif
}
```

```cpp
#include <hip/hip_runtime.h>
#include <hip/hip_cooperative_groups.h>
#include <cstdio>
#include <cstdint>
namespace cg = cooperative_groups;

#ifndef MK_MULTI
#define MK_MULTI 0
#endif

#ifndef PROBE_DUP
#define PROBE_DUP -1
#endif
#define DI __device__ __forceinline__
typedef unsigned short bf16_t;
typedef short bf16x8 __attribute__((ext_vector_type(8)));
typedef float f32x4 __attribute__((ext_vector_type(4)));
typedef float f32x16 __attribute__((ext_vector_type(16)));
typedef unsigned u32x4 __attribute__((ext_vector_type(4)));
typedef unsigned u32x2 __attribute__((ext_vector_type(2)));

constexpr int S = 16384, D = 1024, F = 2816, NGU = 5632, NIN = 4352;
constexpr int NPH = 24;
constexpr float QSCALE = 0.125f * 1.4426950408889634f;
constexpr float LOG2E = 1.4426950408889634f;

constexpr size_t OFF_MOD = 0;
constexpr size_t OFF_LAM = 80000;
constexpr size_t OFF_STAT = 80128;
constexpr size_t OFF_ROPE = 81920;
constexpr size_t OFF_BAR = 131072;
constexpr size_t OFF_WGU = 1u << 20;
constexpr size_t SZ_WGU = (size_t)NGU * D * 2;
constexpr size_t OFF_WD = OFF_WGU + 4 * SZ_WGU;
constexpr size_t SZ_WD = (size_t)D * F * 2;
constexpr size_t OFF_WIN = OFF_WD + 4 * SZ_WD;
constexpr size_t SZ_WIN = (size_t)NIN * D * 2;
constexpr size_t OFF_WBA = OFF_WIN + 2 * SZ_WIN;
constexpr size_t SZ_WB = (size_t)D * 512 * 2;
constexpr size_t OFF_WBB = OFF_WBA + 2 * SZ_WB;
constexpr size_t OFF_WO = OFF_WBB + 2 * SZ_WB;
constexpr size_t SZ_WO = (size_t)D * D * 2;
constexpr size_t OFF_N = OFF_WO + 2 * SZ_WO;
constexpr size_t OFF_MIX = OFF_N + (size_t)S * D * 2;
constexpr size_t OFF_Q = OFF_MIX;
constexpr size_t OFF_QD = OFF_Q + (size_t)S * 512 * 2;
constexpr size_t OFF_KA = OFF_QD + (size_t)S * 512 * 2;
constexpr size_t OFF_VTA = OFF_KA + (size_t)S * 128 * 2;
constexpr size_t OFF_KD = OFF_VTA + (size_t)S * 128 * 2;
constexpr size_t OFF_VTD = OFF_KD + (size_t)S * 512 * 2;
constexpr size_t OFF_G = OFF_VTD + (size_t)S * 512 * 2;
constexpr size_t OFF_ATTA = OFF_G + (size_t)S * 2048 * 2;
constexpr size_t OFF_OD = OFF_ATTA + (size_t)S * 512 * 2;
constexpr size_t OFF_ACT = OFF_MIX;
constexpr size_t WS_END = OFF_OD + (size_t)S * 512 * 2;
static_assert((size_t)S * F * 2 <= WS_END - OFF_MIX, "act overlay");

struct Params {
    const float *x, *c, *ada_w, *ada_b, *norm_g, *ffn_wg, *ffn_wu, *ffn_wd, *w_in, *qk_g, *lam_p, *subln_g, *w_ba, *w_bb, *w_gate, *b_gate, *w_o, *final_g;
    float* out; unsigned char* ws; int ph_lo, ph_hi;
};

typedef __bf16 bf16v2 __attribute__((ext_vector_type(2)));
typedef float f32x2 __attribute__((ext_vector_type(2)));
DI unsigned pk2(float lo, float hi) { f32x2 v = {lo, hi}; bf16v2 b = __builtin_convertvector(v, bf16v2); return __builtin_bit_cast(unsigned, b); }
DI float bf_lo(unsigned u) { return __uint_as_float(u << 16); }
DI float bf_hi(unsigned u) { return __uint_as_float(u & 0xffff0000u); }
DI int lds_off(int row, int chunk) { return row * 128 + ((chunk ^ ((row >> 1) & 7)) << 4); }
DI float fast_exp2(float x) { return __builtin_amdgcn_exp2f(x); }
DI float fast_rcp(float x) { return __builtin_amdgcn_rcpf(x); }
DI int otid() { int t = threadIdx.x; asm volatile("" : "+v"(t)); return t; }
#define SB() __builtin_amdgcn_sched_barrier(0)

DI int perm64(int n) { return (n & ~63) | (((n >> 2) & 3) << 4) | (((n >> 4) & 3) << 2) | (n & 3); }
DI int gumap(int j) { return 128 * (j >> 6) + 64 * ((j >> 5) & 1) + 16 * ((j >> 2) & 1) + 4 * ((j >> 3) & 3) + (j & 3); }

struct TrDesc { const float* src; bf16_t* dst; int N, k0, n0, ldd, mode, roff; };
DI void tr_decode(const Params& p, int tt, TrDesc& d) {
    constexpr int N_TR_L = 5824;
    const int l = tt / N_TR_L, r = tt % N_TR_L;
    if (r < 4224) {
        const int f = r / 2112, r2 = r % 2112, which = r2 / 704, r3 = r2 % 704;
        const size_t lf = (size_t)(l * 2 + f);
        if (which < 2) { d.src = (which == 0 ? p.ffn_wg : p.ffn_wu) + lf * D * F; d.N = F; d.k0 = (r3 / 44) * 64; d.n0 = (r3 % 44) * 64; d.dst = (bf16_t*)(p.ws + OFF_WGU + lf * SZ_WGU); d.ldd = D; d.mode = 3; d.roff = which * 128; }
        else { d.src = p.ffn_wd + lf * F * D; d.N = D; d.k0 = (r3 / 16) * 64; d.n0 = (r3 % 16) * 64; d.dst = (bf16_t*)(p.ws + OFF_WD + lf * SZ_WD); d.ldd = F; d.mode = 0; d.roff = 0; }
    } else if (r < 4800) { const int r3 = r - 4224; d.src = p.w_in + (size_t)l * D * 2304; d.N = 2304; d.k0 = (r3 / 36) * 64; d.n0 = (r3 % 36) * 64; d.dst = (bf16_t*)(p.ws + OFF_WIN + l * SZ_WIN); d.ldd = D; d.mode = 4; d.roff = 0; }
    else if (r < 5312) { const int r3 = r - 4800; d.src = p.w_gate + (size_t)l * D * 2048; d.N = 2048; d.k0 = (r3 / 32) * 64; d.n0 = (r3 % 32) * 64; d.dst = (bf16_t*)(p.ws + OFF_WIN + l * SZ_WIN); d.ldd = D; d.mode = 0; d.roff = 2304; }
    else if (r < 5440) { const int r3 = r - 5312; d.src = p.w_ba + (size_t)l * 512 * D; d.N = D; d.k0 = (r3 / 16) * 64; d.n0 = (r3 % 16) * 64; d.dst = (bf16_t*)(p.ws + OFF_WBA + l * SZ_WB); d.ldd = 512; d.mode = 0; d.roff = 0; }
    else if (r < 5568) { const int r3 = r - 5440; d.src = p.w_bb + (size_t)l * 512 * D; d.N = D; d.k0 = (r3 / 16) * 64; d.n0 = (r3 % 16) * 64; d.dst = (bf16_t*)(p.ws + OFF_WBB + l * SZ_WB); d.ldd = 512; d.mode = 0; d.roff = 0; }
    else { const int r3 = r - 5568; d.src = p.w_o + (size_t)l * D * D; d.N = D; d.k0 = (r3 / 16) * 64; d.n0 = (r3 % 16) * 64; d.dst = (bf16_t*)(p.ws + OFF_WO + l * SZ_WO); d.ldd = D; d.mode = 0; d.roff = 0; }
}
DI void tr_load(const TrDesc& d, int tid, f32x4 (&v)[2]) {
    const int kk = tid >> 4, nn4 = (tid & 15) * 4;
#pragma unroll
    for (int ps = 0; ps < 2; ++ps) v[ps] = *(const f32x4*)(d.src + (size_t)(d.k0 + kk + 32 * ps) * d.N + d.n0 + nn4);
}
DI void tr_store(const TrDesc& d, int tid, const f32x4 (&v)[2], float* ldsf) {
    {
        const int kk = tid >> 4, nn4 = (tid & 15) * 4;
#pragma unroll
        for (int ps = 0; ps < 2; ++ps) { const int k = kk + 32 * ps; ldsf[k * 65 + nn4 + 0] = v[ps][0]; ldsf[k * 65 + nn4 + 1] = v[ps][1]; ldsf[k * 65 + nn4 + 2] = v[ps][2]; ldsf[k * 65 + nn4 + 3] = v[ps][3]; }
    }
    __syncthreads();
    {
        const int n = tid >> 3, ch = tid & 7, gn = d.n0 + n;
        int drow;
        if (d.mode == 0) drow = gn + d.roff; else if (d.mode == 1) drow = perm64(gn); else if (d.mode == 4) drow = (gn & ~255) | (((gn >> 5) & 1) << 7) | (((gn >> 6) & 3) << 5) | (gn & 31);
        else drow = 256 * (gn >> 7) + (gn & 127) + d.roff;
        float w[8];
#pragma unroll
        for (int i = 0; i < 8; ++i) w[i] = ldsf[(ch * 8 + i) * 65 + n];
        u32x4 pk = {pk2(w[0], w[1]), pk2(w[2], w[3]), pk2(w[4], w[5]), pk2(w[6], w[7])};
        *(u32x4*)(d.dst + (size_t)drow * d.ldd + d.k0 + ch * 8) = pk;
    }
    __syncthreads();
}

DI void phase_prologue(const Params& p, char* lds) {
    const int tid = otid();
    float* ldsf = (float*)lds;
    constexpr int N_MOD = 288, N_TR = 2 * 5824;
    for (int it = blockIdx.x; it < N_MOD; it += gridDim.x) {
        const int l = it / 144, j0 = (it % 144) * 64, jj = tid & 15, ii = tid >> 4;
        float* cact = ldsf + 2048;
        for (int i = tid; i < 1024; i += 512) { const float cv = p.c[i]; cact[i] = cv / (1.f + expf(-cv)); }
        __syncthreads();
        f32x4 a = {0.f, 0.f, 0.f, 0.f};
        const float* wb = p.ada_w + (size_t)l * 1024 * 9216 + j0 + 4 * jj;
#pragma unroll 8
        for (int r = 0; r < 32; ++r) { const int i = ii + 32 * r; a += cact[i] * *(const f32x4*)(wb + (size_t)i * 9216); }
        *(f32x4*)(ldsf + ii * 64 + 4 * jj) = a;
        __syncthreads();
        if (tid < 64) {
            float sm = 0.f;
#pragma unroll
            for (int r = 0; r < 32; ++r) sm += ldsf[r * 64 + tid];
            ((float*)(p.ws + OFF_MOD))[l * 9216 + j0 + tid] = sm + p.ada_b[l * 9216 + j0 + tid];
        }
        __syncthreads();
    }
    if (blockIdx.x == gridDim.x - 1) {
        if (tid < 64) {
#pragma unroll
            for (int l = 0; l < 2; ++l) {
                const float* lp = p.lam_p + l * 256;
                float a = lp[tid] * lp[64 + tid], b = lp[128 + tid] * lp[192 + tid];
#pragma unroll
                for (int o = 32; o > 0; o >>= 1) { a += __shfl_xor(a, o); b += __shfl_xor(b, o); }
                const float li = l == 0 ? 0.2f : 0.35550906759096926f;
                if (tid == 0) ((float*)(p.ws + OFF_LAM))[l] = expf(a) - expf(b) + li;
            }
        }
        if (tid < 64) ((unsigned*)(p.ws + OFF_STAT))[tid] = 0u;
        float* rope = (float*)(p.ws + OFF_ROPE);
        for (int e = tid; e < 320 * 16; e += 512) {
            const int pi = e >> 4, i = e & 15;
            const int pos = pi < 256 ? pi - 128 : (pi - 256) - 32;
            const float inv = exp2f(-(float)i * (13.287712379549449f / 16.0f));
            const float angf = (float)pos * inv;
            double r = (double)angf; r -= rint(r * 0.15915494309189535) * 6.283185307179586;
            const double r2 = r * r;
            double sn = 0.0, cs = 0.0;
#pragma unroll 1
            for (int n = 14; n >= 1; --n) { sn = (sn + 1.0) * (-r2 / (double)((2 * n) * (2 * n + 1))); cs = (cs + 1.0) * (-r2 / (double)((2 * n - 1) * (2 * n))); }
            sn = (sn + 1.0) * r; cs = cs + 1.0;
            if (pi < 256) { rope[pi * 16 + i] = (float)cs; rope[4096 + pi * 16 + i] = (float)sn; }
            else { rope[8192 + (pi - 256) * 16 + i] = (float)cs; rope[9216 + (pi - 256) * 16 + i] = (float)sn; }
        }
    }
    {
        int tt = blockIdx.x;
        TrDesc d; f32x4 v[2];
        if (tt < N_TR) { tr_decode(p, tt, d); tr_load(d, tid, v); }
        while (tt < N_TR) {
            const int tn = tt + gridDim.x;
            TrDesc dn; f32x4 vn[2];
            if (tn < N_TR) { tr_decode(p, tn, dn); tr_load(dn, tid, vn); }
            tr_store(d, tid, v, ldsf);
            if (tn < N_TR) { d = dn; v[0] = vn[0]; v[1] = vn[1]; }
            tt = tn;
        }
    }
}

DI void phase_norm(const float* hin, const float* __restrict__ g, const float* __restrict__ sh, const float* __restrict__ sc, bf16_t* nout, float* fout) {
    const int tid_ = otid(), lane = tid_ & 63, wid = tid_ >> 6;
    const int nw = gridDim.x * 8;
    for (int row = blockIdx.x * 8 + wid; row < S; row += nw) {
        const float* hp = hin + (size_t)row * D;
        f32x4 v[4]; float ss = 0.f;
#pragma unroll
        for (int i = 0; i < 4; ++i) { v[i] = *(const f32x4*)(hp + (i * 64 + lane) * 4); ss += v[i][0] * v[i][0] + v[i][1] * v[i][1] + v[i][2] * v[i][2] + v[i][3] * v[i][3]; }
#pragma unroll
        for (int o = 32; o > 0; o >>= 1) ss += __shfl_xor(ss, o);
        const float rstd = rsqrtf(ss * (1.0f / 1024.0f) + 1e-6f);
#pragma unroll
        for (int i = 0; i < 4; ++i) {
            const int col = (i * 64 + lane) * 4;
            const f32x4 gv = *(const f32x4*)(g + col);
            f32x4 y = v[i] * rstd * gv;
            if (sc) { const f32x4 s1 = *(const f32x4*)(sc + col), s0 = *(const f32x4*)(sh + col); y = y * (1.0f + s1) + s0; }
            if (fout) *(f32x4*)(fout + (size_t)row * D + col) = y;
            else { u32x2 pk = {pk2(y[0], y[1]), pk2(y[2], y[3])}; *(u32x2*)(nout + (size_t)row * D + col) = pk; }
        }
    }
}

DI void glds16(const void* g, char* l) { __builtin_amdgcn_global_load_lds((const unsigned*)g, (unsigned*)l, 16, 0, 0); }
template <int N> DI void waitv() { asm volatile("s_waitcnt vmcnt(%0)" ::"n"(N) : "memory"); }
DI void rawbar() { __builtin_amdgcn_s_barrier(); }
constexpr int GST = 49152;
DI void gemm_mainloop(const bf16_t* __restrict__ A, int lda, const bf16_t* __restrict__ W, int ldw, int K, f32x4 (&acc)[4][4], char* lds) {
    const int tid = otid(), lane = tid & 63, wid = tid >> 6, wt = wid >> 1, wc = wid & 1;
    const int srow = tid >> 3, sch = (tid & 7) ^ ((srow >> 1) & 7);
    const bf16_t* ag = A + (size_t)srow * lda + sch * 8;
    const bf16_t* wg = W + (size_t)srow * ldw + sch * 8;
    char* const ld = lds + tid * 16;
    const int nk = K >> 6;
#define G_ISSUE(kt_, st_) do { const int ko_ = (kt_) * 64; char* sn_ = ld + (st_) * GST; \
        _Pragma("unroll") for (int i = 0; i < 4; ++i) glds16(ag + (size_t)(64 * i) * lda + ko_, sn_ + i * 8192); \
        _Pragma("unroll") for (int i = 0; i < 2; ++i) glds16(wg + (size_t)(64 * i) * ldw + ko_, sn_ + 32768 + i * 8192); } while (0)
    waitv<0>();
    G_ISSUE(0, 0); G_ISSUE(1, 1);
    const int fr = lane & 15, fq = lane >> 4, sw = (fr >> 1) & 7;
    const int a_base = (64 * wt + fr) * 128, w_base = 32768 + (64 * wc + fr) * 128;
    int cur = 0, nxt = 2;
    for (int kt = 0; kt < nk; ++kt) {
        if (kt + 1 < nk) waitv<6>(); else waitv<0>();
        rawbar();
        if (kt + 2 < nk) G_ISSUE(kt + 2, nxt);
        const char* st = lds + cur * GST;
#pragma unroll
        for (int kk = 0; kk < 2; ++kk) {
            const int co = ((kk * 4 + fq) ^ sw) << 4;
            bf16x8 af[4], wf[4];
#pragma unroll
            for (int i = 0; i < 4; ++i) af[i] = *(const bf16x8*)(st + a_base + i * 2048 + co);
#pragma unroll
            for (int i = 0; i < 4; ++i) wf[i] = *(const bf16x8*)(st + w_base + i * 2048 + co);
#pragma unroll
            for (int mw = 0; mw < 4; ++mw)
#pragma unroll
                for (int nt = 0; nt < 4; ++nt) acc[mw][nt] = __builtin_amdgcn_mfma_f32_16x16x32_bf16(wf[mw], af[nt], acc[mw][nt], 0, 0, 0);
        }
        cur = cur == 2 ? 0 : cur + 1; nxt = nxt == 2 ? 0 : nxt + 1;
    }
#undef G_ISSUE
    __syncthreads();
}
constexpr int GST2 = 65536;
DI void gemm_mainloop2(const bf16_t* __restrict__ A, int lda, const bf16_t* __restrict__ W, int ldw, int K, f32x4 (&acc)[4][8], char* lds) {
    const int tid = otid(), lane = tid & 63, wid = tid >> 6, wt = wid >> 2, wc = wid & 3;
    const int srow = tid >> 3, sch = (tid & 7) ^ ((srow >> 1) & 7);
    const bf16_t* ag = A + (size_t)srow * lda + sch * 8;
    const bf16_t* wg = W + (size_t)srow * ldw + sch * 8;
    char* const ld = lds + tid * 16;
    const int nk = K >> 6;
#define G2_ISSUE(kt_, st_) do { const int ko_ = (kt_) * 64; char* sn_ = ld + (st_) * GST2; \
        _Pragma("unroll") for (int i = 0; i < 4; ++i) glds16(ag + (size_t)(64 * i) * lda + ko_, sn_ + i * 8192); \
        _Pragma("unroll") for (int i = 0; i < 4; ++i) glds16(wg + (size_t)(64 * i) * ldw + ko_, sn_ + 32768 + i * 8192); } while (0)
    waitv<0>();
    G2_ISSUE(0, 0);
    const int fr = lane & 15, fq = lane >> 4, sw = (fr >> 1) & 7;
    const int a_base = (128 * wt + fr) * 128, w_base = 32768 + (64 * wc + fr) * 128;
    for (int kt = 0; kt < nk; ++kt) {
        waitv<0>();
        rawbar();
        if (kt + 1 < nk) G2_ISSUE(kt + 1, (kt + 1) & 1);
        const char* st = lds + (kt & 1) * GST2;
#pragma unroll
        for (int kk = 0; kk < 2; ++kk) {
            const int co = ((kk * 4 + fq) ^ sw) << 4;
            bf16x8 wf[4], af[2][2];
#pragma unroll
            for (int i = 0; i < 4; ++i) wf[i] = *(const bf16x8*)(st + w_base + i * 2048 + co);
#pragma unroll
            for (int i = 0; i < 2; ++i) af[0][i] = *(const bf16x8*)(st + a_base + i * 2048 + co);
#pragma unroll
            for (int ip = 0; ip < 4; ++ip) {
                if (ip < 3) {
#pragma unroll
                    for (int i = 0; i < 2; ++i) af[(ip + 1) & 1][i] = *(const bf16x8*)(st + a_base + (2 * ip + 2 + i) * 2048 + co);
                }
                __builtin_amdgcn_s_setprio(1);
#pragma unroll
                for (int i = 0; i < 2; ++i)
#pragma unroll
                    for (int mw = 0; mw < 4; ++mw) acc[mw][2 * ip + i] = __builtin_amdgcn_mfma_f32_16x16x32_bf16(wf[mw], af[ip & 1][i], acc[mw][2 * ip + i], 0, 0, 0);
                __builtin_amdgcn_s_setprio(0);
                SB();
            }
        }
    }
#undef G2_ISSUE
    __syncthreads();
}
DI void zero_acc2(f32x4 (&acc)[4][8]) {
#pragma unroll
    for (int a = 0; a < 4; ++a)
#pragma unroll
        for (int b = 0; b < 8; ++b) acc[a][b] = (f32x4){0.f, 0.f, 0.f, 0.f};
}
DI void zero_acc(f32x4 (&acc)[4][4]) {
#pragma unroll
    for (int a = 0; a < 4; ++a)
#pragma unroll
        for (int b = 0; b < 4; ++b) acc[a][b] = (f32x4){0.f, 0.f, 0.f, 0.f};
}

namespace pg8 {
#define PG8_LAS __attribute__((address_space(3)))
constexpr int BM = 256, BK = 64, HALF = 128, HTB = HALF * BK * 2  , STAGE_BYTES = 8 * HTB, NXCD = 8, WGM = 8;

__host__ __device__ __forceinline__ int lds_byte(int r, int c) { const int st = (r >> 4) * 2 + (c >> 5), rr = r & 15, cc = c & 31, ob = rr * 64 + cc * 2; return st * 1024 + (ob ^ (((ob >> 9) & 1) << 5)); }
__host__ __device__ __forceinline__ void stage_rc(int b, int& R, int& C) { const int st = b / 1024, sb = b % 1024, swz = sb ^ (((sb >> 9) & 1) << 5); R = (st >> 1) * 16 + swz / 64; C = (st & 1) * 32 + (swz % 64) / 2; }
__host__ __device__ __forceinline__ int perm32(int rho) { const int n = rho >> 4, i = rho & 15; return 8 * (i >> 2) + 4 * n + (i & 3); }

struct Unit { int pm, pn; };
struct Gemm { const bf16_t* A; const bf16_t* Bt; int M, N, K; };

struct StaticOrder {
    int nM, nN, nwg, G, c;
    __host__ __device__ void init(int M, int N, int G_, int c_) { nM = M / BM; nN = N / BM; nwg = nM * nN; G = G_; c = c_; }
    __host__ __device__ bool next(int i, Unit& u) const {
        const long L = (long)i * G + c; if (L >= nwg) return false;
        int wgid = (int)L; { const int q = nwg / NXCD, r = nwg % NXCD, xcd = wgid % NXCD, off = wgid / NXCD; wgid = (xcd < r ? xcd * (q + 1) : r * (q + 1) + (xcd - r) * q) + off; }
        const int nig = WGM * nN, gid = wgid / nig, fm = gid * WGM, gsz = (nM - fm) < WGM ? (nM - fm) : WGM;
        u.pm = fm + ((wgid % nig) % gsz); u.pn = (wgid % nig) / gsz; return true;
    }
    __device__ __forceinline__ void a_ready(const Unit&) const {}
    __device__ __forceinline__ void done(const Unit&) const {}
};
template <class Epi, class Sched, bool ALIGN_EPI = false, bool SP2 = false>
__device__ __forceinline__ void gemm_phase(PG8_LAS unsigned char* lds, const Gemm g, const Sched& S, const Epi& E) {
    const int tid = ::otid(), wid = __builtin_amdgcn_readfirstlane(tid >> 6), lane = tid & 63, wr = wid >> 2, wc = wid & 3, fr = lane & 15, fq = lane >> 4;
    const int K = g.K, nt = K / BK;
    unsigned voffA[2], voffB[2];
#pragma unroll
    for (int i = 0; i < 2; ++i) { int R, C; stage_rc(tid * 16 + i * 8192, R, C); const int Rb = Epi::PERM ? ((R & ~31) + perm32(R & 31)) : R;
        voffA[i] = (unsigned)(R * K + C) * 2u; voffB[i] = (unsigned)(Rb * K + C) * 2u; }
    const size_t kstep = (size_t)(BK * 2);
    const size_t hstep = (size_t)HALF * K * 2;
    const size_t tstep = 2 * hstep;
    const unsigned ldsw = (unsigned)wid * 1024u;
    const int aoff = lds_byte(wr * 64 + fr, fq * 8), boff = lds_byte(wc * 32 + fr, fq * 8);
#define PG8_SA(b, h) (((b) * 2 + (h)) * HTB)
#define PG8_SB(b, h) ((4 + (b) * 2 + (h)) * HTB)
#define PG8_STAGE(bufoff, gbase, voff) do { _Pragma("unroll") for (int _i = 0; _i < 2; ++_i) \
        __builtin_amdgcn_global_load_lds((const unsigned*)((const char*)(gbase) + (voff)[_i]), (PG8_LAS unsigned*)(lds + (bufoff) + ldsw + _i * 8192), 16, 0, 0); } while (0)
#define PG8_LDA(dst, b, h) do { _Pragma("unroll") for (int m = 0; m < 4; ++m) _Pragma("unroll") for (int k = 0; k < 2; ++k) dst[m][k] = *(const PG8_LAS bf16x8*)(lds + PG8_SA(b, h) + aoff + m * 2048 + k * 1024); } while (0)
#define PG8_LDB(dst, b, h) do { _Pragma("unroll") for (int n = 0; n < 2; ++n) _Pragma("unroll") for (int k = 0; k < 2; ++k) dst[n][k] = *(const PG8_LAS bf16x8*)(lds + PG8_SB(b, h) + boff + n * 2048 + k * 1024); } while (0)
#define PG8_MMA(ai, bj, At, Bt) do { __builtin_amdgcn_s_setprio(1); _Pragma("unroll") for (int m = 0; m < 4; ++m) _Pragma("unroll") for (int n = 0; n < 2; ++n) _Pragma("unroll") for (int k = 0; k < 2; ++k) \
        acc[ai][bj][m][n] = __builtin_amdgcn_mfma_f32_16x16x32_bf16(Bt[n][k], At[m][k], acc[ai][bj][m][n], 0, 0, 0); __builtin_amdgcn_s_setprio(0); } while (0)
#define PG8_WAIT_V(n) asm volatile("s_waitcnt vmcnt(" #n ")" ::: "memory")
#define PG8_WAIT_L(n) asm volatile("s_waitcnt lgkmcnt(" #n ")" ::: "memory")
#define PG8_BAR __builtin_amdgcn_s_barrier()
#define PG8_SCHED __builtin_amdgcn_sched_barrier(0)
    Unit cur, nxt; int ui = 0;
    if (!S.next(0, cur)) return;
    f32x4 acc[2][2][4][2];
#pragma unroll
    for (int a = 0; a < 2; ++a)
#pragma unroll
        for (int b = 0; b < 2; ++b)
#pragma unroll
            for (int m = 0; m < 4; ++m)
#pragma unroll
                for (int n = 0; n < 2; ++n) acc[a][b][m][n] = (f32x4){0.f, 0.f, 0.f, 0.f};
    bf16x8 At[4][2], B0[2][2], B1[2][2];
    const char* cA = (const char*)g.A + (size_t)cur.pm * tstep; const char* cB = (const char*)g.Bt + (size_t)cur.pn * tstep;
    S.a_ready(cur);
    if constexpr (SP2) {
        PG8_STAGE(PG8_SB(0, 0), cB, voffB); PG8_STAGE(PG8_SB(0, 1), cB + hstep, voffB); PG8_STAGE(PG8_SA(0, 0), cA, voffA); PG8_STAGE(PG8_SA(0, 1), cA + hstep, voffA);
        if (wr == 1) PG8_BAR;
        PG8_WAIT_V(2); PG8_BAR;
        PG8_STAGE(PG8_SB(1, 0), cB + kstep, voffB); PG8_STAGE(PG8_SA(1, 0), cA + kstep, voffA); PG8_STAGE(PG8_SB(1, 1), cB + hstep + kstep, voffB);
        PG8_WAIT_V(6); PG8_BAR;
    } else {
        PG8_STAGE(PG8_SB(0, 0), cB, voffB); PG8_STAGE(PG8_SA(0, 0), cA, voffA); PG8_STAGE(PG8_SB(0, 1), cB + hstep, voffB); PG8_STAGE(PG8_SA(0, 1), cA + hstep, voffA);
        if (wr == 1) PG8_BAR;
        PG8_WAIT_V(4); PG8_BAR;
        PG8_STAGE(PG8_SB(1, 0), cB + kstep, voffB); PG8_STAGE(PG8_SA(1, 0), cA + kstep, voffA); PG8_STAGE(PG8_SB(1, 1), cB + hstep + kstep, voffB);
        PG8_WAIT_V(6); PG8_BAR;
    }
    for (;;) {
        const bool has_next = S.next(ui + 1, nxt);
        const char* nA = has_next ? (const char*)g.A + (size_t)nxt.pm * tstep : cA; const char* nB = has_next ? (const char*)g.Bt + (size_t)nxt.pn * tstep : cB;
        for (int t = 0; t < nt; t += 2) {
            const bool last = (t == nt - 2);
            const char* a1 = cA + (size_t)(t + 1) * kstep;
            const char* a2 = last ? nA : cA + (size_t)(t + 2) * kstep; const char* b2 = last ? nB : cB + (size_t)(t + 2) * kstep;
            const char* a3 = a2 + kstep; const char* b3 = b2 + kstep;
            if (last && has_next) S.a_ready(nxt);
            if constexpr (SP2) {
            PG8_LDB(B0, 0, 0); PG8_LDB(B1, 0, 1); PG8_SCHED; PG8_LDA(At, 0, 0); PG8_STAGE(PG8_SA(1, 1), a1 + hstep, voffA);
            PG8_WAIT_V(8); PG8_WAIT_L(0); PG8_BAR; PG8_MMA(0, 0, At, B0); PG8_MMA(0, 1, At, B1); PG8_BAR; PG8_SCHED;
            PG8_LDA(At, 0, 1); PG8_STAGE(PG8_SB(0, 0), b2, voffB); PG8_STAGE(PG8_SB(0, 1), b2 + hstep, voffB); PG8_STAGE(PG8_SA(0, 0), a2, voffA);
            PG8_WAIT_V(8); PG8_WAIT_L(0); PG8_BAR; PG8_MMA(1, 0, At, B0); PG8_MMA(1, 1, At, B1); PG8_BAR; PG8_SCHED;
            PG8_LDB(B0, 1, 0); PG8_LDB(B1, 1, 1); PG8_SCHED; PG8_LDA(At, 1, 0); PG8_STAGE(PG8_SA(0, 1), a2 + hstep, voffA);
            PG8_WAIT_V(8); PG8_WAIT_L(0); PG8_BAR; PG8_MMA(0, 0, At, B0); PG8_MMA(0, 1, At, B1); PG8_BAR; PG8_SCHED;
            PG8_LDA(At, 1, 1); PG8_STAGE(PG8_SB(1, 0), b3, voffB); PG8_STAGE(PG8_SB(1, 1), b3 + hstep, voffB); PG8_STAGE(PG8_SA(1, 0), a3, voffA);
            PG8_WAIT_V(8); PG8_WAIT_L(0); PG8_BAR; PG8_MMA(1, 0, At, B0); PG8_MMA(1, 1, At, B1); PG8_BAR; PG8_SCHED;
            } else {
            PG8_LDB(B0, 0, 0); PG8_SCHED; PG8_LDA(At, 0, 0); PG8_STAGE(PG8_SA(1, 1), a1 + hstep, voffA);
            PG8_WAIT_L(8); PG8_BAR; PG8_WAIT_L(0); PG8_MMA(0, 0, At, B0); PG8_BAR; PG8_SCHED;
            PG8_LDB(B1, 0, 1); PG8_STAGE(PG8_SB(0, 0), b2, voffB);
            PG8_BAR; PG8_WAIT_L(0); PG8_MMA(0, 1, At, B1); PG8_BAR;
            PG8_LDA(At, 0, 1); PG8_STAGE(PG8_SA(0, 0), a2, voffA);
            PG8_BAR; PG8_WAIT_L(0); PG8_MMA(1, 0, At, B0); PG8_BAR; PG8_SCHED;
            PG8_STAGE(PG8_SB(0, 1), b2 + hstep, voffB);
            PG8_WAIT_V(6); PG8_BAR; PG8_MMA(1, 1, At, B1); PG8_BAR;
            PG8_LDB(B0, 1, 0); PG8_SCHED; PG8_LDA(At, 1, 0); PG8_STAGE(PG8_SA(0, 1), a2 + hstep, voffA);
            PG8_WAIT_L(8); PG8_BAR; PG8_WAIT_L(0); PG8_MMA(0, 0, At, B0); PG8_BAR; PG8_SCHED;
            PG8_LDB(B1, 1, 1); PG8_STAGE(PG8_SB(1, 0), b3, voffB);
            PG8_BAR; PG8_WAIT_L(0); PG8_MMA(0, 1, At, B1); PG8_BAR;
            PG8_LDA(At, 1, 1); PG8_STAGE(PG8_SA(1, 0), a3, voffA);
            PG8_BAR; PG8_WAIT_L(0); PG8_MMA(1, 0, At, B0); PG8_BAR; PG8_SCHED;
            PG8_STAGE(PG8_SB(1, 1), b3 + hstep, voffB);
            PG8_WAIT_V(6); PG8_BAR; PG8_MMA(1, 1, At, B1); PG8_BAR;
            }
        }
        if constexpr (ALIGN_EPI) { if (wr == 0) PG8_BAR; }
        if constexpr (!Epi::AFTER_DRAIN) { E(acc, cur, wr, wc, fr, fq); S.done(cur); }
        if (!has_next) break;
#pragma unroll
        for (int a = 0; a < 2; ++a)
#pragma unroll
            for (int b = 0; b < 2; ++b)
#pragma unroll
                for (int m = 0; m < 4; ++m)
#pragma unroll
                    for (int n = 0; n < 2; ++n) acc[a][b][m][n] = (f32x4){0.f, 0.f, 0.f, 0.f};
        cur = nxt; cA = nA; cB = nB; ++ui;
        if constexpr (ALIGN_EPI) { if (wr == 1) PG8_BAR; }
    }
    PG8_WAIT_V(0);
    if constexpr (!ALIGN_EPI) { if (wr == 0) PG8_BAR; }
    PG8_BAR;
    if constexpr (Epi::AFTER_DRAIN) { E.fused(acc, cur, wr, wc, fr, fq, lds, wid, lane); S.done(cur); }
#undef PG8_SA
#undef PG8_SB
#undef PG8_STAGE
#undef PG8_LDA
#undef PG8_LDB
#undef PG8_MMA
#undef PG8_WAIT_V
#undef PG8_WAIT_L
#undef PG8_BAR
#undef PG8_SCHED
}
}

struct EpiGateUp {
    static constexpr bool PERM = true, AFTER_DRAIN = false;
    bf16_t* act;
    DI void operator()(const f32x4 (&acc)[2][2][4][2], const pg8::Unit& u, int wr, int wc, int fr, int fq) const {
#pragma unroll
        for (int ai = 0; ai < 2; ++ai)
#pragma unroll
            for (int m = 0; m < 4; ++m) {
                const int token = u.pm * 256 + ai * 128 + wr * 64 + m * 16 + fr;
                float v[8];
#pragma unroll
                for (int n = 0; n < 2; ++n)
#pragma unroll
                    for (int i = 0; i < 4; ++i) { const float gg = acc[ai][0][m][n][i], uu = acc[ai][1][m][n][i]; v[4 * n + i] = gg * fast_rcp(1.0f + __expf(-gg)) * uu; }
                *(u32x4*)(act + (size_t)token * F + 128 * u.pn + 32 * wc + 8 * fq) = (u32x4){pk2(v[0], v[1]), pk2(v[2], v[3]), pk2(v[4], v[5]), pk2(v[6], v[7])};
            }
    }
};
struct EpiResid {
    static constexpr bool PERM = true, AFTER_DRAIN = false;
    const float* hin; float* hout; const float* gvec; float gs;
    DI void operator()(const f32x4 (&acc)[2][2][4][2], const pg8::Unit& u, int wr, int wc, int fr, int fq) const {
        f32x4 gv[2][2];
#pragma unroll
        for (int bj = 0; bj < 2; ++bj)
#pragma unroll
            for (int n = 0; n < 2; ++n) gv[bj][n] = *(const f32x4*)(gvec + u.pn * 256 + bj * 128 + wc * 32 + 8 * fq + 4 * n) * gs;
#pragma unroll
        for (int ai = 0; ai < 2; ++ai)
#pragma unroll
            for (int m = 0; m < 4; ++m) {
                const size_t off = (size_t)(u.pm * 256 + ai * 128 + wr * 64 + m * 16 + fr) * D + u.pn * 256 + wc * 32 + 8 * fq;
#pragma unroll
                for (int bj = 0; bj < 2; ++bj)
#pragma unroll
                    for (int n = 0; n < 2; ++n) { const f32x4 hv = *(const f32x4*)(hin + off + bj * 128 + 4 * n); *(f32x4*)(hout + off + bj * 128 + 4 * n) = hv + gv[bj][n] * acc[ai][bj][m][n]; }
                SB();
            }
    }
};
struct EpiGates {
    static constexpr bool PERM = true, AFTER_DRAIN = false;
    bf16_t* G; const float* bias;
    DI void operator()(const f32x4 (&acc)[2][2][4][2], const pg8::Unit& u, int wr, int wc, int fr, int fq) const {
#pragma unroll
        for (int bj = 0; bj < 2; ++bj) {
            const int gc = u.pn * 256 + bj * 128 + wc * 32 + 8 * fq;
            const f32x4 b0 = *(const f32x4*)(bias + gc), b1 = *(const f32x4*)(bias + gc + 4);
#pragma unroll
            for (int ai = 0; ai < 2; ++ai)
#pragma unroll
                for (int m = 0; m < 4; ++m) {
                    const int token = u.pm * 256 + ai * 128 + wr * 64 + m * 16 + fr;
                    const f32x4 x0 = acc[ai][bj][m][0] + b0, x1 = acc[ai][bj][m][1] + b1; float z[8];
#pragma unroll
                    for (int i = 0; i < 4; ++i) { z[i] = fast_rcp(1.0f + __expf(-x0[i])); z[4 + i] = fast_rcp(1.0f + __expf(-x1[i])); }
                    *(u32x4*)(G + (size_t)token * 2048 + gc) = (u32x4){pk2(z[0], z[1]), pk2(z[2], z[3]), pk2(z[4], z[5]), pk2(z[6], z[7])};
                }
        }
    }
};
constexpr long TMP_HI_DELTA = (long)((OFF_KA - OFF_N) / 4) - (long)8192 * D;
struct EpiMerge1 {
    static constexpr bool PERM = true, AFTER_DRAIN = false;
    const bf16_t* G; float* tlo;
    DI void operator()(const f32x4 (&acc)[2][2][4][2], const pg8::Unit& u, int wr, int wc, int fr, int fq) const {
#pragma unroll
        for (int ai = 0; ai < 2; ++ai)
#pragma unroll
            for (int m = 0; m < 4; ++m) {
                const int token = u.pm * 256 + ai * 128 + wr * 64 + m * 16 + fr;
                float* tp = tlo + (size_t)token * D + (token < 8192 ? 0 : TMP_HI_DELTA);
#pragma unroll
                for (int bj = 0; bj < 2; ++bj) {
                    const int ch = u.pn * 256 + bj * 128 + wc * 32 + 8 * fq;
                    const u32x4 gu = *(const u32x4*)(G + (size_t)token * 2048 + ch);
                    *(f32x4*)(tp + ch) = (f32x4){bf_lo(gu[0]), bf_hi(gu[0]), bf_lo(gu[1]), bf_hi(gu[1])} * acc[ai][bj][m][0];
                    *(f32x4*)(tp + ch + 4) = (f32x4){bf_lo(gu[2]), bf_hi(gu[2]), bf_lo(gu[3]), bf_hi(gu[3])} * acc[ai][bj][m][1];
                }
            }
    }
};
struct EpiMerge2 {
    static constexpr bool PERM = true, AFTER_DRAIN = false;
    const bf16_t* G; const float* tlo; bf16_t* merged;
    DI void operator()(const f32x4 (&acc)[2][2][4][2], const pg8::Unit& u, int wr, int wc, int fr, int fq) const {
#pragma unroll
        for (int ai = 0; ai < 2; ++ai)
#pragma unroll
            for (int m = 0; m < 4; ++m) {
                const int token = u.pm * 256 + ai * 128 + wr * 64 + m * 16 + fr;
                const float* tp = tlo + (size_t)token * D + (token < 8192 ? 0 : TMP_HI_DELTA);
#pragma unroll
                for (int bj = 0; bj < 2; ++bj) {
                    const int ch = u.pn * 256 + bj * 128 + wc * 32 + 8 * fq;
                    const u32x4 gu = *(const u32x4*)(G + (size_t)token * 2048 + 1024 + ch);
                    const f32x4 o0 = *(const f32x4*)(tp + ch) + (f32x4){bf_lo(gu[0]), bf_hi(gu[0]), bf_lo(gu[1]), bf_hi(gu[1])} * acc[ai][bj][m][0];
                    const f32x4 o1 = *(const f32x4*)(tp + ch + 4) + (f32x4){bf_lo(gu[2]), bf_hi(gu[2]), bf_lo(gu[3]), bf_hi(gu[3])} * acc[ai][bj][m][1];
                    *(u32x4*)(merged + (size_t)token * D + ch) = (u32x4){pk2(o0[0], o0[1]), pk2(o0[2], o0[3]), pk2(o1[0], o1[1]), pk2(o1[2], o1[3])};
                }
            }
    }
};
struct EpiWin {
    static constexpr bool PERM = false, AFTER_DRAIN = false;
    const float* qk_g; const float* rope; unsigned char* ws; unsigned* stat;
    DI void operator()(const f32x4 (&acc)[2][2][4][2], const pg8::Unit& u, int wr, int wc, int fr, int fq) const {
        asm volatile("" : "+v"(fr), "+v"(fq));
        const int cw = 256 * u.pn + 64 * wc;
        bf16_t* Q = (bf16_t*)(ws + OFF_Q); bf16_t* QD = (bf16_t*)(ws + OFF_QD); bf16_t* KA = (bf16_t*)(ws + OFF_KA); bf16_t* VTA = (bf16_t*)(ws + OFF_VTA);
        bf16_t* KD = (bf16_t*)(ws + OFF_KD); bf16_t* VTD = (bf16_t*)(ws + OFF_VTD);
#define WA(mw_) acc[ai][(mw_) >> 1][m][(mw_) & 1]
        if (cw < 640) {
            const bool isq = cw < 512;
            const float* gq = qk_g + (isq ? 0 : 64);
            f32x4 gv[4];
#pragma unroll
            for (int mw = 0; mw < 4; ++mw) gv[mw] = *(const f32x4*)(gq + 16 * mw + 4 * fq);
#pragma unroll
            for (int ai = 0; ai < 2; ++ai)
#pragma unroll
                for (int m = 0; m < 4; ++m) {
                    const int token = u.pm * 256 + ai * 128 + wr * 64 + m * 16 + fr;
                    float ss = 0.f;
#pragma unroll
                    for (int mw = 0; mw < 4; ++mw) { const f32x4 a = WA(mw); ss += a[0] * a[0] + a[1] * a[1] + a[2] * a[2] + a[3] * a[3]; }
                    ss += __shfl_xor(ss, 16); ss += __shfl_xor(ss, 32);
                    const float rstd = rsqrtf(ss * (1.0f / 64.0f) + 1e-6f);
                    f32x4 y[4];
#pragma unroll
                    for (int mw = 0; mw < 4; ++mw) y[mw] = WA(mw) * rstd * gv[mw];
                    const int prow = token >> 6, pcol = token & 63;
                    const f32x4 cr = *(const f32x4*)(rope + prow * 16 + 4 * fq), sr = *(const f32x4*)(rope + 4096 + prow * 16 + 4 * fq);
                    const f32x4 cc = *(const f32x4*)(rope + 8192 + pcol * 16 + 4 * fq), sc = *(const f32x4*)(rope + 9216 + pcol * 16 + 4 * fq);
                    f32x4 o[4];
                    o[0] = y[0] * cr - y[1] * sr; o[1] = y[1] * cr + y[0] * sr; o[2] = y[2] * cc - y[3] * sc; o[3] = y[3] * cc + y[2] * sc;
                    const float qs = isq ? QSCALE : 1.0f;
                    bf16_t* dst = isq ? (Q + (size_t)token * 512 + cw) : (KA + (size_t)token * 128 + (cw - 512));
#pragma unroll
                    for (int mw = 0; mw < 4; ++mw) { const f32x4 z = o[mw] * qs; *(u32x2*)(dst + 16 * mw + 4 * fq) = (u32x2){pk2(z[0], z[1]), pk2(z[2], z[3])}; }
                    SB();
                }
        } else if (cw < 768 || cw >= 1792) {
            bf16_t* vt = cw < 768 ? (VTA + (size_t)(cw - 640) * S) : (VTD + (size_t)(cw - 1792) * S);
            const unsigned rbase = (unsigned)(4 * fq) * S + (unsigned)(u.pm * 256 + wr * 64 + fr);
#pragma unroll
            for (int ai = 0; ai < 2; ++ai)
#pragma unroll
                for (int m = 0; m < 4; ++m) {
#pragma unroll
                    for (int mw = 0; mw < 4; ++mw)
#pragma unroll
                        for (int r = 0; r < 4; ++r) vt[rbase + (unsigned)((16 * mw + r) * S + ai * 128 + m * 16)] = (bf16_t)(pk2(WA(mw)[r], 0.f) & 0xffffu);
                    SB();
                }
        } else {
            const bool isq = cw < 1280; const float qs = isq ? QSCALE : 1.0f;
            bf16_t* base = isq ? (QD + (cw - 768)) : (KD + (cw - 1280));
            float best = 0.f;
#pragma unroll
            for (int ai = 0; ai < 2; ++ai)
#pragma unroll
                for (int m = 0; m < 4; ++m) {
                    bf16_t* dst = base + (size_t)(u.pm * 256 + ai * 128 + wr * 64 + m * 16 + fr) * 512;
                    float ss = 0.f;
#pragma unroll
                    for (int mw = 0; mw < 4; ++mw) { const f32x4 z = WA(mw) * qs; ss += z[0] * z[0] + z[1] * z[1] + z[2] * z[2] + z[3] * z[3];
                        *(u32x2*)(dst + 16 * mw + 4 * fq) = (u32x2){pk2(z[0], z[1]), pk2(z[2], z[3])}; }
                    ss += __shfl_xor(ss, 16); ss += __shfl_xor(ss, 32);
                    best = __builtin_fmaxf(best, ss);
                    SB();
                }
#pragma unroll
            for (int o_ = 8; o_ > 0; o_ >>= 1) best = __builtin_fmaxf(best, __shfl_xor(best, o_));
            if (fr == 0 && fq == 0) atomicMax(stat + (isq ? 0 : 8) + ((cw - (isq ? 768 : 1280)) >> 6), __float_as_uint(best));
        }
#undef WA
    }
};
template <class Epi> DI void run_pg8(const bf16_t* A, const bf16_t* Bt, int N, int K, const Epi& E, char* lds) {
    pg8::Gemm g; g.A = A; g.Bt = Bt; g.M = S; g.N = N; g.K = K;
    int bid_ = (int)blockIdx.x; asm volatile("" : "+s"(bid_));
    pg8::StaticOrder so; so.init(S, N, (int)gridDim.x, bid_);
    pg8::gemm_phase<Epi, pg8::StaticOrder, true, true>((PG8_LAS unsigned char*)lds, g, so, E);
}

DI void phase_gateup(const bf16_t* n, const bf16_t* wgu, bf16_t* act, char* lds) {
    EpiGateUp E; E.act = act;
    run_pg8(n, wgu, NGU, D, E, lds);
}

DI void phase_resid(const bf16_t* A, int K, const bf16_t* W, const float* hin, float* hout, const float* __restrict__ gvec, float gs, char* lds) {
    EpiResid E; E.hin = hin; E.hout = hout; E.gvec = gvec; E.gs = gs;
    run_pg8(A, W, D, K, E, lds);
}

DI void phase_merge(const bf16_t* atta, const bf16_t* od, const bf16_t* wba, const bf16_t* wbb, const bf16_t* G, bf16_t* merged, float* tlo, char* lds) {
    { EpiMerge1 E; E.G = G; E.tlo = tlo; run_pg8(atta, wba, D, 512, E, lds); }
    asm volatile("s_waitcnt vmcnt(0)" ::: "memory");
    { EpiMerge2 E; E.G = G; E.tlo = tlo; E.merged = merged; run_pg8(od, wbb, D, 512, E, lds); }
}

DI void phase_win(const Params& p, int l, char* lds) {
    const int tid_ = otid(), lane = tid_ & 63, wid = tid_ >> 6, wt = wid >> 1, wc = wid & 1, fr = lane & 15, fq = lane >> 4;
    const bf16_t* n = (const bf16_t*)(p.ws + OFF_N);
    const bf16_t* W = (const bf16_t*)(p.ws + OFF_WIN + l * SZ_WIN);
    bf16_t* Q = (bf16_t*)(p.ws + OFF_Q); bf16_t* QD = (bf16_t*)(p.ws + OFF_QD); bf16_t* KA = (bf16_t*)(p.ws + OFF_KA); bf16_t* VTA = (bf16_t*)(p.ws + OFF_VTA);
    bf16_t* KD = (bf16_t*)(p.ws + OFF_KD); bf16_t* VTD = (bf16_t*)(p.ws + OFF_VTD); bf16_t* G = (bf16_t*)(p.ws + OFF_G);
    const float* rope = (const float*)(p.ws + OFF_ROPE);
    { EpiGates E; E.G = G; E.bias = p.b_gate + l * 2048; run_pg8(n, W + (size_t)2304 * D, 2048, D, E, lds); }
    { EpiWin E; E.qk_g = p.qk_g + l * 128; E.rope = rope; E.ws = p.ws; E.stat = (unsigned*)(p.ws + OFF_STAT) + l * 16; run_pg8(n, W, 2304, D, E, lds); }
}

#define MFMA32(a, b, c) __builtin_amdgcn_mfma_f32_32x32x16_bf16((a), (b), (c), 0, 0, 0)
template <int DV, bool ALIBI>
DI void attn_pass(const bf16_t* __restrict__ Qp, const bf16_t* __restrict__ Kb, int kpitch, const bf16_t* __restrict__ Vtb, float slope2, int qpos, int t_lo, int t_hi, float m_init,
                  f32x16 (&o)[DV / 32], float& l_out, char* lds) {
    constexpr int NV = DV / 64, NDT = DV / 32, STAGE = 8192 + DV * 128, G = 1 + NV;
    const int tid = otid(), lane = tid & 63, r32 = lane & 31, h = lane >> 5;
    bf16x8 qf[4];
#pragma unroll
    for (int d0 = 0; d0 < 4; ++d0) qf[d0] = *(const bf16x8*)(Qp + 16 * d0 + 8 * h);
    const int srow = tid >> 3, sch = (tid & 7) ^ ((srow >> 1) & 7);
    const bf16_t* kg = Kb + (size_t)srow * kpitch + sch * 8;
    const bf16_t* vg = Vtb + (size_t)srow * S + sch * 8;
    char* const ld = lds + tid * 16;
#define A_ISSUE(t_, st_) do { char* sn_ = ld + (st_) * STAGE; glds16(kg + (size_t)(t_) * 64 * kpitch, sn_); \
        _Pragma("unroll") for (int i = 0; i < NV; ++i) glds16(vg + (size_t)(64 * i) * S + (t_) * 64, sn_ + 8192 + i * 8192); } while (0)
    waitv<0>();
    A_ISSUE(t_lo, 0);
    if (t_lo + 1 <= t_hi) A_ISSUE(t_lo + 1, 1);
    if (t_lo + 2 <= t_hi) A_ISSUE(t_lo + 2, 2);
    const int pi = (r32 & 0x13) | ((r32 & 4) << 1) | ((r32 & 8) >> 1);
    const int k_base = pi * 128, k_sw = (pi >> 1) & 7, v_base = 8192 + r32 * 128, v_sw = (r32 >> 1) & 7;
    float m = m_init, l = 0.f;
#pragma unroll
    for (int dt = 0; dt < NDT; ++dt)
#pragma unroll
        for (int r = 0; r < 16; ++r) o[dt][r] = 0.f;
    int cur = 0;
    for (int t = t_lo; t <= t_hi; ++t) {
        const int rem = t_hi - t;
        if (rem >= 2) waitv<2 * G>(); else if (rem == 1) waitv<G>(); else waitv<0>();
        rawbar();
        if (rem >= 3) A_ISSUE(t + 3, (cur + 3) & 3);
        const char* st = lds + cur * STAGE;
        cur = (cur + 1) & 3;
        bf16x8 kf[2][4];
#pragma unroll
        for (int kt = 0; kt < 2; ++kt)
#pragma unroll
            for (int d0 = 0; d0 < 4; ++d0) kf[kt][d0] = *(const bf16x8*)(st + kt * 4096 + k_base + (((2 * d0 + h) ^ k_sw) << 4));
        f32x16 sc[2];
        const float nm = -m;
#pragma unroll
        for (int kt = 0; kt < 2; ++kt)
#pragma unroll
            for (int r = 0; r < 16; ++r) sc[kt][r] = nm;
        SB();
        __builtin_amdgcn_s_setprio(1);
#pragma unroll
        for (int d0 = 0; d0 < 4; ++d0)
#pragma unroll
            for (int kt = 0; kt < 2; ++kt) sc[kt] = MFMA32(kf[kt][d0], qf[d0], sc[kt]);
        __builtin_amdgcn_s_setprio(0);
        bf16x8 vf[2][4];
        if (NDT == 2) {
#pragma unroll
            for (int dt = 0; dt < 2; ++dt)
#pragma unroll
                for (int ks = 0; ks < 4; ++ks) vf[dt][ks] = *(const bf16x8*)(st + v_base + dt * 4096 + (((2 * ks + h) ^ v_sw) << 4));
        }
        SB();
        if (ALIBI) {
#pragma unroll
            for (int kt = 0; kt < 2; ++kt) {
                const float dq = (float)(qpos - (64 * t + 32 * kt + 8 * h));
#pragma unroll
                for (int r = 0; r < 16; ++r) sc[kt][r] = __builtin_fmaf(-slope2, __builtin_fabsf(dq - (float)(16 * (r >> 3) + (r & 7))), sc[kt][r]);
            }
        }
        float mt = sc[0][0];
#pragma unroll
        for (int r = 1; r < 16; ++r) mt = __builtin_fmaxf(mt, sc[0][r]);
#pragma unroll
        for (int r = 0; r < 16; ++r) mt = __builtin_fmaxf(mt, sc[1][r]);
        mt = __builtin_fmaxf(mt, __shfl_xor(mt, 32));
        if (__any(mt > 8.0f)) {
            const float dl = __builtin_fmaxf(mt, 0.f), al = fast_exp2(-dl);
            l *= al; m += dl;
#pragma unroll
            for (int kt = 0; kt < 2; ++kt)
#pragma unroll
                for (int r = 0; r < 16; ++r) sc[kt][r] -= dl;
#pragma unroll
            for (int dt = 0; dt < NDT; ++dt)
#pragma unroll
                for (int r = 0; r < 16; ++r) o[dt][r] *= al;
        }
        float ps = 0.f;
#pragma unroll
        for (int kt = 0; kt < 2; ++kt)
#pragma unroll
            for (int r = 0; r < 16; ++r) { const float e = fast_exp2(sc[kt][r]); sc[kt][r] = e; ps += e; }
        l += ps;
        bf16x8 pf[4];
#pragma unroll
        for (int ks = 0; ks < 4; ++ks) {
            const int kt = ks >> 1, b = (ks & 1) * 8;
            u32x4 w = {pk2(sc[kt][b], sc[kt][b + 1]), pk2(sc[kt][b + 2], sc[kt][b + 3]), pk2(sc[kt][b + 4], sc[kt][b + 5]), pk2(sc[kt][b + 6], sc[kt][b + 7])};
            pf[ks] = __builtin_bit_cast(bf16x8, w);
        }
        SB();
        if (NDT == 4) {
#pragma unroll
            for (int gp = 0; gp < 2; ++gp) {
#pragma unroll
                for (int dt = 0; dt < 2; ++dt)
#pragma unroll
                    for (int ks = 0; ks < 4; ++ks) vf[dt][ks] = *(const bf16x8*)(st + v_base + (dt + 2 * gp) * 4096 + (((2 * ks + h) ^ v_sw) << 4));
                __builtin_amdgcn_s_setprio(1);
#pragma unroll
                for (int ks = 0; ks < 4; ++ks)
#pragma unroll
                    for (int dt = 0; dt < 2; ++dt) o[(dt + 2 * gp) % NDT] = MFMA32(vf[dt][ks], pf[ks], o[(dt + 2 * gp) % NDT]);
                __builtin_amdgcn_s_setprio(0);
                SB();
            }
        } else {
            __builtin_amdgcn_s_setprio(1);
#pragma unroll
            for (int ks = 0; ks < 4; ++ks)
#pragma unroll
                for (int dt = 0; dt < 2; ++dt) o[dt] = MFMA32(vf[dt][ks], pf[ks], o[dt]);
            __builtin_amdgcn_s_setprio(0);
        }
        SB();
    }
#undef A_ISSUE
    __syncthreads();
    l += __shfl_xor(l, 32);
    l_out = l;
}

DI void attn_pass_b(const bf16_t* __restrict__ Qp, const bf16_t* __restrict__ Kb, int kpitch, const bf16_t* __restrict__ Vtb, float slope2, int qpos, int t_lo, int t_hi, float mref,
                    f32x16 (&o)[4], float& l_out, char* lds) {
    constexpr int NV = 2, STAGE = 8192 + 128 * 128, G = 1 + NV;
    const int tid = otid(), lane = tid & 63, r32 = lane & 31, h = lane >> 5;
    const int qw0 = __builtin_amdgcn_readfirstlane(qpos - r32);
    bf16x8 qf[4];
#pragma unroll
    for (int d0 = 0; d0 < 4; ++d0) qf[d0] = *(const bf16x8*)(Qp + 16 * d0 + 8 * h);
    const int srow = tid >> 3, sch = (tid & 7) ^ ((srow >> 1) & 7);
    const bf16_t* kg = Kb + (size_t)srow * kpitch + sch * 8;
    const bf16_t* vg = Vtb + (size_t)srow * S + sch * 8;
    char* const ld = lds + tid * 16;
#define B_ISSUE(t_, st_) do { char* sn_ = ld + (st_) * STAGE; glds16(kg + (size_t)(t_) * 64 * kpitch, sn_); \
        _Pragma("unroll") for (int i = 0; i < NV; ++i) glds16(vg + (size_t)(64 * i) * S + (t_) * 64, sn_ + 8192 + i * 8192); } while (0)
    waitv<0>();
    B_ISSUE(t_lo, 0);
    if (t_lo + 1 <= t_hi) B_ISSUE(t_lo + 1, 1);
    if (t_lo + 2 <= t_hi) B_ISSUE(t_lo + 2, 2);
    const int pi = (r32 & 0x13) | ((r32 & 4) << 1) | ((r32 & 8) >> 1);
    const int k_base = pi * 128, k_sw = (pi >> 1) & 7, v_base = 8192 + r32 * 128, v_sw = (r32 >> 1) & 7;
    float l = 0.f;
    const float nm = -mref;
#pragma unroll
    for (int dt = 0; dt < 4; ++dt)
#pragma unroll
        for (int r = 0; r < 16; ++r) o[dt][r] = 0.f;
    int cur = 0;
    for (int t = t_lo; t <= t_hi; ++t) {
        const int rem = t_hi - t;
        if (rem >= 2) waitv<2 * G>(); else if (rem == 1) waitv<G>(); else waitv<0>();
        rawbar();
        if (rem >= 3) B_ISSUE(t + 3, (cur + 3) & 3);
        const char* st = lds + cur * STAGE;
        cur = (cur + 1) & 3;
        bf16x8 kf[2][4];
#pragma unroll
        for (int kt = 0; kt < 2; ++kt)
#pragma unroll
            for (int d0 = 0; d0 < 4; ++d0) kf[kt][d0] = *(const bf16x8*)(st + kt * 4096 + k_base + (((2 * d0 + h) ^ k_sw) << 4));
        const int side = (64 * t + 63 < qw0) ? 1 : ((64 * t > qw0 + 31) ? -1 : 0);
        f32x16 sc[2];
        if (side != 0) {
            const float ss = side > 0 ? slope2 : -slope2;
#pragma unroll
            for (int kt = 0; kt < 2; ++kt) {
                const float base = __builtin_fmaf(ss, (float)(64 * t + 32 * kt + 8 * h - qpos), nm);
#pragma unroll
                for (int r = 0; r < 16; ++r) sc[kt][r] = __builtin_fmaf(ss, (float)(16 * (r >> 3) + (r & 7)), base);
            }
        } else {
#pragma unroll
            for (int kt = 0; kt < 2; ++kt)
#pragma unroll
                for (int r = 0; r < 16; ++r) sc[kt][r] = nm;
        }
        SB();
        __builtin_amdgcn_s_setprio(1);
#pragma unroll
        for (int d0 = 0; d0 < 4; ++d0)
#pragma unroll
            for (int kt = 0; kt < 2; ++kt) sc[kt] = MFMA32(kf[kt][d0], qf[d0], sc[kt]);
        __builtin_amdgcn_s_setprio(0);
        SB();
        if (side == 0) {
#pragma unroll
            for (int kt = 0; kt < 2; ++kt) {
                const float dq = (float)(qpos - (64 * t + 32 * kt + 8 * h));
#pragma unroll
                for (int r = 0; r < 16; ++r) sc[kt][r] = __builtin_fmaf(-slope2, __builtin_fabsf(dq - (float)(16 * (r >> 3) + (r & 7))), sc[kt][r]);
            }
        }
        float ps = 0.f;
#pragma unroll
        for (int kt = 0; kt < 2; ++kt)
#pragma unroll
            for (int r = 0; r < 16; ++r) { const float e = fast_exp2(sc[kt][r]); sc[kt][r] = e; ps += e; }
        l += ps;
        bf16x8 pf[4];
#pragma unroll
        for (int ks = 0; ks < 4; ++ks) {
            const int kt = ks >> 1, b = (ks & 1) * 8;
            u32x4 w = {pk2(sc[kt][b], sc[kt][b + 1]), pk2(sc[kt][b + 2], sc[kt][b + 3]), pk2(sc[kt][b + 4], sc[kt][b + 5]), pk2(sc[kt][b + 6], sc[kt][b + 7])};
            pf[ks] = __builtin_bit_cast(bf16x8, w);
        }
        SB();
#pragma unroll
        for (int gp = 0; gp < 2; ++gp) {
            bf16x8 vf[2][4];
#pragma unroll
            for (int dt = 0; dt < 2; ++dt)
#pragma unroll
                for (int ks = 0; ks < 4; ++ks) vf[dt][ks] = *(const bf16x8*)(st + v_base + (dt + 2 * gp) * 4096 + (((2 * ks + h) ^ v_sw) << 4));
            __builtin_amdgcn_s_setprio(1);
#pragma unroll
            for (int ks = 0; ks < 4; ++ks)
#pragma unroll
                for (int dt = 0; dt < 2; ++dt) o[dt + 2 * gp] = MFMA32(vf[dt][ks], pf[ks], o[dt + 2 * gp]);
            __builtin_amdgcn_s_setprio(0);
            SB();
        }
    }
#undef B_ISSUE
    __syncthreads();
    l += __shfl_xor(l, 32);
    l_out = l;
}

DI void attn_pass_a(const bf16_t* __restrict__ Qp, const bf16_t* __restrict__ Kb, int kpitch, const bf16_t* __restrict__ Vtb, float mref, f32x16 (&o)[2], float& l_out, char* lds) {
    constexpr int STAGE = 16384, NTL = S / 64;
    const int tid = otid(), lane = tid & 63, r32 = lane & 31, h = lane >> 5;
    bf16x8 qf[4];
#pragma unroll
    for (int d0 = 0; d0 < 4; ++d0) qf[d0] = *(const bf16x8*)(Qp + 16 * d0 + 8 * h);
    const int srow = tid >> 3, sch = (tid & 7) ^ ((srow >> 1) & 7);
    const bf16_t* kg = Kb + (size_t)srow * kpitch + sch * 8;
    const bf16_t* vg = Vtb + (size_t)srow * S + sch * 8;
    char* const ld = lds + tid * 16;
#define AA_ISSUE(t_, st_) do { char* sn_ = ld + (st_) * STAGE; glds16(kg + (size_t)(t_) * 64 * kpitch, sn_); glds16(vg + (t_) * 64, sn_ + 8192); } while (0)
    waitv<0>();
    AA_ISSUE(0, 0); AA_ISSUE(1, 1); AA_ISSUE(2, 2);
    const int pi = (r32 & 0x13) | ((r32 & 4) << 1) | ((r32 & 8) >> 1);
    const int k_base = pi * 128, k_sw = (pi >> 1) & 7, v_base = 8192 + r32 * 128, v_sw = (r32 >> 1) & 7;
    f32x16 negm, lacc;
#pragma unroll
    for (int r = 0; r < 16; ++r) { negm[r] = -mref; lacc[r] = 0.f; o[0][r] = 0.f; o[1][r] = 0.f; }
    const bf16x8 ones = {(short)0x3F80, (short)0x3F80, (short)0x3F80, (short)0x3F80, (short)0x3F80, (short)0x3F80, (short)0x3F80, (short)0x3F80};
    f32x16 sA[2], sB[2];
#define AA_QK(DST, stp_) do { bf16x8 kf_[2][4]; \
        _Pragma("unroll") for (int kt = 0; kt < 2; ++kt) _Pragma("unroll") for (int d0 = 0; d0 < 4; ++d0) kf_[kt][d0] = *(const bf16x8*)((stp_) + kt * 4096 + k_base + (((2 * d0 + h) ^ k_sw) << 4)); \
        SB(); __builtin_amdgcn_s_setprio(1); \
        DST[0] = MFMA32(kf_[0][0], qf[0], negm); DST[1] = MFMA32(kf_[1][0], qf[0], negm); \
        _Pragma("unroll") for (int d0 = 1; d0 < 4; ++d0) { DST[0] = MFMA32(kf_[0][d0], qf[d0], DST[0]); DST[1] = MFMA32(kf_[1][d0], qf[d0], DST[1]); } \
        __builtin_amdgcn_s_setprio(0); } while (0)
    waitv<4>();
    rawbar();
    AA_QK(sA, lds);
#define AA_STEP(CUR, NXT, t_) do { const int t = (t_); \
        if (t + 2 < NTL) waitv<2>(); else waitv<0>();              \
        rawbar();                                                  \
        if (t + 3 < NTL) AA_ISSUE(t + 3, (t + 3) & 3); \
        const char* st = lds + (t & 3) * STAGE; \
        if (t + 1 < NTL) AA_QK(NXT, lds + ((t + 1) & 3) * STAGE); \
        bf16x8 vf[2][4]; \
        _Pragma("unroll") for (int dt = 0; dt < 2; ++dt) _Pragma("unroll") for (int ks = 0; ks < 4; ++ks) vf[dt][ks] = *(const bf16x8*)(st + v_base + dt * 4096 + (((2 * ks + h) ^ v_sw) << 4)); \
        SB(); \
        _Pragma("unroll") for (int kt = 0; kt < 2; ++kt) _Pragma("unroll") for (int r = 0; r < 16; ++r) CUR[kt][r] = fast_exp2(CUR[kt][r]); \
        bf16x8 pf[4]; \
        _Pragma("unroll") for (int ks = 0; ks < 4; ++ks) { const int kt = ks >> 1, b = (ks & 1) * 8; \
            u32x4 w = {pk2(CUR[kt][b], CUR[kt][b + 1]), pk2(CUR[kt][b + 2], CUR[kt][b + 3]), pk2(CUR[kt][b + 4], CUR[kt][b + 5]), pk2(CUR[kt][b + 6], CUR[kt][b + 7])}; \
            pf[ks] = __builtin_bit_cast(bf16x8, w); } \
        SB(); __builtin_amdgcn_s_setprio(1); \
        _Pragma("unroll") for (int ks = 0; ks < 4; ++ks) { _Pragma("unroll") for (int dt = 0; dt < 2; ++dt) o[dt] = MFMA32(vf[dt][ks], pf[ks], o[dt]); lacc = MFMA32(ones, pf[ks], lacc); } \
        __builtin_amdgcn_s_setprio(0); SB(); } while (0)
    for (int t2 = 0; t2 < NTL; t2 += 2) { AA_STEP(sA, sB, t2); AA_STEP(sB, sA, t2 + 1); }
#undef AA_STEP
#undef AA_QK
#undef AA_ISSUE
    __syncthreads();
    l_out = lacc[0];
}

DI void phase_attn(const Params& p, int l, int rep, char* lds) {
    const int tid = otid(), lane = tid & 63, wid = tid >> 6, r32 = lane & 31, h = lane >> 5;
    const bf16_t* Q = (const bf16_t*)(p.ws + OFF_Q); const bf16_t* QD = (const bf16_t*)(p.ws + OFF_QD); const bf16_t* KA = (const bf16_t*)(p.ws + OFF_KA);
    const bf16_t* VTA = (const bf16_t*)(p.ws + OFF_VTA); const bf16_t* KD = (const bf16_t*)(p.ws + OFF_KD); const bf16_t* VTD = (const bf16_t*)(p.ws + OFF_VTD);
    bf16_t* ATTA = (bf16_t*)(p.ws + OFF_ATTA); bf16_t* OD = (bf16_t*)(p.ws + OFF_OD); float* BO0 = (float*)(p.ws + OFF_N);
    const float lam = ((const float*)(p.ws + OFF_LAM))[l];
    const float oml = 1.0f - (l == 0 ? 0.2f : 0.35550906759096926f);
    float bA;
    { float gq = __builtin_fabsf(p.qk_g[l * 128 + lane]), gk = __builtin_fabsf(p.qk_g[l * 128 + 64 + lane]);
#pragma unroll
      for (int o_ = 32; o_ > 0; o_ >>= 1) { gq = __builtin_fmaxf(gq, __shfl_xor(gq, o_)); gk = __builtin_fmaxf(gk, __shfl_xor(gk, o_)); }
      bA = 64.0f * gq * gk * QSCALE * 1.01f; }
    unsigned* qcnt = (unsigned*)(p.ws + OFF_STAT) + 32 + l + 2 * rep;
    const unsigned* stat = (const unsigned*)(p.ws + OFF_STAT) + l * 16;
    volatile unsigned* lword = (volatile unsigned*)(lds + 147456 + 16);
    for (;;) {
        if (tid == 0) *lword = atomicAdd(qcnt, 1u);
        __syncthreads();
        const int u = (int)*lword;
        __syncthreads();
        if (u >= 768) break;
        if (PROBE_DUP == 5 && rep && (u < 128 || u >= 640)) continue;
        if (u < 128 || u >= 640) {
            const int hb = u < 64 ? 3 : (u < 128 ? 2 : (u < 704 ? 1 : 0)), qb = u & 63;
            const int token = 256 * qb + 32 * wid + r32;
            const float slope2 = exp2f(-2.0f * (float)(hb + 1)) * LOG2E;
            float* bo = BO0 + (size_t)token * 512 + hb * 128;
            f32x16 o[4]; float ls;
            int tl[2], th[2]; float mi[2];
#pragma unroll
            for (int mp = 0; mp < 2; ++mp) {
                const float qk = sqrtf(__uint_as_float(stat[mp * 4 + hb]) * __uint_as_float(stat[8 + mp * 4 + hb])) * 1.02f;
                const float R = __builtin_fminf((2.0f * qk + 150.0f) / slope2, 40000.0f);
                const int klo = 256 * qb - (int)R - 1, khi = 256 * qb + 255 + (int)R + 1;
                mi[mp] = -qk;
                tl[mp] = klo < 0 ? 0 : (klo >> 6); th[mp] = khi >= S ? (S / 64 - 1) : (khi >> 6);
            }
            if (-mi[0] <= 45.0f) attn_pass_b(QD + (size_t)token * 512 + hb * 64, KD + hb * 64, 512, VTD + (size_t)(hb * 128) * S, slope2, token, tl[0], th[0], -mi[0], o, ls, lds);
            else attn_pass<128, true>(QD + (size_t)token * 512 + hb * 64, KD + hb * 64, 512, VTD + (size_t)(hb * 128) * S, slope2, token, tl[0], th[0], mi[0], o, ls, lds);
            {
                const float inv = 1.0f / ls;
#pragma unroll
                for (int dt = 0; dt < 4; ++dt)
#pragma unroll
                    for (int g = 0; g < 4; ++g) *(f32x4*)(bo + 32 * dt + 8 * g + 4 * h) = (f32x4){o[dt][4 * g] * inv, o[dt][4 * g + 1] * inv, o[dt][4 * g + 2] * inv, o[dt][4 * g + 3] * inv};
            }
            if (-mi[1] <= 45.0f) attn_pass_b(QD + (size_t)token * 512 + 256 + hb * 64, KD + 256 + hb * 64, 512, VTD + (size_t)(hb * 128) * S, slope2, token, tl[1], th[1], -mi[1], o, ls, lds);
            else attn_pass<128, true>(QD + (size_t)token * 512 + 256 + hb * 64, KD + 256 + hb * 64, 512, VTD + (size_t)(hb * 128) * S, slope2, token, tl[1], th[1], mi[1], o, ls, lds);
            {
                const float inv = lam / ls; float ss = 0.f;
#pragma unroll
                for (int dt = 0; dt < 4; ++dt)
#pragma unroll
                    for (int g = 0; g < 4; ++g) {
                        const f32x4 a = *(const f32x4*)(bo + 32 * dt + 8 * g + 4 * h);
#pragma unroll
                        for (int j = 0; j < 4; ++j) { const float v = a[j] - o[dt][4 * g + j] * inv; o[dt][4 * g + j] = v; ss += v * v; }
                    }
                ss += __shfl_xor(ss, 32);
                const float rstd = rsqrtf(ss * (1.0f / 128.0f) + 1e-6f) * oml;
                const float* sg = p.subln_g + l * 128;
                bf16_t* dst = OD + (size_t)token * 512 + hb * 128;
#pragma unroll
                for (int dt = 0; dt < 4; ++dt)
#pragma unroll
                    for (int g = 0; g < 4; ++g) {
                        const int d = 32 * dt + 8 * g + 4 * h;
                        const f32x4 gg = *(const f32x4*)(sg + d);
                        *(u32x2*)(dst + d) = (u32x2){pk2(o[dt][4 * g] * rstd * gg[0], o[dt][4 * g + 1] * rstd * gg[1]), pk2(o[dt][4 * g + 2] * rstd * gg[2], o[dt][4 * g + 3] * rstd * gg[3])};
                    }
            }
        } else {
            const int v = u - 128, kv = v >> 8, hq = kv * 4 + (v & 3), qb = (v >> 2) & 63;
            const int token = 256 * qb + 32 * wid + r32;
            f32x16 o[2]; float ls;
            if (bA <= 40.0f) attn_pass_a(Q + (size_t)token * 512 + hq * 64, KA + kv * 64, 128, VTA + (size_t)(kv * 64) * S, bA, o, ls, lds);
            else attn_pass<64, false>(Q + (size_t)token * 512 + hq * 64, KA + kv * 64, 128, VTA + (size_t)(kv * 64) * S, 0.f, token, 0, S / 64 - 1, 0.f, o, ls, lds);
            const float inv = 1.0f / ls;
            bf16_t* dst = ATTA + (size_t)token * 512 + hq * 64;
#pragma unroll
            for (int dt = 0; dt < 2; ++dt)
#pragma unroll
                for (int g = 0; g < 4; ++g)
                    *(u32x2*)(dst + 32 * dt + 8 * g + 4 * h) = (u32x2){pk2(o[dt][4 * g] * inv, o[dt][4 * g + 1] * inv), pk2(o[dt][4 * g + 2] * inv, o[dt][4 * g + 3] * inv)};
        }
    }
}

#define XB_TMO      128
#define XB_XCNT(j)  (256  + 64 * (j))
#define XB_XSUB(j)  (1280 + 64 * (j))
#define XB_XGEN(j)  (2304 + 64 * (j))
#define XB_TOP      3328
#define XB_TOPGEN   3392
#define XCD_BAR_WORDS 3456
#define XB_SPIN_CAP (1u << 22)
#define LAS __attribute__((address_space(3)))
DI unsigned xb_ld(unsigned* p) { return __hip_atomic_load(p, __ATOMIC_RELAXED, __HIP_MEMORY_SCOPE_AGENT); }
DI unsigned xb_add(unsigned* p, unsigned v) { return __hip_atomic_fetch_add(p, v, __ATOMIC_RELAXED, __HIP_MEMORY_SCOPE_AGENT); }
DI unsigned xb_xcc_id() { return (unsigned)__builtin_amdgcn_s_getreg((3 << 11) | 20) & 0xFu; }
#define XB_SPIN(cond, bar) do { unsigned _sp = 0; while (cond) { __builtin_amdgcn_s_sleep(1); \
    if ((++_sp & 255u) == 0u) { if (xb_ld(&(bar)[XB_TMO])) break; if (_sp > XB_SPIN_CAP) { atomicAdd(&(bar)[XB_TMO], 1u); break; } } } } while (0)
struct XcdBarrier { unsigned* bar; unsigned x; volatile LAS unsigned* st; };
DI XcdBarrier xcd_barrier_post(unsigned* bar, volatile LAS unsigned* st) {
    XcdBarrier b; b.bar = bar; b.x = xb_xcc_id(); b.st = st;
    if (threadIdx.x == 0) (void)xb_add(&bar[XB_XCNT(b.x)], 1u);
    return b;
}
DI void xcd_barrier_complete(unsigned* bar, unsigned x, unsigned& nloc, unsigned& nx) {
    const unsigned G = gridDim.x * gridDim.y * gridDim.z;
    unsigned sum, cnt, mine, sp = 0u;
    for (;;) {
        sum = 0u; cnt = 0u; mine = 0u;
#pragma unroll
        for (unsigned j = 0; j < 16; ++j) { const unsigned c = xb_ld(&bar[XB_XCNT(j)]); sum += c; cnt += (c > 0u) ? 1u : 0u; mine = (j == x) ? c : mine; }
        if (sum == G) break;
        __builtin_amdgcn_s_sleep(1);
        if ((++sp & 255u) == 0u) { if (xb_ld(&bar[XB_TMO])) break; if (sp > XB_SPIN_CAP) { atomicAdd(&bar[XB_TMO], 1u); break; } }
    }
    nloc = mine > 0u ? mine : 1u; nx = cnt > 0u ? cnt : 1u;
}
DI void xcd_barrier(const XcdBarrier& b) {
    asm volatile("s_waitcnt vmcnt(0)" ::: "memory");
    __syncthreads();
    if (otid() == 0) {
        unsigned* bar = b.bar;
        __builtin_amdgcn_s_waitcnt(0);
        unsigned nloc = b.st[0], nx = b.st[1];
        if (nloc == 0u) { xcd_barrier_complete(bar, b.x, nloc, nx); b.st[0] = nloc; b.st[1] = nx; }
        const unsigned old = xb_add(&bar[XB_XSUB(b.x)], 1u);
        const unsigned gen = old / nloc;
        if (old + 1u == (gen + 1u) * nloc) {
            __builtin_amdgcn_fence(__ATOMIC_RELEASE, "agent");
            asm volatile("s_waitcnt vmcnt(0)" ::: "memory");
            const unsigned og = xb_add(&bar[XB_TOP], 1u);
            const unsigned tg = og / nx;
            if (og + 1u == (tg + 1u) * nx) xb_add(&bar[XB_TOPGEN], 1u);
            else XB_SPIN(xb_ld(&bar[XB_TOPGEN]) == tg, bar);
            __builtin_amdgcn_fence(__ATOMIC_ACQUIRE, "agent");
            xb_add(&bar[XB_XGEN(b.x)], 1u);
            asm volatile("s_waitcnt vmcnt(0)" ::: "memory");
        } else {
            XB_SPIN(xb_ld(&bar[XB_XGEN(b.x)]) == gen, bar);
            __builtin_amdgcn_fence(__ATOMIC_ACQUIRE, "agent");
            asm volatile("s_waitcnt vmcnt(0)" ::: "memory");
        }
    }
    __syncthreads();
}

__global__ void __launch_bounds__(512) mega(Params pin) {
    __shared__ __attribute__((aligned(16))) char lds[147456 + 64];
    cg::grid_group grid = cg::this_grid();
    volatile LAS unsigned* xst = (volatile LAS unsigned*)(lds + 147456);
    if (threadIdx.x == 0) { xst[0] = 0u; xst[1] = 0u; }
    __syncthreads();
    const XcdBarrier xb = xcd_barrier_post((unsigned*)(pin.ws + OFF_BAR), xst);
    int rep = 0;
    for (int ph = pin.ph_lo; ph < pin.ph_hi; ++ph) {
        Params p = pin;
        asm volatile("" : "+s"(p.ws), "+s"(p.out), "+s"(p.x));
        bf16_t* nbuf = (bf16_t*)(p.ws + OFF_N);
        bf16_t* act = (bf16_t*)(p.ws + OFF_ACT);
        if (ph == 0) phase_prologue(p, lds);
        else {
            const int l = ph == 23 ? 1 : (ph - 1) / 11, k = ph == 23 ? 11 : (ph - 1) % 11;
            const float* mod = (const float*)(p.ws + OFF_MOD) + l * 9216;
            switch (k) {
            case 0: case 3: case 8: case 11: {
                const int i = k == 0 ? 0 : (k == 3 ? 1 : 2);
                const float* hin = (ph == 1) ? p.x : p.out;
                if (k == 11) phase_norm(hin, p.final_g, nullptr, nullptr, nullptr, p.out);
                else phase_norm(hin, p.norm_g + (l * 3 + i) * D, mod + (3 * i) * D, mod + (3 * i + 1) * D, nbuf, nullptr);
            } break;
            case 1: case 9: {
                const int f = k == 1 ? 0 : 1;
                phase_gateup(nbuf, (const bf16_t*)(p.ws + OFF_WGU + (size_t)(l * 2 + f) * SZ_WGU), act, lds);
            } break;
            case 2: case 10: case 7: {
                if (k == 7) phase_resid((const bf16_t*)(p.ws + OFF_Q), D, (const bf16_t*)(p.ws + OFF_WO + l * SZ_WO), p.out, p.out, mod + 5 * D, rep ? 0.0f : 1.0f, lds);
                else {
                    const int f = k == 2 ? 0 : 1;
                    phase_resid(act, F, (const bf16_t*)(p.ws + OFF_WD + (size_t)(l * 2 + f) * SZ_WD), (ph == 3 && !rep) ? p.x : p.out, p.out, mod + (f == 0 ? 2 : 8) * D, rep ? 0.0f : 0.5f, lds);
                }
            } break;
            case 4: phase_win(p, l, lds); break;
            case 5: phase_attn(p, l, rep, lds); break;
            case 6: phase_merge((const bf16_t*)(p.ws + OFF_ATTA), (const bf16_t*)(p.ws + OFF_OD), (const bf16_t*)(p.ws + OFF_WBA + l * SZ_WB), (const bf16_t*)(p.ws + OFF_WBB + l * SZ_WB),
                                (const bf16_t*)(p.ws + OFF_G), (bf16_t*)(p.ws + OFF_Q), (float*)(p.ws + OFF_N), lds); break;
            default: break;
            }
        }
        if (ph + 1 < pin.ph_hi) { if (ph == 0) grid.sync(); else xcd_barrier(xb); }
        if (PROBE_DUP >= 0 && rep == 0 && (ph == 0 ? PROBE_DUP == 100 : ((ph - 1) % 11 == PROBE_DUP && ph != 23))) { rep = 1; --ph; } else rep = 0;
    }
}

extern "C" void kernel_launch(void* const* d_in, const int* in_sizes, int n_in, void* d_out, int out_size, void* d_ws, size_t ws_size, hipStream_t stream) {
    if (n_in != 18 || out_size != S * D || ws_size < WS_END) { fprintf(stderr, "kernel_launch: unexpected shapes / workspace (n_in %d out %d ws %zu need %zu)\n", n_in, out_size, ws_size, (size_t)WS_END); return; }
    Params p{};
    const float** pp = (const float**)&p;
    for (int i = 0; i < 18; ++i) pp[i] = (const float*)d_in[i];
    p.out = (float*)d_out; p.ws = (unsigned char*)d_ws;
    if (hipMemsetAsync((char*)d_ws + OFF_BAR, 0, 3456 * 4, stream) != hipSuccess) { fprintf(stderr, "kernel_launch: hipMemsetAsync of the barrier words failed\n"); return; }
#if MK_MULTI
    for (int ph = 0; ph < NPH; ++ph) { p.ph_lo = ph; p.ph_hi = ph + 1; hipLaunchKernelGGL(mega, dim3(256), dim3(512), 0, stream, p); }
#else
    static int grid = 0;
    if (!grid) {
        int dev = 0, cus = 0, per_cu = 0;
        hipGetDevice(&dev); hipDeviceGetAttribute(&cus, hipDeviceAttributeMultiprocessorCount, dev);
        hipOccupancyMaxActiveBlocksPerMultiprocessor(&per_cu, (const void*)mega, 512, 0);
        if (per_cu < 1) { fprintf(stderr, "kernel_launch: occupancy query says %d blocks per CU\n", per_cu); per_cu = 1; }
        grid = cus;
    }
    p.ph_lo = 0; p.ph_hi = NPH;
    void* args[] = {&p};
    hipError_t e = hipLaunchCooperativeKernel((const void*)mega, dim3(grid), dim3(512), args, 0, stream);
    if (e != hipSuccess) fprintf(stderr, "cooperative launch failed: %s (grid %d)\n", hipGetErrorString(e), grid);
#endif
}
```
